# Optimizing an MI355X kernel written in HIP

```python
import math
import jax
import jax.numpy as jnp
from jax import lax
import numpy as np

D_MODEL = 2048
BATCH = 2
SEQ = 8192
DEPTH = 4

GRID_W = 64
CTX_LEN = 256
N_MIXERS = 2
CHUNK = 128
GM_WIDTH = 2 * D_MODEL
GM_HEADS = 16
GM_HEAD_DIM = GM_WIDTH // GM_HEADS
S5_WIDTH = D_MODEL
S5_GROUP = 16
S5_GROUPS = S5_WIDTH // S5_GROUP
S5_STATE = 64
FFN_HIDDEN = -(-8 * D_MODEL // (3 * 256)) * 256
N_GM_LAYERS = (DEPTH + 1) // 2
N_S5_LAYERS = DEPTH // 2
EPS = 1e-6

kernel_name = "hybrid_gmlp_s5_diffusion_prefix_trunk"


def rmsnorm(x, g):
    xf = x.astype(jnp.float32)
    y = xf * lax.rsqrt(jnp.mean(xf * xf, axis=-1, keepdims=True) + EPS)
    return (y * g.astype(jnp.float32)).astype(x.dtype)


def layernorm(x, g, b):
    xf = x.astype(jnp.float32)
    mu = jnp.mean(xf, axis=-1, keepdims=True)
    xc = xf - mu
    var = jnp.mean(xc * xc, axis=-1, keepdims=True)
    y = xc * lax.rsqrt(var + EPS) * g.astype(jnp.float32) + b.astype(jnp.float32)
    return y.astype(x.dtype)


def adaln(cond, w, b):
    m = jax.nn.silu(cond) @ w + b
    return jnp.split(m, 6, axis=-1)


def modulate(h, shift, scale):
    return h * (1 + scale) + shift


def sincos_2d(L):
    rows = L // GRID_W
    r, col = jnp.meshgrid(jnp.arange(rows, dtype=jnp.float32),
                          jnp.arange(GRID_W, dtype=jnp.float32), indexing='ij')
    r = r.reshape(-1)
    col = col.reshape(-1)
    q = D_MODEL // 4
    omega = 1.0 / (10000.0 ** (jnp.arange(q, dtype=jnp.float32) / q))

    def emb(p):
        ang = p[:, None] * omega[None, :]
        return jnp.concatenate([jnp.sin(ang), jnp.cos(ang)], axis=-1)

    return jnp.concatenate([emb(r), emb(col)], axis=-1)


def swiglu(h, w1, w3, w2):
    return (jax.nn.silu(h @ w1) * (h @ w3)) @ w2


def gmlp_mixer(h, w_in, ln_g, ln_b, w_s, b_s, w_out):
    bsz, L, _ = h.shape
    z = jax.nn.gelu(h @ w_in)
    u, v = jnp.split(z, 2, axis=-1)
    v = layernorm(v, ln_g, ln_b)
    n_chunks = L // CHUNK
    vc = v.reshape(bsz, n_chunks, CHUNK, GM_HEADS, GM_HEAD_DIM)
    s = jnp.einsum('hij,bcjhd->bcihd', w_s, vc) + b_s.T[None, None, :, :, None]
    return (u * s.reshape(bsz, L, GM_WIDTH)) @ w_out


def s5_discretize(a_re, a_im, log_dt, b_re, b_im):
    A = lax.complex(a_re.astype(jnp.float32), a_im.astype(jnp.float32))
    dt = jnp.exp(log_dt.astype(jnp.float32))[:, None]
    dtA = A * dt
    a_bar = jnp.exp(dtA)
    Bm = lax.complex(b_re.astype(jnp.float32), b_im.astype(jnp.float32))
    b_bar = ((a_bar - 1) / A)[..., None] * Bm
    return (dtA, a_bar, b_bar)


def _linrec_combine(e1, e2):
    a1, b1 = e1
    a2, b2 = e2
    return a1 * a2, a2 * b1 + b2


def s5_scan(u, h0, dtA, a_bar, b_bar, c_re, c_im, emit):
    bsz, L = u.shape[0], u.shape[1]
    n_chunks = L // CHUNK
    uc = jnp.moveaxis(u.reshape(bsz, n_chunks, CHUNK, S5_GROUPS, S5_GROUP), 1, 0)
    decay = jnp.exp(jnp.arange(1, CHUNK + 1, dtype=jnp.float32)[:, None, None] * dtA)
    br, bi = jnp.real(b_bar), jnp.imag(b_bar)
    cr, ci = c_re.astype(jnp.float32), c_im.astype(jnp.float32)

    def body(h, uk):
        bu = lax.complex(jnp.einsum('gpq,btgq->btgp', br, uk),
                         jnp.einsum('gpq,btgq->btgp', bi, uk))
        a = jnp.broadcast_to(a_bar, bu.shape)
        _, hs = lax.associative_scan(_linrec_combine, (a, bu), axis=1)
        hs = hs + decay * h[:, None]
        y = (jnp.einsum('gqp,btgp->btgq', cr, jnp.real(hs))
             - jnp.einsum('gqp,btgp->btgq', ci, jnp.imag(hs))) if emit else None
        return hs[:, -1], y

    h_final, ys = lax.scan(body, h0, uc)
    y = jnp.moveaxis(ys, 0, 1).reshape(bsz, L, S5_GROUPS, S5_GROUP) if emit else None
    return y, h_final


def s5_readout(y_fwd, y_bwd, u, d, w_glu, dtype):
    y = y_fwd + y_bwd + u * d.astype(jnp.float32).reshape(S5_GROUPS, S5_GROUP)
    z = jax.nn.gelu(y.reshape(y.shape[0], y.shape[1], S5_WIDTH)).astype(dtype)
    a, g = jnp.split(z @ w_glu, 2, axis=-1)
    return a * jax.nn.sigmoid(g)


def s5_mixer(hl, hc, w_in, a_re, a_im, log_dt, b_re, b_im, c_re, c_im, d, w_glu, ctx_out):
    dirs = [s5_discretize(a_re[k], a_im[k], log_dt[k], b_re[k], b_im[k]) + (c_re[k], c_im[k])
            for k in range(2)]

    def proj(h):
        return (h @ w_in).astype(jnp.float32).reshape(h.shape[0], h.shape[1], S5_GROUPS, S5_GROUP)

    uc = proj(hc)
    ul = proj(hl)
    h0 = jnp.zeros((hc.shape[0], S5_GROUPS, S5_STATE), jnp.complex64)
    y_cf, h_cf = s5_scan(uc, h0, *dirs[0], ctx_out)
    y_cb, h_cb = s5_scan(uc[:, ::-1], h0, *dirs[1], ctx_out)
    y_lf, _ = s5_scan(ul, h_cf, *dirs[0], True)
    y_lb, _ = s5_scan(ul[:, ::-1], h_cb, *dirs[1], True)
    out_l = s5_readout(y_lf, y_lb[:, ::-1], ul, d, w_glu, hl.dtype)
    out_c = s5_readout(y_cf, y_cb[:, ::-1], uc, d, w_glu, hc.dtype) if ctx_out else None
    return out_l, out_c


def setup_inputs(seed: int = 0) -> dict:
    key = jax.random.key(seed)
    ks = jax.random.split(key, 32)
    f32 = jnp.float32
    D, F, EA, EB = D_MODEL, FFN_HIDDEN, GM_WIDTH, S5_WIDTH
    G, P, Q = S5_GROUPS, S5_STATE, S5_GROUP
    nrm = lambda k, shape, s: jax.random.normal(k, shape, f32) * s
    a_im = jnp.broadcast_to(math.pi * jnp.arange(P, dtype=f32), (N_S5_LAYERS, 2, G, P))
    return {
        "x": nrm(ks[0], (BATCH, SEQ, D), 1.0),
        "c": nrm(ks[1], (BATCH, D), 1.0),
        "ctx": nrm(ks[2], (BATCH, CTX_LEN, D), 1.0),
        "c_ctx": nrm(ks[3], (D,), 1.0),
        "ada_w": nrm(ks[4], (DEPTH, D, 6 * D), 0.5 * D ** -0.5),
        "ada_b": nrm(ks[5], (DEPTH, 6 * D), 0.01),
        "norm1_g": 1.0 + nrm(ks[6], (DEPTH, D), 0.02),
        "norm2_g": 1.0 + nrm(ks[7], (DEPTH, D), 0.02),
        "ffn_w1": nrm(ks[8], (DEPTH, D, F), D ** -0.5),
        "ffn_w3": nrm(ks[9], (DEPTH, D, F), D ** -0.5),
        "ffn_w2": nrm(ks[10], (DEPTH, F, D), F ** -0.5),
        "gm_w_in": nrm(ks[11], (N_GM_LAYERS, D, 2 * EA), D ** -0.5),
        "gm_ln_g": 1.0 + nrm(ks[12], (N_GM_LAYERS, EA), 0.02),
        "gm_ln_b": nrm(ks[13], (N_GM_LAYERS, EA), 0.02),
        "gm_w_s": nrm(ks[14], (N_GM_LAYERS, GM_HEADS, CHUNK, CHUNK), CHUNK ** -0.5),
        "gm_b_s": 1.0 + nrm(ks[15], (N_GM_LAYERS, GM_HEADS, CHUNK), 0.1),
        "gm_w_out": nrm(ks[16], (N_GM_LAYERS, EA, D), EA ** -0.5),
        "s5_w_in": nrm(ks[17], (N_S5_LAYERS, D, EB), D ** -0.5),
        "s5_a_re": -0.5 * jnp.exp(nrm(ks[18], (N_S5_LAYERS, 2, G, P), 0.05)),
        "s5_a_im": a_im,
        "s5_log_dt": jax.random.uniform(ks[19], (N_S5_LAYERS, 2, G), f32,
                                        math.log(1e-3), math.log(1e-1)),
        "s5_b_re": nrm(ks[20], (N_S5_LAYERS, 2, G, P, Q), (2 * Q) ** -0.5),
        "s5_b_im": nrm(ks[21], (N_S5_LAYERS, 2, G, P, Q), (2 * Q) ** -0.5),
        "s5_c_re": nrm(ks[22], (N_S5_LAYERS, 2, G, Q, P), P ** -0.5),
        "s5_c_im": nrm(ks[23], (N_S5_LAYERS, 2, G, Q, P), P ** -0.5),
        "s5_d": nrm(ks[24], (N_S5_LAYERS, EB), 1.0),
        "s5_w_glu": nrm(ks[25], (N_S5_LAYERS, EB, 2 * D), EB ** -0.5),
        "final_g": 1.0 + nrm(ks[26], (D,), 0.02),
    }


def reference(x, c, ctx, c_ctx, ada_w, ada_b, norm1_g, norm2_g, ffn_w1, ffn_w3, ffn_w2,
              gm_w_in, gm_ln_g, gm_ln_b, gm_w_s, gm_b_s, gm_w_out,
              s5_w_in, s5_a_re, s5_a_im, s5_log_dt, s5_b_re, s5_b_im, s5_c_re, s5_c_im, s5_d, s5_w_glu,
              final_g):
    L = x.shape[1]
    h = x + sincos_2d(L).astype(x.dtype)[None]
    hc = ctx
    s5_layers = [i for i in range(DEPTH) if i % N_MIXERS == 1]
    last_s5 = s5_layers[-1] if s5_layers else -1
    cond_l = c[:, None, :]
    cond_c = c_ctx[None, None, :]
    for i in range(DEPTH):
        ctx_read = i <= last_s5
        ctx_carry = i < last_s5
        j = i // N_MIXERS
        sh1, sc1, g1, sh2, sc2, g2 = adaln(cond_l, ada_w[i], ada_b[i])
        hin = modulate(rmsnorm(h, norm1_g[i]), sh1, sc1)
        if ctx_read:
            csh1, csc1, cg1, csh2, csc2, cg2 = adaln(cond_c, ada_w[i], ada_b[i])
            cin = modulate(rmsnorm(hc, norm1_g[i]), csh1, csc1)
        if i % N_MIXERS == 0:
            gm = (gm_w_in[j], gm_ln_g[j], gm_ln_b[j], gm_w_s[j], gm_b_s[j], gm_w_out[j])
            h = h + g1 * gmlp_mixer(hin, *gm)
            if ctx_carry:
                hc = hc + cg1 * gmlp_mixer(cin, *gm)
        else:
            out_l, out_c = s5_mixer(hin, cin, s5_w_in[j], s5_a_re[j], s5_a_im[j], s5_log_dt[j],
                                    s5_b_re[j], s5_b_im[j], s5_c_re[j], s5_c_im[j], s5_d[j],
                                    s5_w_glu[j], ctx_carry)
            h = h + g1 * out_l
            if ctx_carry:
                hc = hc + cg1 * out_c
        h = h + g2 * swiglu(modulate(rmsnorm(h, norm2_g[i]), sh2, sc2), ffn_w1[i], ffn_w3[i], ffn_w2[i])
        if ctx_carry:
            hc = hc + cg2 * swiglu(modulate(rmsnorm(hc, norm2_g[i]), csh2, csc2),
                                   ffn_w1[i], ffn_w3[i], ffn_w2[i])
    return rmsnorm(h, final_g)
```

```cpp
#include <hip/hip_runtime.h>
#include <cstdio>
#include <cstdint>
namespace pg8 {
#define PG8_LAS __attribute__((address_space(3)))
typedef unsigned short bf16_t;
typedef short bf16x8 __attribute__((ext_vector_type(8)));
typedef float f32x4 __attribute__((ext_vector_type(4)));
typedef unsigned u32x4 __attribute__((ext_vector_type(4)));
constexpr int BM = 256, BK = 64, HALF = 128, HTB = HALF * BK * 2  , STAGE_BYTES = 8 * HTB, NXCD = 8, WGM = 8;

__host__ __device__ __forceinline__ int lds_byte(int r, int c) { const int st = (r >> 4) * 2 + (c >> 5), rr = r & 15, cc = c & 31, ob = rr * 64 + cc * 2; return st * 1024 + (ob ^ (((ob >> 9) & 1) << 5)); }
__host__ __device__ __forceinline__ void stage_rc(int b, int& R, int& C) { const int st = b / 1024, sb = b % 1024, swz = sb ^ (((sb >> 9) & 1) << 5); R = (st >> 1) * 16 + swz / 64; C = (st & 1) * 32 + (swz % 64) / 2; }
__host__ __device__ __forceinline__ int perm32(int rho) { const int n = rho >> 4, i = rho & 15; return 8 * (i >> 2) + 4 * n + (i & 3); }

struct Unit { int pm, pn; };
struct Gemm { const bf16_t* A; const bf16_t* Bt; int M, N, K; };

struct StaticOrder {
    int nM, nN, nwg, G, c;
    __host__ __device__ void init(int M, int N, int G_, int c_) { nM = M / BM; nN = N / BM; nwg = nM * nN; G = G_; c = c_; }
    __host__ __device__ bool next(int i, Unit& u) const {
        const long L = (long)i * G + c; if (L >= nwg) return false;
        int wgid = (int)L; { const int q = nwg / NXCD, r = nwg % NXCD, xcd = wgid % NXCD, off = wgid / NXCD; wgid = (xcd < r ? xcd * (q + 1) : r * (q + 1) + (xcd - r) * q) + off; }
        const int nig = WGM * nN, gid = wgid / nig, fm = gid * WGM, gsz = (nM - fm) < WGM ? (nM - fm) : WGM;
        u.pm = fm + ((wgid % nig) % gsz); u.pn = (wgid % nig) / gsz; return true;
    }
    __device__ __forceinline__ void a_ready(const Unit&) const {}
    __device__ __forceinline__ void done(const Unit&) const {}
};

__device__ __forceinline__ unsigned cvt_pk_bf16(float lo, float hi) { unsigned r; asm volatile("v_cvt_pk_bf16_f32 %0, %1, %2" : "=v"(r) : "v"(lo), "v"(hi)); return r; }
typedef float f32x2 __attribute__((ext_vector_type(2)));
__device__ __forceinline__ f32x2 gelu_pk(f32x2 v) {
    const f32x2 av = __builtin_elementwise_abs(v), d = av * 0.2316418882f + 1.0f;
    f32x2 t; t.x = __builtin_amdgcn_rcpf(d.x); t.y = __builtin_amdgcn_rcpf(d.y);
    f32x2 q = t * 0.5307027145f + (-0.7265760135f); q = q * t + 0.7107068705f; q = q * t + (-0.142248368f); q = q * t + 0.127414796f; q = q * t;
    const f32x2 s = (v * v) * (-0.72134752044f);
    f32x2 e; e.x = __builtin_amdgcn_exp2f(s.x); e.y = __builtin_amdgcn_exp2f(s.y);
    const f32x2 m = v * (q * e), r = v - m;
    f32x2 o; o.x = v.x < 0.f ? m.x : r.x; o.y = v.y < 0.f ? m.y : r.y; return o;
}


__device__ __forceinline__ float sigmoid_f(float x) { return __builtin_amdgcn_rcpf(1.0f + __builtin_amdgcn_exp2f(-1.44269504f * x)); }
__device__ __forceinline__ float silu_f(float x) { return x * sigmoid_f(x); }
__device__ __forceinline__ float gelu_tanh_f(float x) { const float u = x * (1.0f + 0.044715f * x * x); return x * __builtin_amdgcn_rcpf(1.0f + __builtin_amdgcn_exp2f(-2.30220820f * u)); }
__device__ __forceinline__ int row_set(int pm) { return pm < 32 ? 0 : (pm < 64 ? 1 : 2); }

struct EpiPlainBf16 {
    static constexpr bool PERM = true, AFTER_DRAIN = false;
    bf16_t* O; int ldc;
    __device__ __forceinline__ void operator()(const f32x4 (&acc)[2][2][4][2], const Unit& u, int wr, int wc, int fr, int fq) const {
        const int row0 = u.pm * BM + wr * 64 + fr, col0 = u.pn * BM + wc * 32 + 8 * fq;
#pragma unroll
        for (int ai = 0; ai < 2; ++ai)
#pragma unroll
            for (int m = 0; m < 4; ++m) { bf16_t* rowp = O + (size_t)(row0 + ai * HALF + m * 16) * ldc + col0;
#pragma unroll
                for (int bj = 0; bj < 2; ++bj) { const f32x4 v0 = acc[ai][bj][m][0], v1 = acc[ai][bj][m][1];
                    u32x4 w; w.x = cvt_pk_bf16(v0[0], v0[1]); w.y = cvt_pk_bf16(v0[2], v0[3]); w.z = cvt_pk_bf16(v1[0], v1[1]); w.w = cvt_pk_bf16(v1[2], v1[3]);
                    *(u32x4*)(rowp + bj * HALF) = w; } }
    }
};
struct EpiG1 {
    static constexpr bool PERM = true, AFTER_DRAIN = false;
    bf16_t* U; bf16_t* V; float* vstat;
    __device__ __forceinline__ void operator()(const f32x4 (&acc)[2][2][4][2], const Unit& u, int wr, int wc, int fr, int fq) const {
        const bool isv = u.pn >= 16;
        const int row0 = u.pm * BM + wr * 64 + fr, col0 = (u.pn & 15) * BM + wc * 32 + 8 * fq;
        bf16_t* base = isv ? V : U;
#pragma unroll
        for (int ai = 0; ai < 2; ++ai)
#pragma unroll
            for (int m = 0; m < 4; ++m) { const int row = row0 + ai * HALF + m * 16; bf16_t* rowp = base + (size_t)row * 4096 + col0; float s = 0.f, ss = 0.f;
#pragma unroll
                for (int bj = 0; bj < 2; ++bj) { f32x4 v0 = acc[ai][bj][m][0], v1 = acc[ai][bj][m][1];
#pragma unroll
                    for (int e = 0; e < 4; ++e) { v0[e] = gelu_tanh_f(v0[e]); v1[e] = gelu_tanh_f(v1[e]); s += v0[e] + v1[e]; ss += v0[e] * v0[e] + v1[e] * v1[e]; }
                    u32x4 w; w.x = cvt_pk_bf16(v0[0], v0[1]); w.y = cvt_pk_bf16(v0[2], v0[3]); w.z = cvt_pk_bf16(v1[0], v1[1]); w.w = cvt_pk_bf16(v1[2], v1[3]);
                    *(u32x4*)(rowp + bj * HALF) = w; }
                if (isv) { s += __shfl_xor(s, 16); s += __shfl_xor(s, 32); ss += __shfl_xor(ss, 16); ss += __shfl_xor(ss, 32);
                    if (fq == 0) { f32x2 o; o.x = s; o.y = ss; *(f32x2*)(vstat + ((size_t)row * 64 + (u.pn - 16) * 4 + wc) * 2) = o; } } }
    }
};
struct EpiResid {
    static constexpr bool PERM = false, AFTER_DRAIN = false;
    float* H; const float* gate;
    __device__ __forceinline__ void operator()(const f32x4 (&acc)[2][2][4][2], const Unit& u, int wr, int wc, int fr, int fq) const {
        const int row0 = u.pm * BM + wr * 64 + fr, col0 = u.pn * BM + wc * 32 + 4 * fq;
        const float* g = gate + row_set(u.pm) * (6 * 2048) + col0;
        f32x4 gv[2][2];
#pragma unroll
        for (int bj = 0; bj < 2; ++bj)
#pragma unroll
            for (int n = 0; n < 2; ++n) gv[bj][n] = *(const f32x4*)(g + bj * HALF + n * 16);
#pragma unroll
        for (int ai = 0; ai < 2; ++ai)
#pragma unroll
            for (int m = 0; m < 4; ++m) { float* rowp = H + (size_t)(row0 + ai * HALF + m * 16) * 2048 + col0;
#pragma unroll
                for (int bj = 0; bj < 2; ++bj)
#pragma unroll
                    for (int n = 0; n < 2; ++n) { f32x4* p = (f32x4*)(rowp + bj * HALF + n * 16); *p = *p + gv[bj][n] * acc[ai][bj][m][n]; } }
    }
};
struct EpiSwiGLU {
    static constexpr bool PERM = true, AFTER_DRAIN = false;
    bf16_t* O;
    __device__ __forceinline__ void operator()(const f32x4 (&acc)[2][2][4][2], const Unit& u, int wr, int wc, int fr, int fq) const {
        const int row0 = u.pm * BM + wr * 64 + fr, col0 = u.pn * HALF + wc * 32 + 8 * fq;
#pragma unroll
        for (int ai = 0; ai < 2; ++ai)
#pragma unroll
            for (int m = 0; m < 4; ++m) { bf16_t* rowp = O + (size_t)(row0 + ai * HALF + m * 16) * 5632 + col0;
                f32x4 a0 = acc[ai][0][m][0], a1 = acc[ai][0][m][1]; const f32x4 b0 = acc[ai][1][m][0], b1 = acc[ai][1][m][1];
#pragma unroll
                for (int e = 0; e < 4; ++e) { a0[e] = silu_f(a0[e]) * b0[e]; a1[e] = silu_f(a1[e]) * b1[e]; }
                u32x4 w; w.x = cvt_pk_bf16(a0[0], a0[1]); w.y = cvt_pk_bf16(a0[2], a0[3]); w.z = cvt_pk_bf16(a1[0], a1[1]); w.w = cvt_pk_bf16(a1[2], a1[3]);
                *(u32x4*)rowp = w; }
    }
};
struct EpiGluResid {
    static constexpr bool PERM = false, AFTER_DRAIN = false;
    float* H; const float* gate;
    __device__ __forceinline__ void operator()(const f32x4 (&acc)[2][2][4][2], const Unit& u, int wr, int wc, int fr, int fq) const {
        const int row0 = u.pm * BM + wr * 64 + fr, col0 = u.pn * HALF + wc * 32 + 4 * fq;
        const float* g = gate + row_set(u.pm) * (6 * 2048) + col0;
        f32x4 gv[2];
#pragma unroll
        for (int n = 0; n < 2; ++n) gv[n] = *(const f32x4*)(g + n * 16);
#pragma unroll
        for (int ai = 0; ai < 2; ++ai)
#pragma unroll
            for (int m = 0; m < 4; ++m) { float* rowp = H + (size_t)(row0 + ai * HALF + m * 16) * 2048 + col0;
#pragma unroll
                for (int n = 0; n < 2; ++n) { const f32x4 a = acc[ai][0][m][n], gg = acc[ai][1][m][n]; f32x4 o;
#pragma unroll
                    for (int e = 0; e < 4; ++e) o[e] = a[e] * sigmoid_f(gg[e]);
                    f32x4* p = (f32x4*)(rowp + n * 16); *p = *p + gv[n] * o; } }
    }
};

template <class Epi, class Sched, bool ALIGN_EPI = false, bool SP2 = false>
__device__ __forceinline__ void gemm_phase(PG8_LAS unsigned char* lds, const Gemm g, const Sched& S, const Epi& E) {
    int tid_ = threadIdx.x; asm volatile("" : "+v"(tid_));
    const int tid = tid_, wid = __builtin_amdgcn_readfirstlane(tid >> 6), lane = tid & 63, wr = wid >> 2, wc = wid & 3, fr = lane & 15, fq = lane >> 4;
    const int K = g.K, nt = K / BK;
    unsigned voffA[2], voffB[2];
#pragma unroll
    for (int i = 0; i < 2; ++i) { int R, C; stage_rc(tid * 16 + i * 8192, R, C); const int Rb = Epi::PERM ? ((R & ~31) + perm32(R & 31)) : R;
        voffA[i] = (unsigned)(R * K + C) * 2u; voffB[i] = (unsigned)(Rb * K + C) * 2u; }
    const size_t kstep = (size_t)(BK * 2);
    const size_t hstep = (size_t)HALF * K * 2;
    const size_t tstep = 2 * hstep;
    const unsigned ldsw = (unsigned)wid * 1024u;
    const int aoff = lds_byte(wr * 64 + fr, fq * 8), boff = lds_byte(wc * 32 + fr, fq * 8);
#define PG8_SA(b, h) (((b) * 2 + (h)) * HTB)
#define PG8_SB(b, h) ((4 + (b) * 2 + (h)) * HTB)
#define PG8_STAGE(bufoff, gbase, voff) do { _Pragma("unroll") for (int _i = 0; _i < 2; ++_i) \
        __builtin_amdgcn_global_load_lds((const unsigned*)((const char*)(gbase) + (voff)[_i]), (PG8_LAS unsigned*)(lds + (bufoff) + ldsw + _i * 8192), 16, 0, 0); } while (0)
#define PG8_LDA(dst, b, h) do { _Pragma("unroll") for (int m = 0; m < 4; ++m) _Pragma("unroll") for (int k = 0; k < 2; ++k) dst[m][k] = *(const PG8_LAS bf16x8*)(lds + PG8_SA(b, h) + aoff + m * 2048 + k * 1024); } while (0)
#define PG8_LDB(dst, b, h) do { _Pragma("unroll") for (int n = 0; n < 2; ++n) _Pragma("unroll") for (int k = 0; k < 2; ++k) dst[n][k] = *(const PG8_LAS bf16x8*)(lds + PG8_SB(b, h) + boff + n * 2048 + k * 1024); } while (0)
#define PG8_MMA(ai, bj, At, Bt) do { __builtin_amdgcn_s_setprio(1); _Pragma("unroll") for (int m = 0; m < 4; ++m) _Pragma("unroll") for (int n = 0; n < 2; ++n) _Pragma("unroll") for (int k = 0; k < 2; ++k) \
        acc[ai][bj][m][n] = __builtin_amdgcn_mfma_f32_16x16x32_bf16(Bt[n][k], At[m][k], acc[ai][bj][m][n], 0, 0, 0); __builtin_amdgcn_s_setprio(0); } while (0)
#define PG8_WAIT_V(n) asm volatile("s_waitcnt vmcnt(" #n ")" ::: "memory")
#define PG8_WAIT_L(n) asm volatile("s_waitcnt lgkmcnt(" #n ")" ::: "memory")
#define PG8_BAR __builtin_amdgcn_s_barrier()
#define PG8_SCHED __builtin_amdgcn_sched_barrier(0)
    Unit cur, nxt; int ui = 0;
    if (!S.next(0, cur)) return;
    f32x4 acc[2][2][4][2];
#pragma unroll
    for (int a = 0; a < 2; ++a)
#pragma unroll
        for (int b = 0; b < 2; ++b)
#pragma unroll
            for (int m = 0; m < 4; ++m)
#pragma unroll
                for (int n = 0; n < 2; ++n) acc[a][b][m][n] = (f32x4){0.f, 0.f, 0.f, 0.f};
    bf16x8 At[4][2], B0[2][2], B1[2][2];
    const char* cA = (const char*)g.A + (size_t)cur.pm * tstep; const char* cB = (const char*)g.Bt + (size_t)cur.pn * tstep;
    S.a_ready(cur);
    if constexpr (SP2) {
        PG8_STAGE(PG8_SB(0, 0), cB, voffB); PG8_STAGE(PG8_SB(0, 1), cB + hstep, voffB); PG8_STAGE(PG8_SA(0, 0), cA, voffA); PG8_STAGE(PG8_SA(0, 1), cA + hstep, voffA);
        if (wr == 1) PG8_BAR;
        PG8_WAIT_V(2); PG8_BAR;
        PG8_STAGE(PG8_SB(1, 0), cB + kstep, voffB); PG8_STAGE(PG8_SA(1, 0), cA + kstep, voffA); PG8_STAGE(PG8_SB(1, 1), cB + hstep + kstep, voffB);
        PG8_WAIT_V(6); PG8_BAR;
    } else {
        PG8_STAGE(PG8_SB(0, 0), cB, voffB); PG8_STAGE(PG8_SA(0, 0), cA, voffA); PG8_STAGE(PG8_SB(0, 1), cB + hstep, voffB); PG8_STAGE(PG8_SA(0, 1), cA + hstep, voffA);
        if (wr == 1) PG8_BAR;
        PG8_WAIT_V(4); PG8_BAR;
        PG8_STAGE(PG8_SB(1, 0), cB + kstep, voffB); PG8_STAGE(PG8_SA(1, 0), cA + kstep, voffA); PG8_STAGE(PG8_SB(1, 1), cB + hstep + kstep, voffB);
        PG8_WAIT_V(6); PG8_BAR;
    }
    for (;;) {
        const bool has_next = S.next(ui + 1, nxt);
        const char* nA = has_next ? (const char*)g.A + (size_t)nxt.pm * tstep : cA; const char* nB = has_next ? (const char*)g.Bt + (size_t)nxt.pn * tstep : cB;
        for (int t = 0; t < nt; t += 2) {
            const bool last = (t == nt - 2);
            const char* a1 = cA + (size_t)(t + 1) * kstep;
            const char* a2 = last ? nA : cA + (size_t)(t + 2) * kstep; const char* b2 = last ? nB : cB + (size_t)(t + 2) * kstep;
            const char* a3 = a2 + kstep; const char* b3 = b2 + kstep;
            if (last && has_next) S.a_ready(nxt);
            if constexpr (SP2) {
            PG8_LDB(B0, 0, 0); PG8_LDB(B1, 0, 1); PG8_SCHED; PG8_LDA(At, 0, 0); PG8_STAGE(PG8_SA(1, 1), a1 + hstep, voffA);
            PG8_WAIT_V(8); PG8_WAIT_L(0); PG8_BAR; PG8_MMA(0, 0, At, B0); PG8_MMA(0, 1, At, B1); PG8_BAR; PG8_SCHED;
            PG8_LDA(At, 0, 1); PG8_STAGE(PG8_SB(0, 0), b2, voffB); PG8_STAGE(PG8_SB(0, 1), b2 + hstep, voffB); PG8_STAGE(PG8_SA(0, 0), a2, voffA);
            PG8_WAIT_V(8); PG8_WAIT_L(0); PG8_BAR; PG8_MMA(1, 0, At, B0); PG8_MMA(1, 1, At, B1); PG8_BAR; PG8_SCHED;
            PG8_LDB(B0, 1, 0); PG8_LDB(B1, 1, 1); PG8_SCHED; PG8_LDA(At, 1, 0); PG8_STAGE(PG8_SA(0, 1), a2 + hstep, voffA);
            PG8_WAIT_V(8); PG8_WAIT_L(0); PG8_BAR; PG8_MMA(0, 0, At, B0); PG8_MMA(0, 1, At, B1); PG8_BAR; PG8_SCHED;
            PG8_LDA(At, 1, 1); PG8_STAGE(PG8_SB(1, 0), b3, voffB); PG8_STAGE(PG8_SB(1, 1), b3 + hstep, voffB); PG8_STAGE(PG8_SA(1, 0), a3, voffA);
            PG8_WAIT_V(8); PG8_WAIT_L(0); PG8_BAR; PG8_MMA(1, 0, At, B0); PG8_MMA(1, 1, At, B1); PG8_BAR; PG8_SCHED;
            } else {
            PG8_LDB(B0, 0, 0); PG8_SCHED; PG8_LDA(At, 0, 0); PG8_STAGE(PG8_SA(1, 1), a1 + hstep, voffA);
            PG8_WAIT_L(8); PG8_BAR; PG8_WAIT_L(0); PG8_MMA(0, 0, At, B0); PG8_BAR; PG8_SCHED;
            PG8_LDB(B1, 0, 1); PG8_STAGE(PG8_SB(0, 0), b2, voffB);
            PG8_BAR; PG8_WAIT_L(0); PG8_MMA(0, 1, At, B1); PG8_BAR;
            PG8_LDA(At, 0, 1); PG8_STAGE(PG8_SA(0, 0), a2, voffA);
            PG8_BAR; PG8_WAIT_L(0); PG8_MMA(1, 0, At, B0); PG8_BAR; PG8_SCHED;
            PG8_STAGE(PG8_SB(0, 1), b2 + hstep, voffB);
            PG8_WAIT_V(6); PG8_BAR; PG8_MMA(1, 1, At, B1); PG8_BAR;
            PG8_LDB(B0, 1, 0); PG8_SCHED; PG8_LDA(At, 1, 0); PG8_STAGE(PG8_SA(0, 1), a2 + hstep, voffA);
            PG8_WAIT_L(8); PG8_BAR; PG8_WAIT_L(0); PG8_MMA(0, 0, At, B0); PG8_BAR; PG8_SCHED;
            PG8_LDB(B1, 1, 1); PG8_STAGE(PG8_SB(1, 0), b3, voffB);
            PG8_BAR; PG8_WAIT_L(0); PG8_MMA(0, 1, At, B1); PG8_BAR;
            PG8_LDA(At, 1, 1); PG8_STAGE(PG8_SA(1, 0), a3, voffA);
            PG8_BAR; PG8_WAIT_L(0); PG8_MMA(1, 0, At, B0); PG8_BAR; PG8_SCHED;
            PG8_STAGE(PG8_SB(1, 1), b3 + hstep, voffB);
            PG8_WAIT_V(6); PG8_BAR; PG8_MMA(1, 1, At, B1); PG8_BAR;
            }
        }
        if constexpr (ALIGN_EPI) { if (wr == 0) PG8_BAR; }
        if constexpr (!Epi::AFTER_DRAIN) { E(acc, cur, wr, wc, fr, fq); S.done(cur); }
        if (!has_next) break;
#pragma unroll
        for (int a = 0; a < 2; ++a)
#pragma unroll
            for (int b = 0; b < 2; ++b)
#pragma unroll
                for (int m = 0; m < 4; ++m)
#pragma unroll
                    for (int n = 0; n < 2; ++n) acc[a][b][m][n] = (f32x4){0.f, 0.f, 0.f, 0.f};
        cur = nxt; cA = nA; cB = nB; ++ui;
        if constexpr (ALIGN_EPI) { if (wr == 1) PG8_BAR; }
    }
    PG8_WAIT_V(0);
    if constexpr (!ALIGN_EPI) { if (wr == 0) PG8_BAR; }
    PG8_BAR;
    if constexpr (Epi::AFTER_DRAIN) { E.fused(acc, cur, wr, wc, fr, fq, lds, wid, lane); S.done(cur); }
#undef PG8_SA
#undef PG8_SB
#undef PG8_STAGE
#undef PG8_LDA
#undef PG8_LDB
#undef PG8_MMA
#undef PG8_WAIT_V
#undef PG8_WAIT_L
#undef PG8_BAR
#undef PG8_SCHED
}
}

constexpr int NWAVES = 8, NTHR = NWAVES * 64;
constexpr int D = 2048, BATCH = 2, SEQ = 8192, ML = BATCH * SEQ, CTXL = 256, MC = BATCH * CTXL, M = ML + MC;
constexpr int FF = 5632, EA = 4096, NH = 16, HDIM = 256, CHUNK = 128, NCHUNK = M / CHUNK;
constexpr int SG = 128, SP = 64, SQ = 16;
constexpr int DEPTH = 4;
constexpr float EPS = 1e-6f;
static_assert(M % 256 == 0 && NCHUNK == 132, "row tiling");

constexpr size_t MiB = 1u << 20;
constexpr size_t WS_CTL = 0, CTL_ZERO_BYTES = 1 * MiB;
constexpr size_t WS_MOD = 1 * MiB;
constexpr size_t WS_S5A = 2 * MiB;
constexpr size_t WS_S5B = 3 * MiB;
constexpr size_t WS_WSB = 11 * MiB;
constexpr size_t WS_VSTAT = 12 * MiB;
constexpr size_t WS_WGIN = 32 * MiB;
constexpr size_t WS_WGOUT = 96 * MiB;
constexpr size_t WS_WF13 = 128 * MiB;
constexpr size_t WS_WF2 = 304 * MiB;
constexpr size_t WS_WSIN = 392 * MiB;
constexpr size_t WS_WGLU = 408 * MiB;
constexpr size_t WS_H = 440 * MiB;
constexpr size_t WS_XN = 572 * MiB;
constexpr size_t WS_BIG = 640 * MiB;
constexpr size_t WS_ZU = WS_BIG, WS_ZV = WS_BIG + 132 * MiB;
constexpr size_t WS_HID = WS_BIG;
constexpr size_t WS_SU = WS_BIG, WS_SZ = WS_BIG + 66 * MiB;
constexpr size_t WS_YF = WS_BIG + 132 * MiB, WS_YB = WS_BIG + 264 * MiB;
constexpr size_t WS_END = WS_BIG + 396 * MiB;
constexpr int CW_BAR = 4096;

constexpr int RING_OFF = 0, RING_BYTES = 131072;
constexpr int LDSCTL_OFF = RING_BYTES, MISC_OFF = LDSCTL_OFF + 320;
constexpr int LDS_BYTES = 147456;
static_assert(MISC_OFF + 128 <= LDS_BYTES, "LDS map");

#define GAS __attribute__((address_space(1)))
#define LAS __attribute__((address_space(3)))
typedef unsigned short bf16;
typedef unsigned v4u __attribute__((ext_vector_type(4)));
typedef unsigned v2u __attribute__((ext_vector_type(2)));
typedef float f32x4 __attribute__((ext_vector_type(4)));
typedef float f32x2 __attribute__((ext_vector_type(2)));
typedef float f32x16 __attribute__((ext_vector_type(16)));
typedef short bf16x8 __attribute__((ext_vector_type(8)));
typedef GAS unsigned gu32;
#define RLX_AGENT __ATOMIC_RELAXED, __HIP_MEMORY_SCOPE_AGENT
#define LDS_WAIT() asm volatile("s_waitcnt lgkmcnt(0)" ::: "memory")
__device__ __forceinline__ unsigned f2bf(float f) { unsigned u = __builtin_bit_cast(unsigned, f); return (u + 0x7fffu + ((u >> 16) & 1u)) >> 16; }
__device__ __forceinline__ unsigned pk2(float lo, float hi) { return f2bf(lo) | (f2bf(hi) << 16); }
__device__ __forceinline__ float bf2f(unsigned short b) { return __builtin_bit_cast(float, (unsigned)b << 16); }
__device__ __forceinline__ float wave_sum(float v) {
#pragma unroll
    for (int o = 1; o < 64; o <<= 1) v += __shfl_xor(v, o);
    return v;
}

#define XB_TMO      128
#define XB_XCNT(j)  (256  + 64 * (j))
#define XB_XSUB(j)  (1280 + 64 * (j))
#define XB_XGEN(j)  (2304 + 64 * (j))
#define XB_TOP      3328
#define XB_TOPGEN   3392
#define XCD_BAR_WORDS 3456
#define XB_SPIN_CAP (1u << 18)

__device__ __forceinline__ unsigned xb_ld(unsigned* p)              { return __hip_atomic_load(p, __ATOMIC_RELAXED, __HIP_MEMORY_SCOPE_AGENT); }
__device__ __forceinline__ unsigned xb_add(unsigned* p, unsigned v) { return __hip_atomic_fetch_add(p, v, __ATOMIC_RELAXED, __HIP_MEMORY_SCOPE_AGENT); }
__device__ __forceinline__ unsigned xb_xcc_id() { return (unsigned)__builtin_amdgcn_s_getreg((3 << 11) | 20) & 0xFu; }
#define XB_SPIN(cond, bar) do { unsigned _sp = 0; while (cond) { __builtin_amdgcn_s_sleep(1); \
    if ((++_sp & 255u) == 0u) { if (xb_ld(&(bar)[XB_TMO])) break; if (_sp > XB_SPIN_CAP) { atomicAdd(&(bar)[XB_TMO], 1u); break; } } } } while (0)

struct XcdBarrier {
    unsigned* bar; unsigned x;
    volatile LAS unsigned* st;
};

__device__ __forceinline__ XcdBarrier xcd_barrier_post(unsigned* bar, volatile LAS unsigned* st) {
    XcdBarrier b; b.bar = bar; b.x = xb_xcc_id(); b.st = st;
    if (threadIdx.x == 0) (void)xb_add(&bar[XB_XCNT(b.x)], 1u);
    return b;
}
__device__ __forceinline__ void xcd_barrier_complete(unsigned* bar, unsigned x, unsigned& nloc, unsigned& nx) {
    const unsigned G = gridDim.x * gridDim.y * gridDim.z;
    unsigned sum, cnt, mine, sp = 0u;
    for (;;) {
        sum = 0u; cnt = 0u; mine = 0u;
#pragma unroll
        for (unsigned j = 0; j < 16; ++j) { const unsigned c = xb_ld(&bar[XB_XCNT(j)]); sum += c; cnt += (c > 0u) ? 1u : 0u; mine = (j == x) ? c : mine; }
        if (sum == G) break;
        __builtin_amdgcn_s_sleep(1);
        if ((++sp & 255u) == 0u) { if (xb_ld(&bar[XB_TMO])) break; if (sp > XB_SPIN_CAP) { atomicAdd(&bar[XB_TMO], 1u); break; } }
    }
    nloc = mine > 0u ? mine : 1u; nx = cnt > 0u ? cnt : 1u;
}

__device__ __forceinline__ void xcd_barrier(const XcdBarrier& b) {
    asm volatile("s_waitcnt vmcnt(0)" ::: "memory");
    __syncthreads();
    if (threadIdx.x == 0) {
        unsigned* bar = b.bar;
        __builtin_amdgcn_s_waitcnt(0);
        unsigned nloc = b.st[0], nx = b.st[1];
        if (nloc == 0u) { xcd_barrier_complete(bar, b.x, nloc, nx); b.st[0] = nloc; b.st[1] = nx; }
        const unsigned old = xb_add(&bar[XB_XSUB(b.x)], 1u);
        const unsigned gen = old / nloc;
        if (old + 1u == (gen + 1u) * nloc) {
            __builtin_amdgcn_fence(__ATOMIC_RELEASE, "agent");
            asm volatile("s_waitcnt vmcnt(0)" ::: "memory");
            const unsigned og = xb_add(&bar[XB_TOP], 1u);
            const unsigned tg = og / nx;
            if (og + 1u == (tg + 1u) * nx) xb_add(&bar[XB_TOPGEN], 1u);
            else XB_SPIN(xb_ld(&bar[XB_TOPGEN]) == tg, bar);
            __builtin_amdgcn_fence(__ATOMIC_ACQUIRE, "agent");
            xb_add(&bar[XB_XGEN(b.x)], 1u);
            asm volatile("s_waitcnt vmcnt(0)" ::: "memory");
        } else {
            XB_SPIN(xb_ld(&bar[XB_XGEN(b.x)]) == gen, bar);
            __builtin_amdgcn_fence(__ATOMIC_ACQUIRE, "agent");
            asm volatile("s_waitcnt vmcnt(0)" ::: "memory");
        }
    }
    __syncthreads();
}

struct Args { const float* in[28]; float* out; unsigned char* ws; int ph_lo, ph_hi; };
enum InIdx { I_X = 0, I_C, I_CTX, I_CCTX, I_ADAW, I_ADAB, I_N1G, I_N2G, I_W1, I_W3, I_W2, I_GWIN, I_GLNG, I_GLNB, I_GWS, I_GBS, I_GWOUT,
             I_SWIN, I_SARE, I_SAIM, I_SLDT, I_SBRE, I_SBIM, I_SCRE, I_SCIM, I_SD, I_SWGLU, I_FING };

__device__ __forceinline__ int opaque_tid() { int t = threadIdx.x; asm volatile("" : "+v"(t)); return t; }
#define PHASE_IDS const int tid = opaque_tid(), lane = tid & 63, wave = __builtin_amdgcn_readfirstlane(tid >> 6); (void)tid; (void)lane; (void)wave

__device__ __forceinline__ void adaln_items(const Args& a, LAS unsigned char* lds, int wg, int nwg) {
    PHASE_IDS;
    LAS float* cs = (LAS float*)lds;
    LAS float* red = cs + 3 * 2048;
    const float* c = a.in[I_C]; const float* cc = a.in[I_CCTX];
    for (int i = tid; i < 3 * 2048; i += NTHR) { const int s = i >> 11, k = i & 2047; const float v = s < 2 ? c[s * 2048 + k] : cc[k]; cs[i] = v / (1.0f + expf(-v)); }
    __syncthreads();
    float* MOD = (float*)(a.ws + WS_MOD);
    const int cq = tid & 15, kg = tid >> 4;
    for (int item = wg; item < DEPTH * 192; item += nwg) {
        const int layer = item / 192, n0 = (item % 192) * 64;
        const float* W = a.in[I_ADAW] + (size_t)layer * 2048 * 12288 + n0 + 4 * cq;
        f32x4 a0 = {0.f, 0.f, 0.f, 0.f}, a1 = a0, a2 = a0;
#pragma unroll 8
        for (int k = kg; k < 2048; k += 32) { const f32x4 w = *(const GAS f32x4*)(W + (size_t)k * 12288); a0 += cs[k] * w; a1 += cs[2048 + k] * w; a2 += cs[4096 + k] * w; }
#pragma unroll
        for (int e = 0; e < 4; ++e) { red[(kg * 3 + 0) * 64 + 4 * cq + e] = a0[e]; red[(kg * 3 + 1) * 64 + 4 * cq + e] = a1[e]; red[(kg * 3 + 2) * 64 + 4 * cq + e] = a2[e]; }
        __syncthreads();
        if (tid < 192) { const int s = tid >> 6, col = tid & 63; float t = 0.f;
            for (int g = 0; g < 32; ++g) t += red[(g * 3 + s) * 64 + col];
            MOD[(size_t)(layer * 3 + s) * 12288 + n0 + col] = t + a.in[I_ADAB][layer * 12288 + n0 + col]; }
        __syncthreads();
    }
}
__device__ __forceinline__ void tr_item(const float* W, int ld, int K, int ncols, bf16* WT, int mode, LAS float* scr, int item, int lane) {
    const int nblk = ncols / 32, kb = item / nblk, nb = item % nblk, k0 = 64 * kb, n0 = 32 * nb;
    const int drow0 = mode == 0 ? n0 : (256 * (n0 >> 7) + (n0 & 127) + (mode == 2 ? 128 : 0));
#pragma unroll 8
    for (int i = 0; i < 32; ++i) { const int kk = 2 * i + (lane >> 5); scr[kk * 33 + (lane & 31)] = W[(size_t)(k0 + kk) * ld + n0 + (lane & 31)]; }
    LDS_WAIT(); asm volatile("" ::: "memory");
    const int c = lane & 7;
#pragma unroll
    for (int j = 0; j < 4; ++j) { const int n = (lane >> 3) + 8 * j; const LAS float* s = scr + (8 * c) * 33 + n;
        v4u o; o.x = pk2(s[0 * 33], s[1 * 33]); o.y = pk2(s[2 * 33], s[3 * 33]); o.z = pk2(s[4 * 33], s[5 * 33]); o.w = pk2(s[6 * 33], s[7 * 33]);
        *(GAS v4u*)(WT + (size_t)(drow0 + n) * K + k0 + 8 * c) = o; }
    LDS_WAIT(); asm volatile("" ::: "memory");
}
constexpr int TR_GIN = 2 * 8192, TR_GOUT = 2 * 4096, TR_FFN = 4 * 3 * 5632, TR_SIN = 2 * 2048, TR_GLU = 2 * 2 * 2048, TR_TOTAL = TR_GIN + TR_GOUT + TR_FFN + TR_SIN + TR_GLU;
__device__ __forceinline__ void transpose_items(const Args& a, LAS unsigned char* lds, int vcu, int G) {
    PHASE_IDS; const int gw = vcu * NWAVES + wave, ngw = G * NWAVES;
    LAS float* scr = (LAS float*)(lds + wave * 16384);
    unsigned char* ws = a.ws;
    for (int it0 = gw; it0 < TR_TOTAL; it0 += ngw) {
        int it = it0;
        if (it < TR_GIN) { const int j = it / 8192, r = it % 8192; tr_item(a.in[I_GWIN] + (size_t)j * 2048 * 8192, 8192, 2048, 8192, (bf16*)(ws + WS_WGIN) + (size_t)j * 8192 * 2048, 0, scr, r, lane); continue; } it -= TR_GIN;
        if (it < TR_GOUT) { const int j = it / 4096, r = it % 4096; tr_item(a.in[I_GWOUT] + (size_t)j * 4096 * 2048, 2048, 4096, 2048, (bf16*)(ws + WS_WGOUT) + (size_t)j * 2048 * 4096, 0, scr, r, lane); continue; } it -= TR_GOUT;
        if (it < TR_FFN) { const int i = it / 16896, r = it % 16896, which = r / 5632, rr = r % 5632;
            if (which == 0) tr_item(a.in[I_W1] + (size_t)i * 2048 * 5632, 5632, 2048, 5632, (bf16*)(ws + WS_WF13) + (size_t)i * 11264 * 2048, 1, scr, rr, lane);
            else if (which == 1) tr_item(a.in[I_W3] + (size_t)i * 2048 * 5632, 5632, 2048, 5632, (bf16*)(ws + WS_WF13) + (size_t)i * 11264 * 2048, 2, scr, rr, lane);
            else tr_item(a.in[I_W2] + (size_t)i * 5632 * 2048, 2048, 5632, 2048, (bf16*)(ws + WS_WF2) + (size_t)i * 2048 * 5632, 0, scr, rr, lane);
            continue; } it -= TR_FFN;
        if (it < TR_SIN) { const int j = it / 2048, r = it % 2048; tr_item(a.in[I_SWIN] + (size_t)j * 2048 * 2048, 2048, 2048, 2048, (bf16*)(ws + WS_WSIN) + (size_t)j * 2048 * 2048, 0, scr, r, lane); continue; } it -= TR_SIN;
        { const int j = it / 4096, r = it % 4096, half = r / 2048, rr = r % 2048;
          tr_item(a.in[I_SWGLU] + (size_t)j * 2048 * 4096 + half * 2048, 4096, 2048, 2048, (bf16*)(ws + WS_WGLU) + (size_t)j * 4096 * 2048, 1 + half, scr, rr, lane); }
    }
}
__device__ __forceinline__ void small_prologue(const Args& a, int vcu, int G) {
    PHASE_IDS; const int gtid = vcu * NTHR + tid, ngt = G * NTHR;
    bf16* WSB = (bf16*)(a.ws + WS_WSB);
    for (int i = gtid; i < 2 * 16 * 128 * 128; i += ngt) WSB[i] = (bf16)f2bf(a.in[I_GWS][i]);
    f32x2* S5A = (f32x2*)(a.ws + WS_S5A); f32x2* S5B = (f32x2*)(a.ws + WS_S5B);
    for (int i = gtid; i < 2 * 2 * SG * SP; i += ngt) {
        const int lg = i / SP;
        const float dt = expf(a.in[I_SLDT][lg]), are = a.in[I_SARE][i], aim = a.in[I_SAIM][i];
        const float e = expf(dt * are), th = dt * aim, abr = e * cosf(th), abi = e * sinf(th);
        f32x2 ab; ab.x = abr; ab.y = abi; S5A[i] = ab;
        const float nr = abr - 1.0f, ni = abi, den = 1.0f / (are * are + aim * aim);
        const float cr = (nr * are + ni * aim) * den, ci = (ni * are - nr * aim) * den;
        for (int q = 0; q < SQ; ++q) { const float br = a.in[I_SBRE][(size_t)i * SQ + q], bi = a.in[I_SBIM][(size_t)i * SQ + q];
            f32x2 o; o.x = cr * br - ci * bi; o.y = cr * bi + ci * br; S5B[(size_t)i * SQ + q] = o; }
    }
}

template <bool INIT> __device__ __forceinline__ void norm_phase(const Args& a, const float* gain, const float* modl  , int which, int vcu, int G) {
    PHASE_IDS; const int gw = vcu * NWAVES + wave, ngw = G * NWAVES;
    float* H = (float*)(a.ws + WS_H); bf16* XN = (bf16*)(a.ws + WS_XN);
    for (int row = gw; row < M; row += ngw) {
        const int set = row < ML ? (row >> 13) : 2;
        GAS f32x4* hr = (GAS f32x4*)(H + (size_t)row * D) + lane;
        f32x4 v[8];
        if (INIT) {
            if (row < ML) {
                const GAS f32x4* xr = (const GAS f32x4*)(a.in[I_X] + (size_t)row * D) + lane;
#pragma unroll
                for (int j = 0; j < 8; ++j) v[j] = xr[64 * j];
                const int t = row & (SEQ - 1); const float pr = (float)(t >> 6), pc = (float)(t & 63);
#pragma unroll
                for (int jj = 0; jj < 2; ++jj)
#pragma unroll
                    for (int e = 0; e < 4; ++e) { const float om = exp2f(-(float)(256 * jj + 4 * lane + e) * (13.287712379549449f / 512.0f));
                        const float ar = pr * om, ac = pc * om;
                        v[0 + jj][e] += sinf(ar); v[2 + jj][e] += cosf(ar); v[4 + jj][e] += sinf(ac); v[6 + jj][e] += cosf(ac); }
            } else {
                const GAS f32x4* xr = (const GAS f32x4*)(a.in[I_CTX] + (size_t)(row - ML) * D) + lane;
#pragma unroll
                for (int j = 0; j < 8; ++j) v[j] = xr[64 * j];
            }
#pragma unroll
            for (int j = 0; j < 8; ++j) hr[64 * j] = v[j];
        } else {
#pragma unroll
            for (int j = 0; j < 8; ++j) v[j] = hr[64 * j];
        }
        float ss = 0.f;
#pragma unroll
        for (int j = 0; j < 8; ++j) ss += (v[j].x * v[j].x + v[j].y * v[j].y) + (v[j].z * v[j].z + v[j].w * v[j].w);
        const float rinv = 1.0f / sqrtf(wave_sum(ss) * (1.0f / D) + EPS);
        const GAS f32x4* gp = (const GAS f32x4*)gain + lane;
        const GAS f32x4* shp = (const GAS f32x4*)(modl + (size_t)set * 12288 + (which * 3 + 0) * D) + lane;
        const GAS f32x4* scp = (const GAS f32x4*)(modl + (size_t)set * 12288 + (which * 3 + 1) * D) + lane;
        GAS v2u* o8 = (GAS v2u*)(XN + (size_t)row * D) + lane;
#pragma unroll
        for (int j = 0; j < 8; ++j) { const f32x4 g = gp[64 * j], sh = shp[64 * j], sc = scp[64 * j];
            const f32x4 y = v[j] * rinv * g * (1.0f + sc) + sh;
            v2u o; o.x = pk2(y.x, y.y); o.y = pk2(y.z, y.w); o8[64 * j] = o; }
    }
}
__device__ __forceinline__ void final_phase(const Args& a, int vcu, int G) {
    PHASE_IDS; const int gw = vcu * NWAVES + wave, ngw = G * NWAVES;
    const float* H = (const float*)(a.ws + WS_H);
    for (int row = gw; row < ML; row += ngw) {
        const GAS f32x4* hr = (const GAS f32x4*)(H + (size_t)row * D) + lane;
        f32x4 v[8]; float ss = 0.f;
#pragma unroll
        for (int j = 0; j < 8; ++j) { v[j] = hr[64 * j]; ss += (v[j].x * v[j].x + v[j].y * v[j].y) + (v[j].z * v[j].z + v[j].w * v[j].w); }
        const float rinv = 1.0f / sqrtf(wave_sum(ss) * (1.0f / D) + EPS);
        const GAS f32x4* gp = (const GAS f32x4*)a.in[I_FING] + lane;
        GAS f32x4* o = (GAS f32x4*)(a.out + (size_t)row * D) + lane;
#pragma unroll
        for (int j = 0; j < 8; ++j) o[64 * j] = v[j] * rinv * gp[64 * j];
    }
}

__device__ __forceinline__ void sgu_phase(const Args& a, int gl  , LAS unsigned char* lds, int wg, int nwg) {
    PHASE_IDS;
    bf16* ZU = (bf16*)(a.ws + WS_ZU); const bf16* ZV = (const bf16*)(a.ws + WS_ZV); const float* VSTAT = (const float*)(a.ws + WS_VSTAT);
    const bf16* WSB = (const bf16*)(a.ws + WS_WSB) + (size_t)gl * 16 * 128 * 128;
    const float* bs = a.in[I_GBS] + gl * 16 * 128; const float* lng = a.in[I_GLNG] + gl * EA; const float* lnb = a.in[I_GLNB] + gl * EA;
    LAS f32x2* st = (LAS f32x2*)lds;
    const int n = lane & 31, h = lane >> 5;
    for (int unit = wg; unit < NCHUNK * NH; unit += nwg) {
        const int c = unit / NH, hd = unit % NH, r0 = c * CHUNK;
        { const int j = tid >> 2, part = tid & 3; const GAS f32x4* p = (const GAS f32x4*)(VSTAT + ((size_t)(r0 + j) * 64 + part * 16) * 2);
          float s = 0.f, ss = 0.f;
#pragma unroll
          for (int q = 0; q < 8; ++q) { const f32x4 w = p[q]; s += w.x + w.z; ss += w.y + w.w; }
          s += __shfl_xor(s, 1); s += __shfl_xor(s, 2); ss += __shfl_xor(ss, 1); ss += __shfl_xor(ss, 2);
          if (part == 0) { const float mean = s * (1.0f / EA), var = ss * (1.0f / EA) - mean * mean; f32x2 o; o.x = mean; o.y = 1.0f / sqrtf(var + EPS); st[j] = o; } }
        __syncthreads();
        const int gcol = hd * HDIM + 32 * wave + n;
        const float lg = lng[gcol], lb = lnb[gcol];
        const GAS bf16* vp = (const GAS bf16*)ZV + (size_t)r0 * EA + gcol;
        unsigned short raw[8][8];
#pragma unroll
        for (int ks = 0; ks < 8; ++ks)
#pragma unroll
            for (int e = 0; e < 8; ++e) raw[ks][e] = vp[(size_t)(16 * ks + 8 * h + e) * EA];
        bf16x8 Bf[8];
#pragma unroll
        for (int ks = 0; ks < 8; ++ks) { float f[8];
#pragma unroll
            for (int e = 0; e < 8; ++e) { const f32x2 m = st[16 * ks + 8 * h + e]; f[e] = (bf2f(raw[ks][e]) - m.x) * m.y * lg + lb; }
            v4u w; w.x = pk2(f[0], f[1]); w.y = pk2(f[2], f[3]); w.z = pk2(f[4], f[5]); w.w = pk2(f[6], f[7]); Bf[ks] = __builtin_bit_cast(bf16x8, w); }
#pragma unroll 1
        for (int ib = 0; ib < 4; ++ib) {
            f32x16 acc;
#pragma unroll
            for (int r = 0; r < 16; ++r) acc[r] = 0.f;
            const GAS bf16x8* ap = (const GAS bf16x8*)(WSB + ((size_t)hd * 128 + 32 * ib + n) * 128 + 8 * h);
#pragma unroll
            for (int ks = 0; ks < 8; ++ks) { const bf16x8 Af = ap[2 * ks]; acc = __builtin_amdgcn_mfma_f32_32x32x16_bf16(Af, Bf[ks], acc, 0, 0, 0); }
#pragma unroll
            for (int r = 0; r < 16; ++r) { const int i = 32 * ib + (r & 3) + 8 * (r >> 2) + 4 * h; const float s = acc[r] + bs[hd * 128 + i];
                GAS bf16* up = (GAS bf16*)ZU + (size_t)(r0 + i) * EA + gcol; *up = (bf16)f2bf(bf2f(*up) * s); }
        }
        __syncthreads();
    }
}

__device__ __forceinline__ void s5_naive_phase(const Args& a, int sl  , int wg, int nwg) {
    PHASE_IDS;
    if (wave >= 2) return;
    const bf16* U = (const bf16*)(a.ws + WS_SU);
    for (int item = wg * 2 + wave; item < 2 * 2 * SG; item += nwg * 2) {
        const int b = item & 1, k = (item >> 1) & 1, g = item >> 2;
        const int pg = ((sl * 2 + k) * SG + g);
        const f32x2 ab = ((const f32x2*)(a.ws + WS_S5A))[(size_t)pg * SP + lane];
        float bre[16], bim[16], cr[16], ci[16];
#pragma unroll
        for (int q = 0; q < 16; ++q) { const f32x2 bb = ((const f32x2*)(a.ws + WS_S5B))[((size_t)pg * SP + lane) * SQ + q]; bre[q] = bb.x; bim[q] = bb.y;
            cr[q] = a.in[I_SCRE][((size_t)pg * SQ + q) * SP + lane]; ci[q] = a.in[I_SCIM][((size_t)pg * SQ + q) * SP + lane]; }
        float* Y = (float*)(a.ws + (k ? WS_YB : WS_YF));
        float hr = 0.f, hi = 0.f;
#pragma unroll 1
        for (int seg = 0; seg < 2; ++seg) {
            const int L = seg ? SEQ : CTXL, base = seg ? b * SEQ : ML + b * CTXL;
#pragma unroll 1
            for (int blk = 0; blk < L; blk += 64) {
                const int myt = k ? (L - 1 - (blk + lane)) : (blk + lane);
                const size_t row = (size_t)(base + myt);
                const GAS v4u* up = (const GAS v4u*)(U + row * D + 16 * g);
                const v4u u0 = up[0], u1 = up[1];
                float keep[16];
#pragma unroll
                for (int q = 0; q < 16; ++q) keep[q] = 0.f;
#pragma unroll 1
                for (int s = 0; s < 64; ++s) {
                    unsigned w[8];
                    w[0] = __builtin_amdgcn_readlane(u0.x, s); w[1] = __builtin_amdgcn_readlane(u0.y, s); w[2] = __builtin_amdgcn_readlane(u0.z, s); w[3] = __builtin_amdgcn_readlane(u0.w, s);
                    w[4] = __builtin_amdgcn_readlane(u1.x, s); w[5] = __builtin_amdgcn_readlane(u1.y, s); w[6] = __builtin_amdgcn_readlane(u1.z, s); w[7] = __builtin_amdgcn_readlane(u1.w, s);
                    float br = 0.f, bi = 0.f;
#pragma unroll
                    for (int q2 = 0; q2 < 8; ++q2) { const float ulo = __builtin_bit_cast(float, w[q2] << 16), uhi = __builtin_bit_cast(float, w[q2] & 0xffff0000u);
                        br += bre[2 * q2] * ulo + bre[2 * q2 + 1] * uhi; bi += bim[2 * q2] * ulo + bim[2 * q2 + 1] * uhi; }
                    const float nhr = ab.x * hr - ab.y * hi + br, nhi = ab.x * hi + ab.y * hr + bi; hr = nhr; hi = nhi;
#pragma unroll
                    for (int q = 0; q < 16; ++q) { const float y = wave_sum(cr[q] * hr - ci[q] * hi); keep[q] = (lane == s) ? y : keep[q]; }
                }
                GAS f32x4* yp = (GAS f32x4*)(Y + row * D + 16 * g);
#pragma unroll
                for (int q4 = 0; q4 < 4; ++q4) { f32x4 o; o.x = keep[4 * q4]; o.y = keep[4 * q4 + 1]; o.z = keep[4 * q4 + 2]; o.w = keep[4 * q4 + 3]; yp[q4] = o; }
            }
        }
    }
}
__device__ __forceinline__ void s5_combine_phase(const Args& a, int sl, int vcu, int G) {
    PHASE_IDS; const int gw = vcu * NWAVES + wave, ngw = G * NWAVES;
    const float* YF = (const float*)(a.ws + WS_YF); const float* YB = (const float*)(a.ws + WS_YB); const bf16* U = (const bf16*)(a.ws + WS_SU); bf16* Z = (bf16*)(a.ws + WS_SZ);
    const GAS f32x4* dp = (const GAS f32x4*)(a.in[I_SD] + sl * D) + lane;
    for (int row = gw; row < M; row += ngw) {
        const GAS f32x4* yf = (const GAS f32x4*)(YF + (size_t)row * D) + lane; const GAS f32x4* yb = (const GAS f32x4*)(YB + (size_t)row * D) + lane;
        const GAS v2u* up = (const GAS v2u*)(U + (size_t)row * D) + lane; GAS v2u* zp = (GAS v2u*)(Z + (size_t)row * D) + lane;
#pragma unroll
        for (int j = 0; j < 8; ++j) { const f32x4 f = yf[64 * j], bk = yb[64 * j], dd = dp[64 * j]; const v2u uu = up[64 * j];
            f32x4 u4; u4.x = __builtin_bit_cast(float, uu.x << 16); u4.y = __builtin_bit_cast(float, uu.x & 0xffff0000u); u4.z = __builtin_bit_cast(float, uu.y << 16); u4.w = __builtin_bit_cast(float, uu.y & 0xffff0000u);
            const f32x4 y = f + bk + u4 * dd;
            v2u o; o.x = pk2(pg8::gelu_tanh_f(y.x), pg8::gelu_tanh_f(y.y)); o.y = pk2(pg8::gelu_tanh_f(y.z), pg8::gelu_tanh_f(y.w)); zp[64 * j] = o; }
    }
}

#ifndef MK_ONE_LAUNCH
#define MK_ONE_LAUNCH 1
#endif
constexpr int N_PHASES = 2 + 2 * 15;

__global__ void __launch_bounds__(NTHR, 2) fwd_kernel(Args args) {
    extern __shared__ __attribute__((aligned(16))) unsigned char lds_raw[];
    LAS unsigned char* lds = (LAS unsigned char*)lds_raw;
    const int tid = threadIdx.x;
    const int G = gridDim.x, bx = blockIdx.x;
    const int vcu = (G % 8 == 0) ? (bx % 8) * (G / 8) + bx / 8 : bx;
    unsigned char* ws = args.ws;
    volatile LAS unsigned* MISC = (volatile LAS unsigned*)(lds + MISC_OFF);
    for (int u = tid; u < (LDS_BYTES - LDSCTL_OFF) / 4; u += NTHR) ((LAS unsigned*)(lds + LDSCTL_OFF))[u] = 0u;
    __syncthreads();
    const int lo = args.ph_lo, hi = args.ph_hi;
    XcdBarrier bar; bar.bar = (unsigned*)(ws + WS_CTL) + CW_BAR; bar.x = 0; bar.st = nullptr;
    if (hi - lo > 1) bar = xcd_barrier_post((unsigned*)(ws + WS_CTL) + CW_BAR, MISC + 8);
#define RUN(k) (lo <= (k) && (k) < hi)
#define SEAM(k) do { if (RUN(k) && RUN((k) + 1)) xcd_barrier(bar); } while (0)
    float* H = (float*)(ws + WS_H); pg8::bf16_t* XN = (pg8::bf16_t*)(ws + WS_XN);
    const float* MOD = (const float*)(ws + WS_MOD);

#ifndef NO_PRO
    if (RUN(0)) {
        adaln_items(args, lds, vcu, G);
        transpose_items(args, lds, vcu, G);
        small_prologue(args, vcu, G);
    }
#endif
    SEAM(0);
    if (RUN(1)) norm_phase<true>(args, args.in[I_N1G], MOD, 0, vcu, G);
    SEAM(1);

#ifdef UNROLL_LP
#pragma unroll
#else
#pragma unroll 1
#endif
    for (int lp = 0; lp < 2; ++lp) {
        const int pb = 2 + lp * 15;
        {
            const int layer = 2 * lp; const float* modl = MOD + (size_t)layer * 3 * 12288;
            if (RUN(pb + 0)) {
                pg8::Gemm g{XN, (const pg8::bf16_t*)(ws + WS_WGIN) + (size_t)lp * 8192 * 2048, M, 8192, D}; pg8::StaticOrder S; S.init(M, 8192, G, bx);
                pg8::EpiG1 E{(pg8::bf16_t*)(ws + WS_ZU), (pg8::bf16_t*)(ws + WS_ZV), (float*)(ws + WS_VSTAT)};
                pg8::gemm_phase<pg8::EpiG1, pg8::StaticOrder, true, true>(lds + RING_OFF, g, S, E);
            }
            SEAM(pb + 0);
            #ifndef NO_SGU
            if (RUN(pb + 1)) sgu_phase(args, lp, lds, bx, G);
#endif
            SEAM(pb + 1);
            if (RUN(pb + 2)) {
                pg8::Gemm g{(const pg8::bf16_t*)(ws + WS_ZU), (const pg8::bf16_t*)(ws + WS_WGOUT) + (size_t)lp * 2048 * 4096, M, D, EA}; pg8::StaticOrder S; S.init(M, D, G, bx);
                pg8::EpiResid E{H, modl + 2 * D};
                pg8::gemm_phase<pg8::EpiResid, pg8::StaticOrder, true, true>(lds + RING_OFF, g, S, E);
            }
            SEAM(pb + 2);
            if (RUN(pb + 3)) norm_phase<false>(args, args.in[I_N2G] + layer * D, modl, 1, vcu, G);
            SEAM(pb + 3);
            if (RUN(pb + 4)) {
                pg8::Gemm g{XN, (const pg8::bf16_t*)(ws + WS_WF13) + (size_t)layer * 11264 * 2048, M, 2 * FF, D}; pg8::StaticOrder S; S.init(M, 2 * FF, G, bx);
                pg8::EpiSwiGLU E{(pg8::bf16_t*)(ws + WS_HID)};
                pg8::gemm_phase<pg8::EpiSwiGLU, pg8::StaticOrder, true, true>(lds + RING_OFF, g, S, E);
            }
            SEAM(pb + 4);
            if (RUN(pb + 5)) {
                pg8::Gemm g{(const pg8::bf16_t*)(ws + WS_HID), (const pg8::bf16_t*)(ws + WS_WF2) + (size_t)layer * 2048 * 5632, M, D, FF}; pg8::StaticOrder S; S.init(M, D, G, bx);
                pg8::EpiResid E{H, modl + 5 * D};
                pg8::gemm_phase<pg8::EpiResid, pg8::StaticOrder, true, true>(lds + RING_OFF, g, S, E);
            }
            SEAM(pb + 5);
            if (RUN(pb + 6)) norm_phase<false>(args, args.in[I_N1G] + (layer + 1) * D, modl + 3 * 12288, 0, vcu, G);
            SEAM(pb + 6);
        }
        {
            const int layer = 2 * lp + 1; const float* modl = MOD + (size_t)layer * 3 * 12288; const int ps = pb + 7;
            if (RUN(ps + 0)) {
                pg8::Gemm g{XN, (const pg8::bf16_t*)(ws + WS_WSIN) + (size_t)lp * 2048 * 2048, M, D, D}; pg8::StaticOrder S; S.init(M, D, G, bx);
                pg8::EpiPlainBf16 E{(pg8::bf16_t*)(ws + WS_SU), D};
                pg8::gemm_phase<pg8::EpiPlainBf16, pg8::StaticOrder, true, true>(lds + RING_OFF, g, S, E);
            }
            SEAM(ps + 0);
            #ifndef NO_S5N
            if (RUN(ps + 1)) s5_naive_phase(args, lp, bx, G);
#endif
            SEAM(ps + 1);
            if (RUN(ps + 2)) s5_combine_phase(args, lp, vcu, G);
            SEAM(ps + 2);
            if (RUN(ps + 3)) {
                pg8::Gemm g{(const pg8::bf16_t*)(ws + WS_SZ), (const pg8::bf16_t*)(ws + WS_WGLU) + (size_t)lp * 4096 * 2048, M, 2 * D, D}; pg8::StaticOrder S; S.init(M, 2 * D, G, bx);
                pg8::EpiGluResid E{H, modl + 2 * D};
                pg8::gemm_phase<pg8::EpiGluResid, pg8::StaticOrder, true, true>(lds + RING_OFF, g, S, E);
            }
            SEAM(ps + 3);
            if (RUN(ps + 4)) norm_phase<false>(args, args.in[I_N2G] + layer * D, modl, 1, vcu, G);
            SEAM(ps + 4);
            if (RUN(ps + 5)) {
                pg8::Gemm g{XN, (const pg8::bf16_t*)(ws + WS_WF13) + (size_t)layer * 11264 * 2048, M, 2 * FF, D}; pg8::StaticOrder S; S.init(M, 2 * FF, G, bx);
                pg8::EpiSwiGLU E{(pg8::bf16_t*)(ws + WS_HID)};
                pg8::gemm_phase<pg8::EpiSwiGLU, pg8::StaticOrder, true, true>(lds + RING_OFF, g, S, E);
            }
            SEAM(ps + 5);
            if (RUN(ps + 6)) {
                pg8::Gemm g{(const pg8::bf16_t*)(ws + WS_HID), (const pg8::bf16_t*)(ws + WS_WF2) + (size_t)layer * 2048 * 5632, M, D, FF}; pg8::StaticOrder S; S.init(M, D, G, bx);
                pg8::EpiResid E{H, modl + 5 * D};
                pg8::gemm_phase<pg8::EpiResid, pg8::StaticOrder, true, true>(lds + RING_OFF, g, S, E);
            }
            SEAM(ps + 6);
            if (RUN(ps + 7)) {
                if (lp == 0) norm_phase<false>(args, args.in[I_N1G] + (layer + 1) * D, modl + 3 * 12288, 0, vcu, G);
                else final_phase(args, vcu, G);
            }
            SEAM(ps + 7);
        }
    }
#undef RUN
#undef SEAM
}

extern "C" void kernel_launch(void* const* d_in, const int* in_sizes, int n_in, void* d_out, int out_size, void* d_ws, size_t ws_size, hipStream_t stream) {
    static int grid = 0;
    if (grid == 0) {
        if (n_in != 28 || in_sizes[0] != ML * D || out_size != ML * D || ws_size < WS_END) {
            fprintf(stderr, "kernel_launch: unexpected problem (n_in %d, in0 %d, out %d, ws %zu, need ws >= %zu); nothing launched\n", n_in, n_in > 0 ? in_sizes[0] : -1, out_size, ws_size, (size_t)WS_END); grid = -1; return; }
        int dev = 0, cus = 0, per_cu = 0;
        if (hipGetDevice(&dev) != hipSuccess || hipDeviceGetAttribute(&cus, hipDeviceAttributeMultiprocessorCount, dev) != hipSuccess) { fprintf(stderr, "kernel_launch: device query failed\n"); grid = -1; return; }
        if (hipFuncSetAttribute((const void*)fwd_kernel, hipFuncAttributeMaxDynamicSharedMemorySize, LDS_BYTES) != hipSuccess) { fprintf(stderr, "kernel_launch: hipFuncSetAttribute failed\n"); grid = -1; return; }
        if (hipOccupancyMaxActiveBlocksPerMultiprocessor(&per_cu, (const void*)fwd_kernel, NTHR, LDS_BYTES) != hipSuccess || per_cu < 1) {
            fprintf(stderr, "kernel_launch: occupancy query reports %d workgroups per CU\n", per_cu); }
        (void)hipGetLastError();
        grid = cus;
    }
    if (grid < 0) return;
    if (hipMemsetAsync((char*)d_ws + WS_CTL, 0, CTL_ZERO_BYTES, stream) != hipSuccess) { fprintf(stderr, "kernel_launch: memset failed\n"); return; }
    Args a{};
    for (int i = 0; i < 28; ++i) a.in[i] = (const float*)d_in[i];
    a.out = (float*)d_out; a.ws = (unsigned char*)d_ws;
#if MK_ONE_LAUNCH
    a.ph_lo = 0; a.ph_hi = N_PHASES;
    hipLaunchKernelGGL(fwd_kernel, dim3(grid), dim3(NTHR), LDS_BYTES, stream, a);
#else
    for (int p = 0; p < N_PHASES; ++p) { a.ph_lo = p; a.ph_hi = p + 1; hipLaunchKernelGGL(fwd_kernel, dim3(grid), dim3(NTHR), LDS_BYTES, stream, a); }
#endif
    const hipError_t le = hipPeekAtLastError();
    if (le != hipSuccess) fprintf(stderr, "kernel_launch: launch failed: %s\n", hipGetErrorName(le));
}
```

```cpp
#include <hip/hip_runtime.h>
#include <cstdio>
#include <cstdint>
namespace pg8 {
#define PG8_LAS __attribute__((address_space(3)))
typedef unsigned short bf16_t;
typedef short bf16x8 __attribute__((ext_vector_type(8)));
typedef float f32x4 __attribute__((ext_vector_type(4)));
typedef unsigned u32x4 __attribute__((ext_vector_type(4)));
constexpr int BM = 256, BK = 64, HALF = 128, HTB = HALF * BK * 2  , STAGE_BYTES = 8 * HTB, NXCD = 8, WGM = 8;

__host__ __device__ __forceinline__ int lds_byte(int r, int c) { const int st = (r >> 4) * 2 + (c >> 5), rr = r & 15, cc = c & 31, ob = rr * 64 + cc * 2; return st * 1024 + (ob ^ (((ob >> 9) & 1) << 5)); }
__host__ __device__ __forceinline__ void stage_rc(int b, int& R, int& C) { const int st = b / 1024, sb = b % 1024, swz = sb ^ (((sb >> 9) & 1) << 5); R = (st >> 1) * 16 + swz / 64; C = (st & 1) * 32 + (swz % 64) / 2; }
__host__ __device__ __forceinline__ int perm32(int rho) { const int n = rho >> 4, i = rho & 15; return 8 * (i >> 2) + 4 * n + (i & 3); }

struct Unit { int pm, pn; };
struct Gemm { const bf16_t* A; const bf16_t* Bt; int M, N, K; int lda; };

struct StaticOrder {
    int nM, nN, nwg, G, c;
    __host__ __device__ void init(int M, int N, int G_, int c_) { nM = M / BM; nN = N / BM; nwg = nM * nN; G = G_; c = c_; }
    __host__ __device__ bool next(int i, Unit& u) const {
        const long L = (long)i * G + c; if (L >= nwg) return false;
        int wgid = (int)L; { const int q = nwg / NXCD, r = nwg % NXCD, xcd = wgid % NXCD, off = wgid / NXCD; wgid = (xcd < r ? xcd * (q + 1) : r * (q + 1) + (xcd - r) * q) + off; }
        const int nig = WGM * nN, gid = wgid / nig, fm = gid * WGM, gsz = (nM - fm) < WGM ? (nM - fm) : WGM;
        u.pm = fm + ((wgid % nig) % gsz); u.pn = (wgid % nig) / gsz; return true;
    }
    __device__ __forceinline__ void a_ready(const Unit&) const {}
    __device__ __forceinline__ void done(const Unit&) const {}
};

__device__ __forceinline__ unsigned cvt_pk_bf16(float lo, float hi) { unsigned r; asm volatile("v_cvt_pk_bf16_f32 %0, %1, %2" : "=v"(r) : "v"(lo), "v"(hi)); return r; }
typedef float f32x2 __attribute__((ext_vector_type(2)));
__device__ __forceinline__ f32x2 gelu_pk(f32x2 v) {
    const f32x2 av = __builtin_elementwise_abs(v), d = av * 0.2316418882f + 1.0f;
    f32x2 t; t.x = __builtin_amdgcn_rcpf(d.x); t.y = __builtin_amdgcn_rcpf(d.y);
    f32x2 q = t * 0.5307027145f + (-0.7265760135f); q = q * t + 0.7107068705f; q = q * t + (-0.142248368f); q = q * t + 0.127414796f; q = q * t;
    const f32x2 s = (v * v) * (-0.72134752044f);
    f32x2 e; e.x = __builtin_amdgcn_exp2f(s.x); e.y = __builtin_amdgcn_exp2f(s.y);
    const f32x2 m = v * (q * e), r = v - m;
    f32x2 o; o.x = v.x < 0.f ? m.x : r.x; o.y = v.y < 0.f ? m.y : r.y; return o;
}


__device__ __forceinline__ float sigmoid_f(float x) { return __builtin_amdgcn_rcpf(1.0f + __builtin_amdgcn_exp2f(-1.44269504f * x)); }
__device__ __forceinline__ float silu_f(float x) { return x * sigmoid_f(x); }
__device__ __forceinline__ float gelu_tanh_f(float x) { const float u = x * (1.0f + 0.044715f * x * x); return x * __builtin_amdgcn_rcpf(1.0f + __builtin_amdgcn_exp2f(-2.30220820f * u)); }
__device__ __forceinline__ int row_set(int pm) { return pm < 32 ? 0 : (pm < 64 ? 1 : 2); }

struct EpiPlainBf16 {
    static constexpr bool PERM = true, AFTER_DRAIN = false;
    bf16_t* O; int ldc;
    __device__ __forceinline__ void operator()(const f32x4 (&acc)[2][2][4][2], const Unit& u, int wr, int wc, int fr, int fq) const {
        const int row0 = u.pm * BM + wr * 64 + fr, col0 = u.pn * BM + wc * 32 + 8 * fq;
#pragma unroll
        for (int ai = 0; ai < 2; ++ai)
#pragma unroll
            for (int m = 0; m < 4; ++m) { bf16_t* rowp = O + (size_t)(row0 + ai * HALF + m * 16) * ldc + col0;
#pragma unroll
                for (int bj = 0; bj < 2; ++bj) { const f32x4 v0 = acc[ai][bj][m][0], v1 = acc[ai][bj][m][1];
                    u32x4 w; w.x = cvt_pk_bf16(v0[0], v0[1]); w.y = cvt_pk_bf16(v0[2], v0[3]); w.z = cvt_pk_bf16(v1[0], v1[1]); w.w = cvt_pk_bf16(v1[2], v1[3]);
                    *(u32x4*)(rowp + bj * HALF) = w; } }
    }
};
struct EpiG1 {
    static constexpr bool PERM = true, AFTER_DRAIN = false;
    bf16_t* U; bf16_t* V; float* vstat;
    __device__ __forceinline__ void operator()(const f32x4 (&acc)[2][2][4][2], const Unit& u, int wr, int wc, int fr, int fq) const {
        const bool isv = u.pn >= 16;
        const int row0 = u.pm * BM + wr * 64 + fr, col0 = (u.pn & 15) * BM + wc * 32 + 8 * fq;
        bf16_t* base = isv ? V : U;
#pragma unroll
        for (int ai = 0; ai < 2; ++ai)
#pragma unroll
            for (int m = 0; m < 4; ++m) { const int row = row0 + ai * HALF + m * 16; bf16_t* rowp = base + (size_t)row * 4096 + col0; float s = 0.f, ss = 0.f;
#pragma unroll
                for (int bj = 0; bj < 2; ++bj) { f32x4 v0 = acc[ai][bj][m][0], v1 = acc[ai][bj][m][1];
#pragma unroll
                    for (int e = 0; e < 4; ++e) { v0[e] = gelu_tanh_f(v0[e]); v1[e] = gelu_tanh_f(v1[e]); s += v0[e] + v1[e]; ss += v0[e] * v0[e] + v1[e] * v1[e]; }
                    u32x4 w; w.x = cvt_pk_bf16(v0[0], v0[1]); w.y = cvt_pk_bf16(v0[2], v0[3]); w.z = cvt_pk_bf16(v1[0], v1[1]); w.w = cvt_pk_bf16(v1[2], v1[3]);
                    *(u32x4*)(rowp + bj * HALF) = w; }
                if (isv) { s += __shfl_xor(s, 16); s += __shfl_xor(s, 32); ss += __shfl_xor(ss, 16); ss += __shfl_xor(ss, 32);
                    if (fq == 0) { f32x2 o; o.x = s; o.y = ss; *(f32x2*)(vstat + ((size_t)row * 64 + (u.pn - 16) * 4 + wc) * 2) = o; } } }
    }
};
struct EpiResid {
    static constexpr bool PERM = false, AFTER_DRAIN = false;
    float* H; const float* gate;
    __device__ __forceinline__ void operator()(const f32x4 (&acc)[2][2][4][2], const Unit& u, int wr, int wc, int fr, int fq) const {
        const int row0 = u.pm * BM + wr * 64 + fr, col0 = u.pn * BM + wc * 32 + 4 * fq;
        const float* g = gate + row_set(u.pm) * (6 * 2048) + col0;
        f32x4 gv[2][2];
#pragma unroll
        for (int bj = 0; bj < 2; ++bj)
#pragma unroll
            for (int n = 0; n < 2; ++n) gv[bj][n] = *(const f32x4*)(g + bj * HALF + n * 16);
#pragma unroll
        for (int ai = 0; ai < 2; ++ai)
#pragma unroll
            for (int m = 0; m < 4; ++m) { float* rowp = H + (size_t)(row0 + ai * HALF + m * 16) * 2048 + col0;
#pragma unroll
                for (int bj = 0; bj < 2; ++bj)
#pragma unroll
                    for (int n = 0; n < 2; ++n) { f32x4* p = (f32x4*)(rowp + bj * HALF + n * 16); *p = *p + gv[bj][n] * acc[ai][bj][m][n]; } }
    }
};
struct EpiSwiGLU {
    static constexpr bool PERM = true, AFTER_DRAIN = false;
    bf16_t* O;
    __device__ __forceinline__ void operator()(const f32x4 (&acc)[2][2][4][2], const Unit& u, int wr, int wc, int fr, int fq) const {
        const int row0 = u.pm * BM + wr * 64 + fr, col0 = u.pn * HALF + wc * 32 + 8 * fq;
#pragma unroll
        for (int ai = 0; ai < 2; ++ai)
#pragma unroll
            for (int m = 0; m < 4; ++m) { bf16_t* rowp = O + (size_t)(row0 + ai * HALF + m * 16) * 5632 + col0;
                f32x4 a0 = acc[ai][0][m][0], a1 = acc[ai][0][m][1]; const f32x4 b0 = acc[ai][1][m][0], b1 = acc[ai][1][m][1];
#pragma unroll
                for (int e = 0; e < 4; ++e) { a0[e] = silu_f(a0[e]) * b0[e]; a1[e] = silu_f(a1[e]) * b1[e]; }
                u32x4 w; w.x = cvt_pk_bf16(a0[0], a0[1]); w.y = cvt_pk_bf16(a0[2], a0[3]); w.z = cvt_pk_bf16(a1[0], a1[1]); w.w = cvt_pk_bf16(a1[2], a1[3]);
                *(u32x4*)rowp = w; }
    }
};
struct EpiGluResid {
    static constexpr bool PERM = false, AFTER_DRAIN = false;
    float* H; const float* gate;
    __device__ __forceinline__ void operator()(const f32x4 (&acc)[2][2][4][2], const Unit& u, int wr, int wc, int fr, int fq) const {
        const int row0 = u.pm * BM + wr * 64 + fr, col0 = u.pn * HALF + wc * 32 + 4 * fq;
        const float* g = gate + row_set(u.pm) * (6 * 2048) + col0;
        f32x4 gv[2];
#pragma unroll
        for (int n = 0; n < 2; ++n) gv[n] = *(const f32x4*)(g + n * 16);
#pragma unroll
        for (int ai = 0; ai < 2; ++ai)
#pragma unroll
            for (int m = 0; m < 4; ++m) { float* rowp = H + (size_t)(row0 + ai * HALF + m * 16) * 2048 + col0;
#pragma unroll
                for (int n = 0; n < 2; ++n) { const f32x4 a = acc[ai][0][m][n], gg = acc[ai][1][m][n]; f32x4 o;
#pragma unroll
                    for (int e = 0; e < 4; ++e) o[e] = a[e] * sigmoid_f(gg[e]);
                    f32x4* p = (f32x4*)(rowp + n * 16); *p = *p + gv[n] * o; } }
    }
};

struct GroupOrder {
    int G, c;
    __host__ __device__ void init(int G_, int c_) { G = G_; c = c_; }
    __host__ __device__ bool next(int i, Unit& u) const { const int L = i * G + c; if (L >= 512) return false; u.pm = L; u.pn = L >> 2; return true; }
    __device__ __forceinline__ void a_ready(const Unit&) const {}
    __device__ __forceinline__ void done(const Unit&) const {}
};
struct EpiS5In {
    static constexpr bool PERM = true, AFTER_DRAIN = false;
    bf16_t* XL; bf16_t* XC;
    __device__ __forceinline__ void operator()(const f32x4 (&acc)[2][2][4][2], const Unit& u, int wr, int wc, int fr, int fq) const {
        const int row0 = u.pm * BM + wr * 64 + fr;
#pragma unroll
        for (int ai = 0; ai < 2; ++ai)
#pragma unroll
            for (int m = 0; m < 4; ++m) { const int row = row0 + ai * HALF + m * 16;
#pragma unroll
                for (int bj = 0; bj < 2; ++bj) { const int col0 = u.pn * BM + bj * HALF + wc * 32 + 8 * fq, g = col0 >> 4, q0 = col0 & 15;
                    bf16_t* dst = row < 16384 ? XL + ((size_t)(g * 1024 + (row >> 4)) * 512 + 16 * (row & 15) + q0)
                                              : XC + ((size_t)(g * 32 + ((row - 16384) >> 4)) * 512 + 16 * (row & 15) + q0);
                    const f32x4 v0 = acc[ai][bj][m][0], v1 = acc[ai][bj][m][1];
                    u32x4 w; w.x = cvt_pk_bf16(v0[0], v0[1]); w.y = cvt_pk_bf16(v0[2], v0[3]); w.z = cvt_pk_bf16(v1[0], v1[1]); w.w = cvt_pk_bf16(v1[2], v1[3]);
                    *(u32x4*)dst = w; } }
    }
};
struct EpiS5State {
    static constexpr bool PERM = true, AFTER_DRAIN = false;
    bf16_t* SL;
    __device__ __forceinline__ void operator()(const f32x4 (&acc)[2][2][4][2], const Unit& u, int wr, int wc, int fr, int fq) const {
        const int row0 = u.pm * BM + wr * 64 + fr, col0 = wc * 32 + 8 * fq;
#pragma unroll
        for (int ai = 0; ai < 2; ++ai)
#pragma unroll
            for (int m = 0; m < 4; ++m) { bf16_t* rowp = SL + (size_t)(row0 + ai * HALF + m * 16) * 256 + col0;
#pragma unroll
                for (int bj = 0; bj < 2; ++bj) { const f32x4 v0 = acc[ai][bj][m][0], v1 = acc[ai][bj][m][1];
                    u32x4 w; w.x = cvt_pk_bf16(v0[0], v0[1]); w.y = cvt_pk_bf16(v0[2], v0[3]); w.z = cvt_pk_bf16(v1[0], v1[1]); w.w = cvt_pk_bf16(v1[2], v1[3]);
                    *(u32x4*)(rowp + bj * HALF) = w; } }
    }
};
struct EpiS5Out {
    static constexpr bool PERM = true, AFTER_DRAIN = false;
    bf16_t* Z;
    __device__ __forceinline__ void operator()(const f32x4 (&acc)[2][2][4][2], const Unit& u, int wr, int wc, int fr, int fq) const {
        const int c0 = (u.pm & 3) * BM + wr * 64 + fr, g = u.pn;
#pragma unroll
        for (int ai = 0; ai < 2; ++ai)
#pragma unroll
            for (int m = 0; m < 4; ++m) { const int c = c0 + ai * HALF + m * 16;
#pragma unroll
                for (int bj = 0; bj < 2; ++bj) { const int n0 = bj * HALF + wc * 32 + 8 * fq, t = n0 >> 4, q0 = n0 & 15;
                    f32x4 v0 = acc[ai][bj][m][0], v1 = acc[ai][bj][m][1];
#pragma unroll
                    for (int e = 0; e < 4; ++e) { v0[e] = gelu_tanh_f(v0[e]); v1[e] = gelu_tanh_f(v1[e]); }
                    u32x4 w; w.x = cvt_pk_bf16(v0[0], v0[1]); w.y = cvt_pk_bf16(v0[2], v0[3]); w.z = cvt_pk_bf16(v1[0], v1[1]); w.w = cvt_pk_bf16(v1[2], v1[3]);
                    *(u32x4*)(Z + (size_t)(16 * c + t) * 2048 + 16 * g + q0) = w; } }
    }
};

template <class Epi, class Sched, bool ALIGN_EPI = false, bool SP2 = false>
__device__ __forceinline__ void gemm_phase(PG8_LAS unsigned char* lds, const Gemm g, const Sched& S, const Epi& E) {
    int tid_ = threadIdx.x; asm volatile("" : "+v"(tid_));
    const int tid = tid_, wid = __builtin_amdgcn_readfirstlane(tid >> 6), lane = tid & 63, wr = wid >> 2, wc = wid & 3, fr = lane & 15, fq = lane >> 4;
    const int K = g.K, nt = K / BK, lda = g.lda ? g.lda : K;
    unsigned voffA[2], voffB[2];
#pragma unroll
    for (int i = 0; i < 2; ++i) { int R, C; stage_rc(tid * 16 + i * 8192, R, C); const int Rb = Epi::PERM ? ((R & ~31) + perm32(R & 31)) : R;
        voffA[i] = (unsigned)(R * lda + C) * 2u; voffB[i] = (unsigned)(Rb * K + C) * 2u; }
    const size_t kstep = (size_t)(BK * 2);
    const size_t hstepB = (size_t)HALF * K * 2, hstepA = (size_t)HALF * lda * 2;
    const size_t tstepB = 2 * hstepB, tstepA = 2 * hstepA;
    const unsigned ldsw = (unsigned)wid * 1024u;
    const int aoff = lds_byte(wr * 64 + fr, fq * 8), boff = lds_byte(wc * 32 + fr, fq * 8);
#define PG8_SA(b, h) (((b) * 2 + (h)) * HTB)
#define PG8_SB(b, h) ((4 + (b) * 2 + (h)) * HTB)
#define PG8_STAGE(bufoff, gbase, voff) do { _Pragma("unroll") for (int _i = 0; _i < 2; ++_i) \
        __builtin_amdgcn_global_load_lds((const unsigned*)((const char*)(gbase) + (voff)[_i]), (PG8_LAS unsigned*)(lds + (bufoff) + ldsw + _i * 8192), 16, 0, 0); } while (0)
#define PG8_LDA(dst, b, h) do { _Pragma("unroll") for (int m = 0; m < 4; ++m) _Pragma("unroll") for (int k = 0; k < 2; ++k) dst[m][k] = *(const PG8_LAS bf16x8*)(lds + PG8_SA(b, h) + aoff + m * 2048 + k * 1024); } while (0)
#define PG8_LDB(dst, b, h) do { _Pragma("unroll") for (int n = 0; n < 2; ++n) _Pragma("unroll") for (int k = 0; k < 2; ++k) dst[n][k] = *(const PG8_LAS bf16x8*)(lds + PG8_SB(b, h) + boff + n * 2048 + k * 1024); } while (0)
#define PG8_MMA(ai, bj, At, Bt) do { __builtin_amdgcn_s_setprio(1); _Pragma("unroll") for (int m = 0; m < 4; ++m) _Pragma("unroll") for (int n = 0; n < 2; ++n) _Pragma("unroll") for (int k = 0; k < 2; ++k) \
        acc[ai][bj][m][n] = __builtin_amdgcn_mfma_f32_16x16x32_bf16(Bt[n][k], At[m][k], acc[ai][bj][m][n], 0, 0, 0); __builtin_amdgcn_s_setprio(0); } while (0)
#define PG8_WAIT_V(n) asm volatile("s_waitcnt vmcnt(" #n ")" ::: "memory")
#define PG8_WAIT_L(n) asm volatile("s_waitcnt lgkmcnt(" #n ")" ::: "memory")
#define PG8_BAR __builtin_amdgcn_s_barrier()
#define PG8_SCHED __builtin_amdgcn_sched_barrier(0)
    Unit cur, nxt; int ui = 0;
    if (!S.next(0, cur)) return;
    f32x4 acc[2][2][4][2];
#pragma unroll
    for (int a = 0; a < 2; ++a)
#pragma unroll
        for (int b = 0; b < 2; ++b)
#pragma unroll
            for (int m = 0; m < 4; ++m)
#pragma unroll
                for (int n = 0; n < 2; ++n) acc[a][b][m][n] = (f32x4){0.f, 0.f, 0.f, 0.f};
    bf16x8 At[4][2], B0[2][2], B1[2][2];
    const char* cA = (const char*)g.A + (size_t)cur.pm * tstepA; const char* cB = (const char*)g.Bt + (size_t)cur.pn * tstepB;
    S.a_ready(cur);
    if constexpr (SP2) {
        PG8_STAGE(PG8_SB(0, 0), cB, voffB); PG8_STAGE(PG8_SB(0, 1), cB + hstepB, voffB); PG8_STAGE(PG8_SA(0, 0), cA, voffA); PG8_STAGE(PG8_SA(0, 1), cA + hstepA, voffA);
        if (wr == 1) PG8_BAR;
        PG8_WAIT_V(2); PG8_BAR;
        PG8_STAGE(PG8_SB(1, 0), cB + kstep, voffB); PG8_STAGE(PG8_SA(1, 0), cA + kstep, voffA); PG8_STAGE(PG8_SB(1, 1), cB + hstepB + kstep, voffB);
        PG8_WAIT_V(6); PG8_BAR;
    } else {
        PG8_STAGE(PG8_SB(0, 0), cB, voffB); PG8_STAGE(PG8_SA(0, 0), cA, voffA); PG8_STAGE(PG8_SB(0, 1), cB + hstepB, voffB); PG8_STAGE(PG8_SA(0, 1), cA + hstepA, voffA);
        if (wr == 1) PG8_BAR;
        PG8_WAIT_V(4); PG8_BAR;
        PG8_STAGE(PG8_SB(1, 0), cB + kstep, voffB); PG8_STAGE(PG8_SA(1, 0), cA + kstep, voffA); PG8_STAGE(PG8_SB(1, 1), cB + hstepB + kstep, voffB);
        PG8_WAIT_V(6); PG8_BAR;
    }
    for (;;) {
        const bool has_next = S.next(ui + 1, nxt);
        const char* nA = has_next ? (const char*)g.A + (size_t)nxt.pm * tstepA : cA; const char* nB = has_next ? (const char*)g.Bt + (size_t)nxt.pn * tstepB : cB;
#pragma unroll 1
        for (int t = 0; t < nt; t += 2) {
            const bool last = (t == nt - 2);
            const char* a1 = cA + (size_t)(t + 1) * kstep;
            const char* a2 = last ? nA : cA + (size_t)(t + 2) * kstep; const char* b2 = last ? nB : cB + (size_t)(t + 2) * kstep;
            const char* a3 = a2 + kstep; const char* b3 = b2 + kstep;
            if (last && has_next) S.a_ready(nxt);
            if constexpr (SP2) {
            PG8_LDB(B0, 0, 0); PG8_LDB(B1, 0, 1); PG8_SCHED; PG8_LDA(At, 0, 0); PG8_STAGE(PG8_SA(1, 1), a1 + hstepA, voffA);
            PG8_WAIT_V(8); PG8_WAIT_L(0); PG8_BAR; PG8_MMA(0, 0, At, B0); PG8_MMA(0, 1, At, B1); PG8_BAR; PG8_SCHED;
            PG8_LDA(At, 0, 1); PG8_STAGE(PG8_SB(0, 0), b2, voffB); PG8_STAGE(PG8_SB(0, 1), b2 + hstepB, voffB); PG8_STAGE(PG8_SA(0, 0), a2, voffA);
            PG8_WAIT_V(8); PG8_WAIT_L(0); PG8_BAR; PG8_MMA(1, 0, At, B0); PG8_MMA(1, 1, At, B1); PG8_BAR; PG8_SCHED;
            PG8_LDB(B0, 1, 0); PG8_LDB(B1, 1, 1); PG8_SCHED; PG8_LDA(At, 1, 0); PG8_STAGE(PG8_SA(0, 1), a2 + hstepA, voffA);
            PG8_WAIT_V(8); PG8_WAIT_L(0); PG8_BAR; PG8_MMA(0, 0, At, B0); PG8_MMA(0, 1, At, B1); PG8_BAR; PG8_SCHED;
            PG8_LDA(At, 1, 1); PG8_STAGE(PG8_SB(1, 0), b3, voffB); PG8_STAGE(PG8_SB(1, 1), b3 + hstepB, voffB); PG8_STAGE(PG8_SA(1, 0), a3, voffA);
            PG8_WAIT_V(8); PG8_WAIT_L(0); PG8_BAR; PG8_MMA(1, 0, At, B0); PG8_MMA(1, 1, At, B1); PG8_BAR; PG8_SCHED;
            } else {
            PG8_LDB(B0, 0, 0); PG8_SCHED; PG8_LDA(At, 0, 0); PG8_STAGE(PG8_SA(1, 1), a1 + hstepA, voffA);
            PG8_WAIT_L(8); PG8_BAR; PG8_WAIT_L(0); PG8_MMA(0, 0, At, B0); PG8_BAR; PG8_SCHED;
            PG8_LDB(B1, 0, 1); PG8_STAGE(PG8_SB(0, 0), b2, voffB);
            PG8_BAR; PG8_WAIT_L(0); PG8_MMA(0, 1, At, B1); PG8_BAR;
            PG8_LDA(At, 0, 1); PG8_STAGE(PG8_SA(0, 0), a2, voffA);
            PG8_BAR; PG8_WAIT_L(0); PG8_MMA(1, 0, At, B0); PG8_BAR; PG8_SCHED;
            PG8_STAGE(PG8_SB(0, 1), b2 + hstepB, voffB);
            PG8_WAIT_V(6); PG8_BAR; PG8_MMA(1, 1, At, B1); PG8_BAR;
            PG8_LDB(B0, 1, 0); PG8_SCHED; PG8_LDA(At, 1, 0); PG8_STAGE(PG8_SA(0, 1), a2 + hstepA, voffA);
            PG8_WAIT_L(8); PG8_BAR; PG8_WAIT_L(0); PG8_MMA(0, 0, At, B0); PG8_BAR; PG8_SCHED;
            PG8_LDB(B1, 1, 1); PG8_STAGE(PG8_SB(1, 0), b3, voffB);
            PG8_BAR; PG8_WAIT_L(0); PG8_MMA(0, 1, At, B1); PG8_BAR;
            PG8_LDA(At, 1, 1); PG8_STAGE(PG8_SA(1, 0), a3, voffA);
            PG8_BAR; PG8_WAIT_L(0); PG8_MMA(1, 0, At, B0); PG8_BAR; PG8_SCHED;
            PG8_STAGE(PG8_SB(1, 1), b3 + hstepB, voffB);
            PG8_WAIT_V(6); PG8_BAR; PG8_MMA(1, 1, At, B1); PG8_BAR;
            }
        }
        if constexpr (ALIGN_EPI) { if (wr == 0) PG8_BAR; }
        if constexpr (!Epi::AFTER_DRAIN) { E(acc, cur, wr, wc, fr, fq); S.done(cur); }
        if (!has_next) break;
#pragma unroll
        for (int a = 0; a < 2; ++a)
#pragma unroll
            for (int b = 0; b < 2; ++b)
#pragma unroll
                for (int m = 0; m < 4; ++m)
#pragma unroll
                    for (int n = 0; n < 2; ++n) acc[a][b][m][n] = (f32x4){0.f, 0.f, 0.f, 0.f};
        cur = nxt; cA = nA; cB = nB; ++ui;
        if constexpr (ALIGN_EPI) { if (wr == 1) PG8_BAR; }
    }
    PG8_WAIT_V(0);
    if constexpr (!ALIGN_EPI) { if (wr == 0) PG8_BAR; }
    PG8_BAR;
    if constexpr (Epi::AFTER_DRAIN) { E.fused(acc, cur, wr, wc, fr, fq, lds, wid, lane); S.done(cur); }
#undef PG8_SA
#undef PG8_SB
#undef PG8_STAGE
#undef PG8_LDA
#undef PG8_LDB
#undef PG8_MMA
#undef PG8_WAIT_V
#undef PG8_WAIT_L
#undef PG8_BAR
#undef PG8_SCHED
}
}

constexpr int NWAVES = 8, NTHR = NWAVES * 64;
constexpr int D = 2048, BATCH = 2, SEQ = 8192, ML = BATCH * SEQ, CTXL = 256, MC = BATCH * CTXL, M = ML + MC;
constexpr int FF = 5632, EA = 4096, NH = 16, HDIM = 256, CHUNK = 128, NCHUNK = M / CHUNK;
constexpr int SG = 128, SP = 64, SQ = 16;
constexpr int DEPTH = 4;
constexpr float EPS = 1e-6f;
static_assert(M % 256 == 0 && NCHUNK == 132, "row tiling");

constexpr size_t MiB = 1u << 20;
constexpr size_t WS_CTL = 0, CTL_ZERO_BYTES = 1 * MiB;
constexpr size_t WS_MOD = 1 * MiB;
constexpr size_t WS_S5A = 2 * MiB;
constexpr size_t WS_S5B = 3 * MiB;
constexpr size_t WS_WSB = 11 * MiB;
constexpr size_t WS_VSTAT = 12 * MiB;
constexpr size_t WS_WGIN = 32 * MiB;
constexpr size_t WS_WGOUT = 96 * MiB;
constexpr size_t WS_WF13 = 128 * MiB;
constexpr size_t WS_WF2 = 304 * MiB;
constexpr size_t WS_WSIN = 392 * MiB;
constexpr size_t WS_WGLU = 408 * MiB;
constexpr size_t WS_H = 440 * MiB;
constexpr size_t WS_XN = 572 * MiB;
constexpr size_t WS_BIG = 640 * MiB;
constexpr size_t WS_ZU = WS_BIG, WS_ZV = WS_BIG + 132 * MiB;
constexpr size_t WS_HID = WS_BIG;
constexpr size_t WS_SU = WS_BIG, WS_SZ = WS_BIG + 66 * MiB;
constexpr size_t WS_YF = WS_BIG + 132 * MiB, WS_YB = WS_BIG + 264 * MiB;
constexpr size_t WS_XL = WS_BIG, WS_XC = WS_BIG + 128 * MiB;
constexpr size_t WS_SL = WS_BIG + 132 * MiB, WS_SC = WS_BIG + 196 * MiB;
constexpr size_t WS_SZ2 = WS_BIG + 200 * MiB;
constexpr size_t WS_MOUTT = WS_BIG + 396 * MiB;
constexpr size_t WS_M2T = WS_MOUTT + 64 * MiB;
constexpr size_t WS_A16 = WS_M2T + 32 * MiB;
constexpr size_t WS_END = WS_A16 + 1 * MiB;
#ifndef S5_NAIVE
#define S5_NAIVE 0
#endif
constexpr size_t WS_Z = S5_NAIVE ? WS_SZ : WS_SZ2;
constexpr int CW_BAR = 4096;

constexpr int RING_OFF = 0, RING_BYTES = 131072;
constexpr int LDSCTL_OFF = RING_BYTES, MISC_OFF = LDSCTL_OFF + 320;
constexpr int LDS_BYTES = 147456;
static_assert(MISC_OFF + 128 <= LDS_BYTES, "LDS map");

#define GAS __attribute__((address_space(1)))
#define LAS __attribute__((address_space(3)))
typedef unsigned short bf16;
typedef unsigned v4u __attribute__((ext_vector_type(4)));
typedef unsigned v2u __attribute__((ext_vector_type(2)));
typedef float f32x4 __attribute__((ext_vector_type(4)));
typedef float f32x2 __attribute__((ext_vector_type(2)));
typedef float f32x16 __attribute__((ext_vector_type(16)));
typedef short bf16x8 __attribute__((ext_vector_type(8)));
typedef GAS unsigned gu32;
#define RLX_AGENT __ATOMIC_RELAXED, __HIP_MEMORY_SCOPE_AGENT
#define LDS_WAIT() asm volatile("s_waitcnt lgkmcnt(0)" ::: "memory")
__device__ __forceinline__ unsigned f2bf(float f) { unsigned u = __builtin_bit_cast(unsigned, f); return (u + 0x7fffu + ((u >> 16) & 1u)) >> 16; }
__device__ __forceinline__ unsigned pk2(float lo, float hi) { return f2bf(lo) | (f2bf(hi) << 16); }
__device__ __forceinline__ float bf2f(unsigned short b) { return __builtin_bit_cast(float, (unsigned)b << 16); }
__device__ __forceinline__ float wave_sum(float v) {
#pragma unroll
    for (int o = 1; o < 64; o <<= 1) v += __shfl_xor(v, o);
    return v;
}

#define XB_TMO      128
#define XB_XCNT(j)  (256  + 64 * (j))
#define XB_XSUB(j)  (1280 + 64 * (j))
#define XB_XGEN(j)  (2304 + 64 * (j))
#define XB_TOP      3328
#define XB_TOPGEN   3392
#define XCD_BAR_WORDS 3456
#define XB_SPIN_CAP (1u << 18)

__device__ __forceinline__ unsigned xb_ld(unsigned* p)              { return __hip_atomic_load(p, __ATOMIC_RELAXED, __HIP_MEMORY_SCOPE_AGENT); }
__device__ __forceinline__ unsigned xb_add(unsigned* p, unsigned v) { return __hip_atomic_fetch_add(p, v, __ATOMIC_RELAXED, __HIP_MEMORY_SCOPE_AGENT); }
__device__ __forceinline__ unsigned xb_xcc_id() { return (unsigned)__builtin_amdgcn_s_getreg((3 << 11) | 20) & 0xFu; }
#define XB_SPIN(cond, bar) do { unsigned _sp = 0; while (cond) { __builtin_amdgcn_s_sleep(1); \
    if ((++_sp & 255u) == 0u) { if (xb_ld(&(bar)[XB_TMO])) break; if (_sp > XB_SPIN_CAP) { atomicAdd(&(bar)[XB_TMO], 1u); break; } } } } while (0)

struct XcdBarrier {
    unsigned* bar; unsigned x;
    volatile LAS unsigned* st;
};

__device__ __forceinline__ XcdBarrier xcd_barrier_post(unsigned* bar, volatile LAS unsigned* st) {
    XcdBarrier b; b.bar = bar; b.x = xb_xcc_id(); b.st = st;
    if (threadIdx.x == 0) (void)xb_add(&bar[XB_XCNT(b.x)], 1u);
    return b;
}
__device__ __forceinline__ void xcd_barrier_complete(unsigned* bar, unsigned x, unsigned& nloc, unsigned& nx) {
    const unsigned G = gridDim.x * gridDim.y * gridDim.z;
    unsigned sum, cnt, mine, sp = 0u;
    for (;;) {
        sum = 0u; cnt = 0u; mine = 0u;
#pragma unroll
        for (unsigned j = 0; j < 16; ++j) { const unsigned c = xb_ld(&bar[XB_XCNT(j)]); sum += c; cnt += (c > 0u) ? 1u : 0u; mine = (j == x) ? c : mine; }
        if (sum == G) break;
        __builtin_amdgcn_s_sleep(1);
        if ((++sp & 255u) == 0u) { if (xb_ld(&bar[XB_TMO])) break; if (sp > XB_SPIN_CAP) { atomicAdd(&bar[XB_TMO], 1u); break; } }
    }
    nloc = mine > 0u ? mine : 1u; nx = cnt > 0u ? cnt : 1u;
}

__device__ __forceinline__ void xcd_barrier(const XcdBarrier& b) {
    asm volatile("s_waitcnt vmcnt(0)" ::: "memory");
    __syncthreads();
    if (threadIdx.x == 0) {
        unsigned* bar = b.bar;
        __builtin_amdgcn_s_waitcnt(0);
        unsigned nloc = b.st[0], nx = b.st[1];
        if (nloc == 0u) { xcd_barrier_complete(bar, b.x, nloc, nx); b.st[0] = nloc; b.st[1] = nx; }
        const unsigned old = xb_add(&bar[XB_XSUB(b.x)], 1u);
        const unsigned gen = old / nloc;
        if (old + 1u == (gen + 1u) * nloc) {
            __builtin_amdgcn_fence(__ATOMIC_RELEASE, "agent");
            asm volatile("s_waitcnt vmcnt(0)" ::: "memory");
            const unsigned og = xb_add(&bar[XB_TOP], 1u);
            const unsigned tg = og / nx;
            if (og + 1u == (tg + 1u) * nx) xb_add(&bar[XB_TOPGEN], 1u);
            else XB_SPIN(xb_ld(&bar[XB_TOPGEN]) == tg, bar);
            __builtin_amdgcn_fence(__ATOMIC_ACQUIRE, "agent");
            xb_add(&bar[XB_XGEN(b.x)], 1u);
            asm volatile("s_waitcnt vmcnt(0)" ::: "memory");
        } else {
            XB_SPIN(xb_ld(&bar[XB_XGEN(b.x)]) == gen, bar);
            __builtin_amdgcn_fence(__ATOMIC_ACQUIRE, "agent");
            asm volatile("s_waitcnt vmcnt(0)" ::: "memory");
        }
    }
    __syncthreads();
}

struct Args { const float* in[28]; float* out; unsigned char* ws; int ph_lo, ph_hi; };
enum InIdx { I_X = 0, I_C, I_CTX, I_CCTX, I_ADAW, I_ADAB, I_N1G, I_N2G, I_W1, I_W3, I_W2, I_GWIN, I_GLNG, I_GLNB, I_GWS, I_GBS, I_GWOUT,
             I_SWIN, I_SARE, I_SAIM, I_SLDT, I_SBRE, I_SBIM, I_SCRE, I_SCIM, I_SD, I_SWGLU, I_FING };

__device__ __forceinline__ int opaque_tid() { int t = threadIdx.x; asm volatile("" : "+v"(t)); return t; }
#define PHASE_IDS const int tid = opaque_tid(), lane = tid & 63, wave = __builtin_amdgcn_readfirstlane(tid >> 6); (void)tid; (void)lane; (void)wave

__device__ __forceinline__ void adaln_items(const Args& a, LAS unsigned char* lds, int wg, int nwg) {
    PHASE_IDS;
    LAS float* cs = (LAS float*)lds;
    LAS float* red = cs + 3 * 2048;
    const float* c = a.in[I_C]; const float* cc = a.in[I_CCTX];
    for (int i = tid; i < 3 * 2048; i += NTHR) { const int s = i >> 11, k = i & 2047; const float v = s < 2 ? c[s * 2048 + k] : cc[k]; cs[i] = v / (1.0f + expf(-v)); }
    __syncthreads();
    float* MOD = (float*)(a.ws + WS_MOD);
    const int cq = tid & 15, kg = tid >> 4;
    for (int item = wg; item < DEPTH * 192; item += nwg) {
        const int layer = item / 192, n0 = (item % 192) * 64;
        const float* W = a.in[I_ADAW] + (size_t)layer * 2048 * 12288 + n0 + 4 * cq;
        f32x4 a0 = {0.f, 0.f, 0.f, 0.f}, a1 = a0, a2 = a0;
#pragma unroll 8
        for (int k = kg; k < 2048; k += 32) { const f32x4 w = *(const GAS f32x4*)(W + (size_t)k * 12288); a0 += cs[k] * w; a1 += cs[2048 + k] * w; a2 += cs[4096 + k] * w; }
#pragma unroll
        for (int e = 0; e < 4; ++e) { red[(kg * 3 + 0) * 64 + 4 * cq + e] = a0[e]; red[(kg * 3 + 1) * 64 + 4 * cq + e] = a1[e]; red[(kg * 3 + 2) * 64 + 4 * cq + e] = a2[e]; }
        __syncthreads();
        if (tid < 192) { const int s = tid >> 6, col = tid & 63; float t = 0.f;
            for (int g = 0; g < 32; ++g) t += red[(g * 3 + s) * 64 + col];
            MOD[(size_t)(layer * 3 + s) * 12288 + n0 + col] = t + a.in[I_ADAB][layer * 12288 + n0 + col]; }
        __syncthreads();
    }
}
__device__ __forceinline__ void tr_item(const float* W, int ld, int K, int ncols, bf16* WT, int mode, LAS float* scr, int item, int lane) {
    const int nblk = ncols / 32, kb = item / nblk, nb = item % nblk, k0 = 64 * kb, n0 = 32 * nb;
    const int drow0 = mode == 0 ? n0 : (256 * (n0 >> 7) + (n0 & 127) + (mode == 2 ? 128 : 0));
#pragma unroll 8
    for (int i = 0; i < 32; ++i) { const int kk = 2 * i + (lane >> 5); scr[kk * 33 + (lane & 31)] = W[(size_t)(k0 + kk) * ld + n0 + (lane & 31)]; }
    LDS_WAIT(); asm volatile("" ::: "memory");
    const int c = lane & 7;
#pragma unroll
    for (int j = 0; j < 4; ++j) { const int n = (lane >> 3) + 8 * j; const LAS float* s = scr + (8 * c) * 33 + n;
        v4u o; o.x = pk2(s[0 * 33], s[1 * 33]); o.y = pk2(s[2 * 33], s[3 * 33]); o.z = pk2(s[4 * 33], s[5 * 33]); o.w = pk2(s[6 * 33], s[7 * 33]);
        *(GAS v4u*)(WT + (size_t)(drow0 + n) * K + k0 + 8 * c) = o; }
    LDS_WAIT(); asm volatile("" ::: "memory");
}
constexpr int TR_GIN = 2 * 8192, TR_GOUT = 2 * 4096, TR_FFN = 4 * 3 * 5632, TR_SIN = 2 * 2048, TR_GLU = 2 * 2 * 2048, TR_TOTAL = TR_GIN + TR_GOUT + TR_FFN + TR_SIN + TR_GLU;
__device__ __forceinline__ void transpose_items(const Args& a, LAS unsigned char* lds, int vcu, int G) {
    PHASE_IDS; const int gw = vcu * NWAVES + wave, ngw = G * NWAVES;
    LAS float* scr = (LAS float*)(lds + wave * 16384);
    unsigned char* ws = a.ws;
    for (int it0 = gw; it0 < TR_TOTAL; it0 += ngw) {
        int it = it0;
        if (it < TR_GIN) { const int j = it / 8192, r = it % 8192; tr_item(a.in[I_GWIN] + (size_t)j * 2048 * 8192, 8192, 2048, 8192, (bf16*)(ws + WS_WGIN) + (size_t)j * 8192 * 2048, 0, scr, r, lane); continue; } it -= TR_GIN;
        if (it < TR_GOUT) { const int j = it / 4096, r = it % 4096; tr_item(a.in[I_GWOUT] + (size_t)j * 4096 * 2048, 2048, 4096, 2048, (bf16*)(ws + WS_WGOUT) + (size_t)j * 2048 * 4096, 0, scr, r, lane); continue; } it -= TR_GOUT;
        if (it < TR_FFN) { const int i = it / 16896, r = it % 16896, which = r / 5632, rr = r % 5632;
            if (which == 0) tr_item(a.in[I_W1] + (size_t)i * 2048 * 5632, 5632, 2048, 5632, (bf16*)(ws + WS_WF13) + (size_t)i * 11264 * 2048, 1, scr, rr, lane);
            else if (which == 1) tr_item(a.in[I_W3] + (size_t)i * 2048 * 5632, 5632, 2048, 5632, (bf16*)(ws + WS_WF13) + (size_t)i * 11264 * 2048, 2, scr, rr, lane);
            else tr_item(a.in[I_W2] + (size_t)i * 5632 * 2048, 2048, 5632, 2048, (bf16*)(ws + WS_WF2) + (size_t)i * 2048 * 5632, 0, scr, rr, lane);
            continue; } it -= TR_FFN;
        if (it < TR_SIN) { const int j = it / 2048, r = it % 2048; tr_item(a.in[I_SWIN] + (size_t)j * 2048 * 2048, 2048, 2048, 2048, (bf16*)(ws + WS_WSIN) + (size_t)j * 2048 * 2048, 0, scr, r, lane); continue; } it -= TR_SIN;
        { const int j = it / 4096, r = it % 4096, half = r / 2048, rr = r % 2048;
          tr_item(a.in[I_SWGLU] + (size_t)j * 2048 * 4096 + half * 2048, 4096, 2048, 2048, (bf16*)(ws + WS_WGLU) + (size_t)j * 4096 * 2048, 1 + half, scr, rr, lane); }
    }
}
__device__ __forceinline__ void small_prologue(const Args& a, int vcu, int G) {
    PHASE_IDS; const int gtid = vcu * NTHR + tid, ngt = G * NTHR;
    bf16* WSB = (bf16*)(a.ws + WS_WSB);
    for (int i = gtid; i < 2 * 16 * 128 * 128; i += ngt) WSB[i] = (bf16)f2bf(a.in[I_GWS][i]);
    f32x2* S5A = (f32x2*)(a.ws + WS_S5A); f32x2* S5B = (f32x2*)(a.ws + WS_S5B);
    for (int i = gtid; i < 2 * 2 * SG * SP; i += ngt) {
        const int lg = i / SP;
        const float dt = expf(a.in[I_SLDT][lg]), are = a.in[I_SARE][i], aim = a.in[I_SAIM][i];
        const float e = expf(dt * are), th = dt * aim, abr = e * cosf(th), abi = e * sinf(th);
        f32x2 ab; ab.x = abr; ab.y = abi; S5A[i] = ab;
        const float nr = abr - 1.0f, ni = abi, den = 1.0f / (are * are + aim * aim);
        const float cr = (nr * are + ni * aim) * den, ci = (ni * are - nr * aim) * den;
        for (int q = 0; q < SQ; ++q) { const float br = a.in[I_SBRE][(size_t)i * SQ + q], bi = a.in[I_SBIM][(size_t)i * SQ + q];
            f32x2 o; o.x = cr * br - ci * bi; o.y = cr * bi + ci * br; S5B[(size_t)i * SQ + q] = o; }
    }
}

template <bool INIT> __device__ __forceinline__ void norm_phase(const Args& a, const float* gain, const float* modl  , int which, int vcu, int G) {
    PHASE_IDS; const int gw = vcu * NWAVES + wave, ngw = G * NWAVES;
    float* H = (float*)(a.ws + WS_H); bf16* XN = (bf16*)(a.ws + WS_XN);
    for (int row = gw; row < M; row += ngw) {
        const int set = row < ML ? (row >> 13) : 2;
        GAS f32x4* hr = (GAS f32x4*)(H + (size_t)row * D) + lane;
        f32x4 v[8];
        if (INIT) {
            if (row < ML) {
                const GAS f32x4* xr = (const GAS f32x4*)(a.in[I_X] + (size_t)row * D) + lane;
#pragma unroll
                for (int j = 0; j < 8; ++j) v[j] = xr[64 * j];
                const int t = row & (SEQ - 1); const float pr = (float)(t >> 6), pc = (float)(t & 63);
#pragma unroll
                for (int jj = 0; jj < 2; ++jj)
#pragma unroll
                    for (int e = 0; e < 4; ++e) { const float om = exp2f(-(float)(256 * jj + 4 * lane + e) * (13.287712379549449f / 512.0f));
                        const float ar = pr * om, ac = pc * om;
                        v[0 + jj][e] += sinf(ar); v[2 + jj][e] += cosf(ar); v[4 + jj][e] += sinf(ac); v[6 + jj][e] += cosf(ac); }
            } else {
                const GAS f32x4* xr = (const GAS f32x4*)(a.in[I_CTX] + (size_t)(row - ML) * D) + lane;
#pragma unroll
                for (int j = 0; j < 8; ++j) v[j] = xr[64 * j];
            }
#pragma unroll
            for (int j = 0; j < 8; ++j) hr[64 * j] = v[j];
        } else {
#pragma unroll
            for (int j = 0; j < 8; ++j) v[j] = hr[64 * j];
        }
        float ss = 0.f;
#pragma unroll
        for (int j = 0; j < 8; ++j) ss += (v[j].x * v[j].x + v[j].y * v[j].y) + (v[j].z * v[j].z + v[j].w * v[j].w);
        const float rinv = 1.0f / sqrtf(wave_sum(ss) * (1.0f / D) + EPS);
        const GAS f32x4* gp = (const GAS f32x4*)gain + lane;
        const GAS f32x4* shp = (const GAS f32x4*)(modl + (size_t)set * 12288 + (which * 3 + 0) * D) + lane;
        const GAS f32x4* scp = (const GAS f32x4*)(modl + (size_t)set * 12288 + (which * 3 + 1) * D) + lane;
        GAS v2u* o8 = (GAS v2u*)(XN + (size_t)row * D) + lane;
#pragma unroll
        for (int j = 0; j < 8; ++j) { const f32x4 g = gp[64 * j], sh = shp[64 * j], sc = scp[64 * j];
            const f32x4 y = v[j] * rinv * g * (1.0f + sc) + sh;
            v2u o; o.x = pk2(y.x, y.y); o.y = pk2(y.z, y.w); o8[64 * j] = o; }
    }
}
__device__ __forceinline__ void final_phase(const Args& a, int vcu, int G) {
    PHASE_IDS; const int gw = vcu * NWAVES + wave, ngw = G * NWAVES;
    const float* H = (const float*)(a.ws + WS_H);
    for (int row = gw; row < ML; row += ngw) {
        const GAS f32x4* hr = (const GAS f32x4*)(H + (size_t)row * D) + lane;
        f32x4 v[8]; float ss = 0.f;
#pragma unroll
        for (int j = 0; j < 8; ++j) { v[j] = hr[64 * j]; ss += (v[j].x * v[j].x + v[j].y * v[j].y) + (v[j].z * v[j].z + v[j].w * v[j].w); }
        const float rinv = 1.0f / sqrtf(wave_sum(ss) * (1.0f / D) + EPS);
        const GAS f32x4* gp = (const GAS f32x4*)a.in[I_FING] + lane;
        GAS f32x4* o = (GAS f32x4*)(a.out + (size_t)row * D) + lane;
#pragma unroll
        for (int j = 0; j < 8; ++j) o[64 * j] = v[j] * rinv * gp[64 * j];
    }
}

__device__ __forceinline__ void sgu_phase(const Args& a, int gl  , LAS unsigned char* lds, int wg, int nwg) {
    PHASE_IDS;
    bf16* ZU = (bf16*)(a.ws + WS_ZU); const bf16* ZV = (const bf16*)(a.ws + WS_ZV); const float* VSTAT = (const float*)(a.ws + WS_VSTAT);
    const bf16* WSB = (const bf16*)(a.ws + WS_WSB) + (size_t)gl * 16 * 128 * 128;
    const float* bs = a.in[I_GBS] + gl * 16 * 128; const float* lng = a.in[I_GLNG] + gl * EA; const float* lnb = a.in[I_GLNB] + gl * EA;
    LAS f32x2* st = (LAS f32x2*)lds;
    const int n = lane & 31, h = lane >> 5;
    for (int unit = wg; unit < NCHUNK * NH; unit += nwg) {
        const int c = unit / NH, hd = unit % NH, r0 = c * CHUNK;
        { const int j = tid >> 2, part = tid & 3; const GAS f32x4* p = (const GAS f32x4*)(VSTAT + ((size_t)(r0 + j) * 64 + part * 16) * 2);
          float s = 0.f, ss = 0.f;
#pragma unroll
          for (int q = 0; q < 8; ++q) { const f32x4 w = p[q]; s += w.x + w.z; ss += w.y + w.w; }
          s += __shfl_xor(s, 1); s += __shfl_xor(s, 2); ss += __shfl_xor(ss, 1); ss += __shfl_xor(ss, 2);
          if (part == 0) { const float mean = s * (1.0f / EA), var = ss * (1.0f / EA) - mean * mean; f32x2 o; o.x = mean; o.y = 1.0f / sqrtf(var + EPS); st[j] = o; } }
        __syncthreads();
        const int gcol = hd * HDIM + 32 * wave + n;
        const float lg = lng[gcol], lb = lnb[gcol];
        const GAS bf16* vp = (const GAS bf16*)ZV + (size_t)r0 * EA + gcol;
        unsigned short raw[8][8];
#pragma unroll
        for (int ks = 0; ks < 8; ++ks)
#pragma unroll
            for (int e = 0; e < 8; ++e) raw[ks][e] = vp[(size_t)(16 * ks + 8 * h + e) * EA];
        bf16x8 Bf[8];
#pragma unroll
        for (int ks = 0; ks < 8; ++ks) { float f[8];
#pragma unroll
            for (int e = 0; e < 8; ++e) { const f32x2 m = st[16 * ks + 8 * h + e]; f[e] = (bf2f(raw[ks][e]) - m.x) * m.y * lg + lb; }
            v4u w; w.x = pk2(f[0], f[1]); w.y = pk2(f[2], f[3]); w.z = pk2(f[4], f[5]); w.w = pk2(f[6], f[7]); Bf[ks] = __builtin_bit_cast(bf16x8, w); }
#pragma unroll 1
        for (int ib = 0; ib < 4; ++ib) {
            f32x16 acc;
#pragma unroll
            for (int r = 0; r < 16; ++r) acc[r] = 0.f;
            const GAS bf16x8* ap = (const GAS bf16x8*)(WSB + ((size_t)hd * 128 + 32 * ib + n) * 128 + 8 * h);
#pragma unroll
            for (int ks = 0; ks < 8; ++ks) { const bf16x8 Af = ap[2 * ks]; acc = __builtin_amdgcn_mfma_f32_32x32x16_bf16(Af, Bf[ks], acc, 0, 0, 0); }
#pragma unroll
            for (int r = 0; r < 16; ++r) { const int i = 32 * ib + (r & 3) + 8 * (r >> 2) + 4 * h; const float s = acc[r] + bs[hd * 128 + i];
                GAS bf16* up = (GAS bf16*)ZU + (size_t)(r0 + i) * EA + gcol; *up = (bf16)f2bf(bf2f(*up) * s); }
        }
        __syncthreads();
    }
}

__device__ __forceinline__ void s5_naive_phase(const Args& a, int sl  , int wg, int nwg) {
    PHASE_IDS;
    if (wave >= 2) return;
    const bf16* U = (const bf16*)(a.ws + WS_SU);
    for (int item = wg * 2 + wave; item < 2 * 2 * SG; item += nwg * 2) {
        const int b = item & 1, k = (item >> 1) & 1, g = item >> 2;
        const int pg = ((sl * 2 + k) * SG + g);
        const f32x2 ab = ((const f32x2*)(a.ws + WS_S5A))[(size_t)pg * SP + lane];
        float bre[16], bim[16], cr[16], ci[16];
#pragma unroll
        for (int q = 0; q < 16; ++q) { const f32x2 bb = ((const f32x2*)(a.ws + WS_S5B))[((size_t)pg * SP + lane) * SQ + q]; bre[q] = bb.x; bim[q] = bb.y;
            cr[q] = a.in[I_SCRE][((size_t)pg * SQ + q) * SP + lane]; ci[q] = a.in[I_SCIM][((size_t)pg * SQ + q) * SP + lane]; }
        float* Y = (float*)(a.ws + (k ? WS_YB : WS_YF));
        float hr = 0.f, hi = 0.f;
#pragma unroll 1
        for (int seg = 0; seg < 2; ++seg) {
            const int L = seg ? SEQ : CTXL, base = seg ? b * SEQ : ML + b * CTXL;
#pragma unroll 1
            for (int blk = 0; blk < L; blk += 64) {
                const int myt = k ? (L - 1 - (blk + lane)) : (blk + lane);
                const size_t row = (size_t)(base + myt);
                const GAS v4u* up = (const GAS v4u*)(U + row * D + 16 * g);
                const v4u u0 = up[0], u1 = up[1];
                float keep[16];
#pragma unroll
                for (int q = 0; q < 16; ++q) keep[q] = 0.f;
#pragma unroll 1
                for (int s = 0; s < 64; ++s) {
                    unsigned w[8];
                    w[0] = __builtin_amdgcn_readlane(u0.x, s); w[1] = __builtin_amdgcn_readlane(u0.y, s); w[2] = __builtin_amdgcn_readlane(u0.z, s); w[3] = __builtin_amdgcn_readlane(u0.w, s);
                    w[4] = __builtin_amdgcn_readlane(u1.x, s); w[5] = __builtin_amdgcn_readlane(u1.y, s); w[6] = __builtin_amdgcn_readlane(u1.z, s); w[7] = __builtin_amdgcn_readlane(u1.w, s);
                    float br = 0.f, bi = 0.f;
#pragma unroll
                    for (int q2 = 0; q2 < 8; ++q2) { const float ulo = __builtin_bit_cast(float, w[q2] << 16), uhi = __builtin_bit_cast(float, w[q2] & 0xffff0000u);
                        br += bre[2 * q2] * ulo + bre[2 * q2 + 1] * uhi; bi += bim[2 * q2] * ulo + bim[2 * q2 + 1] * uhi; }
                    const float nhr = ab.x * hr - ab.y * hi + br, nhi = ab.x * hi + ab.y * hr + bi; hr = nhr; hi = nhi;
#pragma unroll
                    for (int q = 0; q < 16; ++q) { const float y = wave_sum(cr[q] * hr - ci[q] * hi); keep[q] = (lane == s) ? y : keep[q]; }
                }
                GAS f32x4* yp = (GAS f32x4*)(Y + row * D + 16 * g);
#pragma unroll
                for (int q4 = 0; q4 < 4; ++q4) { f32x4 o; o.x = keep[4 * q4]; o.y = keep[4 * q4 + 1]; o.z = keep[4 * q4 + 2]; o.w = keep[4 * q4 + 3]; yp[q4] = o; }
            }
        }
    }
}
__device__ __forceinline__ void s5_combine_phase(const Args& a, int sl, int vcu, int G) {
    PHASE_IDS; const int gw = vcu * NWAVES + wave, ngw = G * NWAVES;
    const float* YF = (const float*)(a.ws + WS_YF); const float* YB = (const float*)(a.ws + WS_YB); const bf16* U = (const bf16*)(a.ws + WS_SU); bf16* Z = (bf16*)(a.ws + WS_SZ);
    const GAS f32x4* dp = (const GAS f32x4*)(a.in[I_SD] + sl * D) + lane;
    for (int row = gw; row < M; row += ngw) {
        const GAS f32x4* yf = (const GAS f32x4*)(YF + (size_t)row * D) + lane; const GAS f32x4* yb = (const GAS f32x4*)(YB + (size_t)row * D) + lane;
        const GAS v2u* up = (const GAS v2u*)(U + (size_t)row * D) + lane; GAS v2u* zp = (GAS v2u*)(Z + (size_t)row * D) + lane;
#pragma unroll
        for (int j = 0; j < 8; ++j) { const f32x4 f = yf[64 * j], bk = yb[64 * j], dd = dp[64 * j]; const v2u uu = up[64 * j];
            f32x4 u4; u4.x = __builtin_bit_cast(float, uu.x << 16); u4.y = __builtin_bit_cast(float, uu.x & 0xffff0000u); u4.z = __builtin_bit_cast(float, uu.y << 16); u4.w = __builtin_bit_cast(float, uu.y & 0xffff0000u);
            const f32x4 y = f + bk + u4 * dd;
            v2u o; o.x = pk2(pg8::gelu_tanh_f(y.x), pg8::gelu_tanh_f(y.y)); o.y = pk2(pg8::gelu_tanh_f(y.z), pg8::gelu_tanh_f(y.w)); zp[64 * j] = o; }
    }
}

__device__ __forceinline__ f32x2 cmul(f32x2 a, f32x2 b) { f32x2 r; r.x = a.x * b.x - a.y * b.y; r.y = a.x * b.y + a.y * b.x; return r; }
__device__ __forceinline__ void s5_precompute(const Args& a, LAS unsigned char* lds, int wg, int nwg) {
    PHASE_IDS;
    LAS f32x2* apw = (LAS f32x2*)lds;
    LAS f32x2* bbl = apw + 2 * 17 * 64;
    LAS f32x2* ccl = bbl + 2 * 64 * 16;
    LAS float* ktab = (LAS float*)(ccl + 2 * 16 * 64);
    for (int item = wg; item < 2 * SG; item += nwg) {
        const int sl = item >> 7, g = item & 127;
        if (tid < 128) { const int d = tid >> 6, p = tid & 63, pg = (sl * 2 + d) * SG + g, i = pg * SP + p;
            const float dt = expf(a.in[I_SLDT][pg]), are = a.in[I_SARE][i], aim = a.in[I_SAIM][i];
            for (int l = 0; l <= 16; ++l) { const float e = expf((float)l * (dt * are)), th = (float)l * (dt * aim); f32x2 o; o.x = e * cosf(th); o.y = e * sinf(th); apw[(d * 17 + l) * 64 + p] = o; }
            const f32x2 ab = apw[(d * 17 + 1) * 64 + p];
            const float nr = ab.x - 1.0f, ni = ab.y, den = 1.0f / (are * are + aim * aim);
            f32x2 coef; coef.x = (nr * are + ni * aim) * den; coef.y = (ni * are - nr * aim) * den;
            for (int q = 0; q < SQ; ++q) { f32x2 bq; bq.x = a.in[I_SBRE][(size_t)i * SQ + q]; bq.y = a.in[I_SBIM][(size_t)i * SQ + q]; bbl[(d * 64 + p) * 16 + q] = cmul(coef, bq); }
            ((f32x2*)(a.ws + WS_A16))[i] = apw[(d * 17 + 16) * 64 + p]; }
        for (int e = tid; e < 2 * 16 * 64; e += NTHR) { const int d = e >> 10, q = (e >> 6) & 15, p = e & 63; const size_t ci = ((size_t)((sl * 2 + d) * SG + g) * SQ + q) * SP + p;
            f32x2 o; o.x = a.in[I_SCRE][ci]; o.y = a.in[I_SCIM][ci]; ccl[e] = o; }
        __syncthreads();
        for (int o = tid; o < 8192; o += NTHR) { const int d = o >> 12, l = (o >> 8) & 15, q = (o >> 4) & 15, qp = o & 15; float acc = 0.f;
            for (int p = 0; p < 64; ++p) { const f32x2 ca = cmul(ccl[(d * 16 + q) * 64 + p], apw[(d * 17 + l) * 64 + p]), bb = bbl[(d * 64 + p) * 16 + qp]; acc += ca.x * bb.x - ca.y * bb.y; }
            ktab[o] = acc; }
        __syncthreads();
        bf16* MoutT = (bf16*)(a.ws + WS_MOUTT) + (size_t)(sl * SG + g) * 256 * 512;
        bf16* M2T = (bf16*)(a.ws + WS_M2T) + (size_t)(sl * SG + g) * 256 * 256;
        for (int ch = tid; ch < 256 * 64; ch += NTHR) { const int n = ch >> 6, jj = ch & 63, t = n >> 4, q = n & 15; float v[8];
            if (jj < 32) { const int s = jj >> 1, q0 = 8 * (jj & 1);
#pragma unroll
                for (int e = 0; e < 8; ++e) { const int qp = q0 + e;
                    v[e] = s < t ? ktab[((0 * 16 + (t - s)) * 16 + q) * 16 + qp] : (s > t ? ktab[((1 * 16 + (s - t)) * 16 + q) * 16 + qp]
                         : ktab[(0 * 16 * 16 + q) * 16 + qp] + ktab[((16) * 16 + q) * 16 + qp] + (q == qp ? a.in[I_SD][sl * D + 16 * g + q] : 0.f)); }
            } else { const int j2 = jj - 32, d = j2 >> 4, p0 = (j2 & 15) * 4, ex = d == 0 ? t + 1 : 16 - t;
#pragma unroll
                for (int pp = 0; pp < 4; ++pp) { const f32x2 ca = cmul(ccl[(d * 16 + q) * 64 + p0 + pp], apw[(d * 17 + ex) * 64 + p0 + pp]); v[2 * pp] = ca.x; v[2 * pp + 1] = -ca.y; } }
            v4u w; w.x = pk2(v[0], v[1]); w.y = pk2(v[2], v[3]); w.z = pk2(v[4], v[5]); w.w = pk2(v[6], v[7]);
            *(GAS v4u*)(MoutT + (size_t)n * 512 + 8 * jj) = w; }
        for (int ch = tid; ch < 256 * 32; ch += NTHR) { const int n = ch >> 5, jj = ch & 31, d = n >> 7, p = (n & 127) >> 1, im = n & 1, s = jj >> 1, q0 = 8 * (jj & 1), ex = d == 0 ? 15 - s : s; float v[8];
            const f32x2 ap = apw[(d * 17 + ex) * 64 + p];
#pragma unroll
            for (int e = 0; e < 8; ++e) { const f32x2 r = cmul(ap, bbl[(d * 64 + p) * 16 + q0 + e]); v[e] = im ? r.y : r.x; }
            v4u w; w.x = pk2(v[0], v[1]); w.y = pk2(v[2], v[3]); w.z = pk2(v[4], v[5]); w.w = pk2(v[6], v[7]);
            *(GAS v4u*)(M2T + (size_t)n * 256 + 8 * jj) = w; }
        __syncthreads();
    }
}
template <bool OUT> __device__ __forceinline__ void s5_ctx_gemm(const Args& a, int sl, int wg, int nwg) {
    PHASE_IDS;
    constexpr int K = OUT ? 512 : 256;
    const int r = lane & 31, hh = lane >> 5;
    for (int g = wg; g < SG; g += nwg) {
        const GAS bf16x8* ap = (const GAS bf16x8*)((const bf16*)(a.ws + WS_XC) + (size_t)(g * 32 + r) * 512 + 8 * hh);
        const bf16* Bt = OUT ? (const bf16*)(a.ws + WS_MOUTT) + (size_t)(sl * SG + g) * 256 * 512 : (const bf16*)(a.ws + WS_M2T) + (size_t)(sl * SG + g) * 256 * 256;
        const GAS bf16x8* bp = (const GAS bf16x8*)(Bt + (size_t)(32 * wave + r) * K + 8 * hh);
        f32x16 acc;
#pragma unroll
        for (int i = 0; i < 16; ++i) acc[i] = 0.f;
#pragma unroll 8
        for (int ks = 0; ks < K / 16; ++ks) acc = __builtin_amdgcn_mfma_f32_32x32x16_bf16(ap[2 * ks], bp[2 * ks], acc, 0, 0, 0);
        const int n = 32 * wave + r;
#pragma unroll
        for (int i = 0; i < 16; ++i) { const int c = (i & 3) + 8 * (i >> 2) + 4 * hh;
            if (OUT) { const int t = n >> 4, q = n & 15; ((GAS bf16*)(a.ws + WS_Z))[(size_t)(ML + 16 * c + t) * D + 16 * g + q] = (bf16)f2bf(pg8::gelu_tanh_f(acc[i])); }
            else ((GAS bf16*)(a.ws + WS_SC))[(size_t)(g * 32 + c) * 256 + n] = (bf16)f2bf(acc[i]); }
    }
}
__device__ __forceinline__ void s5_carry_phase(const Args& a, int sl, int wg, int nwg) {
    PHASE_IDS;
    if (wave >= 2) return;
    for (int item = wg * 2 + wave; item < 2 * 2 * SG; item += nwg * 2) {
        const int b = item & 1, d = (item >> 1) & 1, g = item >> 2;
        const f32x2 a16 = ((const f32x2*)(a.ws + WS_A16))[(size_t)((sl * 2 + d) * SG + g) * SP + lane];
        const GAS unsigned* SLw = (const GAS unsigned*)(a.ws + WS_SL) + (size_t)(g * 1024 + b * 512) * 128 + d * 64 + lane;
        const GAS unsigned* SCw = (const GAS unsigned*)(a.ws + WS_SC) + (size_t)(g * 32 + b * 16) * 128 + d * 64 + lane;
        GAS unsigned* XLw = (GAS unsigned*)(a.ws + WS_XL) + (size_t)(g * 1024 + b * 512) * 256 + 128 + d * 64 + lane;
        GAS unsigned* XCw = (GAS unsigned*)(a.ws + WS_XC) + (size_t)(g * 32 + b * 16) * 256 + 128 + d * 64 + lane;
        float hr = 0.f, hi = 0.f;
        unsigned b0[16], b1[16], b2[16];
#define S5_CIDX(bi, j) ((bi) == 0 ? (d ? 15 - (j) : (j)) : (d ? 511 - (((bi) - 1) * 16 + (j)) : ((bi) - 1) * 16 + (j)))
#define S5_LOAD(bi, arr) do { _Pragma("unroll") for (int j = 0; j < 16; ++j) { const int ci = S5_CIDX(bi, j); arr[j] = (bi) == 0 ? SCw[(size_t)ci * 128] : SLw[(size_t)ci * 128]; } } while (0)
#define S5_PROC(bi, arr) do { _Pragma("unroll") for (int j = 0; j < 16; ++j) { const int ci = S5_CIDX(bi, j); const unsigned hw = pk2(hr, hi); \
            if ((bi) == 0) XCw[(size_t)ci * 256] = hw; else XLw[(size_t)ci * 256] = hw; \
            const float sr = __builtin_bit_cast(float, arr[j] << 16), si = __builtin_bit_cast(float, arr[j] & 0xffff0000u); \
            const float nr = a16.x * hr - a16.y * hi + sr, ni = a16.x * hi + a16.y * hr + si; hr = nr; hi = ni; } } while (0)
        S5_LOAD(0, b0); S5_LOAD(1, b1); S5_LOAD(2, b2);
#pragma unroll 1
        for (int it = 0; it < 11; ++it) { const int bi = 3 * it;
            S5_PROC(bi, b0);     if (bi + 3 < 33) S5_LOAD(bi + 3, b0);
            S5_PROC(bi + 1, b1); if (bi + 4 < 33) S5_LOAD(bi + 4, b1);
            S5_PROC(bi + 2, b2); if (bi + 5 < 33) S5_LOAD(bi + 5, b2);
        }
#undef S5_CIDX
#undef S5_LOAD
#undef S5_PROC
    }
}

#ifndef MK_ONE_LAUNCH
#define MK_ONE_LAUNCH 1
#endif
constexpr int N_PHASES = 2 + 2 * 16;

__global__ void __launch_bounds__(NTHR, 2) fwd_kernel(Args args) {
    extern __shared__ __attribute__((aligned(16))) unsigned char lds_raw[];
    LAS unsigned char* lds = (LAS unsigned char*)lds_raw;
    const int tid = threadIdx.x;
    const int G = gridDim.x, bx = blockIdx.x;
    const int vcu = (G % 8 == 0) ? (bx % 8) * (G / 8) + bx / 8 : bx;
    unsigned char* ws = args.ws;
    volatile LAS unsigned* MISC = (volatile LAS unsigned*)(lds + MISC_OFF);
    for (int u = tid; u < (LDS_BYTES - LDSCTL_OFF) / 4; u += NTHR) ((LAS unsigned*)(lds + LDSCTL_OFF))[u] = 0u;
    __syncthreads();
    const int lo = args.ph_lo, hi = args.ph_hi;
    XcdBarrier bar; bar.bar = (unsigned*)(ws + WS_CTL) + CW_BAR; bar.x = 0; bar.st = nullptr;
    if (hi - lo > 1) bar = xcd_barrier_post((unsigned*)(ws + WS_CTL) + CW_BAR, MISC + 8);
#define RUN(k) (lo <= (k) && (k) < hi)
#define SEAM(k) do { if (RUN(k) && RUN((k) + 1)) xcd_barrier(bar); } while (0)
    float* H = (float*)(ws + WS_H); pg8::bf16_t* XN = (pg8::bf16_t*)(ws + WS_XN);
    const float* MOD = (const float*)(ws + WS_MOD);

#ifndef NO_PRO
    if (RUN(0)) {
        adaln_items(args, lds, vcu, G);
        transpose_items(args, lds, vcu, G);
        small_prologue(args, vcu, G);
#if !S5_NAIVE
        __syncthreads();
        s5_precompute(args, lds, vcu, G);
#endif
    }
#endif
    SEAM(0);
    if (RUN(1)) norm_phase<true>(args, args.in[I_N1G], MOD, 0, vcu, G);
    SEAM(1);

#ifdef UNROLL_LP
#pragma unroll
#else
#pragma unroll 1
#endif
    for (int lp = 0; lp < 2; ++lp) {
        const int pb = 2 + lp * 16;
        {
            const int layer = 2 * lp; const float* modl = MOD + (size_t)layer * 3 * 12288;
            if (RUN(pb + 0)) {
                pg8::Gemm g{XN, (const pg8::bf16_t*)(ws + WS_WGIN) + (size_t)lp * 8192 * 2048, M, 8192, D}; pg8::StaticOrder S; S.init(M, 8192, G, bx);
                pg8::EpiG1 E{(pg8::bf16_t*)(ws + WS_ZU), (pg8::bf16_t*)(ws + WS_ZV), (float*)(ws + WS_VSTAT)};
                pg8::gemm_phase<pg8::EpiG1, pg8::StaticOrder, true, true>(lds + RING_OFF, g, S, E);
            }
            SEAM(pb + 0);
            #ifndef NO_SGU
            if (RUN(pb + 1)) sgu_phase(args, lp, lds, bx, G);
#endif
            SEAM(pb + 1);
            if (RUN(pb + 2)) {
                pg8::Gemm g{(const pg8::bf16_t*)(ws + WS_ZU), (const pg8::bf16_t*)(ws + WS_WGOUT) + (size_t)lp * 2048 * 4096, M, D, EA}; pg8::StaticOrder S; S.init(M, D, G, bx);
                pg8::EpiResid E{H, modl + 2 * D};
                pg8::gemm_phase<pg8::EpiResid, pg8::StaticOrder, true, true>(lds + RING_OFF, g, S, E);
            }
            SEAM(pb + 2);
            if (RUN(pb + 3)) norm_phase<false>(args, args.in[I_N2G] + layer * D, modl, 1, vcu, G);
            SEAM(pb + 3);
            if (RUN(pb + 4)) {
                pg8::Gemm g{XN, (const pg8::bf16_t*)(ws + WS_WF13) + (size_t)layer * 11264 * 2048, M, 2 * FF, D}; pg8::StaticOrder S; S.init(M, 2 * FF, G, bx);
                pg8::EpiSwiGLU E{(pg8::bf16_t*)(ws + WS_HID)};
                pg8::gemm_phase<pg8::EpiSwiGLU, pg8::StaticOrder, true, true>(lds + RING_OFF, g, S, E);
            }
            SEAM(pb + 4);
            if (RUN(pb + 5)) {
                pg8::Gemm g{(const pg8::bf16_t*)(ws + WS_HID), (const pg8::bf16_t*)(ws + WS_WF2) + (size_t)layer * 2048 * 5632, M, D, FF}; pg8::StaticOrder S; S.init(M, D, G, bx);
                pg8::EpiResid E{H, modl + 5 * D};
                pg8::gemm_phase<pg8::EpiResid, pg8::StaticOrder, true, true>(lds + RING_OFF, g, S, E);
            }
            SEAM(pb + 5);
            if (RUN(pb + 6)) norm_phase<false>(args, args.in[I_N1G] + (layer + 1) * D, modl + 3 * 12288, 0, vcu, G);
            SEAM(pb + 6);
        }
        {
            const int layer = 2 * lp + 1; const float* modl = MOD + (size_t)layer * 3 * 12288; const int ps = pb + 7;
#if S5_NAIVE
            if (RUN(ps + 0)) {
                pg8::Gemm g{XN, (const pg8::bf16_t*)(ws + WS_WSIN) + (size_t)lp * 2048 * 2048, M, D, D}; pg8::StaticOrder S; S.init(M, D, G, bx);
                pg8::EpiPlainBf16 E{(pg8::bf16_t*)(ws + WS_SU), D};
                pg8::gemm_phase<pg8::EpiPlainBf16, pg8::StaticOrder, true, true>(lds + RING_OFF, g, S, E);
            }
            SEAM(ps + 0);
            if (RUN(ps + 1)) s5_naive_phase(args, lp, bx, G);
            SEAM(ps + 1);
            if (RUN(ps + 2)) s5_combine_phase(args, lp, vcu, G);
            SEAM(ps + 2);
            SEAM(ps + 3);
#else
            if (RUN(ps + 0)) {
                pg8::Gemm g{XN, (const pg8::bf16_t*)(ws + WS_WSIN) + (size_t)lp * 2048 * 2048, M, D, D}; pg8::StaticOrder S; S.init(M, D, G, bx);
                pg8::EpiS5In E{(pg8::bf16_t*)(ws + WS_XL), (pg8::bf16_t*)(ws + WS_XC)};
                pg8::gemm_phase<pg8::EpiS5In, pg8::StaticOrder, true, true>(lds + RING_OFF, g, S, E);
            }
            SEAM(ps + 0);
            if (RUN(ps + 1)) {
                pg8::Gemm g{(const pg8::bf16_t*)(ws + WS_XL), (const pg8::bf16_t*)(ws + WS_M2T) + (size_t)lp * SG * 256 * 256, SG * 1024, 256, 256, 512}; pg8::GroupOrder S; S.init(G, vcu);
                pg8::EpiS5State E{(pg8::bf16_t*)(ws + WS_SL)};
                pg8::gemm_phase<pg8::EpiS5State, pg8::GroupOrder, true, true>(lds + RING_OFF, g, S, E);
                s5_ctx_gemm<false>(args, lp, vcu, G);
            }
            SEAM(ps + 1);
            if (RUN(ps + 2)) s5_carry_phase(args, lp, bx, G);
            SEAM(ps + 2);
            if (RUN(ps + 3)) {
                pg8::Gemm g{(const pg8::bf16_t*)(ws + WS_XL), (const pg8::bf16_t*)(ws + WS_MOUTT) + (size_t)lp * SG * 256 * 512, SG * 1024, 256, 512, 512}; pg8::GroupOrder S; S.init(G, vcu);
                pg8::EpiS5Out E{(pg8::bf16_t*)(ws + WS_Z)};
                pg8::gemm_phase<pg8::EpiS5Out, pg8::GroupOrder, true, true>(lds + RING_OFF, g, S, E);
                s5_ctx_gemm<true>(args, lp, vcu, G);
            }
            SEAM(ps + 3);
#endif
            if (RUN(ps + 4)) {
                pg8::Gemm g{(const pg8::bf16_t*)(ws + WS_Z), (const pg8::bf16_t*)(ws + WS_WGLU) + (size_t)lp * 4096 * 2048, M, 2 * D, D}; pg8::StaticOrder S; S.init(M, 2 * D, G, bx);
                pg8::EpiGluResid E{H, modl + 2 * D};
                pg8::gemm_phase<pg8::EpiGluResid, pg8::StaticOrder, true, true>(lds + RING_OFF, g, S, E);
            }
            SEAM(ps + 4);
            if (RUN(ps + 5)) norm_phase<false>(args, args.in[I_N2G] + layer * D, modl, 1, vcu, G);
            SEAM(ps + 5);
            if (RUN(ps + 6)) {
                pg8::Gemm g{XN, (const pg8::bf16_t*)(ws + WS_WF13) + (size_t)layer * 11264 * 2048, M, 2 * FF, D}; pg8::StaticOrder S; S.init(M, 2 * FF, G, bx);
                pg8::EpiSwiGLU E{(pg8::bf16_t*)(ws + WS_HID)};
                pg8::gemm_phase<pg8::EpiSwiGLU, pg8::StaticOrder, true, true>(lds + RING_OFF, g, S, E);
            }
            SEAM(ps + 6);
            if (RUN(ps + 7)) {
                pg8::Gemm g{(const pg8::bf16_t*)(ws + WS_HID), (const pg8::bf16_t*)(ws + WS_WF2) + (size_t)layer * 2048 * 5632, M, D, FF}; pg8::StaticOrder S; S.init(M, D, G, bx);
                pg8::EpiResid E{H, modl + 5 * D};
                pg8::gemm_phase<pg8::EpiResid, pg8::StaticOrder, true, true>(lds + RING_OFF, g, S, E);
            }
            SEAM(ps + 7);
            if (RUN(ps + 8)) {
                if (lp == 0) norm_phase<false>(args, args.in[I_N1G] + (layer + 1) * D, modl + 3 * 12288, 0, vcu, G);
                else final_phase(args, vcu, G);
            }
            SEAM(ps + 8);
        }
    }
#undef RUN
#undef SEAM
}

extern "C" void kernel_launch(void* const* d_in, const int* in_sizes, int n_in, void* d_out, int out_size, void* d_ws, size_t ws_size, hipStream_t stream) {
    static int grid = 0;
    if (grid == 0) {
        if (n_in != 28 || in_sizes[0] != ML * D || out_size != ML * D || ws_size < WS_END) {
            fprintf(stderr, "kernel_launch: unexpected problem (n_in %d, in0 %d, out %d, ws %zu, need ws >= %zu); nothing launched\n", n_in, n_in > 0 ? in_sizes[0] : -1, out_size, ws_size, (size_t)WS_END); grid = -1; return; }
        int dev = 0, cus = 0, per_cu = 0;
        if (hipGetDevice(&dev) != hipSuccess || hipDeviceGetAttribute(&cus, hipDeviceAttributeMultiprocessorCount, dev) != hipSuccess) { fprintf(stderr, "kernel_launch: device query failed\n"); grid = -1; return; }
        if (hipFuncSetAttribute((const void*)fwd_kernel, hipFuncAttributeMaxDynamicSharedMemorySize, LDS_BYTES) != hipSuccess) { fprintf(stderr, "kernel_launch: hipFuncSetAttribute failed\n"); grid = -1; return; }
        if (hipOccupancyMaxActiveBlocksPerMultiprocessor(&per_cu, (const void*)fwd_kernel, NTHR, LDS_BYTES) != hipSuccess || per_cu < 1) {
            fprintf(stderr, "kernel_launch: occupancy query reports %d workgroups per CU\n", per_cu); }
        (void)hipGetLastError();
        grid = cus;
    }
    if (grid < 0) return;
    if (hipMemsetAsync((char*)d_ws + WS_CTL, 0, CTL_ZERO_BYTES, stream) != hipSuccess) { fprintf(stderr, "kernel_launch: memset failed\n"); return; }
    Args a{};
    for (int i = 0; i < 28; ++i) a.in[i] = (const float*)d_in[i];
    a.out = (float*)d_out; a.ws = (unsigned char*)d_ws;
#if MK_ONE_LAUNCH
    a.ph_lo = 0; a.ph_hi = N_PHASES;
    hipLaunchKernelGGL(fwd_kernel, dim3(grid), dim3(NTHR), LDS_BYTES, stream, a);
#else
    for (int p = 0; p < N_PHASES; ++p) { a.ph_lo = p; a.ph_hi = p + 1; hipLaunchKernelGGL(fwd_kernel, dim3(grid), dim3(NTHR), LDS_BYTES, stream, a); }
#endif
    const hipError_t le = hipPeekAtLastError();
    if (le != hipSuccess) fprintf(stderr, "kernel_launch: launch failed: %s\n", hipGetErrorName(le));
}
```

```cpp
#include <hip/hip_runtime.h>
#include <cstdio>
#include <cstdint>
namespace pg8 {
#define PG8_LAS __attribute__((address_space(3)))
typedef unsigned short bf16_t;
typedef short bf16x8 __attribute__((ext_vector_type(8)));
typedef float f32x4 __attribute__((ext_vector_type(4)));
typedef unsigned u32x4 __attribute__((ext_vector_type(4)));
constexpr int BM = 256, BK = 64, HALF = 128, HTB = HALF * BK * 2  , STAGE_BYTES = 8 * HTB, NXCD = 8, WGM = 8;

__host__ __device__ __forceinline__ int lds_byte(int r, int c) { const int st = (r >> 4) * 2 + (c >> 5), rr = r & 15, cc = c & 31, ob = rr * 64 + cc * 2; return st * 1024 + (ob ^ (((ob >> 9) & 1) << 5)); }
__host__ __device__ __forceinline__ void stage_rc(int b, int& R, int& C) { const int st = b / 1024, sb = b % 1024, swz = sb ^ (((sb >> 9) & 1) << 5); R = (st >> 1) * 16 + swz / 64; C = (st & 1) * 32 + (swz % 64) / 2; }
__host__ __device__ __forceinline__ int perm32(int rho) { const int n = rho >> 4, i = rho & 15; return 8 * (i >> 2) + 4 * n + (i & 3); }

struct Unit { int pm, pn; int koff; };
struct Gemm { const bf16_t* A; const bf16_t* Bt; int M, N, K; int lda, ldb; };

struct StaticOrder {
    int nM, nN, nwg, G, c;
    __host__ __device__ void init(int M, int N, int G_, int c_) { nM = M / BM; nN = N / BM; nwg = nM * nN; G = G_; c = c_; }
    __host__ __device__ bool next(int i, Unit& u) const {
        const long L = (long)i * G + c; if (L >= nwg) return false;
        int wgid = (int)L; { const int q = nwg / NXCD, r = nwg % NXCD, xcd = wgid % NXCD, off = wgid / NXCD; wgid = (xcd < r ? xcd * (q + 1) : r * (q + 1) + (xcd - r) * q) + off; }
        const int nig = WGM * nN, gid = wgid / nig, fm = gid * WGM, gsz = (nM - fm) < WGM ? (nM - fm) : WGM;
        u.pm = fm + ((wgid % nig) % gsz); u.pn = (wgid % nig) / gsz; u.koff = 0; return true;
    }
    __device__ __forceinline__ void a_ready(const Unit&) const {}
    __device__ __forceinline__ void done(const Unit&) const {}
};

__device__ __forceinline__ unsigned cvt_pk_bf16(float lo, float hi) { unsigned r; asm volatile("v_cvt_pk_bf16_f32 %0, %1, %2" : "=v"(r) : "v"(lo), "v"(hi)); return r; }
typedef float f32x2 __attribute__((ext_vector_type(2)));
__device__ __forceinline__ f32x2 gelu_pk(f32x2 v) {
    const f32x2 av = __builtin_elementwise_abs(v), d = av * 0.2316418882f + 1.0f;
    f32x2 t; t.x = __builtin_amdgcn_rcpf(d.x); t.y = __builtin_amdgcn_rcpf(d.y);
    f32x2 q = t * 0.5307027145f + (-0.7265760135f); q = q * t + 0.7107068705f; q = q * t + (-0.142248368f); q = q * t + 0.127414796f; q = q * t;
    const f32x2 s = (v * v) * (-0.72134752044f);
    f32x2 e; e.x = __builtin_amdgcn_exp2f(s.x); e.y = __builtin_amdgcn_exp2f(s.y);
    const f32x2 m = v * (q * e), r = v - m;
    f32x2 o; o.x = v.x < 0.f ? m.x : r.x; o.y = v.y < 0.f ? m.y : r.y; return o;
}


__device__ __forceinline__ float sigmoid_f(float x) { return __builtin_amdgcn_rcpf(1.0f + __builtin_amdgcn_exp2f(-1.44269504f * x)); }
__device__ __forceinline__ float silu_f(float x) { return x * sigmoid_f(x); }
__device__ __forceinline__ float gelu_tanh_f(float x) { const float u = x * (1.0f + 0.044715f * x * x); return x * __builtin_amdgcn_rcpf(1.0f + __builtin_amdgcn_exp2f(-2.30220820f * u)); }
__device__ __forceinline__ int row_set(int pm) { return pm < 32 ? 0 : (pm < 64 ? 1 : 2); }

struct EpiPlainBf16 {
    static constexpr bool PERM = true, AFTER_DRAIN = false;
    bf16_t* O; int ldc;
    __device__ __forceinline__ void operator()(const f32x4 (&acc)[2][2][4][2], const Unit& u, int wr, int wc, int fr, int fq) const {
        const int row0 = u.pm * BM + wr * 64 + fr, col0 = u.pn * BM + wc * 32 + 8 * fq;
#pragma unroll
        for (int ai = 0; ai < 2; ++ai)
#pragma unroll
            for (int m = 0; m < 4; ++m) { bf16_t* rowp = O + (size_t)(row0 + ai * HALF + m * 16) * ldc + col0;
#pragma unroll
                for (int bj = 0; bj < 2; ++bj) { const f32x4 v0 = acc[ai][bj][m][0], v1 = acc[ai][bj][m][1];
                    u32x4 w; w.x = cvt_pk_bf16(v0[0], v0[1]); w.y = cvt_pk_bf16(v0[2], v0[3]); w.z = cvt_pk_bf16(v1[0], v1[1]); w.w = cvt_pk_bf16(v1[2], v1[3]);
                    *(u32x4*)(rowp + bj * HALF) = w; } }
    }
};
struct EpiG1 {
    static constexpr bool PERM = true, AFTER_DRAIN = false;
    bf16_t* U; bf16_t* V; float* vstat;
    __device__ __forceinline__ void operator()(const f32x4 (&acc)[2][2][4][2], const Unit& u, int wr, int wc, int fr, int fq) const {
        const bool isv = u.pn >= 16;
        const int row0 = u.pm * BM + wr * 64 + fr, col0 = (u.pn & 15) * BM + wc * 32 + 8 * fq;
        bf16_t* base = isv ? V : U;
#pragma unroll
        for (int ai = 0; ai < 2; ++ai)
#pragma unroll
            for (int m = 0; m < 4; ++m) { const int row = row0 + ai * HALF + m * 16; bf16_t* rowp = base + (size_t)row * 4096 + col0; float s = 0.f, ss = 0.f;
#pragma unroll
                for (int bj = 0; bj < 2; ++bj) { f32x4 v0 = acc[ai][bj][m][0], v1 = acc[ai][bj][m][1];
#pragma unroll
                    for (int e = 0; e < 4; ++e) { v0[e] = gelu_tanh_f(v0[e]); v1[e] = gelu_tanh_f(v1[e]); s += v0[e] + v1[e]; ss += v0[e] * v0[e] + v1[e] * v1[e]; }
                    u32x4 w; w.x = cvt_pk_bf16(v0[0], v0[1]); w.y = cvt_pk_bf16(v0[2], v0[3]); w.z = cvt_pk_bf16(v1[0], v1[1]); w.w = cvt_pk_bf16(v1[2], v1[3]);
                    *(u32x4*)(rowp + bj * HALF) = w; }
                if (isv) { s += __shfl_xor(s, 16); s += __shfl_xor(s, 32); ss += __shfl_xor(ss, 16); ss += __shfl_xor(ss, 32);
                    if (fq == 0) { f32x2 o; o.x = s; o.y = ss; *(f32x2*)(vstat + ((size_t)row * 64 + (u.pn - 16) * 4 + wc) * 2) = o; } } }
    }
};
struct EpiResid {
    static constexpr bool PERM = false, AFTER_DRAIN = false;
    float* H; const float* gate; int dry;
    __device__ __forceinline__ void operator()(const f32x4 (&acc)[2][2][4][2], const Unit& u, int wr, int wc, int fr, int fq) const {
        if (dry) return;
        const int row0 = u.pm * BM + wr * 64 + fr, col0 = u.pn * BM + wc * 32 + 4 * fq;
        const float* g = gate + row_set(u.pm) * (6 * 2048) + col0;
        f32x4 gv[2][2];
#pragma unroll
        for (int bj = 0; bj < 2; ++bj)
#pragma unroll
            for (int n = 0; n < 2; ++n) gv[bj][n] = *(const f32x4*)(g + bj * HALF + n * 16);
#pragma unroll
        for (int ai = 0; ai < 2; ++ai)
#pragma unroll
            for (int m = 0; m < 4; ++m) { float* rowp = H + (size_t)(row0 + ai * HALF + m * 16) * 2048 + col0;
#pragma unroll
                for (int bj = 0; bj < 2; ++bj)
#pragma unroll
                    for (int n = 0; n < 2; ++n) { f32x4* p = (f32x4*)(rowp + bj * HALF + n * 16); *p = *p + gv[bj][n] * acc[ai][bj][m][n]; } }
    }
};
struct EpiSwiGLU {
    static constexpr bool PERM = true, AFTER_DRAIN = false;
    bf16_t* O;
    __device__ __forceinline__ void operator()(const f32x4 (&acc)[2][2][4][2], const Unit& u, int wr, int wc, int fr, int fq) const {
        const int row0 = u.pm * BM + wr * 64 + fr, col0 = u.pn * HALF + wc * 32 + 8 * fq;
#pragma unroll
        for (int ai = 0; ai < 2; ++ai)
#pragma unroll
            for (int m = 0; m < 4; ++m) { bf16_t* rowp = O + (size_t)(row0 + ai * HALF + m * 16) * 5632 + col0;
                f32x4 a0 = acc[ai][0][m][0], a1 = acc[ai][0][m][1]; const f32x4 b0 = acc[ai][1][m][0], b1 = acc[ai][1][m][1];
#pragma unroll
                for (int e = 0; e < 4; ++e) { a0[e] = silu_f(a0[e]) * b0[e]; a1[e] = silu_f(a1[e]) * b1[e]; }
                u32x4 w; w.x = cvt_pk_bf16(a0[0], a0[1]); w.y = cvt_pk_bf16(a0[2], a0[3]); w.z = cvt_pk_bf16(a1[0], a1[1]); w.w = cvt_pk_bf16(a1[2], a1[3]);
                *(u32x4*)rowp = w; }
    }
};
struct EpiGluResid {
    static constexpr bool PERM = false, AFTER_DRAIN = false;
    float* H; const float* gate; int dry;
    __device__ __forceinline__ void operator()(const f32x4 (&acc)[2][2][4][2], const Unit& u, int wr, int wc, int fr, int fq) const {
        if (dry) return;
        const int row0 = u.pm * BM + wr * 64 + fr, col0 = u.pn * HALF + wc * 32 + 4 * fq;
        const float* g = gate + row_set(u.pm) * (6 * 2048) + col0;
        f32x4 gv[2];
#pragma unroll
        for (int n = 0; n < 2; ++n) gv[n] = *(const f32x4*)(g + n * 16);
#pragma unroll
        for (int ai = 0; ai < 2; ++ai)
#pragma unroll
            for (int m = 0; m < 4; ++m) { float* rowp = H + (size_t)(row0 + ai * HALF + m * 16) * 2048 + col0;
#pragma unroll
                for (int n = 0; n < 2; ++n) { const f32x4 a = acc[ai][0][m][n], gg = acc[ai][1][m][n]; f32x4 o;
#pragma unroll
                    for (int e = 0; e < 4; ++e) o[e] = a[e] * sigmoid_f(gg[e]);
                    f32x4* p = (f32x4*)(rowp + n * 16); *p = *p + gv[n] * o; } }
    }
};

struct GroupOrder {
    int G, c;
    __host__ __device__ void init(int G_, int c_) { G = G_; c = c_; }
    __host__ __device__ bool next(int i, Unit& u) const { const int L = i * G + c; if (L >= 512) return false; u.pm = L; u.pn = L >> 2; u.koff = 0; return true; }
    __device__ __forceinline__ void a_ready(const Unit&) const {}
    __device__ __forceinline__ void done(const Unit&) const {}
};
struct EpiS5In {
    static constexpr bool PERM = true, AFTER_DRAIN = false;
    bf16_t* XL; bf16_t* XC;
    __device__ __forceinline__ void operator()(const f32x4 (&acc)[2][2][4][2], const Unit& u, int wr, int wc, int fr, int fq) const {
        const int row0 = u.pm * BM + wr * 64 + fr;
#pragma unroll
        for (int ai = 0; ai < 2; ++ai)
#pragma unroll
            for (int m = 0; m < 4; ++m) { const int row = row0 + ai * HALF + m * 16;
#pragma unroll
                for (int bj = 0; bj < 2; ++bj) { const int col0 = u.pn * BM + bj * HALF + wc * 32 + 8 * fq, g = col0 >> 4, q0 = col0 & 15;
                    bf16_t* dst = row < 16384 ? XL + ((size_t)(g * 1024 + (row >> 4)) * 512 + 16 * (row & 15) + q0)
                                              : XC + ((size_t)(g * 32 + ((row - 16384) >> 4)) * 512 + 16 * (row & 15) + q0);
                    const f32x4 v0 = acc[ai][bj][m][0], v1 = acc[ai][bj][m][1];
                    u32x4 w; w.x = cvt_pk_bf16(v0[0], v0[1]); w.y = cvt_pk_bf16(v0[2], v0[3]); w.z = cvt_pk_bf16(v1[0], v1[1]); w.w = cvt_pk_bf16(v1[2], v1[3]);
                    *(u32x4*)dst = w; } }
    }
};
struct EpiS5State {
    static constexpr bool PERM = true, AFTER_DRAIN = false;
    bf16_t* SL;
    __device__ __forceinline__ void operator()(const f32x4 (&acc)[2][2][4][2], const Unit& u, int wr, int wc, int fr, int fq) const {
        const int row0 = u.pm * BM + wr * 64 + fr, col0 = wc * 32 + 8 * fq;
#pragma unroll
        for (int ai = 0; ai < 2; ++ai)
#pragma unroll
            for (int m = 0; m < 4; ++m) { bf16_t* rowp = SL + (size_t)(row0 + ai * HALF + m * 16) * 256 + col0;
#pragma unroll
                for (int bj = 0; bj < 2; ++bj) { const f32x4 v0 = acc[ai][bj][m][0], v1 = acc[ai][bj][m][1];
                    u32x4 w; w.x = cvt_pk_bf16(v0[0], v0[1]); w.y = cvt_pk_bf16(v0[2], v0[3]); w.z = cvt_pk_bf16(v1[0], v1[1]); w.w = cvt_pk_bf16(v1[2], v1[3]);
                    *(u32x4*)(rowp + bj * HALF) = w; } }
    }
};
struct EpiS5Out {
    static constexpr bool PERM = true, AFTER_DRAIN = false;
    bf16_t* Z;
    __device__ __forceinline__ void operator()(const f32x4 (&acc)[2][2][4][2], const Unit& u, int wr, int wc, int fr, int fq) const {
        const int c0 = (u.pm & 3) * BM + wr * 64 + fr, g = u.pn;
#pragma unroll
        for (int ai = 0; ai < 2; ++ai)
#pragma unroll
            for (int m = 0; m < 4; ++m) { const int c = c0 + ai * HALF + m * 16;
#pragma unroll
                for (int bj = 0; bj < 2; ++bj) { const int n0 = bj * HALF + wc * 32 + 8 * fq, t = n0 >> 4, q0 = n0 & 15;
                    f32x4 v0 = acc[ai][bj][m][0], v1 = acc[ai][bj][m][1];
#pragma unroll
                    for (int e = 0; e < 4; ++e) { v0[e] = gelu_tanh_f(v0[e]); v1[e] = gelu_tanh_f(v1[e]); }
                    u32x4 w; w.x = cvt_pk_bf16(v0[0], v0[1]); w.y = cvt_pk_bf16(v0[2], v0[3]); w.z = cvt_pk_bf16(v1[0], v1[1]); w.w = cvt_pk_bf16(v1[2], v1[3]);
                    *(u32x4*)(Z + (size_t)(16 * c + t) * 2048 + 16 * g + q0) = w; } }
    }
};

struct SliceOrder {
    int G, c, nsl, kbytes;
    __host__ __device__ void init(int G_, int c_, int nsl_, int kslice) { G = G_; c = c_; nsl = nsl_; kbytes = kslice * 2; }
    __host__ __device__ bool next(int i, Unit& u) const { const int L = i * G + c; if (L >= nsl * 16) return false; const int s = L >> 4, r = L & 15; u.pm = 64 + (r >> 3); u.pn = r & 7; u.koff = s * kbytes; return true; }
    __device__ __forceinline__ void a_ready(const Unit&) const {}
    __device__ __forceinline__ void done(const Unit&) const {}
};
struct EpiSlab {
    static constexpr bool PERM = false, AFTER_DRAIN = false;
    float* SLAB; int kbytes;
    __device__ __forceinline__ void operator()(const f32x4 (&acc)[2][2][4][2], const Unit& u, int wr, int wc, int fr, int fq) const {
        const int s = u.koff / kbytes, row0 = (u.pm - 64) * BM + wr * 64 + fr, col0 = u.pn * BM + wc * 32 + 4 * fq;
        float* base = SLAB + (size_t)s * 512 * 2048;
#pragma unroll
        for (int ai = 0; ai < 2; ++ai)
#pragma unroll
            for (int m = 0; m < 4; ++m) { float* rowp = base + (size_t)(row0 + ai * HALF + m * 16) * 2048 + col0;
#pragma unroll
                for (int bj = 0; bj < 2; ++bj)
#pragma unroll
                    for (int n = 0; n < 2; ++n) *(f32x4*)(rowp + bj * HALF + n * 16) = acc[ai][bj][m][n]; }
    }
};

template <class Epi, class Sched, bool ALIGN_EPI = false, bool SP2 = false>
__device__ __forceinline__ void gemm_phase(PG8_LAS unsigned char* lds, const Gemm g, const Sched& S, const Epi& E) {
    int tid_ = threadIdx.x; asm volatile("" : "+v"(tid_));
    const int tid = tid_, wid = __builtin_amdgcn_readfirstlane(tid >> 6), lane = tid & 63, wr = wid >> 2, wc = wid & 3, fr = lane & 15, fq = lane >> 4;
    const int K = g.K, nt = K / BK, lda = g.lda ? g.lda : K, ldb = g.ldb ? g.ldb : K;
    unsigned voffA[2], voffB[2];
#pragma unroll
    for (int i = 0; i < 2; ++i) { int R, C; stage_rc(tid * 16 + i * 8192, R, C); const int Rb = Epi::PERM ? ((R & ~31) + perm32(R & 31)) : R;
        voffA[i] = (unsigned)(R * lda + C) * 2u; voffB[i] = (unsigned)(Rb * ldb + C) * 2u; }
    const size_t kstep = (size_t)(BK * 2);
    const size_t hstepB = (size_t)HALF * ldb * 2, hstepA = (size_t)HALF * lda * 2;
    const size_t tstepB = 2 * hstepB, tstepA = 2 * hstepA;
    const unsigned ldsw = (unsigned)wid * 1024u;
    const int aoff = lds_byte(wr * 64 + fr, fq * 8), boff = lds_byte(wc * 32 + fr, fq * 8);
#define PG8_SA(b, h) (((b) * 2 + (h)) * HTB)
#define PG8_SB(b, h) ((4 + (b) * 2 + (h)) * HTB)
#define PG8_STAGE(bufoff, gbase, voff) do { _Pragma("unroll") for (int _i = 0; _i < 2; ++_i) \
        __builtin_amdgcn_global_load_lds((const unsigned*)((const char*)(gbase) + (voff)[_i]), (PG8_LAS unsigned*)(lds + (bufoff) + ldsw + _i * 8192), 16, 0, 0); } while (0)
#define PG8_LDA(dst, b, h) do { _Pragma("unroll") for (int m = 0; m < 4; ++m) _Pragma("unroll") for (int k = 0; k < 2; ++k) dst[m][k] = *(const PG8_LAS bf16x8*)(lds + PG8_SA(b, h) + aoff + m * 2048 + k * 1024); } while (0)
#define PG8_LDB(dst, b, h) do { _Pragma("unroll") for (int n = 0; n < 2; ++n) _Pragma("unroll") for (int k = 0; k < 2; ++k) dst[n][k] = *(const PG8_LAS bf16x8*)(lds + PG8_SB(b, h) + boff + n * 2048 + k * 1024); } while (0)
#define PG8_MMA(ai, bj, At, Bt) do { __builtin_amdgcn_s_setprio(1); _Pragma("unroll") for (int m = 0; m < 4; ++m) _Pragma("unroll") for (int n = 0; n < 2; ++n) _Pragma("unroll") for (int k = 0; k < 2; ++k) \
        acc[ai][bj][m][n] = __builtin_amdgcn_mfma_f32_16x16x32_bf16(Bt[n][k], At[m][k], acc[ai][bj][m][n], 0, 0, 0); __builtin_amdgcn_s_setprio(0); } while (0)
#define PG8_WAIT_V(n) asm volatile("s_waitcnt vmcnt(" #n ")" ::: "memory")
#define PG8_WAIT_L(n) asm volatile("s_waitcnt lgkmcnt(" #n ")" ::: "memory")
#define PG8_BAR __builtin_amdgcn_s_barrier()
#define PG8_SCHED __builtin_amdgcn_sched_barrier(0)
    Unit cur, nxt; int ui = 0;
    if (!S.next(0, cur)) return;
    f32x4 acc[2][2][4][2];
#pragma unroll
    for (int a = 0; a < 2; ++a)
#pragma unroll
        for (int b = 0; b < 2; ++b)
#pragma unroll
            for (int m = 0; m < 4; ++m)
#pragma unroll
                for (int n = 0; n < 2; ++n) acc[a][b][m][n] = (f32x4){0.f, 0.f, 0.f, 0.f};
    bf16x8 At[4][2], B0[2][2], B1[2][2];
    const char* cA = (const char*)g.A + (size_t)cur.pm * tstepA + cur.koff; const char* cB = (const char*)g.Bt + (size_t)cur.pn * tstepB + cur.koff;
    S.a_ready(cur);
    if constexpr (SP2) {
        PG8_STAGE(PG8_SB(0, 0), cB, voffB); PG8_STAGE(PG8_SB(0, 1), cB + hstepB, voffB); PG8_STAGE(PG8_SA(0, 0), cA, voffA); PG8_STAGE(PG8_SA(0, 1), cA + hstepA, voffA);
        if (wr == 1) PG8_BAR;
        PG8_WAIT_V(2); PG8_BAR;
        PG8_STAGE(PG8_SB(1, 0), cB + kstep, voffB); PG8_STAGE(PG8_SA(1, 0), cA + kstep, voffA); PG8_STAGE(PG8_SB(1, 1), cB + hstepB + kstep, voffB);
        PG8_WAIT_V(6); PG8_BAR;
    } else {
        PG8_STAGE(PG8_SB(0, 0), cB, voffB); PG8_STAGE(PG8_SA(0, 0), cA, voffA); PG8_STAGE(PG8_SB(0, 1), cB + hstepB, voffB); PG8_STAGE(PG8_SA(0, 1), cA + hstepA, voffA);
        if (wr == 1) PG8_BAR;
        PG8_WAIT_V(4); PG8_BAR;
        PG8_STAGE(PG8_SB(1, 0), cB + kstep, voffB); PG8_STAGE(PG8_SA(1, 0), cA + kstep, voffA); PG8_STAGE(PG8_SB(1, 1), cB + hstepB + kstep, voffB);
        PG8_WAIT_V(6); PG8_BAR;
    }
    for (;;) {
        const bool has_next = S.next(ui + 1, nxt);
        const char* nA = has_next ? (const char*)g.A + (size_t)nxt.pm * tstepA + nxt.koff : cA; const char* nB = has_next ? (const char*)g.Bt + (size_t)nxt.pn * tstepB + nxt.koff : cB;
#pragma unroll 1
        for (int t = 0; t < nt; t += 2) {
            const bool last = (t == nt - 2);
            const char* a1 = cA + (size_t)(t + 1) * kstep;
            const char* a2 = last ? nA : cA + (size_t)(t + 2) * kstep; const char* b2 = last ? nB : cB + (size_t)(t + 2) * kstep;
            const char* a3 = a2 + kstep; const char* b3 = b2 + kstep;
            if (last && has_next) S.a_ready(nxt);
            if constexpr (SP2) {
            PG8_LDB(B0, 0, 0); PG8_LDB(B1, 0, 1); PG8_SCHED; PG8_LDA(At, 0, 0); PG8_STAGE(PG8_SA(1, 1), a1 + hstepA, voffA);
            PG8_WAIT_V(8); PG8_WAIT_L(0); PG8_BAR; PG8_MMA(0, 0, At, B0); PG8_MMA(0, 1, At, B1); PG8_BAR; PG8_SCHED;
            PG8_LDA(At, 0, 1); PG8_STAGE(PG8_SB(0, 0), b2, voffB); PG8_STAGE(PG8_SB(0, 1), b2 + hstepB, voffB); PG8_STAGE(PG8_SA(0, 0), a2, voffA);
            PG8_WAIT_V(8); PG8_WAIT_L(0); PG8_BAR; PG8_MMA(1, 0, At, B0); PG8_MMA(1, 1, At, B1); PG8_BAR; PG8_SCHED;
            PG8_LDB(B0, 1, 0); PG8_LDB(B1, 1, 1); PG8_SCHED; PG8_LDA(At, 1, 0); PG8_STAGE(PG8_SA(0, 1), a2 + hstepA, voffA);
            PG8_WAIT_V(8); PG8_WAIT_L(0); PG8_BAR; PG8_MMA(0, 0, At, B0); PG8_MMA(0, 1, At, B1); PG8_BAR; PG8_SCHED;
            PG8_LDA(At, 1, 1); PG8_STAGE(PG8_SB(1, 0), b3, voffB); PG8_STAGE(PG8_SB(1, 1), b3 + hstepB, voffB); PG8_STAGE(PG8_SA(1, 0), a3, voffA);
            PG8_WAIT_V(8); PG8_WAIT_L(0); PG8_BAR; PG8_MMA(1, 0, At, B0); PG8_MMA(1, 1, At, B1); PG8_BAR; PG8_SCHED;
            } else {
            PG8_LDB(B0, 0, 0); PG8_SCHED; PG8_LDA(At, 0, 0); PG8_STAGE(PG8_SA(1, 1), a1 + hstepA, voffA);
            PG8_WAIT_L(8); PG8_BAR; PG8_WAIT_L(0); PG8_MMA(0, 0, At, B0); PG8_BAR; PG8_SCHED;
            PG8_LDB(B1, 0, 1); PG8_STAGE(PG8_SB(0, 0), b2, voffB);
            PG8_BAR; PG8_WAIT_L(0); PG8_MMA(0, 1, At, B1); PG8_BAR;
            PG8_LDA(At, 0, 1); PG8_STAGE(PG8_SA(0, 0), a2, voffA);
            PG8_BAR; PG8_WAIT_L(0); PG8_MMA(1, 0, At, B0); PG8_BAR; PG8_SCHED;
            PG8_STAGE(PG8_SB(0, 1), b2 + hstepB, voffB);
            PG8_WAIT_V(6); PG8_BAR; PG8_MMA(1, 1, At, B1); PG8_BAR;
            PG8_LDB(B0, 1, 0); PG8_SCHED; PG8_LDA(At, 1, 0); PG8_STAGE(PG8_SA(0, 1), a2 + hstepA, voffA);
            PG8_WAIT_L(8); PG8_BAR; PG8_WAIT_L(0); PG8_MMA(0, 0, At, B0); PG8_BAR; PG8_SCHED;
            PG8_LDB(B1, 1, 1); PG8_STAGE(PG8_SB(1, 0), b3, voffB);
            PG8_BAR; PG8_WAIT_L(0); PG8_MMA(0, 1, At, B1); PG8_BAR;
            PG8_LDA(At, 1, 1); PG8_STAGE(PG8_SA(1, 0), a3, voffA);
            PG8_BAR; PG8_WAIT_L(0); PG8_MMA(1, 0, At, B0); PG8_BAR; PG8_SCHED;
            PG8_STAGE(PG8_SB(1, 1), b3 + hstepB, voffB);
            PG8_WAIT_V(6); PG8_BAR; PG8_MMA(1, 1, At, B1); PG8_BAR;
            }
        }
        if constexpr (ALIGN_EPI) { if (wr == 0) PG8_BAR; }
        if constexpr (!Epi::AFTER_DRAIN) { E(acc, cur, wr, wc, fr, fq); S.done(cur); }
        if (!has_next) break;
#pragma unroll
        for (int a = 0; a < 2; ++a)
#pragma unroll
            for (int b = 0; b < 2; ++b)
#pragma unroll
                for (int m = 0; m < 4; ++m)
#pragma unroll
                    for (int n = 0; n < 2; ++n) acc[a][b][m][n] = (f32x4){0.f, 0.f, 0.f, 0.f};
        cur = nxt; cA = nA; cB = nB; ++ui;
        if constexpr (ALIGN_EPI) { if (wr == 1) PG8_BAR; }
    }
    PG8_WAIT_V(0);
    if constexpr (!ALIGN_EPI) { if (wr == 0) PG8_BAR; }
    PG8_BAR;
    if constexpr (Epi::AFTER_DRAIN) { E.fused(acc, cur, wr, wc, fr, fq, lds, wid, lane); S.done(cur); }
#undef PG8_SA
#undef PG8_SB
#undef PG8_STAGE
#undef PG8_LDA
#undef PG8_LDB
#undef PG8_MMA
#undef PG8_WAIT_V
#undef PG8_WAIT_L
#undef PG8_BAR
#undef PG8_SCHED
}
}

constexpr int NWAVES = 8, NTHR = NWAVES * 64;
constexpr int D = 2048, BATCH = 2, SEQ = 8192, ML = BATCH * SEQ, CTXL = 256, MC = BATCH * CTXL, M = ML + MC;
constexpr int FF = 5632, EA = 4096, NH = 16, HDIM = 256, CHUNK = 128, NCHUNK = M / CHUNK;
constexpr int SG = 128, SP = 64, SQ = 16;
constexpr int DEPTH = 4;
constexpr float EPS = 1e-6f;
static_assert(M % 256 == 0 && NCHUNK == 132, "row tiling");

constexpr size_t MiB = 1u << 20;
constexpr size_t WS_CTL = 0, CTL_ZERO_BYTES = 1 * MiB;
constexpr size_t WS_MOD = 1 * MiB;
constexpr size_t WS_S5A = 2 * MiB;
constexpr size_t WS_S5B = 3 * MiB;
constexpr size_t WS_WSB = 11 * MiB;
constexpr size_t WS_VSTAT = 12 * MiB;
constexpr size_t WS_WGIN = 32 * MiB;
constexpr size_t WS_WGOUT = 96 * MiB;
constexpr size_t WS_WF13 = 128 * MiB;
constexpr size_t WS_WF2 = 304 * MiB;
constexpr size_t WS_WSIN = 392 * MiB;
constexpr size_t WS_WGLU = 408 * MiB;
constexpr size_t WS_H = 440 * MiB;
constexpr size_t WS_XN = 572 * MiB;
constexpr size_t WS_BIG = 640 * MiB;
constexpr size_t WS_ZU = WS_BIG, WS_ZV = WS_BIG + 132 * MiB;
constexpr size_t WS_HID = WS_BIG;
constexpr size_t WS_SU = WS_BIG, WS_SZ = WS_BIG + 66 * MiB;
constexpr size_t WS_YF = WS_BIG + 132 * MiB, WS_YB = WS_BIG + 264 * MiB;
constexpr size_t WS_XL = WS_BIG, WS_XC = WS_BIG + 128 * MiB;
constexpr size_t WS_SL = WS_BIG + 132 * MiB, WS_SC = WS_BIG + 196 * MiB;
constexpr size_t WS_SZ2 = WS_BIG + 200 * MiB;
constexpr size_t WS_MOUTT = WS_BIG + 396 * MiB;
constexpr size_t WS_M2T = WS_MOUTT + 64 * MiB;
constexpr size_t WS_A16 = WS_M2T + 32 * MiB;
constexpr size_t WS_SLAB = WS_A16 + 1 * MiB;
constexpr size_t WS_END = WS_SLAB + 44 * MiB;
#ifndef S5_NAIVE
#define S5_NAIVE 0
#endif
constexpr size_t WS_Z = S5_NAIVE ? WS_SZ : WS_SZ2;
constexpr int CW_BAR = 4096;

constexpr int RING_OFF = 0, RING_BYTES = 131072;
constexpr int LDSCTL_OFF = RING_BYTES, MISC_OFF = LDSCTL_OFF + 320;
constexpr int LDS_BYTES = 147456;
static_assert(MISC_OFF + 128 <= LDS_BYTES, "LDS map");

#define GAS __attribute__((address_space(1)))
#define LAS __attribute__((address_space(3)))
typedef unsigned short bf16;
typedef unsigned v4u __attribute__((ext_vector_type(4)));
typedef unsigned v2u __attribute__((ext_vector_type(2)));
typedef float f32x4 __attribute__((ext_vector_type(4)));
typedef float f32x2 __attribute__((ext_vector_type(2)));
typedef float f32x16 __attribute__((ext_vector_type(16)));
typedef short bf16x8 __attribute__((ext_vector_type(8)));
typedef GAS unsigned gu32;
#define RLX_AGENT __ATOMIC_RELAXED, __HIP_MEMORY_SCOPE_AGENT
#define LDS_WAIT() asm volatile("s_waitcnt lgkmcnt(0)" ::: "memory")
__device__ __forceinline__ unsigned f2bf(float f) { unsigned u = __builtin_bit_cast(unsigned, f); return (u + 0x7fffu + ((u >> 16) & 1u)) >> 16; }
__device__ __forceinline__ unsigned pk2(float lo, float hi) { return f2bf(lo) | (f2bf(hi) << 16); }
__device__ __forceinline__ float bf2f(unsigned short b) { return __builtin_bit_cast(float, (unsigned)b << 16); }
__device__ __forceinline__ float wave_sum(float v) {
#pragma unroll
    for (int o = 1; o < 64; o <<= 1) v += __shfl_xor(v, o);
    return v;
}

#define XB_TMO      128
#define XB_XCNT(j)  (256  + 64 * (j))
#define XB_XSUB(j)  (1280 + 64 * (j))
#define XB_XGEN(j)  (2304 + 64 * (j))
#define XB_TOP      3328
#define XB_TOPGEN   3392
#define XCD_BAR_WORDS 3456
#define XB_SPIN_CAP (1u << 18)

__device__ __forceinline__ unsigned xb_ld(unsigned* p)              { return __hip_atomic_load(p, __ATOMIC_RELAXED, __HIP_MEMORY_SCOPE_AGENT); }
__device__ __forceinline__ unsigned xb_add(unsigned* p, unsigned v) { return __hip_atomic_fetch_add(p, v, __ATOMIC_RELAXED, __HIP_MEMORY_SCOPE_AGENT); }
__device__ __forceinline__ unsigned xb_xcc_id() { return (unsigned)__builtin_amdgcn_s_getreg((3 << 11) | 20) & 0xFu; }
#define XB_SPIN(cond, bar) do { unsigned _sp = 0; while (cond) { __builtin_amdgcn_s_sleep(1); \
    if ((++_sp & 255u) == 0u) { if (xb_ld(&(bar)[XB_TMO])) break; if (_sp > XB_SPIN_CAP) { atomicAdd(&(bar)[XB_TMO], 1u); break; } } } } while (0)

struct XcdBarrier {
    unsigned* bar; unsigned x;
    volatile LAS unsigned* st;
};

__device__ __forceinline__ XcdBarrier xcd_barrier_post(unsigned* bar, volatile LAS unsigned* st) {
    XcdBarrier b; b.bar = bar; b.x = xb_xcc_id(); b.st = st;
    if (threadIdx.x == 0) (void)xb_add(&bar[XB_XCNT(b.x)], 1u);
    return b;
}
__device__ __forceinline__ void xcd_barrier_complete(unsigned* bar, unsigned x, unsigned& nloc, unsigned& nx) {
    const unsigned G = gridDim.x * gridDim.y * gridDim.z;
    unsigned sum, cnt, mine, sp = 0u;
    for (;;) {
        sum = 0u; cnt = 0u; mine = 0u;
#pragma unroll
        for (unsigned j = 0; j < 16; ++j) { const unsigned c = xb_ld(&bar[XB_XCNT(j)]); sum += c; cnt += (c > 0u) ? 1u : 0u; mine = (j == x) ? c : mine; }
        if (sum == G) break;
        __builtin_amdgcn_s_sleep(1);
        if ((++sp & 255u) == 0u) { if (xb_ld(&bar[XB_TMO])) break; if (sp > XB_SPIN_CAP) { atomicAdd(&bar[XB_TMO], 1u); break; } }
    }
    nloc = mine > 0u ? mine : 1u; nx = cnt > 0u ? cnt : 1u;
}

__device__ __forceinline__ void xcd_barrier(const XcdBarrier& b) {
    asm volatile("s_waitcnt vmcnt(0)" ::: "memory");
    __syncthreads();
    if (threadIdx.x == 0) {
        unsigned* bar = b.bar;
        __builtin_amdgcn_s_waitcnt(0);
        unsigned nloc = b.st[0], nx = b.st[1];
        if (nloc == 0u) { xcd_barrier_complete(bar, b.x, nloc, nx); b.st[0] = nloc; b.st[1] = nx; }
        const unsigned old = xb_add(&bar[XB_XSUB(b.x)], 1u);
        const unsigned gen = old / nloc;
        if (old + 1u == (gen + 1u) * nloc) {
            __builtin_amdgcn_fence(__ATOMIC_RELEASE, "agent");
            asm volatile("s_waitcnt vmcnt(0)" ::: "memory");
            const unsigned og = xb_add(&bar[XB_TOP], 1u);
            const unsigned tg = og / nx;
            if (og + 1u == (tg + 1u) * nx) xb_add(&bar[XB_TOPGEN], 1u);
            else XB_SPIN(xb_ld(&bar[XB_TOPGEN]) == tg, bar);
            __builtin_amdgcn_fence(__ATOMIC_ACQUIRE, "agent");
            xb_add(&bar[XB_XGEN(b.x)], 1u);
            asm volatile("s_waitcnt vmcnt(0)" ::: "memory");
        } else {
            XB_SPIN(xb_ld(&bar[XB_XGEN(b.x)]) == gen, bar);
            __builtin_amdgcn_fence(__ATOMIC_ACQUIRE, "agent");
            asm volatile("s_waitcnt vmcnt(0)" ::: "memory");
        }
    }
    __syncthreads();
}

struct Args { const float* in[28]; float* out; unsigned char* ws; int ph_lo, ph_hi; };
enum InIdx { I_X = 0, I_C, I_CTX, I_CCTX, I_ADAW, I_ADAB, I_N1G, I_N2G, I_W1, I_W3, I_W2, I_GWIN, I_GLNG, I_GLNB, I_GWS, I_GBS, I_GWOUT,
             I_SWIN, I_SARE, I_SAIM, I_SLDT, I_SBRE, I_SBIM, I_SCRE, I_SCIM, I_SD, I_SWGLU, I_FING };

__device__ __forceinline__ int opaque_tid() { int t = threadIdx.x; asm volatile("" : "+v"(t)); return t; }
#define PHASE_IDS const int tid = opaque_tid(), lane = tid & 63, wave = __builtin_amdgcn_readfirstlane(tid >> 6); (void)tid; (void)lane; (void)wave

__device__ __forceinline__ void adaln_items(const Args& a, LAS unsigned char* lds, int wg, int nwg) {
    PHASE_IDS;
    LAS float* cs = (LAS float*)lds;
    LAS float* red = cs + 3 * 2048;
    const float* c = a.in[I_C]; const float* cc = a.in[I_CCTX];
    for (int i = tid; i < 3 * 2048; i += NTHR) { const int s = i >> 11, k = i & 2047; const float v = s < 2 ? c[s * 2048 + k] : cc[k]; cs[i] = v / (1.0f + expf(-v)); }
    __syncthreads();
    float* MOD = (float*)(a.ws + WS_MOD);
    const int cq = tid & 15, kg = tid >> 4;
    for (int item = wg; item < DEPTH * 192; item += nwg) {
        const int layer = item / 192, n0 = (item % 192) * 64;
        const float* W = a.in[I_ADAW] + (size_t)layer * 2048 * 12288 + n0 + 4 * cq;
        f32x4 a0 = {0.f, 0.f, 0.f, 0.f}, a1 = a0, a2 = a0;
#pragma unroll 8
        for (int k = kg; k < 2048; k += 32) { const f32x4 w = *(const GAS f32x4*)(W + (size_t)k * 12288); a0 += cs[k] * w; a1 += cs[2048 + k] * w; a2 += cs[4096 + k] * w; }
#pragma unroll
        for (int e = 0; e < 4; ++e) { red[(kg * 3 + 0) * 64 + 4 * cq + e] = a0[e]; red[(kg * 3 + 1) * 64 + 4 * cq + e] = a1[e]; red[(kg * 3 + 2) * 64 + 4 * cq + e] = a2[e]; }
        __syncthreads();
        if (tid < 192) { const int s = tid >> 6, col = tid & 63; float t = 0.f;
            for (int g = 0; g < 32; ++g) t += red[(g * 3 + s) * 64 + col];
            MOD[(size_t)(layer * 3 + s) * 12288 + n0 + col] = t + a.in[I_ADAB][layer * 12288 + n0 + col]; }
        __syncthreads();
    }
}
__device__ __forceinline__ void tr_item(const float* W, int ld, int K, int ncols, bf16* WT, int mode, LAS float* scr, int item, int lane) {
    const int nblk = ncols / 32, kb = item / nblk, nb = item % nblk, k0 = 64 * kb, n0 = 32 * nb;
    const int drow0 = mode == 0 ? n0 : (256 * (n0 >> 7) + (n0 & 127) + (mode == 2 ? 128 : 0));
#pragma unroll 8
    for (int i = 0; i < 32; ++i) { const int kk = 2 * i + (lane >> 5); scr[kk * 33 + (lane & 31)] = W[(size_t)(k0 + kk) * ld + n0 + (lane & 31)]; }
    LDS_WAIT(); asm volatile("" ::: "memory");
    const int c = lane & 7;
#pragma unroll
    for (int j = 0; j < 4; ++j) { const int n = (lane >> 3) + 8 * j; const LAS float* s = scr + (8 * c) * 33 + n;
        v4u o; o.x = pk2(s[0 * 33], s[1 * 33]); o.y = pk2(s[2 * 33], s[3 * 33]); o.z = pk2(s[4 * 33], s[5 * 33]); o.w = pk2(s[6 * 33], s[7 * 33]);
        *(GAS v4u*)(WT + (size_t)(drow0 + n) * K + k0 + 8 * c) = o; }
    LDS_WAIT(); asm volatile("" ::: "memory");
}
constexpr int TR_GIN = 2 * 8192, TR_GOUT = 2 * 4096, TR_FFN = 4 * 3 * 5632, TR_SIN = 2 * 2048, TR_GLU = 2 * 2 * 2048, TR_TOTAL = TR_GIN + TR_GOUT + TR_FFN + TR_SIN + TR_GLU;
__device__ __forceinline__ void transpose_items(const Args& a, LAS unsigned char* lds, int vcu, int G) {
    PHASE_IDS; const int gw = vcu * NWAVES + wave, ngw = G * NWAVES;
    LAS float* scr = (LAS float*)(lds + wave * 16384);
    unsigned char* ws = a.ws;
    for (int it0 = gw; it0 < TR_TOTAL; it0 += ngw) {
        int it = it0;
        if (it < TR_GIN) { const int j = it / 8192, r = it % 8192; tr_item(a.in[I_GWIN] + (size_t)j * 2048 * 8192, 8192, 2048, 8192, (bf16*)(ws + WS_WGIN) + (size_t)j * 8192 * 2048, 0, scr, r, lane); continue; } it -= TR_GIN;
        if (it < TR_GOUT) { const int j = it / 4096, r = it % 4096; tr_item(a.in[I_GWOUT] + (size_t)j * 4096 * 2048, 2048, 4096, 2048, (bf16*)(ws + WS_WGOUT) + (size_t)j * 2048 * 4096, 0, scr, r, lane); continue; } it -= TR_GOUT;
        if (it < TR_FFN) { const int i = it / 16896, r = it % 16896, which = r / 5632, rr = r % 5632;
            if (which == 0) tr_item(a.in[I_W1] + (size_t)i * 2048 * 5632, 5632, 2048, 5632, (bf16*)(ws + WS_WF13) + (size_t)i * 11264 * 2048, 1, scr, rr, lane);
            else if (which == 1) tr_item(a.in[I_W3] + (size_t)i * 2048 * 5632, 5632, 2048, 5632, (bf16*)(ws + WS_WF13) + (size_t)i * 11264 * 2048, 2, scr, rr, lane);
            else tr_item(a.in[I_W2] + (size_t)i * 5632 * 2048, 2048, 5632, 2048, (bf16*)(ws + WS_WF2) + (size_t)i * 2048 * 5632, 0, scr, rr, lane);
            continue; } it -= TR_FFN;
        if (it < TR_SIN) { const int j = it / 2048, r = it % 2048; tr_item(a.in[I_SWIN] + (size_t)j * 2048 * 2048, 2048, 2048, 2048, (bf16*)(ws + WS_WSIN) + (size_t)j * 2048 * 2048, 0, scr, r, lane); continue; } it -= TR_SIN;
        { const int j = it / 4096, r = it % 4096, half = r / 2048, rr = r % 2048;
          tr_item(a.in[I_SWGLU] + (size_t)j * 2048 * 4096 + half * 2048, 4096, 2048, 2048, (bf16*)(ws + WS_WGLU) + (size_t)j * 4096 * 2048, 1 + half, scr, rr, lane); }
    }
}
__device__ __forceinline__ void small_prologue(const Args& a, int vcu, int G) {
    PHASE_IDS; const int gtid = vcu * NTHR + tid, ngt = G * NTHR;
    bf16* WSB = (bf16*)(a.ws + WS_WSB);
    for (int i = gtid; i < 2 * 16 * 128 * 128; i += ngt) WSB[i] = (bf16)f2bf(a.in[I_GWS][i]);
    f32x2* S5A = (f32x2*)(a.ws + WS_S5A); f32x2* S5B = (f32x2*)(a.ws + WS_S5B);
    for (int i = gtid; i < 2 * 2 * SG * SP; i += ngt) {
        const int lg = i / SP;
        const float dt = expf(a.in[I_SLDT][lg]), are = a.in[I_SARE][i], aim = a.in[I_SAIM][i];
        const float e = expf(dt * are), th = dt * aim, abr = e * cosf(th), abi = e * sinf(th);
        f32x2 ab; ab.x = abr; ab.y = abi; S5A[i] = ab;
        const float nr = abr - 1.0f, ni = abi, den = 1.0f / (are * are + aim * aim);
        const float cr = (nr * are + ni * aim) * den, ci = (ni * are - nr * aim) * den;
        for (int q = 0; q < SQ; ++q) { const float br = a.in[I_SBRE][(size_t)i * SQ + q], bi = a.in[I_SBIM][(size_t)i * SQ + q];
            f32x2 o; o.x = cr * br - ci * bi; o.y = cr * bi + ci * br; S5B[(size_t)i * SQ + q] = o; }
    }
}

template <bool INIT> __device__ __forceinline__ void norm_phase(const Args& a, const float* gain, const float* modl  , int which, int vcu, int G, int nslab = 0, const float* sgate = nullptr, int mrows = M) {
    PHASE_IDS; const int gw = vcu * NWAVES + wave, ngw = G * NWAVES;
    float* H = (float*)(a.ws + WS_H); bf16* XN = (bf16*)(a.ws + WS_XN);
    for (int row = gw; row < mrows; row += ngw) {
        const int set = row < ML ? (row >> 13) : 2;
        GAS f32x4* hr = (GAS f32x4*)(H + (size_t)row * D) + lane;
        f32x4 v[8];
        if (INIT) {
            if (row < ML) {
                const GAS f32x4* xr = (const GAS f32x4*)(a.in[I_X] + (size_t)row * D) + lane;
#pragma unroll
                for (int j = 0; j < 8; ++j) v[j] = xr[64 * j];
                const int t = row & (SEQ - 1); const float pr = (float)(t >> 6), pc = (float)(t & 63);
#pragma unroll
                for (int jj = 0; jj < 2; ++jj)
#pragma unroll
                    for (int e = 0; e < 4; ++e) { const float om = exp2f(-(float)(256 * jj + 4 * lane + e) * (13.287712379549449f / 512.0f));
                        const float ar = pr * om, ac = pc * om;
                        v[0 + jj][e] += sinf(ar); v[2 + jj][e] += cosf(ar); v[4 + jj][e] += sinf(ac); v[6 + jj][e] += cosf(ac); }
            } else {
                const GAS f32x4* xr = (const GAS f32x4*)(a.in[I_CTX] + (size_t)(row - ML) * D) + lane;
#pragma unroll
                for (int j = 0; j < 8; ++j) v[j] = xr[64 * j];
            }
#pragma unroll
            for (int j = 0; j < 8; ++j) hr[64 * j] = v[j];
        } else {
#pragma unroll
            for (int j = 0; j < 8; ++j) v[j] = hr[64 * j];
            if (nslab > 0 && row >= ML) {
                const GAS f32x4* sp = (const GAS f32x4*)((const float*)(a.ws + WS_SLAB) + (size_t)(row - ML) * D) + lane; const GAS f32x4* gp2 = (const GAS f32x4*)sgate + lane;
                f32x4 t[8];
#pragma unroll
                for (int j = 0; j < 8; ++j) t[j] = sp[64 * j];
                for (int s = 1; s < nslab; ++s) {
#pragma unroll
                    for (int j = 0; j < 8; ++j) t[j] += sp[(size_t)s * (512 * D / 4) + 64 * j]; }
#pragma unroll
                for (int j = 0; j < 8; ++j) { v[j] += gp2[64 * j] * t[j]; hr[64 * j] = v[j]; }
            }
        }
        float ss = 0.f;
#pragma unroll
        for (int j = 0; j < 8; ++j) ss += (v[j].x * v[j].x + v[j].y * v[j].y) + (v[j].z * v[j].z + v[j].w * v[j].w);
        const float rinv = 1.0f / sqrtf(wave_sum(ss) * (1.0f / D) + EPS);
        const GAS f32x4* gp = (const GAS f32x4*)gain + lane;
        const GAS f32x4* shp = (const GAS f32x4*)(modl + (size_t)set * 12288 + (which * 3 + 0) * D) + lane;
        const GAS f32x4* scp = (const GAS f32x4*)(modl + (size_t)set * 12288 + (which * 3 + 1) * D) + lane;
        GAS v2u* o8 = (GAS v2u*)(XN + (size_t)row * D) + lane;
#pragma unroll
        for (int j = 0; j < 8; ++j) { const f32x4 g = gp[64 * j], sh = shp[64 * j], sc = scp[64 * j];
            const f32x4 y = v[j] * rinv * g * (1.0f + sc) + sh;
            v2u o; o.x = pk2(y.x, y.y); o.y = pk2(y.z, y.w); o8[64 * j] = o; }
    }
}
__device__ __forceinline__ void final_phase(const Args& a, int vcu, int G) {
    PHASE_IDS; const int gw = vcu * NWAVES + wave, ngw = G * NWAVES;
    const float* H = (const float*)(a.ws + WS_H);
    for (int row = gw; row < ML; row += ngw) {
        const GAS f32x4* hr = (const GAS f32x4*)(H + (size_t)row * D) + lane;
        f32x4 v[8]; float ss = 0.f;
#pragma unroll
        for (int j = 0; j < 8; ++j) { v[j] = hr[64 * j]; ss += (v[j].x * v[j].x + v[j].y * v[j].y) + (v[j].z * v[j].z + v[j].w * v[j].w); }
        const float rinv = 1.0f / sqrtf(wave_sum(ss) * (1.0f / D) + EPS);
        const GAS f32x4* gp = (const GAS f32x4*)a.in[I_FING] + lane;
        GAS f32x4* o = (GAS f32x4*)(a.out + (size_t)row * D) + lane;
#pragma unroll
        for (int j = 0; j < 8; ++j) o[64 * j] = v[j] * rinv * gp[64 * j];
    }
}

__device__ __forceinline__ void sgu_phase(const Args& a, int gl  , LAS unsigned char* lds, int wg, int nwg, int dry) {
    PHASE_IDS;
    bf16* ZU = (bf16*)(a.ws + WS_ZU); const bf16* ZV = (const bf16*)(a.ws + WS_ZV); const float* VSTAT = (const float*)(a.ws + WS_VSTAT);
    const bf16* WSB = (const bf16*)(a.ws + WS_WSB) + (size_t)gl * 16 * 128 * 128;
    const float* bs = a.in[I_GBS] + gl * 16 * 128; const float* lng = a.in[I_GLNG] + gl * EA; const float* lnb = a.in[I_GLNB] + gl * EA;
    LAS f32x2* st = (LAS f32x2*)lds;
    const int n = lane & 31, h = lane >> 5;
    for (int unit = wg; unit < NCHUNK * NH; unit += nwg) {
        const int c = unit / NH, hd = unit % NH, r0 = c * CHUNK;
        { const int j = tid >> 2, part = tid & 3; const GAS f32x4* p = (const GAS f32x4*)(VSTAT + ((size_t)(r0 + j) * 64 + part * 16) * 2);
          float s = 0.f, ss = 0.f;
#pragma unroll
          for (int q = 0; q < 8; ++q) { const f32x4 w = p[q]; s += w.x + w.z; ss += w.y + w.w; }
          s += __shfl_xor(s, 1); s += __shfl_xor(s, 2); ss += __shfl_xor(ss, 1); ss += __shfl_xor(ss, 2);
          if (part == 0) { const float mean = s * (1.0f / EA), var = ss * (1.0f / EA) - mean * mean; f32x2 o; o.x = mean; o.y = 1.0f / sqrtf(var + EPS); st[j] = o; } }
        __syncthreads();
        const int gcol = hd * HDIM + 32 * wave + n;
        const float lg = lng[gcol], lb = lnb[gcol];
        const GAS bf16* vp = (const GAS bf16*)ZV + (size_t)r0 * EA + gcol;
        unsigned short raw[8][8];
#pragma unroll
        for (int ks = 0; ks < 8; ++ks)
#pragma unroll
            for (int e = 0; e < 8; ++e) raw[ks][e] = vp[(size_t)(16 * ks + 8 * h + e) * EA];
        bf16x8 Bf[8];
#pragma unroll
        for (int ks = 0; ks < 8; ++ks) { float f[8];
#pragma unroll
            for (int e = 0; e < 8; ++e) { const f32x2 m = st[16 * ks + 8 * h + e]; f[e] = (bf2f(raw[ks][e]) - m.x) * m.y * lg + lb; }
            v4u w; w.x = pk2(f[0], f[1]); w.y = pk2(f[2], f[3]); w.z = pk2(f[4], f[5]); w.w = pk2(f[6], f[7]); Bf[ks] = __builtin_bit_cast(bf16x8, w); }
#pragma unroll 1
        for (int ib = 0; ib < 4; ++ib) {
            f32x16 acc;
#pragma unroll
            for (int r = 0; r < 16; ++r) acc[r] = 0.f;
            const GAS bf16x8* ap = (const GAS bf16x8*)(WSB + ((size_t)hd * 128 + 32 * ib + n) * 128 + 8 * h);
#pragma unroll
            for (int ks = 0; ks < 8; ++ks) { const bf16x8 Af = ap[2 * ks]; acc = __builtin_amdgcn_mfma_f32_32x32x16_bf16(Af, Bf[ks], acc, 0, 0, 0); }
#pragma unroll
            for (int r = 0; r < 16; ++r) { const int i = 32 * ib + (r & 3) + 8 * (r >> 2) + 4 * h; const float s = acc[r] + bs[hd * 128 + i];
                GAS bf16* up = (GAS bf16*)ZU + (size_t)(r0 + i) * EA + gcol; const bf16 nv = (bf16)f2bf(bf2f(*up) * s); if (!dry) *up = nv; }
        }
        __syncthreads();
    }
}

__device__ __forceinline__ void s5_naive_phase(const Args& a, int sl  , int wg, int nwg) {
    PHASE_IDS;
    if (wave >= 2) return;
    const bf16* U = (const bf16*)(a.ws + WS_SU);
    for (int item = wg * 2 + wave; item < 2 * 2 * SG; item += nwg * 2) {
        const int b = item & 1, k = (item >> 1) & 1, g = item >> 2;
        const int pg = ((sl * 2 + k) * SG + g);
        const f32x2 ab = ((const f32x2*)(a.ws + WS_S5A))[(size_t)pg * SP + lane];
        float bre[16], bim[16], cr[16], ci[16];
#pragma unroll
        for (int q = 0; q < 16; ++q) { const f32x2 bb = ((const f32x2*)(a.ws + WS_S5B))[((size_t)pg * SP + lane) * SQ + q]; bre[q] = bb.x; bim[q] = bb.y;
            cr[q] = a.in[I_SCRE][((size_t)pg * SQ + q) * SP + lane]; ci[q] = a.in[I_SCIM][((size_t)pg * SQ + q) * SP + lane]; }
        float* Y = (float*)(a.ws + (k ? WS_YB : WS_YF));
        float hr = 0.f, hi = 0.f;
#pragma unroll 1
        for (int seg = 0; seg < 2; ++seg) {
            const int L = seg ? SEQ : CTXL, base = seg ? b * SEQ : ML + b * CTXL;
#pragma unroll 1
            for (int blk = 0; blk < L; blk += 64) {
                const int myt = k ? (L - 1 - (blk + lane)) : (blk + lane);
                const size_t row = (size_t)(base + myt);
                const GAS v4u* up = (const GAS v4u*)(U + row * D + 16 * g);
                const v4u u0 = up[0], u1 = up[1];
                float keep[16];
#pragma unroll
                for (int q = 0; q < 16; ++q) keep[q] = 0.f;
#pragma unroll 1
                for (int s = 0; s < 64; ++s) {
                    unsigned w[8];
                    w[0] = __builtin_amdgcn_readlane(u0.x, s); w[1] = __builtin_amdgcn_readlane(u0.y, s); w[2] = __builtin_amdgcn_readlane(u0.z, s); w[3] = __builtin_amdgcn_readlane(u0.w, s);
                    w[4] = __builtin_amdgcn_readlane(u1.x, s); w[5] = __builtin_amdgcn_readlane(u1.y, s); w[6] = __builtin_amdgcn_readlane(u1.z, s); w[7] = __builtin_amdgcn_readlane(u1.w, s);
                    float br = 0.f, bi = 0.f;
#pragma unroll
                    for (int q2 = 0; q2 < 8; ++q2) { const float ulo = __builtin_bit_cast(float, w[q2] << 16), uhi = __builtin_bit_cast(float, w[q2] & 0xffff0000u);
                        br += bre[2 * q2] * ulo + bre[2 * q2 + 1] * uhi; bi += bim[2 * q2] * ulo + bim[2 * q2 + 1] * uhi; }
                    const float nhr = ab.x * hr - ab.y * hi + br, nhi = ab.x * hi + ab.y * hr + bi; hr = nhr; hi = nhi;
#pragma unroll
                    for (int q = 0; q < 16; ++q) { const float y = wave_sum(cr[q] * hr - ci[q] * hi); keep[q] = (lane == s) ? y : keep[q]; }
                }
                GAS f32x4* yp = (GAS f32x4*)(Y + row * D + 16 * g);
#pragma unroll
                for (int q4 = 0; q4 < 4; ++q4) { f32x4 o; o.x = keep[4 * q4]; o.y = keep[4 * q4 + 1]; o.z = keep[4 * q4 + 2]; o.w = keep[4 * q4 + 3]; yp[q4] = o; }
            }
        }
    }
}
__device__ __forceinline__ void s5_combine_phase(const Args& a, int sl, int vcu, int G) {
    PHASE_IDS; const int gw = vcu * NWAVES + wave, ngw = G * NWAVES;
    const float* YF = (const float*)(a.ws + WS_YF); const float* YB = (const float*)(a.ws + WS_YB); const bf16* U = (const bf16*)(a.ws + WS_SU); bf16* Z = (bf16*)(a.ws + WS_SZ);
    const GAS f32x4* dp = (const GAS f32x4*)(a.in[I_SD] + sl * D) + lane;
    for (int row = gw; row < M; row += ngw) {
        const GAS f32x4* yf = (const GAS f32x4*)(YF + (size_t)row * D) + lane; const GAS f32x4* yb = (const GAS f32x4*)(YB + (size_t)row * D) + lane;
        const GAS v2u* up = (const GAS v2u*)(U + (size_t)row * D) + lane; GAS v2u* zp = (GAS v2u*)(Z + (size_t)row * D) + lane;
#pragma unroll
        for (int j = 0; j < 8; ++j) { const f32x4 f = yf[64 * j], bk = yb[64 * j], dd = dp[64 * j]; const v2u uu = up[64 * j];
            f32x4 u4; u4.x = __builtin_bit_cast(float, uu.x << 16); u4.y = __builtin_bit_cast(float, uu.x & 0xffff0000u); u4.z = __builtin_bit_cast(float, uu.y << 16); u4.w = __builtin_bit_cast(float, uu.y & 0xffff0000u);
            const f32x4 y = f + bk + u4 * dd;
            v2u o; o.x = pk2(pg8::gelu_tanh_f(y.x), pg8::gelu_tanh_f(y.y)); o.y = pk2(pg8::gelu_tanh_f(y.z), pg8::gelu_tanh_f(y.w)); zp[64 * j] = o; }
    }
}

__device__ __forceinline__ f32x2 cmul(f32x2 a, f32x2 b) { f32x2 r; r.x = a.x * b.x - a.y * b.y; r.y = a.x * b.y + a.y * b.x; return r; }
__device__ __forceinline__ void s5_precompute(const Args& a, LAS unsigned char* lds, int wg, int nwg) {
    PHASE_IDS;
    LAS f32x2* apw = (LAS f32x2*)lds;
    LAS f32x2* bbl = apw + 2 * 17 * 64;
    LAS f32x2* ccl = bbl + 2 * 64 * 16;
    LAS float* ktab = (LAS float*)(ccl + 2 * 16 * 64);
    for (int item = wg; item < 2 * SG; item += nwg) {
        const int sl = item >> 7, g = item & 127;
        if (tid < 128) { const int d = tid >> 6, p = tid & 63, pg = (sl * 2 + d) * SG + g, i = pg * SP + p;
            const float dt = expf(a.in[I_SLDT][pg]), are = a.in[I_SARE][i], aim = a.in[I_SAIM][i];
            for (int l = 0; l <= 16; ++l) { const float e = expf((float)l * (dt * are)), th = (float)l * (dt * aim); f32x2 o; o.x = e * cosf(th); o.y = e * sinf(th); apw[(d * 17 + l) * 64 + p] = o; }
            const f32x2 ab = apw[(d * 17 + 1) * 64 + p];
            const float nr = ab.x - 1.0f, ni = ab.y, den = 1.0f / (are * are + aim * aim);
            f32x2 coef; coef.x = (nr * are + ni * aim) * den; coef.y = (ni * are - nr * aim) * den;
            for (int q = 0; q < SQ; ++q) { f32x2 bq; bq.x = a.in[I_SBRE][(size_t)i * SQ + q]; bq.y = a.in[I_SBIM][(size_t)i * SQ + q]; bbl[(d * 64 + p) * 16 + q] = cmul(coef, bq); }
            ((f32x2*)(a.ws + WS_A16))[i] = apw[(d * 17 + 16) * 64 + p]; }
        for (int e = tid; e < 2 * 16 * 64; e += NTHR) { const int d = e >> 10, q = (e >> 6) & 15, p = e & 63; const size_t ci = ((size_t)((sl * 2 + d) * SG + g) * SQ + q) * SP + p;
            f32x2 o; o.x = a.in[I_SCRE][ci]; o.y = a.in[I_SCIM][ci]; ccl[e] = o; }
        __syncthreads();
        for (int o = tid; o < 8192; o += NTHR) { const int d = o >> 12, l = (o >> 8) & 15, q = (o >> 4) & 15, qp = o & 15; float acc = 0.f;
            for (int p = 0; p < 64; ++p) { const f32x2 ca = cmul(ccl[(d * 16 + q) * 64 + p], apw[(d * 17 + l) * 64 + p]), bb = bbl[(d * 64 + p) * 16 + qp]; acc += ca.x * bb.x - ca.y * bb.y; }
            ktab[o] = acc; }
        __syncthreads();
        bf16* MoutT = (bf16*)(a.ws + WS_MOUTT) + (size_t)(sl * SG + g) * 256 * 512;
        bf16* M2T = (bf16*)(a.ws + WS_M2T) + (size_t)(sl * SG + g) * 256 * 256;
        for (int ch = tid; ch < 256 * 64; ch += NTHR) { const int n = ch >> 6, jj = ch & 63, t = n >> 4, q = n & 15; float v[8];
            if (jj < 32) { const int s = jj >> 1, q0 = 8 * (jj & 1);
#pragma unroll
                for (int e = 0; e < 8; ++e) { const int qp = q0 + e;
                    v[e] = s < t ? ktab[((0 * 16 + (t - s)) * 16 + q) * 16 + qp] : (s > t ? ktab[((1 * 16 + (s - t)) * 16 + q) * 16 + qp]
                         : ktab[(0 * 16 * 16 + q) * 16 + qp] + ktab[((16) * 16 + q) * 16 + qp] + (q == qp ? a.in[I_SD][sl * D + 16 * g + q] : 0.f)); }
            } else { const int j2 = jj - 32, d = j2 >> 4, p0 = (j2 & 15) * 4, ex = d == 0 ? t + 1 : 16 - t;
#pragma unroll
                for (int pp = 0; pp < 4; ++pp) { const f32x2 ca = cmul(ccl[(d * 16 + q) * 64 + p0 + pp], apw[(d * 17 + ex) * 64 + p0 + pp]); v[2 * pp] = ca.x; v[2 * pp + 1] = -ca.y; } }
            v4u w; w.x = pk2(v[0], v[1]); w.y = pk2(v[2], v[3]); w.z = pk2(v[4], v[5]); w.w = pk2(v[6], v[7]);
            *(GAS v4u*)(MoutT + (size_t)n * 512 + 8 * jj) = w; }
        for (int ch = tid; ch < 256 * 32; ch += NTHR) { const int n = ch >> 5, jj = ch & 31, d = n >> 7, p = (n & 127) >> 1, im = n & 1, s = jj >> 1, q0 = 8 * (jj & 1), ex = d == 0 ? 15 - s : s; float v[8];
            const f32x2 ap = apw[(d * 17 + ex) * 64 + p];
#pragma unroll
            for (int e = 0; e < 8; ++e) { const f32x2 r = cmul(ap, bbl[(d * 64 + p) * 16 + q0 + e]); v[e] = im ? r.y : r.x; }
            v4u w; w.x = pk2(v[0], v[1]); w.y = pk2(v[2], v[3]); w.z = pk2(v[4], v[5]); w.w = pk2(v[6], v[7]);
            *(GAS v4u*)(M2T + (size_t)n * 256 + 8 * jj) = w; }
        __syncthreads();
    }
}
template <bool OUT> __device__ __forceinline__ void s5_ctx_gemm(const Args& a, int sl, int wg, int nwg) {
    PHASE_IDS;
    constexpr int K = OUT ? 512 : 256;
    const int r = lane & 31, hh = lane >> 5;
    for (int g = wg; g < SG; g += nwg) {
        const GAS bf16x8* ap = (const GAS bf16x8*)((const bf16*)(a.ws + WS_XC) + (size_t)(g * 32 + r) * 512 + 8 * hh);
        const bf16* Bt = OUT ? (const bf16*)(a.ws + WS_MOUTT) + (size_t)(sl * SG + g) * 256 * 512 : (const bf16*)(a.ws + WS_M2T) + (size_t)(sl * SG + g) * 256 * 256;
        const GAS bf16x8* bp = (const GAS bf16x8*)(Bt + (size_t)(32 * wave + r) * K + 8 * hh);
        f32x16 acc;
#pragma unroll
        for (int i = 0; i < 16; ++i) acc[i] = 0.f;
#pragma unroll 8
        for (int ks = 0; ks < K / 16; ++ks) acc = __builtin_amdgcn_mfma_f32_32x32x16_bf16(ap[2 * ks], bp[2 * ks], acc, 0, 0, 0);
        const int n = 32 * wave + r;
#pragma unroll
        for (int i = 0; i < 16; ++i) { const int c = (i & 3) + 8 * (i >> 2) + 4 * hh;
            if (OUT) { const int t = n >> 4, q = n & 15; ((GAS bf16*)(a.ws + WS_Z))[(size_t)(ML + 16 * c + t) * D + 16 * g + q] = (bf16)f2bf(pg8::gelu_tanh_f(acc[i])); }
            else ((GAS bf16*)(a.ws + WS_SC))[(size_t)(g * 32 + c) * 256 + n] = (bf16)f2bf(acc[i]); }
    }
}
__device__ __forceinline__ void s5_carry_phase(const Args& a, int sl, int wg, int nwg) {
    PHASE_IDS;
    if (wave >= 2) return;
    for (int item = wg * 2 + wave; item < 2 * 2 * SG; item += nwg * 2) {
        const int b = item & 1, d = (item >> 1) & 1, g = item >> 2;
        const f32x2 a16 = ((const f32x2*)(a.ws + WS_A16))[(size_t)((sl * 2 + d) * SG + g) * SP + lane];
        const GAS unsigned* SLw = (const GAS unsigned*)(a.ws + WS_SL) + (size_t)(g * 1024 + b * 512) * 128 + d * 64 + lane;
        const GAS unsigned* SCw = (const GAS unsigned*)(a.ws + WS_SC) + (size_t)(g * 32 + b * 16) * 128 + d * 64 + lane;
        GAS unsigned* XLw = (GAS unsigned*)(a.ws + WS_XL) + (size_t)(g * 1024 + b * 512) * 256 + 128 + d * 64 + lane;
        GAS unsigned* XCw = (GAS unsigned*)(a.ws + WS_XC) + (size_t)(g * 32 + b * 16) * 256 + 128 + d * 64 + lane;
        float hr = 0.f, hi = 0.f;
        unsigned b0[16], b1[16], b2[16];
#define S5_CIDX(bi, j) ((bi) == 0 ? (d ? 15 - (j) : (j)) : (d ? 511 - (((bi) - 1) * 16 + (j)) : ((bi) - 1) * 16 + (j)))
#define S5_LOAD(bi, arr) do { _Pragma("unroll") for (int j = 0; j < 16; ++j) { const int ci = S5_CIDX(bi, j); arr[j] = (bi) == 0 ? SCw[(size_t)ci * 128] : SLw[(size_t)ci * 128]; } } while (0)
#define S5_PROC(bi, arr) do { _Pragma("unroll") for (int j = 0; j < 16; ++j) { const int ci = S5_CIDX(bi, j); const unsigned hw = pk2(hr, hi); \
            if ((bi) == 0) XCw[(size_t)ci * 256] = hw; else XLw[(size_t)ci * 256] = hw; \
            const float sr = __builtin_bit_cast(float, arr[j] << 16), si = __builtin_bit_cast(float, arr[j] & 0xffff0000u); \
            const float nr = a16.x * hr - a16.y * hi + sr, ni = a16.x * hi + a16.y * hr + si; hr = nr; hi = ni; } } while (0)
        S5_LOAD(0, b0); S5_LOAD(1, b1); S5_LOAD(2, b2);
#pragma unroll 1
        for (int it = 0; it < 11; ++it) { const int bi = 3 * it;
            S5_PROC(bi, b0);     if (bi + 3 < 33) S5_LOAD(bi + 3, b0);
            S5_PROC(bi + 1, b1); if (bi + 4 < 33) S5_LOAD(bi + 4, b1);
            S5_PROC(bi + 2, b2); if (bi + 5 < 33) S5_LOAD(bi + 5, b2);
        }
#undef S5_CIDX
#undef S5_LOAD
#undef S5_PROC
    }
}

#ifndef MK_ONE_LAUNCH
#define MK_ONE_LAUNCH 1
#endif
constexpr int N_PHASES = 2 + 2 * 16;

__global__ void __launch_bounds__(NTHR, 2) fwd_kernel(Args args) {
    extern __shared__ __attribute__((aligned(16))) unsigned char lds_raw[];
    LAS unsigned char* lds = (LAS unsigned char*)lds_raw;
    const int tid = threadIdx.x;
    const int G = gridDim.x, bx = blockIdx.x;
    const int vcu = (G % 8 == 0) ? (bx % 8) * (G / 8) + bx / 8 : bx;
    unsigned char* ws = args.ws;
    volatile LAS unsigned* MISC = (volatile LAS unsigned*)(lds + MISC_OFF);
    for (int u = tid; u < (LDS_BYTES - LDSCTL_OFF) / 4; u += NTHR) ((LAS unsigned*)(lds + LDSCTL_OFF))[u] = 0u;
    __syncthreads();
    const int lo = args.ph_lo, hi = args.ph_hi;
    XcdBarrier bar; bar.bar = (unsigned*)(ws + WS_CTL) + CW_BAR; bar.x = 0; bar.st = nullptr;
    if (hi - lo > 1) bar = xcd_barrier_post((unsigned*)(ws + WS_CTL) + CW_BAR, MISC + 8);
#define RUN(k) (lo <= (k) && (k) < hi)
#ifndef PROBE_MASK
#define PROBE_MASK 0
#endif
#define REP(kind) for (int rep = 0, nrep = 1 + ((PROBE_MASK >> (kind)) & 1); rep < nrep; ++rep)
#ifndef PROBE_WET
#define PROBE_WET 0
#endif
#define GATE(p) ((PROBE_WET && rep) ? (const float*)(ws + WS_CTL + 512 * 1024) : (p))
#define DRY (PROBE_WET ? 0 : rep)
#define REPSYNC() do { if (rep + 1 < nrep) __syncthreads(); } while (0)
#define SEAM(k) do { if (RUN(k) && RUN((k) + 1)) { xcd_barrier(bar); if ((PROBE_MASK >> 12) & 1) xcd_barrier(bar); } } while (0)
    float* H = (float*)(ws + WS_H); pg8::bf16_t* XN = (pg8::bf16_t*)(ws + WS_XN);
    const float* MOD = (const float*)(ws + WS_MOD);

#ifndef NO_PRO
    if (RUN(0)) REP(0) {
        adaln_items(args, lds, vcu, G);
        transpose_items(args, lds, vcu, G);
        small_prologue(args, vcu, G);
#if !S5_NAIVE
        __syncthreads();
        s5_precompute(args, lds, vcu, G);
#endif
        REPSYNC();
    }
#endif
    SEAM(0);
    if (RUN(1)) REP(1) norm_phase<true>(args, args.in[I_N1G], MOD, 0, vcu, G);
    SEAM(1);

#ifdef UNROLL_LP
#pragma unroll
#else
#pragma unroll 1
#endif
    for (int lp = 0; lp < 2; ++lp) {
        const int pb = 2 + lp * 16;
        {
            const int layer = 2 * lp; const float* modl = MOD + (size_t)layer * 3 * 12288;
            if (RUN(pb + 0)) { REP(2) {
                pg8::Gemm g{XN, (const pg8::bf16_t*)(ws + WS_WGIN) + (size_t)lp * 8192 * 2048, M, 8192, D}; pg8::StaticOrder S; S.init(M, 8192, G, bx);
                pg8::EpiG1 E{(pg8::bf16_t*)(ws + WS_ZU), (pg8::bf16_t*)(ws + WS_ZV), (float*)(ws + WS_VSTAT)};
                pg8::gemm_phase<pg8::EpiG1, pg8::StaticOrder, true, true>(lds + RING_OFF, g, S, E);
                REPSYNC(); }
            }
            SEAM(pb + 0);
            #ifndef NO_SGU
            if (RUN(pb + 1)) REP(3) sgu_phase(args, lp, lds, bx, G, rep);
#endif
            SEAM(pb + 1);
            if (RUN(pb + 2)) { REP(4) {
                pg8::Gemm g{(const pg8::bf16_t*)(ws + WS_ZU), (const pg8::bf16_t*)(ws + WS_WGOUT) + (size_t)lp * 2048 * 4096, ML, D, EA}; pg8::StaticOrder S; S.init(ML, D, G, bx);
                pg8::EpiResid E{H, GATE(modl + 2 * D), DRY};
                pg8::gemm_phase<pg8::EpiResid, pg8::StaticOrder, true, true>(lds + RING_OFF, g, S, E);
                __syncthreads();
                pg8::Gemm gc{(const pg8::bf16_t*)(ws + WS_ZU), (const pg8::bf16_t*)(ws + WS_WGOUT) + (size_t)lp * 2048 * 4096, M, D, 512, EA, EA}; pg8::SliceOrder SS; SS.init(G, bx, 8, 512);
                pg8::EpiSlab ES{(float*)(ws + WS_SLAB), 1024};
                pg8::gemm_phase<pg8::EpiSlab, pg8::SliceOrder, true, true>(lds + RING_OFF, gc, SS, ES);
                REPSYNC(); }
            }
            SEAM(pb + 2);
            if (RUN(pb + 3)) REP(1) norm_phase<false>(args, args.in[I_N2G] + layer * D, modl, 1, vcu, G, rep ? 0 : 8, modl + 2 * 12288 + 2 * D);
            SEAM(pb + 3);
            if (RUN(pb + 4)) { REP(5) {
                pg8::Gemm g{XN, (const pg8::bf16_t*)(ws + WS_WF13) + (size_t)layer * 11264 * 2048, M, 2 * FF, D}; pg8::StaticOrder S; S.init(M, 2 * FF, G, bx);
                pg8::EpiSwiGLU E{(pg8::bf16_t*)(ws + WS_HID)};
                pg8::gemm_phase<pg8::EpiSwiGLU, pg8::StaticOrder, true, true>(lds + RING_OFF, g, S, E);
                REPSYNC(); }
            }
            SEAM(pb + 4);
            if (RUN(pb + 5)) { REP(6) {
                pg8::Gemm g{(const pg8::bf16_t*)(ws + WS_HID), (const pg8::bf16_t*)(ws + WS_WF2) + (size_t)layer * 2048 * 5632, ML, D, FF}; pg8::StaticOrder S; S.init(ML, D, G, bx);
                pg8::EpiResid E{H, GATE(modl + 5 * D), DRY};
                pg8::gemm_phase<pg8::EpiResid, pg8::StaticOrder, true, true>(lds + RING_OFF, g, S, E);
                if (true) { __syncthreads();
                pg8::Gemm gc{(const pg8::bf16_t*)(ws + WS_HID), (const pg8::bf16_t*)(ws + WS_WF2) + (size_t)layer * 2048 * 5632, M, D, 512, FF, FF}; pg8::SliceOrder SS; SS.init(G, bx, 11, 512);
                pg8::EpiSlab ES{(float*)(ws + WS_SLAB), 1024};
                pg8::gemm_phase<pg8::EpiSlab, pg8::SliceOrder, true, true>(lds + RING_OFF, gc, SS, ES); }
                REPSYNC(); }
            }
            SEAM(pb + 5);
            if (RUN(pb + 6)) REP(1) norm_phase<false>(args, args.in[I_N1G] + (layer + 1) * D, modl + 3 * 12288, 0, vcu, G, rep ? 0 : 11, modl + 2 * 12288 + 5 * D);
            SEAM(pb + 6);
        }
        {
            const int layer = 2 * lp + 1; const float* modl = MOD + (size_t)layer * 3 * 12288; const int ps = pb + 7;
            const int Mrows = lp == 0 ? M : ML;
#if S5_NAIVE
            if (RUN(ps + 0)) {
                pg8::Gemm g{XN, (const pg8::bf16_t*)(ws + WS_WSIN) + (size_t)lp * 2048 * 2048, M, D, D}; pg8::StaticOrder S; S.init(M, D, G, bx);
                pg8::EpiPlainBf16 E{(pg8::bf16_t*)(ws + WS_SU), D};
                pg8::gemm_phase<pg8::EpiPlainBf16, pg8::StaticOrder, true, true>(lds + RING_OFF, g, S, E);
            }
            SEAM(ps + 0);
            if (RUN(ps + 1)) s5_naive_phase(args, lp, bx, G);
            SEAM(ps + 1);
            if (RUN(ps + 2)) s5_combine_phase(args, lp, vcu, G);
            SEAM(ps + 2);
            SEAM(ps + 3);
#else
            if (RUN(ps + 0)) { REP(7) {
                pg8::Gemm g{XN, (const pg8::bf16_t*)(ws + WS_WSIN) + (size_t)lp * 2048 * 2048, M, D, D}; pg8::StaticOrder S; S.init(M, D, G, bx);
                pg8::EpiS5In E{(pg8::bf16_t*)(ws + WS_XL), (pg8::bf16_t*)(ws + WS_XC)};
                pg8::gemm_phase<pg8::EpiS5In, pg8::StaticOrder, true, true>(lds + RING_OFF, g, S, E);
                REPSYNC(); }
            }
            SEAM(ps + 0);
            if (RUN(ps + 1)) { REP(8) {
                pg8::Gemm g{(const pg8::bf16_t*)(ws + WS_XL), (const pg8::bf16_t*)(ws + WS_M2T) + (size_t)lp * SG * 256 * 256, SG * 1024, 256, 256, 512}; pg8::GroupOrder S; S.init(G, vcu);
                pg8::EpiS5State E{(pg8::bf16_t*)(ws + WS_SL)};
                pg8::gemm_phase<pg8::EpiS5State, pg8::GroupOrder, true, true>(lds + RING_OFF, g, S, E);
                s5_ctx_gemm<false>(args, lp, vcu, G);
                REPSYNC(); }
            }
            SEAM(ps + 1);
            if (RUN(ps + 2)) REP(9) s5_carry_phase(args, lp, bx, G);
            SEAM(ps + 2);
            if (RUN(ps + 3)) { REP(10) {
                pg8::Gemm g{(const pg8::bf16_t*)(ws + WS_XL), (const pg8::bf16_t*)(ws + WS_MOUTT) + (size_t)lp * SG * 256 * 512, SG * 1024, 256, 512, 512}; pg8::GroupOrder S; S.init(G, vcu);
                pg8::EpiS5Out E{(pg8::bf16_t*)(ws + WS_Z)};
                pg8::gemm_phase<pg8::EpiS5Out, pg8::GroupOrder, true, true>(lds + RING_OFF, g, S, E);
                s5_ctx_gemm<true>(args, lp, vcu, G);
                REPSYNC(); }
            }
            SEAM(ps + 3);
#endif
            if (RUN(ps + 4)) { REP(11) {
                pg8::Gemm g{(const pg8::bf16_t*)(ws + WS_Z), (const pg8::bf16_t*)(ws + WS_WGLU) + (size_t)lp * 4096 * 2048, Mrows, 2 * D, D}; pg8::StaticOrder S; S.init(Mrows, 2 * D, G, bx);
                pg8::EpiGluResid E{H, GATE(modl + 2 * D), DRY};
                pg8::gemm_phase<pg8::EpiGluResid, pg8::StaticOrder, true, true>(lds + RING_OFF, g, S, E);
                REPSYNC(); }
            }
            SEAM(ps + 4);
            if (RUN(ps + 5)) REP(1) norm_phase<false>(args, args.in[I_N2G] + layer * D, modl, 1, vcu, G, 0, nullptr, Mrows);
            SEAM(ps + 5);
            if (RUN(ps + 6)) { REP(5) {
                pg8::Gemm g{XN, (const pg8::bf16_t*)(ws + WS_WF13) + (size_t)layer * 11264 * 2048, Mrows, 2 * FF, D}; pg8::StaticOrder S; S.init(Mrows, 2 * FF, G, bx);
                pg8::EpiSwiGLU E{(pg8::bf16_t*)(ws + WS_HID)};
                pg8::gemm_phase<pg8::EpiSwiGLU, pg8::StaticOrder, true, true>(lds + RING_OFF, g, S, E);
                REPSYNC(); }
            }
            SEAM(ps + 6);
            if (RUN(ps + 7)) { REP(6) {
                pg8::Gemm g{(const pg8::bf16_t*)(ws + WS_HID), (const pg8::bf16_t*)(ws + WS_WF2) + (size_t)layer * 2048 * 5632, ML, D, FF}; pg8::StaticOrder S; S.init(ML, D, G, bx);
                pg8::EpiResid E{H, GATE(modl + 5 * D), DRY};
                pg8::gemm_phase<pg8::EpiResid, pg8::StaticOrder, true, true>(lds + RING_OFF, g, S, E);
                if (lp == 0) { __syncthreads();
                pg8::Gemm gc{(const pg8::bf16_t*)(ws + WS_HID), (const pg8::bf16_t*)(ws + WS_WF2) + (size_t)layer * 2048 * 5632, M, D, 512, FF, FF}; pg8::SliceOrder SS; SS.init(G, bx, 11, 512);
                pg8::EpiSlab ES{(float*)(ws + WS_SLAB), 1024};
                pg8::gemm_phase<pg8::EpiSlab, pg8::SliceOrder, true, true>(lds + RING_OFF, gc, SS, ES); }
                REPSYNC(); }
            }
            SEAM(ps + 7);
            if (RUN(ps + 8)) {
                REP(1) if (lp == 0) norm_phase<false>(args, args.in[I_N1G] + (layer + 1) * D, modl + 3 * 12288, 0, vcu, G, rep ? 0 : 11, modl + 2 * 12288 + 5 * D);
                else final_phase(args, vcu, G);
            }
            SEAM(ps + 8);
        }
    }
#undef RUN
#undef SEAM
}

extern "C" void kernel_launch(void* const* d_in, const int* in_sizes, int n_in, void* d_out, int out_size, void* d_ws, size_t ws_size, hipStream_t stream) {
    static int grid = 0;
    if (grid == 0) {
        if (n_in != 28 || in_sizes[0] != ML * D || out_size != ML * D || ws_size < WS_END) {
            fprintf(stderr, "kernel_launch: unexpected problem (n_in %d, in0 %d, out %d, ws %zu, need ws >= %zu); nothing launched\n", n_in, n_in > 0 ? in_sizes[0] : -1, out_size, ws_size, (size_t)WS_END); grid = -1; return; }
        int dev = 0, cus = 0, per_cu = 0;
        if (hipGetDevice(&dev) != hipSuccess || hipDeviceGetAttribute(&cus, hipDeviceAttributeMultiprocessorCount, dev) != hipSuccess) { fprintf(stderr, "kernel_launch: device query failed\n"); grid = -1; return; }
        if (hipFuncSetAttribute((const void*)fwd_kernel, hipFuncAttributeMaxDynamicSharedMemorySize, LDS_BYTES) != hipSuccess) { fprintf(stderr, "kernel_launch: hipFuncSetAttribute failed\n"); grid = -1; return; }
        if (hipOccupancyMaxActiveBlocksPerMultiprocessor(&per_cu, (const void*)fwd_kernel, NTHR, LDS_BYTES) != hipSuccess || per_cu < 1) {
            fprintf(stderr, "kernel_launch: occupancy query reports %d workgroups per CU\n", per_cu); }
        (void)hipGetLastError();
        grid = cus;
    }
    if (grid < 0) return;
    if (hipMemsetAsync((char*)d_ws + WS_CTL, 0, CTL_ZERO_BYTES, stream) != hipSuccess) { fprintf(stderr, "kernel_launch: memset failed\n"); return; }
    Args a{};
    for (int i = 0; i < 28; ++i) a.in[i] = (const float*)d_in[i];
    a.out = (float*)d_out; a.ws = (unsigned char*)d_ws;
#if MK_ONE_LAUNCH
    a.ph_lo = 0; a.ph_hi = N_PHASES;
    hipLaunchKernelGGL(fwd_kernel, dim3(grid), dim3(NTHR), LDS_BYTES, stream, a);
#else
    for (int p = 0; p < N_PHASES; ++p) { a.ph_lo = p; a.ph_hi = p + 1; hipLaunchKernelGGL(fwd_kernel, dim3(grid), dim3(NTHR), LDS_BYTES, stream, a); }
#endif
    const hipError_t le = hipPeekAtLastError();
    if (le != hipSuccess) fprintf(stderr, "kernel_launch: launch failed: %s\n", hipGetErrorName(le));
}
```

```cpp
#include <hip/hip_runtime.h>
#include <cstdio>
#include <cstdint>
namespace pg8 {
#define PG8_LAS __attribute__((address_space(3)))
typedef unsigned short bf16_t;
typedef short bf16x8 __attribute__((ext_vector_type(8)));
typedef float f32x4 __attribute__((ext_vector_type(4)));
typedef unsigned u32x4 __attribute__((ext_vector_type(4)));
constexpr int BM = 256, BK = 64, HALF = 128, HTB = HALF * BK * 2  , STAGE_BYTES = 8 * HTB, NXCD = 8, WGM = 8;

__host__ __device__ __forceinline__ int lds_byte(int r, int c) { const int st = (r >> 4) * 2 + (c >> 5), rr = r & 15, cc = c & 31, ob = rr * 64 + cc * 2; return st * 1024 + (ob ^ (((ob >> 9) & 1) << 5)); }
__host__ __device__ __forceinline__ void stage_rc(int b, int& R, int& C) { const int st = b / 1024, sb = b % 1024, swz = sb ^ (((sb >> 9) & 1) << 5); R = (st >> 1) * 16 + swz / 64; C = (st & 1) * 32 + (swz % 64) / 2; }
__host__ __device__ __forceinline__ int perm32(int rho) { const int n = rho >> 4, i = rho & 15; return 8 * (i >> 2) + 4 * n + (i & 3); }

struct Unit { int pm, pn; int koff; };
struct Gemm { const bf16_t* A; const bf16_t* Bt; int M, N, K; int lda, ldb; };

struct StaticOrder {
    int nM, nN, nwg, G, c;
    __host__ __device__ void init(int M, int N, int G_, int c_) { nM = M / BM; nN = N / BM; nwg = nM * nN; G = G_; c = c_; }
    __host__ __device__ bool next(int i, Unit& u) const {
        const long L = (long)i * G + c; if (L >= nwg) return false;
        int wgid = (int)L; { const int q = nwg / NXCD, r = nwg % NXCD, xcd = wgid % NXCD, off = wgid / NXCD; wgid = (xcd < r ? xcd * (q + 1) : r * (q + 1) + (xcd - r) * q) + off; }
        const int nig = WGM * nN, gid = wgid / nig, fm = gid * WGM, gsz = (nM - fm) < WGM ? (nM - fm) : WGM;
        u.pm = fm + ((wgid % nig) % gsz); u.pn = (wgid % nig) / gsz; u.koff = 0; return true;
    }
    __device__ __forceinline__ void a_ready(const Unit&) const {}
    __device__ __forceinline__ void done(const Unit&) const {}
};

__device__ __forceinline__ unsigned cvt_pk_bf16(float lo, float hi) { unsigned r; asm volatile("v_cvt_pk_bf16_f32 %0, %1, %2" : "=v"(r) : "v"(lo), "v"(hi)); return r; }
typedef float f32x2 __attribute__((ext_vector_type(2)));
__device__ __forceinline__ f32x2 gelu_pk(f32x2 v) {
    const f32x2 av = __builtin_elementwise_abs(v), d = av * 0.2316418882f + 1.0f;
    f32x2 t; t.x = __builtin_amdgcn_rcpf(d.x); t.y = __builtin_amdgcn_rcpf(d.y);
    f32x2 q = t * 0.5307027145f + (-0.7265760135f); q = q * t + 0.7107068705f; q = q * t + (-0.142248368f); q = q * t + 0.127414796f; q = q * t;
    const f32x2 s = (v * v) * (-0.72134752044f);
    f32x2 e; e.x = __builtin_amdgcn_exp2f(s.x); e.y = __builtin_amdgcn_exp2f(s.y);
    const f32x2 m = v * (q * e), r = v - m;
    f32x2 o; o.x = v.x < 0.f ? m.x : r.x; o.y = v.y < 0.f ? m.y : r.y; return o;
}


__device__ __forceinline__ float sigmoid_f(float x) { return __builtin_amdgcn_rcpf(1.0f + __builtin_amdgcn_exp2f(-1.44269504f * x)); }
__device__ __forceinline__ float silu_f(float x) { return x * sigmoid_f(x); }
__device__ __forceinline__ float gelu_tanh_f(float x) { const float u = x * (1.0f + 0.044715f * x * x); return x * __builtin_amdgcn_rcpf(1.0f + __builtin_amdgcn_exp2f(-2.30220820f * u)); }
__device__ __forceinline__ int row_set(int pm) { return pm < 32 ? 0 : (pm < 64 ? 1 : 2); }

struct EpiPlainBf16 {
    static constexpr bool PERM = true, AFTER_DRAIN = false;
    bf16_t* O; int ldc;
    __device__ __forceinline__ void operator()(const f32x4 (&acc)[2][2][4][2], const Unit& u, int wr, int wc, int fr, int fq) const {
        const int row0 = u.pm * BM + wr * 64 + fr, col0 = u.pn * BM + wc * 32 + 8 * fq;
#pragma unroll
        for (int ai = 0; ai < 2; ++ai)
#pragma unroll
            for (int m = 0; m < 4; ++m) { bf16_t* rowp = O + (size_t)(row0 + ai * HALF + m * 16) * ldc + col0;
#pragma unroll
                for (int bj = 0; bj < 2; ++bj) { const f32x4 v0 = acc[ai][bj][m][0], v1 = acc[ai][bj][m][1];
                    u32x4 w; w.x = cvt_pk_bf16(v0[0], v0[1]); w.y = cvt_pk_bf16(v0[2], v0[3]); w.z = cvt_pk_bf16(v1[0], v1[1]); w.w = cvt_pk_bf16(v1[2], v1[3]);
                    *(u32x4*)(rowp + bj * HALF) = w; } }
    }
};
struct EpiG1 {
    static constexpr bool PERM = true, AFTER_DRAIN = false;
    bf16_t* U; bf16_t* V; float* vstat;
    __device__ __forceinline__ void operator()(const f32x4 (&acc)[2][2][4][2], const Unit& u, int wr, int wc, int fr, int fq) const {
        const bool isv = u.pn >= 16;
        const int row0 = u.pm * BM + wr * 64 + fr, col0 = (u.pn & 15) * BM + wc * 32 + 8 * fq;
        bf16_t* base = isv ? V : U;
#pragma unroll
        for (int ai = 0; ai < 2; ++ai)
#pragma unroll
            for (int m = 0; m < 4; ++m) { const int row = row0 + ai * HALF + m * 16; bf16_t* rowp = base + (size_t)row * 4096 + col0; float s = 0.f, ss = 0.f;
#pragma unroll
                for (int bj = 0; bj < 2; ++bj) { f32x4 v0 = acc[ai][bj][m][0], v1 = acc[ai][bj][m][1];
#pragma unroll
                    for (int e = 0; e < 4; ++e) { v0[e] = gelu_tanh_f(v0[e]); v1[e] = gelu_tanh_f(v1[e]); s += v0[e] + v1[e]; ss += v0[e] * v0[e] + v1[e] * v1[e]; }
                    u32x4 w; w.x = cvt_pk_bf16(v0[0], v0[1]); w.y = cvt_pk_bf16(v0[2], v0[3]); w.z = cvt_pk_bf16(v1[0], v1[1]); w.w = cvt_pk_bf16(v1[2], v1[3]);
                    *(u32x4*)(rowp + bj * HALF) = w; }
                if (isv) { s += __shfl_xor(s, 16); s += __shfl_xor(s, 32); ss += __shfl_xor(ss, 16); ss += __shfl_xor(ss, 32);
                    if (fq == 0) { f32x2 o; o.x = s; o.y = ss; *(f32x2*)(vstat + ((size_t)row * 64 + (u.pn - 16) * 4 + wc) * 2) = o; } } }
    }
};
typedef _Float16 h16x8 __attribute__((ext_vector_type(8)));
struct EpiResid {
    static constexpr bool PERM = true, AFTER_DRAIN = false;
    _Float16* H; const float* gate; int dry;
    __device__ __forceinline__ void operator()(const f32x4 (&acc)[2][2][4][2], const Unit& u, int wr, int wc, int fr, int fq) const {
        if (dry) return;
        const int row0 = u.pm * BM + wr * 64 + fr, col0 = u.pn * BM + wc * 32 + 8 * fq;
        const float* g = gate + row_set(u.pm) * (6 * 2048) + col0;
        f32x4 gv[2][2];
#pragma unroll
        for (int bj = 0; bj < 2; ++bj)
#pragma unroll
            for (int n = 0; n < 2; ++n) gv[bj][n] = *(const f32x4*)(g + bj * HALF + n * 4);
#pragma unroll
        for (int ai = 0; ai < 2; ++ai)
#pragma unroll
            for (int m = 0; m < 4; ++m) { _Float16* rowp = H + (size_t)(row0 + ai * HALF + m * 16) * 2048 + col0;
#pragma unroll
                for (int bj = 0; bj < 2; ++bj) { h16x8* p = (h16x8*)(rowp + bj * HALF); h16x8 hv = *p;
#pragma unroll
                    for (int e = 0; e < 4; ++e) { hv[e] = (_Float16)((float)hv[e] + gv[bj][0][e] * acc[ai][bj][m][0][e]); hv[4 + e] = (_Float16)((float)hv[4 + e] + gv[bj][1][e] * acc[ai][bj][m][1][e]); }
                    *p = hv; } }
    }
};
struct EpiSwiGLU {
    static constexpr bool PERM = true, AFTER_DRAIN = false;
    bf16_t* O;
    __device__ __forceinline__ void operator()(const f32x4 (&acc)[2][2][4][2], const Unit& u, int wr, int wc, int fr, int fq) const {
        const int row0 = u.pm * BM + wr * 64 + fr, col0 = u.pn * HALF + wc * 32 + 8 * fq;
#pragma unroll
        for (int ai = 0; ai < 2; ++ai)
#pragma unroll
            for (int m = 0; m < 4; ++m) { bf16_t* rowp = O + (size_t)(row0 + ai * HALF + m * 16) * 5632 + col0;
                f32x4 a0 = acc[ai][0][m][0], a1 = acc[ai][0][m][1]; const f32x4 b0 = acc[ai][1][m][0], b1 = acc[ai][1][m][1];
#pragma unroll
                for (int e = 0; e < 4; ++e) { a0[e] = silu_f(a0[e]) * b0[e]; a1[e] = silu_f(a1[e]) * b1[e]; }
                u32x4 w; w.x = cvt_pk_bf16(a0[0], a0[1]); w.y = cvt_pk_bf16(a0[2], a0[3]); w.z = cvt_pk_bf16(a1[0], a1[1]); w.w = cvt_pk_bf16(a1[2], a1[3]);
                *(u32x4*)rowp = w; }
    }
};
struct EpiGluResid {
    static constexpr bool PERM = true, AFTER_DRAIN = false;
    _Float16* H; const float* gate; int dry;
    __device__ __forceinline__ void operator()(const f32x4 (&acc)[2][2][4][2], const Unit& u, int wr, int wc, int fr, int fq) const {
        if (dry) return;
        const int row0 = u.pm * BM + wr * 64 + fr, col0 = u.pn * HALF + wc * 32 + 8 * fq;
        const float* g = gate + row_set(u.pm) * (6 * 2048) + col0;
        f32x4 gv[2];
#pragma unroll
        for (int n = 0; n < 2; ++n) gv[n] = *(const f32x4*)(g + n * 4);
#pragma unroll
        for (int ai = 0; ai < 2; ++ai)
#pragma unroll
            for (int m = 0; m < 4; ++m) { h16x8* p = (h16x8*)(H + (size_t)(row0 + ai * HALF + m * 16) * 2048 + col0); h16x8 hv = *p;
#pragma unroll
                for (int n = 0; n < 2; ++n) { const f32x4 a = acc[ai][0][m][n], gg = acc[ai][1][m][n];
#pragma unroll
                    for (int e = 0; e < 4; ++e) hv[4 * n + e] = (_Float16)((float)hv[4 * n + e] + gv[n][e] * a[e] * sigmoid_f(gg[e])); }
                *p = hv; }
    }
};

struct GroupOrder {
    int G, c;
    __host__ __device__ void init(int G_, int c_) { G = G_; c = c_; }
    __host__ __device__ bool next(int i, Unit& u) const { const int L = i * G + c; if (L >= 512) return false; u.pm = L; u.pn = L >> 2; u.koff = 0; return true; }
    __device__ __forceinline__ void a_ready(const Unit&) const {}
    __device__ __forceinline__ void done(const Unit&) const {}
};
struct EpiS5In {
    static constexpr bool PERM = true, AFTER_DRAIN = false;
    bf16_t* XL; bf16_t* XC;
    __device__ __forceinline__ void operator()(const f32x4 (&acc)[2][2][4][2], const Unit& u, int wr, int wc, int fr, int fq) const {
        const int row0 = u.pm * BM + wr * 64 + fr;
#pragma unroll
        for (int ai = 0; ai < 2; ++ai)
#pragma unroll
            for (int m = 0; m < 4; ++m) { const int row = row0 + ai * HALF + m * 16;
#pragma unroll
                for (int bj = 0; bj < 2; ++bj) { const int col0 = u.pn * BM + bj * HALF + wc * 32 + 8 * fq, g = col0 >> 4, q0 = col0 & 15;
                    bf16_t* dst = row < 16384 ? XL + ((size_t)(g * 1024 + (row >> 4)) * 512 + 16 * (row & 15) + q0)
                                              : XC + ((size_t)(g * 32 + ((row - 16384) >> 4)) * 512 + 16 * (row & 15) + q0);
                    const f32x4 v0 = acc[ai][bj][m][0], v1 = acc[ai][bj][m][1];
                    u32x4 w; w.x = cvt_pk_bf16(v0[0], v0[1]); w.y = cvt_pk_bf16(v0[2], v0[3]); w.z = cvt_pk_bf16(v1[0], v1[1]); w.w = cvt_pk_bf16(v1[2], v1[3]);
                    *(u32x4*)dst = w; } }
    }
};
struct EpiS5State {
    static constexpr bool PERM = true, AFTER_DRAIN = false;
    bf16_t* SL;
    __device__ __forceinline__ void operator()(const f32x4 (&acc)[2][2][4][2], const Unit& u, int wr, int wc, int fr, int fq) const {
        const int row0 = u.pm * BM + wr * 64 + fr, col0 = wc * 32 + 8 * fq;
#pragma unroll
        for (int ai = 0; ai < 2; ++ai)
#pragma unroll
            for (int m = 0; m < 4; ++m) { bf16_t* rowp = SL + (size_t)(row0 + ai * HALF + m * 16) * 256 + col0;
#pragma unroll
                for (int bj = 0; bj < 2; ++bj) { const f32x4 v0 = acc[ai][bj][m][0], v1 = acc[ai][bj][m][1];
                    u32x4 w; w.x = cvt_pk_bf16(v0[0], v0[1]); w.y = cvt_pk_bf16(v0[2], v0[3]); w.z = cvt_pk_bf16(v1[0], v1[1]); w.w = cvt_pk_bf16(v1[2], v1[3]);
                    *(u32x4*)(rowp + bj * HALF) = w; } }
    }
};
struct EpiS5Out {
    static constexpr bool PERM = true, AFTER_DRAIN = false;
    bf16_t* Z;
    __device__ __forceinline__ void operator()(const f32x4 (&acc)[2][2][4][2], const Unit& u, int wr, int wc, int fr, int fq) const {
        const int c0 = (u.pm & 3) * BM + wr * 64 + fr, g = u.pn;
#pragma unroll
        for (int ai = 0; ai < 2; ++ai)
#pragma unroll
            for (int m = 0; m < 4; ++m) { const int c = c0 + ai * HALF + m * 16;
#pragma unroll
                for (int bj = 0; bj < 2; ++bj) { const int n0 = bj * HALF + wc * 32 + 8 * fq, t = n0 >> 4, q0 = n0 & 15;
                    f32x4 v0 = acc[ai][bj][m][0], v1 = acc[ai][bj][m][1];
#pragma unroll
                    for (int e = 0; e < 4; ++e) { v0[e] = gelu_tanh_f(v0[e]); v1[e] = gelu_tanh_f(v1[e]); }
                    u32x4 w; w.x = cvt_pk_bf16(v0[0], v0[1]); w.y = cvt_pk_bf16(v0[2], v0[3]); w.z = cvt_pk_bf16(v1[0], v1[1]); w.w = cvt_pk_bf16(v1[2], v1[3]);
                    *(u32x4*)(Z + (size_t)(16 * c + t) * 2048 + 16 * g + q0) = w; } }
    }
};

struct SliceOrder {
    int G, c, nsl, kbytes;
    __host__ __device__ void init(int G_, int c_, int nsl_, int kslice) { G = G_; c = c_; nsl = nsl_; kbytes = kslice * 2; }
    __host__ __device__ bool next(int i, Unit& u) const { const int L = i * G + c; if (L >= nsl * 16) return false; const int s = L >> 4, r = L & 15; u.pm = 64 + (r >> 3); u.pn = r & 7; u.koff = s * kbytes; return true; }
    __device__ __forceinline__ void a_ready(const Unit&) const {}
    __device__ __forceinline__ void done(const Unit&) const {}
};
struct EpiSlab {
    static constexpr bool PERM = false, AFTER_DRAIN = false;
    float* SLAB; int kbytes;
    __device__ __forceinline__ void operator()(const f32x4 (&acc)[2][2][4][2], const Unit& u, int wr, int wc, int fr, int fq) const {
        const int s = u.koff / kbytes, row0 = (u.pm - 64) * BM + wr * 64 + fr, col0 = u.pn * BM + wc * 32 + 4 * fq;
        float* base = SLAB + (size_t)s * 512 * 2048;
#pragma unroll
        for (int ai = 0; ai < 2; ++ai)
#pragma unroll
            for (int m = 0; m < 4; ++m) { float* rowp = base + (size_t)(row0 + ai * HALF + m * 16) * 2048 + col0;
#pragma unroll
                for (int bj = 0; bj < 2; ++bj)
#pragma unroll
                    for (int n = 0; n < 2; ++n) *(f32x4*)(rowp + bj * HALF + n * 16) = acc[ai][bj][m][n]; }
    }
};

template <class Epi, class Sched, bool ALIGN_EPI = false, bool SP2 = false>
__device__ __forceinline__ void gemm_phase(PG8_LAS unsigned char* lds, const Gemm g, const Sched& S, const Epi& E) {
    int tid_ = threadIdx.x; asm volatile("" : "+v"(tid_));
    const int tid = tid_, wid = __builtin_amdgcn_readfirstlane(tid >> 6), lane = tid & 63, wr = wid >> 2, wc = wid & 3, fr = lane & 15, fq = lane >> 4;
    const int K = g.K, nt = K / BK, lda = g.lda ? g.lda : K, ldb = g.ldb ? g.ldb : K;
    unsigned voffA[2], voffB[2];
#pragma unroll
    for (int i = 0; i < 2; ++i) { int R, C; stage_rc(tid * 16 + i * 8192, R, C); const int Rb = Epi::PERM ? ((R & ~31) + perm32(R & 31)) : R;
        voffA[i] = (unsigned)(R * lda + C) * 2u; voffB[i] = (unsigned)(Rb * ldb + C) * 2u; }
    const size_t kstep = (size_t)(BK * 2);
    const size_t hstepB = (size_t)HALF * ldb * 2, hstepA = (size_t)HALF * lda * 2;
    const size_t tstepB = 2 * hstepB, tstepA = 2 * hstepA;
    const unsigned ldsw = (unsigned)wid * 1024u;
    const int aoff = lds_byte(wr * 64 + fr, fq * 8), boff = lds_byte(wc * 32 + fr, fq * 8);
#define PG8_SA(b, h) (((b) * 2 + (h)) * HTB)
#define PG8_SB(b, h) ((4 + (b) * 2 + (h)) * HTB)
#define PG8_STAGE(bufoff, gbase, voff) do { _Pragma("unroll") for (int _i = 0; _i < 2; ++_i) \
        __builtin_amdgcn_global_load_lds((const unsigned*)((const char*)(gbase) + (voff)[_i]), (PG8_LAS unsigned*)(lds + (bufoff) + ldsw + _i * 8192), 16, 0, 0); } while (0)
#define PG8_LDA(dst, b, h) do { _Pragma("unroll") for (int m = 0; m < 4; ++m) _Pragma("unroll") for (int k = 0; k < 2; ++k) dst[m][k] = *(const PG8_LAS bf16x8*)(lds + PG8_SA(b, h) + aoff + m * 2048 + k * 1024); } while (0)
#define PG8_LDB(dst, b, h) do { _Pragma("unroll") for (int n = 0; n < 2; ++n) _Pragma("unroll") for (int k = 0; k < 2; ++k) dst[n][k] = *(const PG8_LAS bf16x8*)(lds + PG8_SB(b, h) + boff + n * 2048 + k * 1024); } while (0)
#define PG8_MMA(ai, bj, At, Bt) do { __builtin_amdgcn_s_setprio(1); _Pragma("unroll") for (int m = 0; m < 4; ++m) _Pragma("unroll") for (int n = 0; n < 2; ++n) _Pragma("unroll") for (int k = 0; k < 2; ++k) \
        acc[ai][bj][m][n] = __builtin_amdgcn_mfma_f32_16x16x32_bf16(Bt[n][k], At[m][k], acc[ai][bj][m][n], 0, 0, 0); __builtin_amdgcn_s_setprio(0); } while (0)
#define PG8_WAIT_V(n) asm volatile("s_waitcnt vmcnt(" #n ")" ::: "memory")
#define PG8_WAIT_L(n) asm volatile("s_waitcnt lgkmcnt(" #n ")" ::: "memory")
#define PG8_BAR __builtin_amdgcn_s_barrier()
#define PG8_SCHED __builtin_amdgcn_sched_barrier(0)
    Unit cur, nxt; int ui = 0;
    if (!S.next(0, cur)) return;
    f32x4 acc[2][2][4][2];
#pragma unroll
    for (int a = 0; a < 2; ++a)
#pragma unroll
        for (int b = 0; b < 2; ++b)
#pragma unroll
            for (int m = 0; m < 4; ++m)
#pragma unroll
                for (int n = 0; n < 2; ++n) acc[a][b][m][n] = (f32x4){0.f, 0.f, 0.f, 0.f};
    bf16x8 At[4][2], B0[2][2], B1[2][2];
    const char* cA = (const char*)g.A + (size_t)cur.pm * tstepA + cur.koff; const char* cB = (const char*)g.Bt + (size_t)cur.pn * tstepB + cur.koff;
    S.a_ready(cur);
    if constexpr (SP2) {
        PG8_STAGE(PG8_SB(0, 0), cB, voffB); PG8_STAGE(PG8_SB(0, 1), cB + hstepB, voffB); PG8_STAGE(PG8_SA(0, 0), cA, voffA); PG8_STAGE(PG8_SA(0, 1), cA + hstepA, voffA);
        if (wr == 1) PG8_BAR;
        PG8_WAIT_V(2); PG8_BAR;
        PG8_STAGE(PG8_SB(1, 0), cB + kstep, voffB); PG8_STAGE(PG8_SA(1, 0), cA + kstep, voffA); PG8_STAGE(PG8_SB(1, 1), cB + hstepB + kstep, voffB);
        PG8_WAIT_V(6); PG8_BAR;
    } else {
        PG8_STAGE(PG8_SB(0, 0), cB, voffB); PG8_STAGE(PG8_SA(0, 0), cA, voffA); PG8_STAGE(PG8_SB(0, 1), cB + hstepB, voffB); PG8_STAGE(PG8_SA(0, 1), cA + hstepA, voffA);
        if (wr == 1) PG8_BAR;
        PG8_WAIT_V(4); PG8_BAR;
        PG8_STAGE(PG8_SB(1, 0), cB + kstep, voffB); PG8_STAGE(PG8_SA(1, 0), cA + kstep, voffA); PG8_STAGE(PG8_SB(1, 1), cB + hstepB + kstep, voffB);
        PG8_WAIT_V(6); PG8_BAR;
    }
    for (;;) {
        const bool has_next = S.next(ui + 1, nxt);
        const char* nA = has_next ? (const char*)g.A + (size_t)nxt.pm * tstepA + nxt.koff : cA; const char* nB = has_next ? (const char*)g.Bt + (size_t)nxt.pn * tstepB + nxt.koff : cB;
#pragma unroll 1
        for (int t = 0; t < nt; t += 2) {
            const bool last = (t == nt - 2);
            const char* a1 = cA + (size_t)(t + 1) * kstep;
            const char* a2 = last ? nA : cA + (size_t)(t + 2) * kstep; const char* b2 = last ? nB : cB + (size_t)(t + 2) * kstep;
            const char* a3 = a2 + kstep; const char* b3 = b2 + kstep;
            if (last && has_next) S.a_ready(nxt);
            if constexpr (SP2) {
            PG8_LDB(B0, 0, 0); PG8_LDB(B1, 0, 1); PG8_SCHED; PG8_LDA(At, 0, 0); PG8_STAGE(PG8_SA(1, 1), a1 + hstepA, voffA);
            PG8_WAIT_V(8); PG8_WAIT_L(0); PG8_BAR; PG8_MMA(0, 0, At, B0); PG8_MMA(0, 1, At, B1); PG8_BAR; PG8_SCHED;
            PG8_LDA(At, 0, 1); PG8_STAGE(PG8_SB(0, 0), b2, voffB); PG8_STAGE(PG8_SB(0, 1), b2 + hstepB, voffB); PG8_STAGE(PG8_SA(0, 0), a2, voffA);
            PG8_WAIT_V(8); PG8_WAIT_L(0); PG8_BAR; PG8_MMA(1, 0, At, B0); PG8_MMA(1, 1, At, B1); PG8_BAR; PG8_SCHED;
            PG8_LDB(B0, 1, 0); PG8_LDB(B1, 1, 1); PG8_SCHED; PG8_LDA(At, 1, 0); PG8_STAGE(PG8_SA(0, 1), a2 + hstepA, voffA);
            PG8_WAIT_V(8); PG8_WAIT_L(0); PG8_BAR; PG8_MMA(0, 0, At, B0); PG8_MMA(0, 1, At, B1); PG8_BAR; PG8_SCHED;
            PG8_LDA(At, 1, 1); PG8_STAGE(PG8_SB(1, 0), b3, voffB); PG8_STAGE(PG8_SB(1, 1), b3 + hstepB, voffB); PG8_STAGE(PG8_SA(1, 0), a3, voffA);
            PG8_WAIT_V(8); PG8_WAIT_L(0); PG8_BAR; PG8_MMA(1, 0, At, B0); PG8_MMA(1, 1, At, B1); PG8_BAR; PG8_SCHED;
            } else {
            PG8_LDB(B0, 0, 0); PG8_SCHED; PG8_LDA(At, 0, 0); PG8_STAGE(PG8_SA(1, 1), a1 + hstepA, voffA);
            PG8_WAIT_L(8); PG8_BAR; PG8_WAIT_L(0); PG8_MMA(0, 0, At, B0); PG8_BAR; PG8_SCHED;
            PG8_LDB(B1, 0, 1); PG8_STAGE(PG8_SB(0, 0), b2, voffB);
            PG8_BAR; PG8_WAIT_L(0); PG8_MMA(0, 1, At, B1); PG8_BAR;
            PG8_LDA(At, 0, 1); PG8_STAGE(PG8_SA(0, 0), a2, voffA);
            PG8_BAR; PG8_WAIT_L(0); PG8_MMA(1, 0, At, B0); PG8_BAR; PG8_SCHED;
            PG8_STAGE(PG8_SB(0, 1), b2 + hstepB, voffB);
            PG8_WAIT_V(6); PG8_BAR; PG8_MMA(1, 1, At, B1); PG8_BAR;
            PG8_LDB(B0, 1, 0); PG8_SCHED; PG8_LDA(At, 1, 0); PG8_STAGE(PG8_SA(0, 1), a2 + hstepA, voffA);
            PG8_WAIT_L(8); PG8_BAR; PG8_WAIT_L(0); PG8_MMA(0, 0, At, B0); PG8_BAR; PG8_SCHED;
            PG8_LDB(B1, 1, 1); PG8_STAGE(PG8_SB(1, 0), b3, voffB);
            PG8_BAR; PG8_WAIT_L(0); PG8_MMA(0, 1, At, B1); PG8_BAR;
            PG8_LDA(At, 1, 1); PG8_STAGE(PG8_SA(1, 0), a3, voffA);
            PG8_BAR; PG8_WAIT_L(0); PG8_MMA(1, 0, At, B0); PG8_BAR; PG8_SCHED;
            PG8_STAGE(PG8_SB(1, 1), b3 + hstepB, voffB);
            PG8_WAIT_V(6); PG8_BAR; PG8_MMA(1, 1, At, B1); PG8_BAR;
            }
        }
        if constexpr (ALIGN_EPI) { if (wr == 0) PG8_BAR; }
        if constexpr (!Epi::AFTER_DRAIN) { E(acc, cur, wr, wc, fr, fq); S.done(cur); }
        if (!has_next) break;
#pragma unroll
        for (int a = 0; a < 2; ++a)
#pragma unroll
            for (int b = 0; b < 2; ++b)
#pragma unroll
                for (int m = 0; m < 4; ++m)
#pragma unroll
                    for (int n = 0; n < 2; ++n) acc[a][b][m][n] = (f32x4){0.f, 0.f, 0.f, 0.f};
        cur = nxt; cA = nA; cB = nB; ++ui;
        if constexpr (ALIGN_EPI) { if (wr == 1) PG8_BAR; }
    }
    PG8_WAIT_V(0);
    if constexpr (!ALIGN_EPI) { if (wr == 0) PG8_BAR; }
    PG8_BAR;
    if constexpr (Epi::AFTER_DRAIN) { E.fused(acc, cur, wr, wc, fr, fq, lds, wid, lane); S.done(cur); }
#undef PG8_SA
#undef PG8_SB
#undef PG8_STAGE
#undef PG8_LDA
#undef PG8_LDB
#undef PG8_MMA
#undef PG8_WAIT_V
#undef PG8_WAIT_L
#undef PG8_BAR
#undef PG8_SCHED
}
}

constexpr int NWAVES = 8, NTHR = NWAVES * 64;
constexpr int D = 2048, BATCH = 2, SEQ = 8192, ML = BATCH * SEQ, CTXL = 256, MC = BATCH * CTXL, M = ML + MC;
constexpr int FF = 5632, EA = 4096, NH = 16, HDIM = 256, CHUNK = 128, NCHUNK = M / CHUNK;
constexpr int SG = 128, SP = 64, SQ = 16;
constexpr int DEPTH = 4;
constexpr float EPS = 1e-6f;
static_assert(M % 256 == 0 && NCHUNK == 132, "row tiling");

constexpr size_t MiB = 1u << 20;
constexpr size_t WS_CTL = 0, CTL_ZERO_BYTES = 1 * MiB;
constexpr size_t WS_MOD = 1 * MiB;
constexpr size_t WS_S5A = 2 * MiB;
constexpr size_t WS_S5B = 3 * MiB;
constexpr size_t WS_WSB = 11 * MiB;
constexpr size_t WS_VSTAT = 12 * MiB;
constexpr size_t WS_WGIN = 32 * MiB;
constexpr size_t WS_WGOUT = 96 * MiB;
constexpr size_t WS_WF13 = 128 * MiB;
constexpr size_t WS_WF2 = 304 * MiB;
constexpr size_t WS_WSIN = 392 * MiB;
constexpr size_t WS_WGLU = 408 * MiB;
constexpr size_t WS_H = 440 * MiB;
constexpr size_t WS_XN = 572 * MiB;
constexpr size_t WS_BIG = 640 * MiB;
constexpr size_t WS_ZU = WS_BIG, WS_ZV = WS_BIG + 132 * MiB;
constexpr size_t WS_HID = WS_BIG;
constexpr size_t WS_SU = WS_BIG, WS_SZ = WS_BIG + 66 * MiB;
constexpr size_t WS_YF = WS_BIG + 132 * MiB, WS_YB = WS_BIG + 264 * MiB;
constexpr size_t WS_XL = WS_BIG, WS_XC = WS_BIG + 128 * MiB;
constexpr size_t WS_SL = WS_BIG + 132 * MiB, WS_SC = WS_BIG + 196 * MiB;
constexpr size_t WS_SZ2 = WS_BIG + 200 * MiB;
constexpr size_t WS_MOUTT = WS_BIG + 396 * MiB;
constexpr size_t WS_M2T = WS_MOUTT + 64 * MiB;
constexpr size_t WS_A16 = WS_M2T + 32 * MiB;
constexpr size_t WS_SLAB = WS_A16 + 1 * MiB;
constexpr size_t WS_END = WS_SLAB + 44 * MiB;
#ifndef S5_NAIVE
#define S5_NAIVE 0
#endif
constexpr size_t WS_Z = S5_NAIVE ? WS_SZ : WS_SZ2;
constexpr int CW_BAR = 4096;

constexpr int RING_OFF = 0, RING_BYTES = 131072;
constexpr int LDSCTL_OFF = RING_BYTES, MISC_OFF = LDSCTL_OFF + 320;
constexpr int LDS_BYTES = 147456;
static_assert(MISC_OFF + 128 <= LDS_BYTES, "LDS map");

#define GAS __attribute__((address_space(1)))
#define LAS __attribute__((address_space(3)))
typedef unsigned short bf16;
typedef unsigned v4u __attribute__((ext_vector_type(4)));
typedef unsigned v2u __attribute__((ext_vector_type(2)));
typedef float f32x4 __attribute__((ext_vector_type(4)));
typedef float f32x2 __attribute__((ext_vector_type(2)));
typedef float f32x16 __attribute__((ext_vector_type(16)));
typedef short bf16x8 __attribute__((ext_vector_type(8)));
typedef GAS unsigned gu32;
#define RLX_AGENT __ATOMIC_RELAXED, __HIP_MEMORY_SCOPE_AGENT
#define LDS_WAIT() asm volatile("s_waitcnt lgkmcnt(0)" ::: "memory")
__device__ __forceinline__ unsigned f2bf(float f) { unsigned u = __builtin_bit_cast(unsigned, f); return (u + 0x7fffu + ((u >> 16) & 1u)) >> 16; }
__device__ __forceinline__ unsigned pk2(float lo, float hi) { return f2bf(lo) | (f2bf(hi) << 16); }
__device__ __forceinline__ float bf2f(unsigned short b) { return __builtin_bit_cast(float, (unsigned)b << 16); }
__device__ __forceinline__ float wave_sum(float v) {
#pragma unroll
    for (int o = 1; o < 64; o <<= 1) v += __shfl_xor(v, o);
    return v;
}

#define XB_TMO      128
#define XB_XCNT(j)  (256  + 64 * (j))
#define XB_XSUB(j)  (1280 + 64 * (j))
#define XB_XGEN(j)  (2304 + 64 * (j))
#define XB_TOP      3328
#define XB_TOPGEN   3392
#define XCD_BAR_WORDS 3456
#define XB_SPIN_CAP (1u << 18)

__device__ __forceinline__ unsigned xb_ld(unsigned* p)              { return __hip_atomic_load(p, __ATOMIC_RELAXED, __HIP_MEMORY_SCOPE_AGENT); }
__device__ __forceinline__ unsigned xb_add(unsigned* p, unsigned v) { return __hip_atomic_fetch_add(p, v, __ATOMIC_RELAXED, __HIP_MEMORY_SCOPE_AGENT); }
__device__ __forceinline__ unsigned xb_xcc_id() { return (unsigned)__builtin_amdgcn_s_getreg((3 << 11) | 20) & 0xFu; }
#define XB_SPIN(cond, bar) do { unsigned _sp = 0; while (cond) { __builtin_amdgcn_s_sleep(1); \
    if ((++_sp & 255u) == 0u) { if (xb_ld(&(bar)[XB_TMO])) break; if (_sp > XB_SPIN_CAP) { atomicAdd(&(bar)[XB_TMO], 1u); break; } } } } while (0)

struct XcdBarrier {
    unsigned* bar; unsigned x;
    volatile LAS unsigned* st;
};

__device__ __forceinline__ XcdBarrier xcd_barrier_post(unsigned* bar, volatile LAS unsigned* st) {
    XcdBarrier b; b.bar = bar; b.x = xb_xcc_id(); b.st = st;
    if (threadIdx.x == 0) (void)xb_add(&bar[XB_XCNT(b.x)], 1u);
    return b;
}
__device__ __forceinline__ void xcd_barrier_complete(unsigned* bar, unsigned x, unsigned& nloc, unsigned& nx) {
    const unsigned G = gridDim.x * gridDim.y * gridDim.z;
    unsigned sum, cnt, mine, sp = 0u;
    for (;;) {
        sum = 0u; cnt = 0u; mine = 0u;
#pragma unroll
        for (unsigned j = 0; j < 16; ++j) { const unsigned c = xb_ld(&bar[XB_XCNT(j)]); sum += c; cnt += (c > 0u) ? 1u : 0u; mine = (j == x) ? c : mine; }
        if (sum == G) break;
        __builtin_amdgcn_s_sleep(1);
        if ((++sp & 255u) == 0u) { if (xb_ld(&bar[XB_TMO])) break; if (sp > XB_SPIN_CAP) { atomicAdd(&bar[XB_TMO], 1u); break; } }
    }
    nloc = mine > 0u ? mine : 1u; nx = cnt > 0u ? cnt : 1u;
}

__device__ __forceinline__ void xcd_barrier(const XcdBarrier& b) {
    asm volatile("s_waitcnt vmcnt(0)" ::: "memory");
    __syncthreads();
    if (threadIdx.x == 0) {
        unsigned* bar = b.bar;
        __builtin_amdgcn_s_waitcnt(0);
        unsigned nloc = b.st[0], nx = b.st[1];
        if (nloc == 0u) { xcd_barrier_complete(bar, b.x, nloc, nx); b.st[0] = nloc; b.st[1] = nx; }
        const unsigned old = xb_add(&bar[XB_XSUB(b.x)], 1u);
        const unsigned gen = old / nloc;
        if (old + 1u == (gen + 1u) * nloc) {
            __builtin_amdgcn_fence(__ATOMIC_RELEASE, "agent");
            asm volatile("s_waitcnt vmcnt(0)" ::: "memory");
            const unsigned og = xb_add(&bar[XB_TOP], 1u);
            const unsigned tg = og / nx;
            if (og + 1u == (tg + 1u) * nx) xb_add(&bar[XB_TOPGEN], 1u);
            else XB_SPIN(xb_ld(&bar[XB_TOPGEN]) == tg, bar);
            __builtin_amdgcn_fence(__ATOMIC_ACQUIRE, "agent");
            xb_add(&bar[XB_XGEN(b.x)], 1u);
            asm volatile("s_waitcnt vmcnt(0)" ::: "memory");
        } else {
            XB_SPIN(xb_ld(&bar[XB_XGEN(b.x)]) == gen, bar);
            __builtin_amdgcn_fence(__ATOMIC_ACQUIRE, "agent");
            asm volatile("s_waitcnt vmcnt(0)" ::: "memory");
        }
    }
    __syncthreads();
}

struct Args { const float* in[28]; float* out; unsigned char* ws; int ph_lo, ph_hi; };
enum InIdx { I_X = 0, I_C, I_CTX, I_CCTX, I_ADAW, I_ADAB, I_N1G, I_N2G, I_W1, I_W3, I_W2, I_GWIN, I_GLNG, I_GLNB, I_GWS, I_GBS, I_GWOUT,
             I_SWIN, I_SARE, I_SAIM, I_SLDT, I_SBRE, I_SBIM, I_SCRE, I_SCIM, I_SD, I_SWGLU, I_FING };

__device__ __forceinline__ int opaque_tid() { int t = threadIdx.x; asm volatile("" : "+v"(t)); return t; }
#define PHASE_IDS const int tid = opaque_tid(), lane = tid & 63, wave = __builtin_amdgcn_readfirstlane(tid >> 6); (void)tid; (void)lane; (void)wave

__device__ __forceinline__ void adaln_items(const Args& a, LAS unsigned char* lds, int wg, int nwg) {
    PHASE_IDS;
    LAS float* cs = (LAS float*)lds;
    LAS float* red = cs + 3 * 2048;
    const float* c = a.in[I_C]; const float* cc = a.in[I_CCTX];
    for (int i = tid; i < 3 * 2048; i += NTHR) { const int s = i >> 11, k = i & 2047; const float v = s < 2 ? c[s * 2048 + k] : cc[k]; cs[i] = v / (1.0f + expf(-v)); }
    __syncthreads();
    float* MOD = (float*)(a.ws + WS_MOD);
    const int cq = tid & 15, kg = tid >> 4;
    for (int item = wg; item < DEPTH * 192; item += nwg) {
        const int layer = item / 192, n0 = (item % 192) * 64;
        const float* W = a.in[I_ADAW] + (size_t)layer * 2048 * 12288 + n0 + 4 * cq;
        f32x4 a0 = {0.f, 0.f, 0.f, 0.f}, a1 = a0, a2 = a0;
#pragma unroll 8
        for (int k = kg; k < 2048; k += 32) { const f32x4 w = *(const GAS f32x4*)(W + (size_t)k * 12288); a0 += cs[k] * w; a1 += cs[2048 + k] * w; a2 += cs[4096 + k] * w; }
#pragma unroll
        for (int e = 0; e < 4; ++e) { red[(kg * 3 + 0) * 64 + 4 * cq + e] = a0[e]; red[(kg * 3 + 1) * 64 + 4 * cq + e] = a1[e]; red[(kg * 3 + 2) * 64 + 4 * cq + e] = a2[e]; }
        __syncthreads();
        if (tid < 192) { const int s = tid >> 6, col = tid & 63; float t = 0.f;
            for (int g = 0; g < 32; ++g) t += red[(g * 3 + s) * 64 + col];
            MOD[(size_t)(layer * 3 + s) * 12288 + n0 + col] = t + a.in[I_ADAB][layer * 12288 + n0 + col]; }
        __syncthreads();
    }
}
__device__ __forceinline__ void tr_item(const float* W, int ld, int K, int ncols, bf16* WT, int mode, LAS float* scr, int item, int lane) {
    const int nblk = ncols / 32, kb = item / nblk, nb = item % nblk, k0 = 64 * kb, n0 = 32 * nb;
    const int drow0 = mode == 0 ? n0 : (256 * (n0 >> 7) + (n0 & 127) + (mode == 2 ? 128 : 0));
#pragma unroll 8
    for (int i = 0; i < 32; ++i) { const int kk = 2 * i + (lane >> 5); scr[kk * 33 + (lane & 31)] = W[(size_t)(k0 + kk) * ld + n0 + (lane & 31)]; }
    LDS_WAIT(); asm volatile("" ::: "memory");
    const int c = lane & 7;
#pragma unroll
    for (int j = 0; j < 4; ++j) { const int n = (lane >> 3) + 8 * j; const LAS float* s = scr + (8 * c) * 33 + n;
        v4u o; o.x = pk2(s[0 * 33], s[1 * 33]); o.y = pk2(s[2 * 33], s[3 * 33]); o.z = pk2(s[4 * 33], s[5 * 33]); o.w = pk2(s[6 * 33], s[7 * 33]);
        *(GAS v4u*)(WT + (size_t)(drow0 + n) * K + k0 + 8 * c) = o; }
    LDS_WAIT(); asm volatile("" ::: "memory");
}
constexpr int TR_GIN = 2 * 8192, TR_GOUT = 2 * 4096, TR_FFN = 4 * 3 * 5632, TR_SIN = 2 * 2048, TR_GLU = 2 * 2 * 2048, TR_TOTAL = TR_GIN + TR_GOUT + TR_FFN + TR_SIN + TR_GLU;
__device__ __forceinline__ void transpose_items(const Args& a, LAS unsigned char* lds, int vcu, int G) {
    PHASE_IDS; const int gw = vcu * NWAVES + wave, ngw = G * NWAVES;
    LAS float* scr = (LAS float*)(lds + wave * 16384);
    unsigned char* ws = a.ws;
    for (int it0 = gw; it0 < TR_TOTAL; it0 += ngw) {
        int it = it0;
        if (it < TR_GIN) { const int j = it / 8192, r = it % 8192; tr_item(a.in[I_GWIN] + (size_t)j * 2048 * 8192, 8192, 2048, 8192, (bf16*)(ws + WS_WGIN) + (size_t)j * 8192 * 2048, 0, scr, r, lane); continue; } it -= TR_GIN;
        if (it < TR_GOUT) { const int j = it / 4096, r = it % 4096; tr_item(a.in[I_GWOUT] + (size_t)j * 4096 * 2048, 2048, 4096, 2048, (bf16*)(ws + WS_WGOUT) + (size_t)j * 2048 * 4096, 0, scr, r, lane); continue; } it -= TR_GOUT;
        if (it < TR_FFN) { const int i = it / 16896, r = it % 16896, which = r / 5632, rr = r % 5632;
            if (which == 0) tr_item(a.in[I_W1] + (size_t)i * 2048 * 5632, 5632, 2048, 5632, (bf16*)(ws + WS_WF13) + (size_t)i * 11264 * 2048, 1, scr, rr, lane);
            else if (which == 1) tr_item(a.in[I_W3] + (size_t)i * 2048 * 5632, 5632, 2048, 5632, (bf16*)(ws + WS_WF13) + (size_t)i * 11264 * 2048, 2, scr, rr, lane);
            else tr_item(a.in[I_W2] + (size_t)i * 5632 * 2048, 2048, 5632, 2048, (bf16*)(ws + WS_WF2) + (size_t)i * 2048 * 5632, 0, scr, rr, lane);
            continue; } it -= TR_FFN;
        if (it < TR_SIN) { const int j = it / 2048, r = it % 2048; tr_item(a.in[I_SWIN] + (size_t)j * 2048 * 2048, 2048, 2048, 2048, (bf16*)(ws + WS_WSIN) + (size_t)j * 2048 * 2048, 0, scr, r, lane); continue; } it -= TR_SIN;
        { const int j = it / 4096, r = it % 4096, half = r / 2048, rr = r % 2048;
          tr_item(a.in[I_SWGLU] + (size_t)j * 2048 * 4096 + half * 2048, 4096, 2048, 2048, (bf16*)(ws + WS_WGLU) + (size_t)j * 4096 * 2048, 1 + half, scr, rr, lane); }
    }
}
__device__ __forceinline__ void small_prologue(const Args& a, int vcu, int G) {
    PHASE_IDS; const int gtid = vcu * NTHR + tid, ngt = G * NTHR;
    bf16* WSB = (bf16*)(a.ws + WS_WSB);
    for (int i = gtid; i < 2 * 16 * 128 * 128; i += ngt) WSB[i] = (bf16)f2bf(a.in[I_GWS][i]);
    f32x2* S5A = (f32x2*)(a.ws + WS_S5A); f32x2* S5B = (f32x2*)(a.ws + WS_S5B);
    for (int i = gtid; i < 2 * 2 * SG * SP; i += ngt) {
        const int lg = i / SP;
        const float dt = expf(a.in[I_SLDT][lg]), are = a.in[I_SARE][i], aim = a.in[I_SAIM][i];
        const float e = expf(dt * are), th = dt * aim, abr = e * cosf(th), abi = e * sinf(th);
        f32x2 ab; ab.x = abr; ab.y = abi; S5A[i] = ab;
        const float nr = abr - 1.0f, ni = abi, den = 1.0f / (are * are + aim * aim);
        const float cr = (nr * are + ni * aim) * den, ci = (ni * are - nr * aim) * den;
        for (int q = 0; q < SQ; ++q) { const float br = a.in[I_SBRE][(size_t)i * SQ + q], bi = a.in[I_SBIM][(size_t)i * SQ + q];
            f32x2 o; o.x = cr * br - ci * bi; o.y = cr * bi + ci * br; S5B[(size_t)i * SQ + q] = o; }
    }
}

typedef _Float16 h16x8 __attribute__((ext_vector_type(8)));
template <bool INIT> __device__ __forceinline__ void norm_phase(const Args& a, const float* gain, const float* modl  , int which, int vcu, int G, int nslab = 0, const float* sgate = nullptr, int mrows = M) {
    PHASE_IDS; const int gw = vcu * NWAVES + wave, ngw = G * NWAVES;
    _Float16* H = (_Float16*)(a.ws + WS_H); bf16* XN = (bf16*)(a.ws + WS_XN);
    for (int row = gw; row < mrows; row += ngw) {
        const int set = row < ML ? (row >> 13) : 2;
        GAS h16x8* hr = (GAS h16x8*)(H + (size_t)row * D) + lane;
        float v[4][8];
        if (INIT) {
            const float* src = row < ML ? a.in[I_X] + (size_t)row * D : a.in[I_CTX] + (size_t)(row - ML) * D;
            const GAS f32x4* xr = (const GAS f32x4*)src + 2 * lane;
#pragma unroll
            for (int j = 0; j < 4; ++j) { const f32x4 x0 = xr[128 * j], x1 = xr[128 * j + 1];
#pragma unroll
                for (int e = 0; e < 4; ++e) { v[j][e] = x0[e]; v[j][4 + e] = x1[e]; } }
            if (row < ML) {
                const int t = row & (SEQ - 1); const float pr = (float)(t >> 6), pc = (float)(t & 63);
#pragma unroll
                for (int e = 0; e < 8; ++e) { const float om = exp2f(-(float)(8 * lane + e) * (13.287712379549449f / 512.0f)); const float ar = pr * om, ac = pc * om;
                    v[0][e] += sinf(ar); v[1][e] += cosf(ar); v[2][e] += sinf(ac); v[3][e] += cosf(ac); }
            }
        } else {
#pragma unroll
            for (int j = 0; j < 4; ++j) { const h16x8 hv = hr[64 * j];
#pragma unroll
                for (int e = 0; e < 8; ++e) v[j][e] = (float)hv[e]; }
            if (nslab > 0 && row >= ML) {
                const GAS f32x4* sp = (const GAS f32x4*)((const float*)(a.ws + WS_SLAB) + (size_t)(row - ML) * D) + 2 * lane; const GAS f32x4* gp2 = (const GAS f32x4*)sgate + 2 * lane;
                f32x4 t[4][2];
#pragma unroll
                for (int j = 0; j < 4; ++j) { t[j][0] = sp[128 * j]; t[j][1] = sp[128 * j + 1]; }
                for (int s = 1; s < nslab; ++s) {
#pragma unroll
                    for (int j = 0; j < 4; ++j) { t[j][0] += sp[(size_t)s * (512 * D / 4) + 128 * j]; t[j][1] += sp[(size_t)s * (512 * D / 4) + 128 * j + 1]; } }
#pragma unroll
                for (int j = 0; j < 4; ++j) { const f32x4 g0 = gp2[128 * j], g1 = gp2[128 * j + 1];
#pragma unroll
                    for (int e = 0; e < 4; ++e) { v[j][e] += g0[e] * t[j][0][e]; v[j][4 + e] += g1[e] * t[j][1][e]; } }
            }
        }
        if (INIT || (nslab > 0 && row >= ML)) {
#pragma unroll
            for (int j = 0; j < 4; ++j) { h16x8 hv;
#pragma unroll
                for (int e = 0; e < 8; ++e) { hv[e] = (_Float16)v[j][e]; v[j][e] = (float)hv[e]; }
                hr[64 * j] = hv; }
        }
        float ss = 0.f;
#pragma unroll
        for (int j = 0; j < 4; ++j)
#pragma unroll
            for (int e = 0; e < 8; ++e) ss += v[j][e] * v[j][e];
        const float rinv = 1.0f / sqrtf(wave_sum(ss) * (1.0f / D) + EPS);
        const GAS f32x4* gp = (const GAS f32x4*)gain + 2 * lane;
        const GAS f32x4* shp = (const GAS f32x4*)(modl + (size_t)set * 12288 + (which * 3 + 0) * D) + 2 * lane;
        const GAS f32x4* scp = (const GAS f32x4*)(modl + (size_t)set * 12288 + (which * 3 + 1) * D) + 2 * lane;
        GAS v4u* o16 = (GAS v4u*)(XN + (size_t)row * D) + lane;
#pragma unroll
        for (int j = 0; j < 4; ++j) { float y[8];
#pragma unroll
            for (int hlf = 0; hlf < 2; ++hlf) { const f32x4 g = gp[128 * j + hlf], sh = shp[128 * j + hlf], sc = scp[128 * j + hlf];
#pragma unroll
                for (int e = 0; e < 4; ++e) y[4 * hlf + e] = v[j][4 * hlf + e] * rinv * g[e] * (1.0f + sc[e]) + sh[e]; }
            v4u o; o.x = pk2(y[0], y[1]); o.y = pk2(y[2], y[3]); o.z = pk2(y[4], y[5]); o.w = pk2(y[6], y[7]); o16[64 * j] = o; }
    }
}
__device__ __forceinline__ void final_phase(const Args& a, int vcu, int G) {
    PHASE_IDS; const int gw = vcu * NWAVES + wave, ngw = G * NWAVES;
    const _Float16* H = (const _Float16*)(a.ws + WS_H);
    for (int row = gw; row < ML; row += ngw) {
        const GAS h16x8* hr = (const GAS h16x8*)(H + (size_t)row * D) + lane;
        float v[4][8]; float ss = 0.f;
#pragma unroll
        for (int j = 0; j < 4; ++j) { const h16x8 hv = hr[64 * j];
#pragma unroll
            for (int e = 0; e < 8; ++e) { v[j][e] = (float)hv[e]; ss += v[j][e] * v[j][e]; } }
        const float rinv = 1.0f / sqrtf(wave_sum(ss) * (1.0f / D) + EPS);
        const GAS f32x4* gp = (const GAS f32x4*)a.in[I_FING] + 2 * lane;
        GAS f32x4* o = (GAS f32x4*)(a.out + (size_t)row * D) + 2 * lane;
#pragma unroll
        for (int j = 0; j < 4; ++j)
#pragma unroll
            for (int hlf = 0; hlf < 2; ++hlf) { const f32x4 g = gp[128 * j + hlf]; f32x4 r;
#pragma unroll
                for (int e = 0; e < 4; ++e) r[e] = v[j][4 * hlf + e] * rinv * g[e];
                o[128 * j + hlf] = r; }
    }
}

__device__ __forceinline__ void sgu_phase(const Args& a, int gl  , LAS unsigned char* lds, int wg, int nwg, int dry) {
    PHASE_IDS;
    bf16* ZU = (bf16*)(a.ws + WS_ZU); const bf16* ZV = (const bf16*)(a.ws + WS_ZV); const float* VSTAT = (const float*)(a.ws + WS_VSTAT);
    const bf16* WSB = (const bf16*)(a.ws + WS_WSB) + (size_t)gl * 16 * 128 * 128;
    const float* bs = a.in[I_GBS] + gl * 16 * 128; const float* lng = a.in[I_GLNG] + gl * EA; const float* lnb = a.in[I_GLNB] + gl * EA;
    LAS f32x2* st = (LAS f32x2*)lds;
    const int n = lane & 31, h = lane >> 5;
    for (int unit = wg; unit < NCHUNK * NH; unit += nwg) {
        const int c = unit / NH, hd = unit % NH, r0 = c * CHUNK;
        { const int j = tid >> 2, part = tid & 3; const GAS f32x4* p = (const GAS f32x4*)(VSTAT + ((size_t)(r0 + j) * 64 + part * 16) * 2);
          float s = 0.f, ss = 0.f;
#pragma unroll
          for (int q = 0; q < 8; ++q) { const f32x4 w = p[q]; s += w.x + w.z; ss += w.y + w.w; }
          s += __shfl_xor(s, 1); s += __shfl_xor(s, 2); ss += __shfl_xor(ss, 1); ss += __shfl_xor(ss, 2);
          if (part == 0) { const float mean = s * (1.0f / EA), var = ss * (1.0f / EA) - mean * mean; f32x2 o; o.x = mean; o.y = 1.0f / sqrtf(var + EPS); st[j] = o; } }
        __syncthreads();
        const int gcol = hd * HDIM + 32 * wave + n;
        const float lg = lng[gcol], lb = lnb[gcol];
        const GAS bf16* vp = (const GAS bf16*)ZV + (size_t)r0 * EA + gcol;
        unsigned short raw[8][8];
#pragma unroll
        for (int ks = 0; ks < 8; ++ks)
#pragma unroll
            for (int e = 0; e < 8; ++e) raw[ks][e] = vp[(size_t)(16 * ks + 8 * h + e) * EA];
        bf16x8 Bf[8];
#pragma unroll
        for (int ks = 0; ks < 8; ++ks) { float f[8];
#pragma unroll
            for (int e = 0; e < 8; ++e) { const f32x2 m = st[16 * ks + 8 * h + e]; f[e] = (bf2f(raw[ks][e]) - m.x) * m.y * lg + lb; }
            v4u w; w.x = pk2(f[0], f[1]); w.y = pk2(f[2], f[3]); w.z = pk2(f[4], f[5]); w.w = pk2(f[6], f[7]); Bf[ks] = __builtin_bit_cast(bf16x8, w); }
#pragma unroll 1
        for (int ib = 0; ib < 4; ++ib) {
            f32x16 acc;
#pragma unroll
            for (int r = 0; r < 16; ++r) acc[r] = 0.f;
            const GAS bf16x8* ap = (const GAS bf16x8*)(WSB + ((size_t)hd * 128 + 32 * ib + n) * 128 + 8 * h);
#pragma unroll
            for (int ks = 0; ks < 8; ++ks) { const bf16x8 Af = ap[2 * ks]; acc = __builtin_amdgcn_mfma_f32_32x32x16_bf16(Af, Bf[ks], acc, 0, 0, 0); }
#pragma unroll
            for (int r = 0; r < 16; ++r) { const int i = 32 * ib + (r & 3) + 8 * (r >> 2) + 4 * h; const float s = acc[r] + bs[hd * 128 + i];
                GAS bf16* up = (GAS bf16*)ZU + (size_t)(r0 + i) * EA + gcol; const bf16 nv = (bf16)f2bf(bf2f(*up) * s); if (!dry) *up = nv; }
        }
        __syncthreads();
    }
}

__device__ __forceinline__ void s5_naive_phase(const Args& a, int sl  , int wg, int nwg) {
    PHASE_IDS;
    if (wave >= 2) return;
    const bf16* U = (const bf16*)(a.ws + WS_SU);
    for (int item = wg * 2 + wave; item < 2 * 2 * SG; item += nwg * 2) {
        const int b = item & 1, k = (item >> 1) & 1, g = item >> 2;
        const int pg = ((sl * 2 + k) * SG + g);
        const f32x2 ab = ((const f32x2*)(a.ws + WS_S5A))[(size_t)pg * SP + lane];
        float bre[16], bim[16], cr[16], ci[16];
#pragma unroll
        for (int q = 0; q < 16; ++q) { const f32x2 bb = ((const f32x2*)(a.ws + WS_S5B))[((size_t)pg * SP + lane) * SQ + q]; bre[q] = bb.x; bim[q] = bb.y;
            cr[q] = a.in[I_SCRE][((size_t)pg * SQ + q) * SP + lane]; ci[q] = a.in[I_SCIM][((size_t)pg * SQ + q) * SP + lane]; }
        float* Y = (float*)(a.ws + (k ? WS_YB : WS_YF));
        float hr = 0.f, hi = 0.f;
#pragma unroll 1
        for (int seg = 0; seg < 2; ++seg) {
            const int L = seg ? SEQ : CTXL, base = seg ? b * SEQ : ML + b * CTXL;
#pragma unroll 1
            for (int blk = 0; blk < L; blk += 64) {
                const int myt = k ? (L - 1 - (blk + lane)) : (blk + lane);
                const size_t row = (size_t)(base + myt);
                const GAS v4u* up = (const GAS v4u*)(U + row * D + 16 * g);
                const v4u u0 = up[0], u1 = up[1];
                float keep[16];
#pragma unroll
                for (int q = 0; q < 16; ++q) keep[q] = 0.f;
#pragma unroll 1
                for (int s = 0; s < 64; ++s) {
                    unsigned w[8];
                    w[0] = __builtin_amdgcn_readlane(u0.x, s); w[1] = __builtin_amdgcn_readlane(u0.y, s); w[2] = __builtin_amdgcn_readlane(u0.z, s); w[3] = __builtin_amdgcn_readlane(u0.w, s);
                    w[4] = __builtin_amdgcn_readlane(u1.x, s); w[5] = __builtin_amdgcn_readlane(u1.y, s); w[6] = __builtin_amdgcn_readlane(u1.z, s); w[7] = __builtin_amdgcn_readlane(u1.w, s);
                    float br = 0.f, bi = 0.f;
#pragma unroll
                    for (int q2 = 0; q2 < 8; ++q2) { const float ulo = __builtin_bit_cast(float, w[q2] << 16), uhi = __builtin_bit_cast(float, w[q2] & 0xffff0000u);
                        br += bre[2 * q2] * ulo + bre[2 * q2 + 1] * uhi; bi += bim[2 * q2] * ulo + bim[2 * q2 + 1] * uhi; }
                    const float nhr = ab.x * hr - ab.y * hi + br, nhi = ab.x * hi + ab.y * hr + bi; hr = nhr; hi = nhi;
#pragma unroll
                    for (int q = 0; q < 16; ++q) { const float y = wave_sum(cr[q] * hr - ci[q] * hi); keep[q] = (lane == s) ? y : keep[q]; }
                }
                GAS f32x4* yp = (GAS f32x4*)(Y + row * D + 16 * g);
#pragma unroll
                for (int q4 = 0; q4 < 4; ++q4) { f32x4 o; o.x = keep[4 * q4]; o.y = keep[4 * q4 + 1]; o.z = keep[4 * q4 + 2]; o.w = keep[4 * q4 + 3]; yp[q4] = o; }
            }
        }
    }
}
__device__ __forceinline__ void s5_combine_phase(const Args& a, int sl, int vcu, int G) {
    PHASE_IDS; const int gw = vcu * NWAVES + wave, ngw = G * NWAVES;
    const float* YF = (const float*)(a.ws + WS_YF); const float* YB = (const float*)(a.ws + WS_YB); const bf16* U = (const bf16*)(a.ws + WS_SU); bf16* Z = (bf16*)(a.ws + WS_SZ);
    const GAS f32x4* dp = (const GAS f32x4*)(a.in[I_SD] + sl * D) + lane;
    for (int row = gw; row < M; row += ngw) {
        const GAS f32x4* yf = (const GAS f32x4*)(YF + (size_t)row * D) + lane; const GAS f32x4* yb = (const GAS f32x4*)(YB + (size_t)row * D) + lane;
        const GAS v2u* up = (const GAS v2u*)(U + (size_t)row * D) + lane; GAS v2u* zp = (GAS v2u*)(Z + (size_t)row * D) + lane;
#pragma unroll
        for (int j = 0; j < 8; ++j) { const f32x4 f = yf[64 * j], bk = yb[64 * j], dd = dp[64 * j]; const v2u uu = up[64 * j];
            f32x4 u4; u4.x = __builtin_bit_cast(float, uu.x << 16); u4.y = __builtin_bit_cast(float, uu.x & 0xffff0000u); u4.z = __builtin_bit_cast(float, uu.y << 16); u4.w = __builtin_bit_cast(float, uu.y & 0xffff0000u);
            const f32x4 y = f + bk + u4 * dd;
            v2u o; o.x = pk2(pg8::gelu_tanh_f(y.x), pg8::gelu_tanh_f(y.y)); o.y = pk2(pg8::gelu_tanh_f(y.z), pg8::gelu_tanh_f(y.w)); zp[64 * j] = o; }
    }
}

__device__ __forceinline__ f32x2 cmul(f32x2 a, f32x2 b) { f32x2 r; r.x = a.x * b.x - a.y * b.y; r.y = a.x * b.y + a.y * b.x; return r; }
__device__ __forceinline__ void s5_precompute(const Args& a, LAS unsigned char* lds, int wg, int nwg) {
    PHASE_IDS;
    LAS f32x2* apw = (LAS f32x2*)lds;
    LAS f32x2* bbl = apw + 2 * 17 * 64;
    LAS f32x2* ccl = bbl + 2 * 64 * 16;
    LAS float* ktab = (LAS float*)(ccl + 2 * 16 * 64);
    for (int item = wg; item < 2 * SG; item += nwg) {
        const int sl = item >> 7, g = item & 127;
        if (tid < 128) { const int d = tid >> 6, p = tid & 63, pg = (sl * 2 + d) * SG + g, i = pg * SP + p;
            const float dt = expf(a.in[I_SLDT][pg]), are = a.in[I_SARE][i], aim = a.in[I_SAIM][i];
            for (int l = 0; l <= 16; ++l) { const float e = expf((float)l * (dt * are)), th = (float)l * (dt * aim); f32x2 o; o.x = e * cosf(th); o.y = e * sinf(th); apw[(d * 17 + l) * 64 + p] = o; }
            const f32x2 ab = apw[(d * 17 + 1) * 64 + p];
            const float nr = ab.x - 1.0f, ni = ab.y, den = 1.0f / (are * are + aim * aim);
            f32x2 coef; coef.x = (nr * are + ni * aim) * den; coef.y = (ni * are - nr * aim) * den;
            for (int q = 0; q < SQ; ++q) { f32x2 bq; bq.x = a.in[I_SBRE][(size_t)i * SQ + q]; bq.y = a.in[I_SBIM][(size_t)i * SQ + q]; bbl[(d * 64 + p) * 16 + q] = cmul(coef, bq); }
            ((f32x2*)(a.ws + WS_A16))[i] = apw[(d * 17 + 16) * 64 + p]; }
        for (int e = tid; e < 2 * 16 * 64; e += NTHR) { const int d = e >> 10, q = (e >> 6) & 15, p = e & 63; const size_t ci = ((size_t)((sl * 2 + d) * SG + g) * SQ + q) * SP + p;
            f32x2 o; o.x = a.in[I_SCRE][ci]; o.y = a.in[I_SCIM][ci]; ccl[e] = o; }
        __syncthreads();
        for (int o = tid; o < 8192; o += NTHR) { const int d = o >> 12, l = (o >> 8) & 15, q = (o >> 4) & 15, qp = o & 15; float acc = 0.f;
            for (int p = 0; p < 64; ++p) { const f32x2 ca = cmul(ccl[(d * 16 + q) * 64 + p], apw[(d * 17 + l) * 64 + p]), bb = bbl[(d * 64 + p) * 16 + qp]; acc += ca.x * bb.x - ca.y * bb.y; }
            ktab[o] = acc; }
        __syncthreads();
        bf16* MoutT = (bf16*)(a.ws + WS_MOUTT) + (size_t)(sl * SG + g) * 256 * 512;
        bf16* M2T = (bf16*)(a.ws + WS_M2T) + (size_t)(sl * SG + g) * 256 * 256;
        for (int ch = tid; ch < 256 * 64; ch += NTHR) { const int n = ch >> 6, jj = ch & 63, t = n >> 4, q = n & 15; float v[8];
            if (jj < 32) { const int s = jj >> 1, q0 = 8 * (jj & 1);
#pragma unroll
                for (int e = 0; e < 8; ++e) { const int qp = q0 + e;
                    v[e] = s < t ? ktab[((0 * 16 + (t - s)) * 16 + q) * 16 + qp] : (s > t ? ktab[((1 * 16 + (s - t)) * 16 + q) * 16 + qp]
                         : ktab[(0 * 16 * 16 + q) * 16 + qp] + ktab[((16) * 16 + q) * 16 + qp] + (q == qp ? a.in[I_SD][sl * D + 16 * g + q] : 0.f)); }
            } else { const int j2 = jj - 32, d = j2 >> 4, p0 = (j2 & 15) * 4, ex = d == 0 ? t + 1 : 16 - t;
#pragma unroll
                for (int pp = 0; pp < 4; ++pp) { const f32x2 ca = cmul(ccl[(d * 16 + q) * 64 + p0 + pp], apw[(d * 17 + ex) * 64 + p0 + pp]); v[2 * pp] = ca.x; v[2 * pp + 1] = -ca.y; } }
            v4u w; w.x = pk2(v[0], v[1]); w.y = pk2(v[2], v[3]); w.z = pk2(v[4], v[5]); w.w = pk2(v[6], v[7]);
            *(GAS v4u*)(MoutT + (size_t)n * 512 + 8 * jj) = w; }
        for (int ch = tid; ch < 256 * 32; ch += NTHR) { const int n = ch >> 5, jj = ch & 31, d = n >> 7, p = (n & 127) >> 1, im = n & 1, s = jj >> 1, q0 = 8 * (jj & 1), ex = d == 0 ? 15 - s : s; float v[8];
            const f32x2 ap = apw[(d * 17 + ex) * 64 + p];
#pragma unroll
            for (int e = 0; e < 8; ++e) { const f32x2 r = cmul(ap, bbl[(d * 64 + p) * 16 + q0 + e]); v[e] = im ? r.y : r.x; }
            v4u w; w.x = pk2(v[0], v[1]); w.y = pk2(v[2], v[3]); w.z = pk2(v[4], v[5]); w.w = pk2(v[6], v[7]);
            *(GAS v4u*)(M2T + (size_t)n * 256 + 8 * jj) = w; }
        __syncthreads();
    }
}
template <bool OUT> __device__ __forceinline__ void s5_ctx_gemm(const Args& a, int sl, int wg, int nwg) {
    PHASE_IDS;
    constexpr int K = OUT ? 512 : 256;
    const int r = lane & 31, hh = lane >> 5;
    for (int g = wg; g < SG; g += nwg) {
        const GAS bf16x8* ap = (const GAS bf16x8*)((const bf16*)(a.ws + WS_XC) + (size_t)(g * 32 + r) * 512 + 8 * hh);
        const bf16* Bt = OUT ? (const bf16*)(a.ws + WS_MOUTT) + (size_t)(sl * SG + g) * 256 * 512 : (const bf16*)(a.ws + WS_M2T) + (size_t)(sl * SG + g) * 256 * 256;
        const GAS bf16x8* bp = (const GAS bf16x8*)(Bt + (size_t)(32 * wave + r) * K + 8 * hh);
        f32x16 acc;
#pragma unroll
        for (int i = 0; i < 16; ++i) acc[i] = 0.f;
#pragma unroll 8
        for (int ks = 0; ks < K / 16; ++ks) acc = __builtin_amdgcn_mfma_f32_32x32x16_bf16(ap[2 * ks], bp[2 * ks], acc, 0, 0, 0);
        const int n = 32 * wave + r;
#pragma unroll
        for (int i = 0; i < 16; ++i) { const int c = (i & 3) + 8 * (i >> 2) + 4 * hh;
            if (OUT) { const int t = n >> 4, q = n & 15; ((GAS bf16*)(a.ws + WS_Z))[(size_t)(ML + 16 * c + t) * D + 16 * g + q] = (bf16)f2bf(pg8::gelu_tanh_f(acc[i])); }
            else ((GAS bf16*)(a.ws + WS_SC))[(size_t)(g * 32 + c) * 256 + n] = (bf16)f2bf(acc[i]); }
    }
}
__device__ __forceinline__ void s5_carry_phase(const Args& a, int sl, int wg, int nwg) {
    PHASE_IDS;
    if (wave >= 2) return;
    for (int item = wg * 2 + wave; item < 2 * 2 * SG; item += nwg * 2) {
        const int b = item & 1, d = (item >> 1) & 1, g = item >> 2;
        const f32x2 a16 = ((const f32x2*)(a.ws + WS_A16))[(size_t)((sl * 2 + d) * SG + g) * SP + lane];
        const GAS unsigned* SLw = (const GAS unsigned*)(a.ws + WS_SL) + (size_t)(g * 1024 + b * 512) * 128 + d * 64 + lane;
        const GAS unsigned* SCw = (const GAS unsigned*)(a.ws + WS_SC) + (size_t)(g * 32 + b * 16) * 128 + d * 64 + lane;
        GAS unsigned* XLw = (GAS unsigned*)(a.ws + WS_XL) + (size_t)(g * 1024 + b * 512) * 256 + 128 + d * 64 + lane;
        GAS unsigned* XCw = (GAS unsigned*)(a.ws + WS_XC) + (size_t)(g * 32 + b * 16) * 256 + 128 + d * 64 + lane;
        float hr = 0.f, hi = 0.f;
        unsigned b0[16], b1[16], b2[16];
#define S5_CIDX(bi, j) ((bi) == 0 ? (d ? 15 - (j) : (j)) : (d ? 511 - (((bi) - 1) * 16 + (j)) : ((bi) - 1) * 16 + (j)))
#define S5_LOAD(bi, arr) do { _Pragma("unroll") for (int j = 0; j < 16; ++j) { const int ci = S5_CIDX(bi, j); arr[j] = (bi) == 0 ? SCw[(size_t)ci * 128] : SLw[(size_t)ci * 128]; } } while (0)
#define S5_PROC(bi, arr) do { _Pragma("unroll") for (int j = 0; j < 16; ++j) { const int ci = S5_CIDX(bi, j); const unsigned hw = pk2(hr, hi); \
            if ((bi) == 0) XCw[(size_t)ci * 256] = hw; else XLw[(size_t)ci * 256] = hw; \
            const float sr = __builtin_bit_cast(float, arr[j] << 16), si = __builtin_bit_cast(float, arr[j] & 0xffff0000u); \
            const float nr = a16.x * hr - a16.y * hi + sr, ni = a16.x * hi + a16.y * hr + si; hr = nr; hi = ni; } } while (0)
        S5_LOAD(0, b0); S5_LOAD(1, b1); S5_LOAD(2, b2);
#pragma unroll 1
        for (int it = 0; it < 11; ++it) { const int bi = 3 * it;
            S5_PROC(bi, b0);     if (bi + 3 < 33) S5_LOAD(bi + 3, b0);
            S5_PROC(bi + 1, b1); if (bi + 4 < 33) S5_LOAD(bi + 4, b1);
            S5_PROC(bi + 2, b2); if (bi + 5 < 33) S5_LOAD(bi + 5, b2);
        }
#undef S5_CIDX
#undef S5_LOAD
#undef S5_PROC
    }
}

__device__ __forceinline__ void probe_flush(const Args& a, int vcu, int G) {
    PHASE_IDS; const int gt = vcu * NTHR + tid, ngt = G * NTHR;
    const GAS f32x4* p1 = (const GAS f32x4*)a.in[I_W1]; const GAS f32x4* p3 = (const GAS f32x4*)a.in[I_W3];
    f32x4 s = {0.f, 0.f, 0.f, 0.f};
    const int n4 = 4 * 2048 * 5632 / 4;
#pragma unroll 8
    for (int i = gt; i < n4; i += ngt) { s += p1[i]; s += p3[i]; }
    if (s.x + s.y + s.z + s.w == 1.2345e30f) ((float*)(a.ws + WS_CTL))[1000 + (tid & 7)] = s.x;
    __syncthreads();
}

#ifndef GEMM_ALIGN
#define GEMM_ALIGN true
#endif
#ifndef GEMM_SP2
#define GEMM_SP2 true
#endif
#ifndef MK_ONE_LAUNCH
#define MK_ONE_LAUNCH 1
#endif
constexpr int N_PHASES = 2 + 2 * 16;

__global__ void __launch_bounds__(NTHR, 2) fwd_kernel(Args args) {
    extern __shared__ __attribute__((aligned(16))) unsigned char lds_raw[];
    LAS unsigned char* lds = (LAS unsigned char*)lds_raw;
    const int tid = threadIdx.x;
    const int G = gridDim.x, bx = blockIdx.x;
    const int vcu = (G % 8 == 0) ? (bx % 8) * (G / 8) + bx / 8 : bx;
    unsigned char* ws = args.ws;
    volatile LAS unsigned* MISC = (volatile LAS unsigned*)(lds + MISC_OFF);
    for (int u = tid; u < (LDS_BYTES - LDSCTL_OFF) / 4; u += NTHR) ((LAS unsigned*)(lds + LDSCTL_OFF))[u] = 0u;
    __syncthreads();
    const int lo = args.ph_lo, hi = args.ph_hi;
    XcdBarrier bar; bar.bar = (unsigned*)(ws + WS_CTL) + CW_BAR; bar.x = 0; bar.st = nullptr;
    if (hi - lo > 1) bar = xcd_barrier_post((unsigned*)(ws + WS_CTL) + CW_BAR, MISC + 8);
#define RUN(k) (lo <= (k) && (k) < hi)
#ifndef PROBE_MASK
#define PROBE_MASK 0
#endif
#define REP(kind) for (int rep = 0, nrep = 1 + ((PROBE_MASK >> (kind)) & 1); rep < nrep; ++rep)
#ifndef PROBE_WET
#define PROBE_WET 0
#endif
#define GATE(p) ((PROBE_WET && rep) ? (const float*)(ws + WS_CTL + 512 * 1024) : (p))
#define DRY (PROBE_WET ? 0 : rep)
#ifndef PROBE_FLUSH
#define PROBE_FLUSH 0
#endif
#define REPSYNC() do { if (rep + 1 < nrep) { __syncthreads(); if (PROBE_FLUSH == 1) probe_flush(args, vcu, G); } else if (PROBE_FLUSH == 2) { __syncthreads(); probe_flush(args, vcu, G); } } while (0)
#define SEAM(k) do { if (RUN(k) && RUN((k) + 1)) { xcd_barrier(bar); if ((PROBE_MASK >> 12) & 1) xcd_barrier(bar); } } while (0)
    _Float16* H = (_Float16*)(ws + WS_H); pg8::bf16_t* XN = (pg8::bf16_t*)(ws + WS_XN);
    const float* MOD = (const float*)(ws + WS_MOD);

#ifndef NO_PRO
    if (RUN(0)) REP(0) {
        adaln_items(args, lds, vcu, G);
        transpose_items(args, lds, vcu, G);
        small_prologue(args, vcu, G);
#if !S5_NAIVE
        __syncthreads();
        s5_precompute(args, lds, vcu, G);
#endif
        REPSYNC();
    }
#endif
    SEAM(0);
    if (RUN(1)) REP(1) norm_phase<true>(args, args.in[I_N1G], MOD, 0, vcu, G);
    SEAM(1);

#ifdef UNROLL_LP
#pragma unroll
#else
#pragma unroll 1
#endif
    for (int lp = 0; lp < 2; ++lp) {
        const int pb = 2 + lp * 16;
        {
            const int layer = 2 * lp; const float* modl = MOD + (size_t)layer * 3 * 12288;
            if (RUN(pb + 0)) { REP(2) {
                pg8::Gemm g{XN, (const pg8::bf16_t*)(ws + WS_WGIN) + (size_t)lp * 8192 * 2048, M, 8192, D}; pg8::StaticOrder S; S.init(M, 8192, G, bx);
                pg8::EpiG1 E{(pg8::bf16_t*)(ws + WS_ZU), (pg8::bf16_t*)(ws + WS_ZV), (float*)(ws + WS_VSTAT)};
                pg8::gemm_phase<pg8::EpiG1, pg8::StaticOrder, GEMM_ALIGN, GEMM_SP2>(lds + RING_OFF, g, S, E);
                REPSYNC(); }
            }
            SEAM(pb + 0);
            #ifndef NO_SGU
            if (RUN(pb + 1)) REP(3) sgu_phase(args, lp, lds, bx, G, rep);
#endif
            SEAM(pb + 1);
            if (RUN(pb + 2)) { REP(4) {
                pg8::Gemm g{(const pg8::bf16_t*)(ws + WS_ZU), (const pg8::bf16_t*)(ws + WS_WGOUT) + (size_t)lp * 2048 * 4096, ML, D, EA}; pg8::StaticOrder S; S.init(ML, D, G, bx);
                pg8::EpiResid E{H, GATE(modl + 2 * D), DRY};
                pg8::gemm_phase<pg8::EpiResid, pg8::StaticOrder, GEMM_ALIGN, GEMM_SP2>(lds + RING_OFF, g, S, E);
                __syncthreads();
                pg8::Gemm gc{(const pg8::bf16_t*)(ws + WS_ZU), (const pg8::bf16_t*)(ws + WS_WGOUT) + (size_t)lp * 2048 * 4096, M, D, 512, EA, EA}; pg8::SliceOrder SS; SS.init(G, bx, 8, 512);
                pg8::EpiSlab ES{(float*)(ws + WS_SLAB), 1024};
                pg8::gemm_phase<pg8::EpiSlab, pg8::SliceOrder, GEMM_ALIGN, GEMM_SP2>(lds + RING_OFF, gc, SS, ES);
                REPSYNC(); }
            }
            SEAM(pb + 2);
            if (RUN(pb + 3)) REP(1) norm_phase<false>(args, args.in[I_N2G] + layer * D, modl, 1, vcu, G, rep ? 0 : 8, modl + 2 * 12288 + 2 * D);
            SEAM(pb + 3);
            if (RUN(pb + 4)) { REP(5) {
                pg8::Gemm g{XN, (const pg8::bf16_t*)(ws + WS_WF13) + (size_t)layer * 11264 * 2048, M, 2 * FF, D}; pg8::StaticOrder S; S.init(M, 2 * FF, G, bx);
                pg8::EpiSwiGLU E{(pg8::bf16_t*)(ws + WS_HID)};
                pg8::gemm_phase<pg8::EpiSwiGLU, pg8::StaticOrder, GEMM_ALIGN, GEMM_SP2>(lds + RING_OFF, g, S, E);
                REPSYNC(); }
            }
            SEAM(pb + 4);
            if (RUN(pb + 5)) { REP(6) {
                pg8::Gemm g{(const pg8::bf16_t*)(ws + WS_HID), (const pg8::bf16_t*)(ws + WS_WF2) + (size_t)layer * 2048 * 5632, ML, D, FF}; pg8::StaticOrder S; S.init(ML, D, G, bx);
                pg8::EpiResid E{H, GATE(modl + 5 * D), DRY};
                pg8::gemm_phase<pg8::EpiResid, pg8::StaticOrder, GEMM_ALIGN, GEMM_SP2>(lds + RING_OFF, g, S, E);
                if (true) { __syncthreads();
                pg8::Gemm gc{(const pg8::bf16_t*)(ws + WS_HID), (const pg8::bf16_t*)(ws + WS_WF2) + (size_t)layer * 2048 * 5632, M, D, 512, FF, FF}; pg8::SliceOrder SS; SS.init(G, bx, 11, 512);
                pg8::EpiSlab ES{(float*)(ws + WS_SLAB), 1024};
                pg8::gemm_phase<pg8::EpiSlab, pg8::SliceOrder, GEMM_ALIGN, GEMM_SP2>(lds + RING_OFF, gc, SS, ES); }
                REPSYNC(); }
            }
            SEAM(pb + 5);
            if (RUN(pb + 6)) REP(1) norm_phase<false>(args, args.in[I_N1G] + (layer + 1) * D, modl + 3 * 12288, 0, vcu, G, rep ? 0 : 11, modl + 2 * 12288 + 5 * D);
            SEAM(pb + 6);
        }
        {
            const int layer = 2 * lp + 1; const float* modl = MOD + (size_t)layer * 3 * 12288; const int ps = pb + 7;
            const int Mrows = lp == 0 ? M : ML;
#if S5_NAIVE
            if (RUN(ps + 0)) {
                pg8::Gemm g{XN, (const pg8::bf16_t*)(ws + WS_WSIN) + (size_t)lp * 2048 * 2048, M, D, D}; pg8::StaticOrder S; S.init(M, D, G, bx);
                pg8::EpiPlainBf16 E{(pg8::bf16_t*)(ws + WS_SU), D};
                pg8::gemm_phase<pg8::EpiPlainBf16, pg8::StaticOrder, GEMM_ALIGN, GEMM_SP2>(lds + RING_OFF, g, S, E);
            }
            SEAM(ps + 0);
            if (RUN(ps + 1)) s5_naive_phase(args, lp, bx, G);
            SEAM(ps + 1);
            if (RUN(ps + 2)) s5_combine_phase(args, lp, vcu, G);
            SEAM(ps + 2);
            SEAM(ps + 3);
#else
            if (RUN(ps + 0)) { REP(7) {
                pg8::Gemm g{XN, (const pg8::bf16_t*)(ws + WS_WSIN) + (size_t)lp * 2048 * 2048, M, D, D}; pg8::StaticOrder S; S.init(M, D, G, bx);
                pg8::EpiS5In E{(pg8::bf16_t*)(ws + WS_XL), (pg8::bf16_t*)(ws + WS_XC)};
                pg8::gemm_phase<pg8::EpiS5In, pg8::StaticOrder, GEMM_ALIGN, GEMM_SP2>(lds + RING_OFF, g, S, E);
                REPSYNC(); }
            }
            SEAM(ps + 0);
            if (RUN(ps + 1)) { REP(8) {
                pg8::Gemm g{(const pg8::bf16_t*)(ws + WS_XL), (const pg8::bf16_t*)(ws + WS_M2T) + (size_t)lp * SG * 256 * 256, SG * 1024, 256, 256, 512}; pg8::GroupOrder S; S.init(G, vcu);
                pg8::EpiS5State E{(pg8::bf16_t*)(ws + WS_SL)};
                pg8::gemm_phase<pg8::EpiS5State, pg8::GroupOrder, GEMM_ALIGN, GEMM_SP2>(lds + RING_OFF, g, S, E);
                s5_ctx_gemm<false>(args, lp, vcu, G);
                REPSYNC(); }
            }
            SEAM(ps + 1);
            if (RUN(ps + 2)) REP(9) s5_carry_phase(args, lp, bx, G);
            SEAM(ps + 2);
            if (RUN(ps + 3)) { REP(10) {
                pg8::Gemm g{(const pg8::bf16_t*)(ws + WS_XL), (const pg8::bf16_t*)(ws + WS_MOUTT) + (size_t)lp * SG * 256 * 512, SG * 1024, 256, 512, 512}; pg8::GroupOrder S; S.init(G, vcu);
                pg8::EpiS5Out E{(pg8::bf16_t*)(ws + WS_Z)};
                pg8::gemm_phase<pg8::EpiS5Out, pg8::GroupOrder, GEMM_ALIGN, GEMM_SP2>(lds + RING_OFF, g, S, E);
                s5_ctx_gemm<true>(args, lp, vcu, G);
                REPSYNC(); }
            }
            SEAM(ps + 3);
#endif
            if (RUN(ps + 4)) { REP(11) {
                pg8::Gemm g{(const pg8::bf16_t*)(ws + WS_Z), (const pg8::bf16_t*)(ws + WS_WGLU) + (size_t)lp * 4096 * 2048, Mrows, 2 * D, D}; pg8::StaticOrder S; S.init(Mrows, 2 * D, G, bx);
                pg8::EpiGluResid E{H, GATE(modl + 2 * D), DRY};
                pg8::gemm_phase<pg8::EpiGluResid, pg8::StaticOrder, GEMM_ALIGN, GEMM_SP2>(lds + RING_OFF, g, S, E);
                REPSYNC(); }
            }
            SEAM(ps + 4);
            if (RUN(ps + 5)) REP(1) norm_phase<false>(args, args.in[I_N2G] + layer * D, modl, 1, vcu, G, 0, nullptr, Mrows);
            SEAM(ps + 5);
            if (RUN(ps + 6)) { REP(5) {
                pg8::Gemm g{XN, (const pg8::bf16_t*)(ws + WS_WF13) + (size_t)layer * 11264 * 2048, Mrows, 2 * FF, D}; pg8::StaticOrder S; S.init(Mrows, 2 * FF, G, bx);
                pg8::EpiSwiGLU E{(pg8::bf16_t*)(ws + WS_HID)};
                pg8::gemm_phase<pg8::EpiSwiGLU, pg8::StaticOrder, GEMM_ALIGN, GEMM_SP2>(lds + RING_OFF, g, S, E);
                REPSYNC(); }
            }
            SEAM(ps + 6);
            if (RUN(ps + 7)) { REP(6) {
                pg8::Gemm g{(const pg8::bf16_t*)(ws + WS_HID), (const pg8::bf16_t*)(ws + WS_WF2) + (size_t)layer * 2048 * 5632, ML, D, FF}; pg8::StaticOrder S; S.init(ML, D, G, bx);
                pg8::EpiResid E{H, GATE(modl + 5 * D), DRY};
                pg8::gemm_phase<pg8::EpiResid, pg8::StaticOrder, GEMM_ALIGN, GEMM_SP2>(lds + RING_OFF, g, S, E);
                if (lp == 0) { __syncthreads();
                pg8::Gemm gc{(const pg8::bf16_t*)(ws + WS_HID), (const pg8::bf16_t*)(ws + WS_WF2) + (size_t)layer * 2048 * 5632, M, D, 512, FF, FF}; pg8::SliceOrder SS; SS.init(G, bx, 11, 512);
                pg8::EpiSlab ES{(float*)(ws + WS_SLAB), 1024};
                pg8::gemm_phase<pg8::EpiSlab, pg8::SliceOrder, GEMM_ALIGN, GEMM_SP2>(lds + RING_OFF, gc, SS, ES); }
                REPSYNC(); }
            }
            SEAM(ps + 7);
            if (RUN(ps + 8)) {
                REP(1) if (lp == 0) norm_phase<false>(args, args.in[I_N1G] + (layer + 1) * D, modl + 3 * 12288, 0, vcu, G, rep ? 0 : 11, modl + 2 * 12288 + 5 * D);
                else final_phase(args, vcu, G);
            }
            SEAM(ps + 8);
        }
    }
#undef RUN
#undef SEAM
}

extern "C" void kernel_launch(void* const* d_in, const int* in_sizes, int n_in, void* d_out, int out_size, void* d_ws, size_t ws_size, hipStream_t stream) {
    static int grid = 0;
    if (grid == 0) {
        if (n_in != 28 || in_sizes[0] != ML * D || out_size != ML * D || ws_size < WS_END) {
            fprintf(stderr, "kernel_launch: unexpected problem (n_in %d, in0 %d, out %d, ws %zu, need ws >= %zu); nothing launched\n", n_in, n_in > 0 ? in_sizes[0] : -1, out_size, ws_size, (size_t)WS_END); grid = -1; return; }
        int dev = 0, cus = 0, per_cu = 0;
        if (hipGetDevice(&dev) != hipSuccess || hipDeviceGetAttribute(&cus, hipDeviceAttributeMultiprocessorCount, dev) != hipSuccess) { fprintf(stderr, "kernel_launch: device query failed\n"); grid = -1; return; }
        if (hipFuncSetAttribute((const void*)fwd_kernel, hipFuncAttributeMaxDynamicSharedMemorySize, LDS_BYTES) != hipSuccess) { fprintf(stderr, "kernel_launch: hipFuncSetAttribute failed\n"); grid = -1; return; }
        if (hipOccupancyMaxActiveBlocksPerMultiprocessor(&per_cu, (const void*)fwd_kernel, NTHR, LDS_BYTES) != hipSuccess || per_cu < 1) {
            fprintf(stderr, "kernel_launch: occupancy query reports %d workgroups per CU\n", per_cu); }
        (void)hipGetLastError();
        grid = cus;
    }
    if (grid < 0) return;
    if (hipMemsetAsync((char*)d_ws + WS_CTL, 0, CTL_ZERO_BYTES, stream) != hipSuccess) { fprintf(stderr, "kernel_launch: memset failed\n"); return; }
    Args a{};
    for (int i = 0; i < 28; ++i) a.in[i] = (const float*)d_in[i];
    a.out = (float*)d_out; a.ws = (unsigned char*)d_ws;
#if MK_ONE_LAUNCH
    a.ph_lo = 0; a.ph_hi = N_PHASES;
    hipLaunchKernelGGL(fwd_kernel, dim3(grid), dim3(NTHR), LDS_BYTES, stream, a);
#else
    for (int p = 0; p < N_PHASES; ++p) { a.ph_lo = p; a.ph_hi = p + 1; hipLaunchKernelGGL(fwd_kernel, dim3(grid), dim3(NTHR), LDS_BYTES, stream, a); }
#endif
    const hipError_t le = hipPeekAtLastError();
    if (le != hipSuccess) fprintf(stderr, "kernel_launch: launch failed: %s\n", hipGetErrorName(le));
}
```

```cpp
#include <hip/hip_runtime.h>
#include <cstdio>
#include <cstdint>
namespace pg8 {
#define PG8_LAS __attribute__((address_space(3)))
typedef unsigned short bf16_t;
typedef short bf16x8 __attribute__((ext_vector_type(8)));
typedef float f32x4 __attribute__((ext_vector_type(4)));
typedef unsigned u32x4 __attribute__((ext_vector_type(4)));
constexpr int BM = 256, BK = 64, HALF = 128, HTB = HALF * BK * 2  , STAGE_BYTES = 8 * HTB, NXCD = 8, WGM = 8;

__host__ __device__ __forceinline__ int lds_byte(int r, int c) { const int st = (r >> 4) * 2 + (c >> 5), rr = r & 15, cc = c & 31, ob = rr * 64 + cc * 2; return st * 1024 + (ob ^ (((ob >> 9) & 1) << 5)); }
__host__ __device__ __forceinline__ void stage_rc(int b, int& R, int& C) { const int st = b / 1024, sb = b % 1024, swz = sb ^ (((sb >> 9) & 1) << 5); R = (st >> 1) * 16 + swz / 64; C = (st & 1) * 32 + (swz % 64) / 2; }
__host__ __device__ __forceinline__ int perm32(int rho) { const int n = rho >> 4, i = rho & 15; return 8 * (i >> 2) + 4 * n + (i & 3); }

struct Unit { int pm, pn; int koff; };
struct Gemm { const bf16_t* A; const bf16_t* Bt; int M, N, K; int lda, ldb; };

struct StaticOrder {
    int nM, nN, nwg, G, c;
    __host__ __device__ void init(int M, int N, int G_, int c_) { nM = M / BM; nN = N / BM; nwg = nM * nN; G = G_; c = c_; }
    __host__ __device__ bool next(int i, Unit& u) const {
        const long L = (long)i * G + c; if (L >= nwg) return false;
        int wgid = (int)L; { const int q = nwg / NXCD, r = nwg % NXCD, xcd = wgid % NXCD, off = wgid / NXCD; wgid = (xcd < r ? xcd * (q + 1) : r * (q + 1) + (xcd - r) * q) + off; }
        const int nig = WGM * nN, gid = wgid / nig, fm = gid * WGM, gsz = (nM - fm) < WGM ? (nM - fm) : WGM;
        u.pm = fm + ((wgid % nig) % gsz); u.pn = (wgid % nig) / gsz; u.koff = 0; return true;
    }
    __device__ __forceinline__ void a_ready(const Unit&) const {}
    __device__ __forceinline__ void done(const Unit&) const {}
};

__device__ __forceinline__ unsigned cvt_pk_bf16(float lo, float hi) { unsigned r; asm volatile("v_cvt_pk_bf16_f32 %0, %1, %2" : "=v"(r) : "v"(lo), "v"(hi)); return r; }
typedef float f32x2 __attribute__((ext_vector_type(2)));
__device__ __forceinline__ f32x2 gelu_pk(f32x2 v) {
    const f32x2 av = __builtin_elementwise_abs(v), d = av * 0.2316418882f + 1.0f;
    f32x2 t; t.x = __builtin_amdgcn_rcpf(d.x); t.y = __builtin_amdgcn_rcpf(d.y);
    f32x2 q = t * 0.5307027145f + (-0.7265760135f); q = q * t + 0.7107068705f; q = q * t + (-0.142248368f); q = q * t + 0.127414796f; q = q * t;
    const f32x2 s = (v * v) * (-0.72134752044f);
    f32x2 e; e.x = __builtin_amdgcn_exp2f(s.x); e.y = __builtin_amdgcn_exp2f(s.y);
    const f32x2 m = v * (q * e), r = v - m;
    f32x2 o; o.x = v.x < 0.f ? m.x : r.x; o.y = v.y < 0.f ? m.y : r.y; return o;
}


__device__ __forceinline__ float sigmoid_f(float x) { return __builtin_amdgcn_rcpf(1.0f + __builtin_amdgcn_exp2f(-1.44269504f * x)); }
__device__ __forceinline__ float silu_f(float x) { return x * sigmoid_f(x); }
__device__ __forceinline__ float gelu_tanh_f(float x) { const float u = x * (1.0f + 0.044715f * x * x); return x * __builtin_amdgcn_rcpf(1.0f + __builtin_amdgcn_exp2f(-2.30220820f * u)); }
__device__ __forceinline__ f32x2 gelu_tanh_pk(f32x2 x) {
    f32x2 xc; xc.x = __builtin_amdgcn_fmed3f(x.x, -3.6f, 3.6f); xc.y = __builtin_amdgcn_fmed3f(x.y, -3.6f, 3.6f);
    const f32x2 z = xc * 0.277777778f, z2 = z * z;
    f32x2 p = z2 * (-0.707277966f) + 3.50913538f;
    p = p * z2 + (-7.72999719f); p = p * z2 + 10.1716655f; p = p * z2 + (-9.14213848f); p = p * z2 + 6.07337743f; p = p * z2 + (-3.11094742f); p = p * z2 + 1.43606059f;
    return x * (p * z + 0.5f);
}
__device__ __forceinline__ int row_set(int pm) { return pm < 32 ? 0 : (pm < 64 ? 1 : 2); }

struct EpiPlainBf16 {
    static constexpr bool PERM = true, AFTER_DRAIN = false;
    bf16_t* O; int ldc;
    __device__ __forceinline__ void operator()(const f32x4 (&acc)[2][2][4][2], const Unit& u, int wr, int wc, int fr, int fq) const {
        const int row0 = u.pm * BM + wr * 64 + fr, col0 = u.pn * BM + wc * 32 + 8 * fq;
#pragma unroll
        for (int ai = 0; ai < 2; ++ai)
#pragma unroll
            for (int m = 0; m < 4; ++m) { bf16_t* rowp = O + (size_t)(row0 + ai * HALF + m * 16) * ldc + col0;
#pragma unroll
                for (int bj = 0; bj < 2; ++bj) { const f32x4 v0 = acc[ai][bj][m][0], v1 = acc[ai][bj][m][1];
                    u32x4 w; w.x = cvt_pk_bf16(v0[0], v0[1]); w.y = cvt_pk_bf16(v0[2], v0[3]); w.z = cvt_pk_bf16(v1[0], v1[1]); w.w = cvt_pk_bf16(v1[2], v1[3]);
                    *(u32x4*)(rowp + bj * HALF) = w; } }
    }
};
struct EpiG1 {
    static constexpr bool PERM = true, AFTER_DRAIN = false;
    bf16_t* U; bf16_t* V; float* vstat;
    __device__ __forceinline__ void operator()(const f32x4 (&acc)[2][2][4][2], const Unit& u, int wr, int wc, int fr, int fq) const {
        const bool isv = u.pn >= 16;
        const int row0 = u.pm * BM + wr * 64 + fr, col0 = (u.pn & 15) * BM + wc * 32 + 8 * fq;
        bf16_t* base = isv ? V : U;
#pragma unroll
        for (int ai = 0; ai < 2; ++ai)
#pragma unroll
            for (int m = 0; m < 4; ++m) { const int row = row0 + ai * HALF + m * 16; bf16_t* rowp = base + (size_t)row * 4096 + col0; float s = 0.f, ss = 0.f;
#pragma unroll
                for (int bj = 0; bj < 2; ++bj) { f32x4 v0 = acc[ai][bj][m][0], v1 = acc[ai][bj][m][1];
                    { const f32x2 a0 = gelu_tanh_pk((f32x2){v0[0], v0[1]}), a1 = gelu_tanh_pk((f32x2){v0[2], v0[3]}), a2 = gelu_tanh_pk((f32x2){v1[0], v1[1]}), a3 = gelu_tanh_pk((f32x2){v1[2], v1[3]});
                      v0 = (f32x4){a0.x, a0.y, a1.x, a1.y}; v1 = (f32x4){a2.x, a2.y, a3.x, a3.y}; }
                    if (isv) {
#pragma unroll
                        for (int e = 0; e < 4; ++e) { s += v0[e] + v1[e]; ss += v0[e] * v0[e] + v1[e] * v1[e]; } }
                    u32x4 w; w.x = cvt_pk_bf16(v0[0], v0[1]); w.y = cvt_pk_bf16(v0[2], v0[3]); w.z = cvt_pk_bf16(v1[0], v1[1]); w.w = cvt_pk_bf16(v1[2], v1[3]);
                    *(u32x4*)(rowp + bj * HALF) = w; }
                if (isv) { s += __shfl_xor(s, 16); s += __shfl_xor(s, 32); ss += __shfl_xor(ss, 16); ss += __shfl_xor(ss, 32);
                    if (fq == 0) { f32x2 o; o.x = s; o.y = ss; *(f32x2*)(vstat + ((size_t)row * 64 + (u.pn - 16) * 4 + wc) * 2) = o; } } }
    }
};
typedef _Float16 h16x8 __attribute__((ext_vector_type(8)));
struct EpiResid {
    static constexpr bool PERM = true, AFTER_DRAIN = false;
    _Float16* H; const float* gate; int dry;
    __device__ __forceinline__ void operator()(const f32x4 (&acc)[2][2][4][2], const Unit& u, int wr, int wc, int fr, int fq) const {
        if (dry) return;
        const int row0 = u.pm * BM + wr * 64 + fr, col0 = u.pn * BM + wc * 32 + 8 * fq;
        const float* g = gate + row_set(u.pm) * (6 * 2048) + col0;
        f32x4 gv[2][2];
#pragma unroll
        for (int bj = 0; bj < 2; ++bj)
#pragma unroll
            for (int n = 0; n < 2; ++n) gv[bj][n] = *(const f32x4*)(g + bj * HALF + n * 4);
#pragma unroll
        for (int ai = 0; ai < 2; ++ai)
#pragma unroll
            for (int m = 0; m < 4; ++m) { _Float16* rowp = H + (size_t)(row0 + ai * HALF + m * 16) * 2048 + col0;
#pragma unroll
                for (int bj = 0; bj < 2; ++bj) { h16x8* p = (h16x8*)(rowp + bj * HALF); h16x8 hv = *p;
#pragma unroll
                    for (int e = 0; e < 4; ++e) { hv[e] = (_Float16)((float)hv[e] + gv[bj][0][e] * acc[ai][bj][m][0][e]); hv[4 + e] = (_Float16)((float)hv[4 + e] + gv[bj][1][e] * acc[ai][bj][m][1][e]); }
                    *p = hv; } }
    }
};
struct EpiSwiGLU {
    static constexpr bool PERM = true, AFTER_DRAIN = false;
    bf16_t* O;
    __device__ __forceinline__ void operator()(const f32x4 (&acc)[2][2][4][2], const Unit& u, int wr, int wc, int fr, int fq) const {
        const int row0 = u.pm * BM + wr * 64 + fr, col0 = u.pn * HALF + wc * 32 + 8 * fq;
#pragma unroll
        for (int ai = 0; ai < 2; ++ai)
#pragma unroll
            for (int m = 0; m < 4; ++m) { bf16_t* rowp = O + (size_t)(row0 + ai * HALF + m * 16) * 5632 + col0;
                f32x4 a0 = acc[ai][0][m][0], a1 = acc[ai][0][m][1]; const f32x4 b0 = acc[ai][1][m][0], b1 = acc[ai][1][m][1];
#pragma unroll
                for (int e = 0; e < 4; ++e) { a0[e] = silu_f(a0[e]) * b0[e]; a1[e] = silu_f(a1[e]) * b1[e]; }
                u32x4 w; w.x = cvt_pk_bf16(a0[0], a0[1]); w.y = cvt_pk_bf16(a0[2], a0[3]); w.z = cvt_pk_bf16(a1[0], a1[1]); w.w = cvt_pk_bf16(a1[2], a1[3]);
                *(u32x4*)rowp = w; }
    }
};
struct EpiGluResid {
    static constexpr bool PERM = true, AFTER_DRAIN = false;
    _Float16* H; const float* gate; int dry;
    __device__ __forceinline__ void operator()(const f32x4 (&acc)[2][2][4][2], const Unit& u, int wr, int wc, int fr, int fq) const {
        if (dry) return;
        const int row0 = u.pm * BM + wr * 64 + fr, col0 = u.pn * HALF + wc * 32 + 8 * fq;
        const float* g = gate + row_set(u.pm) * (6 * 2048) + col0;
        f32x4 gv[2];
#pragma unroll
        for (int n = 0; n < 2; ++n) gv[n] = *(const f32x4*)(g + n * 4);
#pragma unroll
        for (int ai = 0; ai < 2; ++ai)
#pragma unroll
            for (int m = 0; m < 4; ++m) { h16x8* p = (h16x8*)(H + (size_t)(row0 + ai * HALF + m * 16) * 2048 + col0); h16x8 hv = *p;
#pragma unroll
                for (int n = 0; n < 2; ++n) { const f32x4 a = acc[ai][0][m][n], gg = acc[ai][1][m][n];
#pragma unroll
                    for (int e = 0; e < 4; ++e) hv[4 * n + e] = (_Float16)((float)hv[4 * n + e] + gv[n][e] * a[e] * sigmoid_f(gg[e])); }
                *p = hv; }
    }
};

struct GroupOrder {
    int G, c;
    __host__ __device__ void init(int G_, int c_) { G = G_; c = c_; }
    __host__ __device__ bool next(int i, Unit& u) const { const int L = i * G + c; if (L >= 512) return false; u.pm = L; u.pn = L >> 2; u.koff = 0; return true; }
    __device__ __forceinline__ void a_ready(const Unit&) const {}
    __device__ __forceinline__ void done(const Unit&) const {}
};
struct EpiS5In {
    static constexpr bool PERM = true, AFTER_DRAIN = false;
    bf16_t* XL; bf16_t* XC;
    __device__ __forceinline__ void operator()(const f32x4 (&acc)[2][2][4][2], const Unit& u, int wr, int wc, int fr, int fq) const {
        const int row0 = u.pm * BM + wr * 64 + fr;
#pragma unroll
        for (int ai = 0; ai < 2; ++ai)
#pragma unroll
            for (int m = 0; m < 4; ++m) { const int row = row0 + ai * HALF + m * 16;
#pragma unroll
                for (int bj = 0; bj < 2; ++bj) { const int col0 = u.pn * BM + bj * HALF + wc * 32 + 8 * fq, g = col0 >> 4, q0 = col0 & 15;
                    bf16_t* dst = row < 16384 ? XL + ((size_t)(g * 1024 + (row >> 4)) * 512 + 16 * (row & 15) + q0)
                                              : XC + ((size_t)(g * 32 + ((row - 16384) >> 4)) * 512 + 16 * (row & 15) + q0);
                    const f32x4 v0 = acc[ai][bj][m][0], v1 = acc[ai][bj][m][1];
                    u32x4 w; w.x = cvt_pk_bf16(v0[0], v0[1]); w.y = cvt_pk_bf16(v0[2], v0[3]); w.z = cvt_pk_bf16(v1[0], v1[1]); w.w = cvt_pk_bf16(v1[2], v1[3]);
                    *(u32x4*)dst = w; } }
    }
};
struct EpiS5State {
    static constexpr bool PERM = true, AFTER_DRAIN = false;
    bf16_t* SL;
    __device__ __forceinline__ void operator()(const f32x4 (&acc)[2][2][4][2], const Unit& u, int wr, int wc, int fr, int fq) const {
        const int row0 = u.pm * BM + wr * 64 + fr, col0 = wc * 32 + 8 * fq;
#pragma unroll
        for (int ai = 0; ai < 2; ++ai)
#pragma unroll
            for (int m = 0; m < 4; ++m) { bf16_t* rowp = SL + (size_t)(row0 + ai * HALF + m * 16) * 256 + col0;
#pragma unroll
                for (int bj = 0; bj < 2; ++bj) { const f32x4 v0 = acc[ai][bj][m][0], v1 = acc[ai][bj][m][1];
                    u32x4 w; w.x = cvt_pk_bf16(v0[0], v0[1]); w.y = cvt_pk_bf16(v0[2], v0[3]); w.z = cvt_pk_bf16(v1[0], v1[1]); w.w = cvt_pk_bf16(v1[2], v1[3]);
                    *(u32x4*)(rowp + bj * HALF) = w; } }
    }
};
struct EpiS5Out {
    static constexpr bool PERM = true, AFTER_DRAIN = false;
    bf16_t* Z;
    __device__ __forceinline__ void operator()(const f32x4 (&acc)[2][2][4][2], const Unit& u, int wr, int wc, int fr, int fq) const {
        const int c0 = (u.pm & 3) * BM + wr * 64 + fr, g = u.pn;
#pragma unroll
        for (int ai = 0; ai < 2; ++ai)
#pragma unroll
            for (int m = 0; m < 4; ++m) { const int c = c0 + ai * HALF + m * 16;
#pragma unroll
                for (int bj = 0; bj < 2; ++bj) { const int n0 = bj * HALF + wc * 32 + 8 * fq, t = n0 >> 4, q0 = n0 & 15;
                    f32x4 v0 = acc[ai][bj][m][0], v1 = acc[ai][bj][m][1];
#pragma unroll
                    for (int e = 0; e < 4; ++e) { v0[e] = gelu_tanh_f(v0[e]); v1[e] = gelu_tanh_f(v1[e]); }
                    u32x4 w; w.x = cvt_pk_bf16(v0[0], v0[1]); w.y = cvt_pk_bf16(v0[2], v0[3]); w.z = cvt_pk_bf16(v1[0], v1[1]); w.w = cvt_pk_bf16(v1[2], v1[3]);
                    *(u32x4*)(Z + (size_t)(16 * c + t) * 2048 + 16 * g + q0) = w; } }
    }
};

struct SliceOrder {
    int G, c, nsl, kbytes;
    __host__ __device__ void init(int G_, int c_, int nsl_, int kslice) { G = G_; c = c_; nsl = nsl_; kbytes = kslice * 2; }
    __host__ __device__ bool next(int i, Unit& u) const { const int L = i * G + c; if (L >= nsl * 16) return false; const int s = L >> 4, r = L & 15; u.pm = 64 + (r >> 3); u.pn = r & 7; u.koff = s * kbytes; return true; }
    __device__ __forceinline__ void a_ready(const Unit&) const {}
    __device__ __forceinline__ void done(const Unit&) const {}
};
struct EpiSlab {
    static constexpr bool PERM = false, AFTER_DRAIN = false;
    float* SLAB; int kbytes;
    __device__ __forceinline__ void operator()(const f32x4 (&acc)[2][2][4][2], const Unit& u, int wr, int wc, int fr, int fq) const {
        const int s = u.koff / kbytes, row0 = (u.pm - 64) * BM + wr * 64 + fr, col0 = u.pn * BM + wc * 32 + 4 * fq;
        float* base = SLAB + (size_t)s * 512 * 2048;
#pragma unroll
        for (int ai = 0; ai < 2; ++ai)
#pragma unroll
            for (int m = 0; m < 4; ++m) { float* rowp = base + (size_t)(row0 + ai * HALF + m * 16) * 2048 + col0;
#pragma unroll
                for (int bj = 0; bj < 2; ++bj)
#pragma unroll
                    for (int n = 0; n < 2; ++n) *(f32x4*)(rowp + bj * HALF + n * 16) = acc[ai][bj][m][n]; }
    }
};

template <class Epi, class Sched, bool ALIGN_EPI = false, bool SP2 = false>
__device__ __forceinline__ void gemm_phase(PG8_LAS unsigned char* lds, const Gemm g, const Sched& S, const Epi& E) {
    int tid_ = threadIdx.x; asm volatile("" : "+v"(tid_));
    const int tid = tid_, wid = __builtin_amdgcn_readfirstlane(tid >> 6), lane = tid & 63, wr = wid >> 2, wc = wid & 3, fr = lane & 15, fq = lane >> 4;
    const int K = g.K, nt = K / BK, lda = g.lda ? g.lda : K, ldb = g.ldb ? g.ldb : K;
    unsigned voffA[2], voffB[2];
#pragma unroll
    for (int i = 0; i < 2; ++i) { int R, C; stage_rc(tid * 16 + i * 8192, R, C); const int Rb = Epi::PERM ? ((R & ~31) + perm32(R & 31)) : R;
        voffA[i] = (unsigned)(R * lda + C) * 2u; voffB[i] = (unsigned)(Rb * ldb + C) * 2u; }
    const size_t kstep = (size_t)(BK * 2);
    const size_t hstepB = (size_t)HALF * ldb * 2, hstepA = (size_t)HALF * lda * 2;
    const size_t tstepB = 2 * hstepB, tstepA = 2 * hstepA;
    const unsigned ldsw = (unsigned)wid * 1024u;
    const int aoff = lds_byte(wr * 64 + fr, fq * 8), boff = lds_byte(wc * 32 + fr, fq * 8);
#define PG8_SA(b, h) (((b) * 2 + (h)) * HTB)
#define PG8_SB(b, h) ((4 + (b) * 2 + (h)) * HTB)
#define PG8_STAGE(bufoff, gbase, voff) do { _Pragma("unroll") for (int _i = 0; _i < 2; ++_i) \
        __builtin_amdgcn_global_load_lds((const unsigned*)((const char*)(gbase) + (voff)[_i]), (PG8_LAS unsigned*)(lds + (bufoff) + ldsw + _i * 8192), 16, 0, 0); } while (0)
#define PG8_LDA(dst, b, h) do { _Pragma("unroll") for (int m = 0; m < 4; ++m) _Pragma("unroll") for (int k = 0; k < 2; ++k) dst[m][k] = *(const PG8_LAS bf16x8*)(lds + PG8_SA(b, h) + aoff + m * 2048 + k * 1024); } while (0)
#define PG8_LDB(dst, b, h) do { _Pragma("unroll") for (int n = 0; n < 2; ++n) _Pragma("unroll") for (int k = 0; k < 2; ++k) dst[n][k] = *(const PG8_LAS bf16x8*)(lds + PG8_SB(b, h) + boff + n * 2048 + k * 1024); } while (0)
#define PG8_MMA(ai, bj, At, Bt) do { __builtin_amdgcn_s_setprio(1); _Pragma("unroll") for (int m = 0; m < 4; ++m) _Pragma("unroll") for (int n = 0; n < 2; ++n) _Pragma("unroll") for (int k = 0; k < 2; ++k) \
        acc[ai][bj][m][n] = __builtin_amdgcn_mfma_f32_16x16x32_bf16(Bt[n][k], At[m][k], acc[ai][bj][m][n], 0, 0, 0); __builtin_amdgcn_s_setprio(0); } while (0)
#define PG8_WAIT_V(n) asm volatile("s_waitcnt vmcnt(" #n ")" ::: "memory")
#define PG8_WAIT_L(n) asm volatile("s_waitcnt lgkmcnt(" #n ")" ::: "memory")
#define PG8_BAR __builtin_amdgcn_s_barrier()
#define PG8_SCHED __builtin_amdgcn_sched_barrier(0)
    Unit cur, nxt; int ui = 0;
    if (!S.next(0, cur)) return;
    f32x4 acc[2][2][4][2];
#pragma unroll
    for (int a = 0; a < 2; ++a)
#pragma unroll
        for (int b = 0; b < 2; ++b)
#pragma unroll
            for (int m = 0; m < 4; ++m)
#pragma unroll
                for (int n = 0; n < 2; ++n) acc[a][b][m][n] = (f32x4){0.f, 0.f, 0.f, 0.f};
    bf16x8 At[4][2], B0[2][2], B1[2][2];
    const char* cA = (const char*)g.A + (size_t)cur.pm * tstepA + cur.koff; const char* cB = (const char*)g.Bt + (size_t)cur.pn * tstepB + cur.koff;
    S.a_ready(cur);
    if constexpr (SP2) {
        PG8_STAGE(PG8_SB(0, 0), cB, voffB); PG8_STAGE(PG8_SB(0, 1), cB + hstepB, voffB); PG8_STAGE(PG8_SA(0, 0), cA, voffA); PG8_STAGE(PG8_SA(0, 1), cA + hstepA, voffA);
        if (wr == 1) PG8_BAR;
        PG8_WAIT_V(2); PG8_BAR;
        PG8_STAGE(PG8_SB(1, 0), cB + kstep, voffB); PG8_STAGE(PG8_SA(1, 0), cA + kstep, voffA); PG8_STAGE(PG8_SB(1, 1), cB + hstepB + kstep, voffB);
        PG8_WAIT_V(6); PG8_BAR;
    } else {
        PG8_STAGE(PG8_SB(0, 0), cB, voffB); PG8_STAGE(PG8_SA(0, 0), cA, voffA); PG8_STAGE(PG8_SB(0, 1), cB + hstepB, voffB); PG8_STAGE(PG8_SA(0, 1), cA + hstepA, voffA);
        if (wr == 1) PG8_BAR;
        PG8_WAIT_V(4); PG8_BAR;
        PG8_STAGE(PG8_SB(1, 0), cB + kstep, voffB); PG8_STAGE(PG8_SA(1, 0), cA + kstep, voffA); PG8_STAGE(PG8_SB(1, 1), cB + hstepB + kstep, voffB);
        PG8_WAIT_V(6); PG8_BAR;
    }
    for (;;) {
        const bool has_next = S.next(ui + 1, nxt);
        const char* nA = has_next ? (const char*)g.A + (size_t)nxt.pm * tstepA + nxt.koff : cA; const char* nB = has_next ? (const char*)g.Bt + (size_t)nxt.pn * tstepB + nxt.koff : cB;
#pragma unroll 1
        for (int t = 0; t < nt; t += 2) {
            const bool last = (t == nt - 2);
            const char* a1 = cA + (size_t)(t + 1) * kstep;
            const char* a2 = last ? nA : cA + (size_t)(t + 2) * kstep; const char* b2 = last ? nB : cB + (size_t)(t + 2) * kstep;
            const char* a3 = a2 + kstep; const char* b3 = b2 + kstep;
            if (last && has_next) S.a_ready(nxt);
            if constexpr (SP2) {
            PG8_LDB(B0, 0, 0); PG8_LDB(B1, 0, 1); PG8_SCHED; PG8_LDA(At, 0, 0); PG8_STAGE(PG8_SA(1, 1), a1 + hstepA, voffA);
            PG8_WAIT_V(8); PG8_WAIT_L(0); PG8_BAR; PG8_MMA(0, 0, At, B0); PG8_MMA(0, 1, At, B1); PG8_BAR; PG8_SCHED;
            PG8_LDA(At, 0, 1); PG8_STAGE(PG8_SB(0, 0), b2, voffB); PG8_STAGE(PG8_SB(0, 1), b2 + hstepB, voffB); PG8_STAGE(PG8_SA(0, 0), a2, voffA);
            PG8_WAIT_V(8); PG8_WAIT_L(0); PG8_BAR; PG8_MMA(1, 0, At, B0); PG8_MMA(1, 1, At, B1); PG8_BAR; PG8_SCHED;
            PG8_LDB(B0, 1, 0); PG8_LDB(B1, 1, 1); PG8_SCHED; PG8_LDA(At, 1, 0); PG8_STAGE(PG8_SA(0, 1), a2 + hstepA, voffA);
            PG8_WAIT_V(8); PG8_WAIT_L(0); PG8_BAR; PG8_MMA(0, 0, At, B0); PG8_MMA(0, 1, At, B1); PG8_BAR; PG8_SCHED;
            PG8_LDA(At, 1, 1); PG8_STAGE(PG8_SB(1, 0), b3, voffB); PG8_STAGE(PG8_SB(1, 1), b3 + hstepB, voffB); PG8_STAGE(PG8_SA(1, 0), a3, voffA);
            PG8_WAIT_V(8); PG8_WAIT_L(0); PG8_BAR; PG8_MMA(1, 0, At, B0); PG8_MMA(1, 1, At, B1); PG8_BAR; PG8_SCHED;
            } else {
            PG8_LDB(B0, 0, 0); PG8_SCHED; PG8_LDA(At, 0, 0); PG8_STAGE(PG8_SA(1, 1), a1 + hstepA, voffA);
            PG8_WAIT_L(8); PG8_BAR; PG8_WAIT_L(0); PG8_MMA(0, 0, At, B0); PG8_BAR; PG8_SCHED;
            PG8_LDB(B1, 0, 1); PG8_STAGE(PG8_SB(0, 0), b2, voffB);
            PG8_BAR; PG8_WAIT_L(0); PG8_MMA(0, 1, At, B1); PG8_BAR;
            PG8_LDA(At, 0, 1); PG8_STAGE(PG8_SA(0, 0), a2, voffA);
            PG8_BAR; PG8_WAIT_L(0); PG8_MMA(1, 0, At, B0); PG8_BAR; PG8_SCHED;
            PG8_STAGE(PG8_SB(0, 1), b2 + hstepB, voffB);
            PG8_WAIT_V(6); PG8_BAR; PG8_MMA(1, 1, At, B1); PG8_BAR;
            PG8_LDB(B0, 1, 0); PG8_SCHED; PG8_LDA(At, 1, 0); PG8_STAGE(PG8_SA(0, 1), a2 + hstepA, voffA);
            PG8_WAIT_L(8); PG8_BAR; PG8_WAIT_L(0); PG8_MMA(0, 0, At, B0); PG8_BAR; PG8_SCHED;
            PG8_LDB(B1, 1, 1); PG8_STAGE(PG8_SB(1, 0), b3, voffB);
            PG8_BAR; PG8_WAIT_L(0); PG8_MMA(0, 1, At, B1); PG8_BAR;
            PG8_LDA(At, 1, 1); PG8_STAGE(PG8_SA(1, 0), a3, voffA);
            PG8_BAR; PG8_WAIT_L(0); PG8_MMA(1, 0, At, B0); PG8_BAR; PG8_SCHED;
            PG8_STAGE(PG8_SB(1, 1), b3 + hstepB, voffB);
            PG8_WAIT_V(6); PG8_BAR; PG8_MMA(1, 1, At, B1); PG8_BAR;
            }
        }
        if constexpr (ALIGN_EPI) { if (wr == 0) PG8_BAR; }
        if constexpr (!Epi::AFTER_DRAIN) { E(acc, cur, wr, wc, fr, fq); S.done(cur); }
        if (!has_next) break;
#pragma unroll
        for (int a = 0; a < 2; ++a)
#pragma unroll
            for (int b = 0; b < 2; ++b)
#pragma unroll
                for (int m = 0; m < 4; ++m)
#pragma unroll
                    for (int n = 0; n < 2; ++n) acc[a][b][m][n] = (f32x4){0.f, 0.f, 0.f, 0.f};
        cur = nxt; cA = nA; cB = nB; ++ui;
        if constexpr (ALIGN_EPI) { if (wr == 1) PG8_BAR; }
    }
    PG8_WAIT_V(0);
    if constexpr (!ALIGN_EPI) { if (wr == 0) PG8_BAR; }
    PG8_BAR;
    if constexpr (Epi::AFTER_DRAIN) { E.fused(acc, cur, wr, wc, fr, fq, lds, wid, lane); S.done(cur); }
#undef PG8_SA
#undef PG8_SB
#undef PG8_STAGE
#undef PG8_LDA
#undef PG8_LDB
#undef PG8_MMA
#undef PG8_WAIT_V
#undef PG8_WAIT_L
#undef PG8_BAR
#undef PG8_SCHED
}
}

constexpr int NWAVES = 8, NTHR = NWAVES * 64;
constexpr int D = 2048, BATCH = 2, SEQ = 8192, ML = BATCH * SEQ, CTXL = 256, MC = BATCH * CTXL, M = ML + MC;
constexpr int FF = 5632, EA = 4096, NH = 16, HDIM = 256, CHUNK = 128, NCHUNK = M / CHUNK;
constexpr int SG = 128, SP = 64, SQ = 16;
constexpr int DEPTH = 4;
constexpr float EPS = 1e-6f;
static_assert(M % 256 == 0 && NCHUNK == 132, "row tiling");

constexpr size_t MiB = 1u << 20;
constexpr size_t WS_CTL = 0, CTL_ZERO_BYTES = 1 * MiB;
constexpr size_t WS_MOD = 1 * MiB;
constexpr size_t WS_S5A = 2 * MiB;
constexpr size_t WS_S5B = 3 * MiB;
constexpr size_t WS_WSB = 11 * MiB;
constexpr size_t WS_VSTAT = 12 * MiB;
constexpr size_t WS_WGIN = 32 * MiB;
constexpr size_t WS_WGOUT = 96 * MiB;
constexpr size_t WS_WF13 = 128 * MiB;
constexpr size_t WS_WF2 = 304 * MiB;
constexpr size_t WS_WSIN = 392 * MiB;
constexpr size_t WS_WGLU = 408 * MiB;
constexpr size_t WS_H = 440 * MiB;
constexpr size_t WS_XN = 572 * MiB;
constexpr size_t WS_BIG = 640 * MiB;
constexpr size_t WS_ZU = WS_BIG, WS_ZV = WS_BIG + 132 * MiB;
constexpr size_t WS_HID = WS_BIG;
constexpr size_t WS_SU = WS_BIG, WS_SZ = WS_BIG + 66 * MiB;
constexpr size_t WS_YF = WS_BIG + 132 * MiB, WS_YB = WS_BIG + 264 * MiB;
constexpr size_t WS_XL = WS_BIG, WS_XC = WS_BIG + 128 * MiB;
constexpr size_t WS_SL = WS_BIG + 132 * MiB, WS_SC = WS_BIG + 196 * MiB;
constexpr size_t WS_SZ2 = WS_BIG + 200 * MiB;
constexpr size_t WS_MOUTT = WS_BIG + 396 * MiB;
constexpr size_t WS_M2T = WS_MOUTT + 64 * MiB;
constexpr size_t WS_A16 = WS_M2T + 32 * MiB;
constexpr size_t WS_SLAB = WS_A16 + 1 * MiB;
constexpr size_t WS_END = WS_SLAB + 44 * MiB;
#ifndef S5_NAIVE
#define S5_NAIVE 0
#endif
constexpr size_t WS_Z = S5_NAIVE ? WS_SZ : WS_SZ2;
constexpr int CW_BAR = 4096;

constexpr int RING_OFF = 0, RING_BYTES = 131072;
constexpr int LDSCTL_OFF = RING_BYTES, MISC_OFF = LDSCTL_OFF + 320;
constexpr int LDS_BYTES = 147456;
static_assert(MISC_OFF + 128 <= LDS_BYTES, "LDS map");

#define GAS __attribute__((address_space(1)))
#define LAS __attribute__((address_space(3)))
typedef unsigned short bf16;
typedef unsigned v4u __attribute__((ext_vector_type(4)));
typedef unsigned v2u __attribute__((ext_vector_type(2)));
typedef float f32x4 __attribute__((ext_vector_type(4)));
typedef float f32x2 __attribute__((ext_vector_type(2)));
typedef float f32x16 __attribute__((ext_vector_type(16)));
typedef short bf16x8 __attribute__((ext_vector_type(8)));
typedef GAS unsigned gu32;
#define RLX_AGENT __ATOMIC_RELAXED, __HIP_MEMORY_SCOPE_AGENT
#define LDS_WAIT() asm volatile("s_waitcnt lgkmcnt(0)" ::: "memory")
__device__ __forceinline__ unsigned f2bf(float f) { unsigned u = __builtin_bit_cast(unsigned, f); return (u + 0x7fffu + ((u >> 16) & 1u)) >> 16; }
__device__ __forceinline__ unsigned pk2(float lo, float hi) { return f2bf(lo) | (f2bf(hi) << 16); }
__device__ __forceinline__ float bf2f(unsigned short b) { return __builtin_bit_cast(float, (unsigned)b << 16); }
__device__ __forceinline__ float wave_sum(float v) {
#pragma unroll
    for (int o = 1; o < 64; o <<= 1) v += __shfl_xor(v, o);
    return v;
}

#define XB_TMO      128
#define XB_XCNT(j)  (256  + 64 * (j))
#define XB_XSUB(j)  (1280 + 64 * (j))
#define XB_XGEN(j)  (2304 + 64 * (j))
#define XB_TOP      3328
#define XB_TOPGEN   3392
#define XCD_BAR_WORDS 3456
#define XB_SPIN_CAP (1u << 18)

__device__ __forceinline__ unsigned xb_ld(unsigned* p)              { return __hip_atomic_load(p, __ATOMIC_RELAXED, __HIP_MEMORY_SCOPE_AGENT); }
__device__ __forceinline__ unsigned xb_add(unsigned* p, unsigned v) { return __hip_atomic_fetch_add(p, v, __ATOMIC_RELAXED, __HIP_MEMORY_SCOPE_AGENT); }
__device__ __forceinline__ unsigned xb_xcc_id() { return (unsigned)__builtin_amdgcn_s_getreg((3 << 11) | 20) & 0xFu; }
#define XB_SPIN(cond, bar) do { unsigned _sp = 0; while (cond) { __builtin_amdgcn_s_sleep(1); \
    if ((++_sp & 255u) == 0u) { if (xb_ld(&(bar)[XB_TMO])) break; if (_sp > XB_SPIN_CAP) { atomicAdd(&(bar)[XB_TMO], 1u); break; } } } } while (0)

struct XcdBarrier {
    unsigned* bar; unsigned x;
    volatile LAS unsigned* st;
};

__device__ __forceinline__ XcdBarrier xcd_barrier_post(unsigned* bar, volatile LAS unsigned* st) {
    XcdBarrier b; b.bar = bar; b.x = xb_xcc_id(); b.st = st;
    if (threadIdx.x == 0) (void)xb_add(&bar[XB_XCNT(b.x)], 1u);
    return b;
}
__device__ __forceinline__ void xcd_barrier_complete(unsigned* bar, unsigned x, unsigned& nloc, unsigned& nx) {
    const unsigned G = gridDim.x * gridDim.y * gridDim.z;
    unsigned sum, cnt, mine, sp = 0u;
    for (;;) {
        sum = 0u; cnt = 0u; mine = 0u;
#pragma unroll
        for (unsigned j = 0; j < 16; ++j) { const unsigned c = xb_ld(&bar[XB_XCNT(j)]); sum += c; cnt += (c > 0u) ? 1u : 0u; mine = (j == x) ? c : mine; }
        if (sum == G) break;
        __builtin_amdgcn_s_sleep(1);
        if ((++sp & 255u) == 0u) { if (xb_ld(&bar[XB_TMO])) break; if (sp > XB_SPIN_CAP) { atomicAdd(&bar[XB_TMO], 1u); break; } }
    }
    nloc = mine > 0u ? mine : 1u; nx = cnt > 0u ? cnt : 1u;
}

__device__ __forceinline__ void xcd_barrier(const XcdBarrier& b) {
    asm volatile("s_waitcnt vmcnt(0)" ::: "memory");
    __syncthreads();
    if (threadIdx.x == 0) {
        unsigned* bar = b.bar;
        __builtin_amdgcn_s_waitcnt(0);
        unsigned nloc = b.st[0], nx = b.st[1];
        if (nloc == 0u) { xcd_barrier_complete(bar, b.x, nloc, nx); b.st[0] = nloc; b.st[1] = nx; }
        const unsigned old = xb_add(&bar[XB_XSUB(b.x)], 1u);
        const unsigned gen = old / nloc;
        if (old + 1u == (gen + 1u) * nloc) {
            __builtin_amdgcn_fence(__ATOMIC_RELEASE, "agent");
            asm volatile("s_waitcnt vmcnt(0)" ::: "memory");
            const unsigned og = xb_add(&bar[XB_TOP], 1u);
            const unsigned tg = og / nx;
            if (og + 1u == (tg + 1u) * nx) xb_add(&bar[XB_TOPGEN], 1u);
            else XB_SPIN(xb_ld(&bar[XB_TOPGEN]) == tg, bar);
            __builtin_amdgcn_fence(__ATOMIC_ACQUIRE, "agent");
            xb_add(&bar[XB_XGEN(b.x)], 1u);
            asm volatile("s_waitcnt vmcnt(0)" ::: "memory");
        } else {
            XB_SPIN(xb_ld(&bar[XB_XGEN(b.x)]) == gen, bar);
            __builtin_amdgcn_fence(__ATOMIC_ACQUIRE, "agent");
            asm volatile("s_waitcnt vmcnt(0)" ::: "memory");
        }
    }
    __syncthreads();
}

struct Args { const float* in[28]; float* out; unsigned char* ws; int ph_lo, ph_hi; };
enum InIdx { I_X = 0, I_C, I_CTX, I_CCTX, I_ADAW, I_ADAB, I_N1G, I_N2G, I_W1, I_W3, I_W2, I_GWIN, I_GLNG, I_GLNB, I_GWS, I_GBS, I_GWOUT,
             I_SWIN, I_SARE, I_SAIM, I_SLDT, I_SBRE, I_SBIM, I_SCRE, I_SCIM, I_SD, I_SWGLU, I_FING };

__device__ __forceinline__ int opaque_tid() { int t = threadIdx.x; asm volatile("" : "+v"(t)); return t; }
#define PHASE_IDS const int tid = opaque_tid(), lane = tid & 63, wave = __builtin_amdgcn_readfirstlane(tid >> 6); (void)tid; (void)lane; (void)wave

__device__ __forceinline__ void adaln_items(const Args& a, LAS unsigned char* lds, int wg, int nwg) {
    PHASE_IDS;
    LAS float* cs = (LAS float*)lds;
    LAS float* red = cs + 3 * 2048;
    const float* c = a.in[I_C]; const float* cc = a.in[I_CCTX];
    for (int i = tid; i < 3 * 2048; i += NTHR) { const int s = i >> 11, k = i & 2047; const float v = s < 2 ? c[s * 2048 + k] : cc[k]; cs[i] = v / (1.0f + expf(-v)); }
    __syncthreads();
    float* MOD = (float*)(a.ws + WS_MOD);
    const int cq = tid & 15, kg = tid >> 4;
    for (int item = wg; item < DEPTH * 192; item += nwg) {
        const int layer = item / 192, n0 = (item % 192) * 64;
        const float* W = a.in[I_ADAW] + (size_t)layer * 2048 * 12288 + n0 + 4 * cq;
        f32x4 a0 = {0.f, 0.f, 0.f, 0.f}, a1 = a0, a2 = a0;
#pragma unroll 8
        for (int k = kg; k < 2048; k += 32) { const f32x4 w = *(const GAS f32x4*)(W + (size_t)k * 12288); a0 += cs[k] * w; a1 += cs[2048 + k] * w; a2 += cs[4096 + k] * w; }
#pragma unroll
        for (int e = 0; e < 4; ++e) { red[(kg * 3 + 0) * 64 + 4 * cq + e] = a0[e]; red[(kg * 3 + 1) * 64 + 4 * cq + e] = a1[e]; red[(kg * 3 + 2) * 64 + 4 * cq + e] = a2[e]; }
        __syncthreads();
        if (tid < 192) { const int s = tid >> 6, col = tid & 63; float t = 0.f;
            for (int g = 0; g < 32; ++g) t += red[(g * 3 + s) * 64 + col];
            MOD[(size_t)(layer * 3 + s) * 12288 + n0 + col] = t + a.in[I_ADAB][layer * 12288 + n0 + col]; }
        __syncthreads();
    }
}
__device__ __forceinline__ void tr_item(const float* W, int ld, int K, int ncols, bf16* WT, int mode, LAS float* scr, int item, int lane) {
    const int nblk = ncols / 32, kb = item / nblk, nb = item % nblk, k0 = 64 * kb, n0 = 32 * nb;
    const int drow0 = mode == 0 ? n0 : (256 * (n0 >> 7) + (n0 & 127) + (mode == 2 ? 128 : 0));
#pragma unroll 8
    for (int i = 0; i < 32; ++i) { const int kk = 2 * i + (lane >> 5); scr[kk * 33 + (lane & 31)] = W[(size_t)(k0 + kk) * ld + n0 + (lane & 31)]; }
    LDS_WAIT(); asm volatile("" ::: "memory");
    const int c = lane & 7;
#pragma unroll
    for (int j = 0; j < 4; ++j) { const int n = (lane >> 3) + 8 * j; const LAS float* s = scr + (8 * c) * 33 + n;
        v4u o; o.x = pk2(s[0 * 33], s[1 * 33]); o.y = pk2(s[2 * 33], s[3 * 33]); o.z = pk2(s[4 * 33], s[5 * 33]); o.w = pk2(s[6 * 33], s[7 * 33]);
        *(GAS v4u*)(WT + (size_t)(drow0 + n) * K + k0 + 8 * c) = o; }
    LDS_WAIT(); asm volatile("" ::: "memory");
}
constexpr int TR_GIN = 2 * 8192, TR_GOUT = 2 * 4096, TR_FFN = 4 * 3 * 5632, TR_SIN = 2 * 2048, TR_GLU = 2 * 2 * 2048, TR_TOTAL = TR_GIN + TR_GOUT + TR_FFN + TR_SIN + TR_GLU;
__device__ __forceinline__ void transpose_items(const Args& a, LAS unsigned char* lds, int vcu, int G) {
    PHASE_IDS; const int gw = vcu * NWAVES + wave, ngw = G * NWAVES;
    LAS float* scr = (LAS float*)(lds + wave * 16384);
    unsigned char* ws = a.ws;
    for (int it0 = gw; it0 < TR_TOTAL; it0 += ngw) {
        int it = it0;
        if (it < TR_GIN) { const int j = it / 8192, r = it % 8192; tr_item(a.in[I_GWIN] + (size_t)j * 2048 * 8192, 8192, 2048, 8192, (bf16*)(ws + WS_WGIN) + (size_t)j * 8192 * 2048, 0, scr, r, lane); continue; } it -= TR_GIN;
        if (it < TR_GOUT) { const int j = it / 4096, r = it % 4096; tr_item(a.in[I_GWOUT] + (size_t)j * 4096 * 2048, 2048, 4096, 2048, (bf16*)(ws + WS_WGOUT) + (size_t)j * 2048 * 4096, 0, scr, r, lane); continue; } it -= TR_GOUT;
        if (it < TR_FFN) { const int i = it / 16896, r = it % 16896, which = r / 5632, rr = r % 5632;
            if (which == 0) tr_item(a.in[I_W1] + (size_t)i * 2048 * 5632, 5632, 2048, 5632, (bf16*)(ws + WS_WF13) + (size_t)i * 11264 * 2048, 1, scr, rr, lane);
            else if (which == 1) tr_item(a.in[I_W3] + (size_t)i * 2048 * 5632, 5632, 2048, 5632, (bf16*)(ws + WS_WF13) + (size_t)i * 11264 * 2048, 2, scr, rr, lane);
            else tr_item(a.in[I_W2] + (size_t)i * 5632 * 2048, 2048, 5632, 2048, (bf16*)(ws + WS_WF2) + (size_t)i * 2048 * 5632, 0, scr, rr, lane);
            continue; } it -= TR_FFN;
        if (it < TR_SIN) { const int j = it / 2048, r = it % 2048; tr_item(a.in[I_SWIN] + (size_t)j * 2048 * 2048, 2048, 2048, 2048, (bf16*)(ws + WS_WSIN) + (size_t)j * 2048 * 2048, 0, scr, r, lane); continue; } it -= TR_SIN;
        { const int j = it / 4096, r = it % 4096, half = r / 2048, rr = r % 2048;
          tr_item(a.in[I_SWGLU] + (size_t)j * 2048 * 4096 + half * 2048, 4096, 2048, 2048, (bf16*)(ws + WS_WGLU) + (size_t)j * 4096 * 2048, 1 + half, scr, rr, lane); }
    }
}
__device__ __forceinline__ void small_prologue(const Args& a, int vcu, int G) {
    PHASE_IDS; const int gtid = vcu * NTHR + tid, ngt = G * NTHR;
    bf16* WSB = (bf16*)(a.ws + WS_WSB);
    for (int i = gtid; i < 2 * 16 * 128 * 128; i += ngt) WSB[i] = (bf16)f2bf(a.in[I_GWS][i]);
    f32x2* S5A = (f32x2*)(a.ws + WS_S5A); f32x2* S5B = (f32x2*)(a.ws + WS_S5B);
    for (int i = gtid; i < 2 * 2 * SG * SP; i += ngt) {
        const int lg = i / SP;
        const float dt = expf(a.in[I_SLDT][lg]), are = a.in[I_SARE][i], aim = a.in[I_SAIM][i];
        const float e = expf(dt * are), th = dt * aim, abr = e * cosf(th), abi = e * sinf(th);
        f32x2 ab; ab.x = abr; ab.y = abi; S5A[i] = ab;
        const float nr = abr - 1.0f, ni = abi, den = 1.0f / (are * are + aim * aim);
        const float cr = (nr * are + ni * aim) * den, ci = (ni * are - nr * aim) * den;
        for (int q = 0; q < SQ; ++q) { const float br = a.in[I_SBRE][(size_t)i * SQ + q], bi = a.in[I_SBIM][(size_t)i * SQ + q];
            f32x2 o; o.x = cr * br - ci * bi; o.y = cr * bi + ci * br; S5B[(size_t)i * SQ + q] = o; }
    }
}

typedef _Float16 h16x8 __attribute__((ext_vector_type(8)));
template <bool INIT> __device__ __forceinline__ void norm_phase(const Args& a, const float* gain, const float* modl  , int which, int vcu, int G, int nslab = 0, const float* sgate = nullptr, int mrows = M) {
    PHASE_IDS; const int gw = vcu * NWAVES + wave, ngw = G * NWAVES;
    _Float16* H = (_Float16*)(a.ws + WS_H); bf16* XN = (bf16*)(a.ws + WS_XN);
    for (int row = gw; row < mrows; row += ngw) {
        const int set = row < ML ? (row >> 13) : 2;
        GAS h16x8* hr = (GAS h16x8*)(H + (size_t)row * D) + lane;
        float v[4][8];
        if (INIT) {
            const float* src = row < ML ? a.in[I_X] + (size_t)row * D : a.in[I_CTX] + (size_t)(row - ML) * D;
            const GAS f32x4* xr = (const GAS f32x4*)src + 2 * lane;
#pragma unroll
            for (int j = 0; j < 4; ++j) { const f32x4 x0 = xr[128 * j], x1 = xr[128 * j + 1];
#pragma unroll
                for (int e = 0; e < 4; ++e) { v[j][e] = x0[e]; v[j][4 + e] = x1[e]; } }
            if (row < ML) {
                const int t = row & (SEQ - 1); const float pr = (float)(t >> 6), pc = (float)(t & 63);
#pragma unroll
                for (int e = 0; e < 8; ++e) { const float om = exp2f(-(float)(8 * lane + e) * (13.287712379549449f / 512.0f)); const float ar = pr * om, ac = pc * om;
                    v[0][e] += sinf(ar); v[1][e] += cosf(ar); v[2][e] += sinf(ac); v[3][e] += cosf(ac); }
            }
        } else {
#pragma unroll
            for (int j = 0; j < 4; ++j) { const h16x8 hv = hr[64 * j];
#pragma unroll
                for (int e = 0; e < 8; ++e) v[j][e] = (float)hv[e]; }
            if (nslab > 0 && row >= ML) {
                const GAS f32x4* sp = (const GAS f32x4*)((const float*)(a.ws + WS_SLAB) + (size_t)(row - ML) * D) + 2 * lane; const GAS f32x4* gp2 = (const GAS f32x4*)sgate + 2 * lane;
                f32x4 t[4][2];
#pragma unroll
                for (int j = 0; j < 4; ++j) { t[j][0] = sp[128 * j]; t[j][1] = sp[128 * j + 1]; }
                for (int s = 1; s < nslab; ++s) {
#pragma unroll
                    for (int j = 0; j < 4; ++j) { t[j][0] += sp[(size_t)s * (512 * D / 4) + 128 * j]; t[j][1] += sp[(size_t)s * (512 * D / 4) + 128 * j + 1]; } }
#pragma unroll
                for (int j = 0; j < 4; ++j) { const f32x4 g0 = gp2[128 * j], g1 = gp2[128 * j + 1];
#pragma unroll
                    for (int e = 0; e < 4; ++e) { v[j][e] += g0[e] * t[j][0][e]; v[j][4 + e] += g1[e] * t[j][1][e]; } }
            }
        }
        if (INIT || (nslab > 0 && row >= ML)) {
#pragma unroll
            for (int j = 0; j < 4; ++j) { h16x8 hv;
#pragma unroll
                for (int e = 0; e < 8; ++e) { hv[e] = (_Float16)v[j][e]; v[j][e] = (float)hv[e]; }
                hr[64 * j] = hv; }
        }
        float ss = 0.f;
#pragma unroll
        for (int j = 0; j < 4; ++j)
#pragma unroll
            for (int e = 0; e < 8; ++e) ss += v[j][e] * v[j][e];
        const float rinv = 1.0f / sqrtf(wave_sum(ss) * (1.0f / D) + EPS);
        const GAS f32x4* gp = (const GAS f32x4*)gain + 2 * lane;
        const GAS f32x4* shp = (const GAS f32x4*)(modl + (size_t)set * 12288 + (which * 3 + 0) * D) + 2 * lane;
        const GAS f32x4* scp = (const GAS f32x4*)(modl + (size_t)set * 12288 + (which * 3 + 1) * D) + 2 * lane;
        GAS v4u* o16 = (GAS v4u*)(XN + (size_t)row * D) + lane;
#pragma unroll
        for (int j = 0; j < 4; ++j) { float y[8];
#pragma unroll
            for (int hlf = 0; hlf < 2; ++hlf) { const f32x4 g = gp[128 * j + hlf], sh = shp[128 * j + hlf], sc = scp[128 * j + hlf];
#pragma unroll
                for (int e = 0; e < 4; ++e) y[4 * hlf + e] = v[j][4 * hlf + e] * rinv * g[e] * (1.0f + sc[e]) + sh[e]; }
            v4u o; o.x = pk2(y[0], y[1]); o.y = pk2(y[2], y[3]); o.z = pk2(y[4], y[5]); o.w = pk2(y[6], y[7]); o16[64 * j] = o; }
    }
}
__device__ __forceinline__ void final_phase(const Args& a, int vcu, int G) {
    PHASE_IDS; const int gw = vcu * NWAVES + wave, ngw = G * NWAVES;
    const _Float16* H = (const _Float16*)(a.ws + WS_H);
    for (int row = gw; row < ML; row += ngw) {
        const GAS h16x8* hr = (const GAS h16x8*)(H + (size_t)row * D) + lane;
        float v[4][8]; float ss = 0.f;
#pragma unroll
        for (int j = 0; j < 4; ++j) { const h16x8 hv = hr[64 * j];
#pragma unroll
            for (int e = 0; e < 8; ++e) { v[j][e] = (float)hv[e]; ss += v[j][e] * v[j][e]; } }
        const float rinv = 1.0f / sqrtf(wave_sum(ss) * (1.0f / D) + EPS);
        const GAS f32x4* gp = (const GAS f32x4*)a.in[I_FING] + 2 * lane;
        GAS f32x4* o = (GAS f32x4*)(a.out + (size_t)row * D) + 2 * lane;
#pragma unroll
        for (int j = 0; j < 4; ++j)
#pragma unroll
            for (int hlf = 0; hlf < 2; ++hlf) { const f32x4 g = gp[128 * j + hlf]; f32x4 r;
#pragma unroll
                for (int e = 0; e < 4; ++e) r[e] = v[j][4 * hlf + e] * rinv * g[e];
                o[128 * j + hlf] = r; }
    }
}

__device__ __forceinline__ void sgu_phase(const Args& a, int gl  , LAS unsigned char* lds, int wg, int nwg, int dry) {
    PHASE_IDS;
    bf16* ZU = (bf16*)(a.ws + WS_ZU); const bf16* ZV = (const bf16*)(a.ws + WS_ZV); const float* VSTAT = (const float*)(a.ws + WS_VSTAT);
    const bf16* WSB = (const bf16*)(a.ws + WS_WSB) + (size_t)gl * 16 * 128 * 128;
    const float* bs = a.in[I_GBS] + gl * 16 * 128; const float* lng = a.in[I_GLNG] + gl * EA; const float* lnb = a.in[I_GLNB] + gl * EA;
    LAS f32x2* st = (LAS f32x2*)lds;
    const int n = lane & 31, h = lane >> 5;
    for (int unit = wg; unit < NCHUNK * NH; unit += nwg) {
        const int c = unit / NH, hd = unit % NH, r0 = c * CHUNK;
        { const int j = tid >> 2, part = tid & 3; const GAS f32x4* p = (const GAS f32x4*)(VSTAT + ((size_t)(r0 + j) * 64 + part * 16) * 2);
          float s = 0.f, ss = 0.f;
#pragma unroll
          for (int q = 0; q < 8; ++q) { const f32x4 w = p[q]; s += w.x + w.z; ss += w.y + w.w; }
          s += __shfl_xor(s, 1); s += __shfl_xor(s, 2); ss += __shfl_xor(ss, 1); ss += __shfl_xor(ss, 2);
          if (part == 0) { const float mean = s * (1.0f / EA), var = ss * (1.0f / EA) - mean * mean; f32x2 o; o.x = mean; o.y = 1.0f / sqrtf(var + EPS); st[j] = o; } }
        __syncthreads();
        const int gcol = hd * HDIM + 32 * wave + n;
        const float lg = lng[gcol], lb = lnb[gcol];
        const GAS bf16* vp = (const GAS bf16*)ZV + (size_t)r0 * EA + gcol;
        unsigned short raw[8][8];
#pragma unroll
        for (int ks = 0; ks < 8; ++ks)
#pragma unroll
            for (int e = 0; e < 8; ++e) raw[ks][e] = vp[(size_t)(16 * ks + 8 * h + e) * EA];
        bf16x8 Bf[8];
#pragma unroll
        for (int ks = 0; ks < 8; ++ks) { float f[8];
#pragma unroll
            for (int e = 0; e < 8; ++e) { const f32x2 m = st[16 * ks + 8 * h + e]; f[e] = (bf2f(raw[ks][e]) - m.x) * m.y * lg + lb; }
            v4u w; w.x = pk2(f[0], f[1]); w.y = pk2(f[2], f[3]); w.z = pk2(f[4], f[5]); w.w = pk2(f[6], f[7]); Bf[ks] = __builtin_bit_cast(bf16x8, w); }
#pragma unroll 1
        for (int ib = 0; ib < 4; ++ib) {
            f32x16 acc;
#pragma unroll
            for (int r = 0; r < 16; ++r) acc[r] = 0.f;
            const GAS bf16x8* ap = (const GAS bf16x8*)(WSB + ((size_t)hd * 128 + 32 * ib + n) * 128 + 8 * h);
#pragma unroll
            for (int ks = 0; ks < 8; ++ks) { const bf16x8 Af = ap[2 * ks]; acc = __builtin_amdgcn_mfma_f32_32x32x16_bf16(Af, Bf[ks], acc, 0, 0, 0); }
#pragma unroll
            for (int r = 0; r < 16; ++r) { const int i = 32 * ib + (r & 3) + 8 * (r >> 2) + 4 * h; const float s = acc[r] + bs[hd * 128 + i];
                GAS bf16* up = (GAS bf16*)ZU + (size_t)(r0 + i) * EA + gcol; const bf16 nv = (bf16)f2bf(bf2f(*up) * s); if (!dry) *up = nv; }
        }
        __syncthreads();
    }
}

__device__ __forceinline__ void s5_naive_phase(const Args& a, int sl  , int wg, int nwg) {
    PHASE_IDS;
    if (wave >= 2) return;
    const bf16* U = (const bf16*)(a.ws + WS_SU);
    for (int item = wg * 2 + wave; item < 2 * 2 * SG; item += nwg * 2) {
        const int b = item & 1, k = (item >> 1) & 1, g = item >> 2;
        const int pg = ((sl * 2 + k) * SG + g);
        const f32x2 ab = ((const f32x2*)(a.ws + WS_S5A))[(size_t)pg * SP + lane];
        float bre[16], bim[16], cr[16], ci[16];
#pragma unroll
        for (int q = 0; q < 16; ++q) { const f32x2 bb = ((const f32x2*)(a.ws + WS_S5B))[((size_t)pg * SP + lane) * SQ + q]; bre[q] = bb.x; bim[q] = bb.y;
            cr[q] = a.in[I_SCRE][((size_t)pg * SQ + q) * SP + lane]; ci[q] = a.in[I_SCIM][((size_t)pg * SQ + q) * SP + lane]; }
        float* Y = (float*)(a.ws + (k ? WS_YB : WS_YF));
        float hr = 0.f, hi = 0.f;
#pragma unroll 1
        for (int seg = 0; seg < 2; ++seg) {
            const int L = seg ? SEQ : CTXL, base = seg ? b * SEQ : ML + b * CTXL;
#pragma unroll 1
            for (int blk = 0; blk < L; blk += 64) {
                const int myt = k ? (L - 1 - (blk + lane)) : (blk + lane);
                const size_t row = (size_t)(base + myt);
                const GAS v4u* up = (const GAS v4u*)(U + row * D + 16 * g);
                const v4u u0 = up[0], u1 = up[1];
                float keep[16];
#pragma unroll
                for (int q = 0; q < 16; ++q) keep[q] = 0.f;
#pragma unroll 1
                for (int s = 0; s < 64; ++s) {
                    unsigned w[8];
                    w[0] = __builtin_amdgcn_readlane(u0.x, s); w[1] = __builtin_amdgcn_readlane(u0.y, s); w[2] = __builtin_amdgcn_readlane(u0.z, s); w[3] = __builtin_amdgcn_readlane(u0.w, s);
                    w[4] = __builtin_amdgcn_readlane(u1.x, s); w[5] = __builtin_amdgcn_readlane(u1.y, s); w[6] = __builtin_amdgcn_readlane(u1.z, s); w[7] = __builtin_amdgcn_readlane(u1.w, s);
                    float br = 0.f, bi = 0.f;
#pragma unroll
                    for (int q2 = 0; q2 < 8; ++q2) { const float ulo = __builtin_bit_cast(float, w[q2] << 16), uhi = __builtin_bit_cast(float, w[q2] & 0xffff0000u);
                        br += bre[2 * q2] * ulo + bre[2 * q2 + 1] * uhi; bi += bim[2 * q2] * ulo + bim[2 * q2 + 1] * uhi; }
                    const float nhr = ab.x * hr - ab.y * hi + br, nhi = ab.x * hi + ab.y * hr + bi; hr = nhr; hi = nhi;
#pragma unroll
                    for (int q = 0; q < 16; ++q) { const float y = wave_sum(cr[q] * hr - ci[q] * hi); keep[q] = (lane == s) ? y : keep[q]; }
                }
                GAS f32x4* yp = (GAS f32x4*)(Y + row * D + 16 * g);
#pragma unroll
                for (int q4 = 0; q4 < 4; ++q4) { f32x4 o; o.x = keep[4 * q4]; o.y = keep[4 * q4 + 1]; o.z = keep[4 * q4 + 2]; o.w = keep[4 * q4 + 3]; yp[q4] = o; }
            }
        }
    }
}
__device__ __forceinline__ void s5_combine_phase(const Args& a, int sl, int vcu, int G) {
    PHASE_IDS; const int gw = vcu * NWAVES + wave, ngw = G * NWAVES;
    const float* YF = (const float*)(a.ws + WS_YF); const float* YB = (const float*)(a.ws + WS_YB); const bf16* U = (const bf16*)(a.ws + WS_SU); bf16* Z = (bf16*)(a.ws + WS_SZ);
    const GAS f32x4* dp = (const GAS f32x4*)(a.in[I_SD] + sl * D) + lane;
    for (int row = gw; row < M; row += ngw) {
        const GAS f32x4* yf = (const GAS f32x4*)(YF + (size_t)row * D) + lane; const GAS f32x4* yb = (const GAS f32x4*)(YB + (size_t)row * D) + lane;
        const GAS v2u* up = (const GAS v2u*)(U + (size_t)row * D) + lane; GAS v2u* zp = (GAS v2u*)(Z + (size_t)row * D) + lane;
#pragma unroll
        for (int j = 0; j < 8; ++j) { const f32x4 f = yf[64 * j], bk = yb[64 * j], dd = dp[64 * j]; const v2u uu = up[64 * j];
            f32x4 u4; u4.x = __builtin_bit_cast(float, uu.x << 16); u4.y = __builtin_bit_cast(float, uu.x & 0xffff0000u); u4.z = __builtin_bit_cast(float, uu.y << 16); u4.w = __builtin_bit_cast(float, uu.y & 0xffff0000u);
            const f32x4 y = f + bk + u4 * dd;
            v2u o; o.x = pk2(pg8::gelu_tanh_f(y.x), pg8::gelu_tanh_f(y.y)); o.y = pk2(pg8::gelu_tanh_f(y.z), pg8::gelu_tanh_f(y.w)); zp[64 * j] = o; }
    }
}

__device__ __forceinline__ f32x2 cmul(f32x2 a, f32x2 b) { f32x2 r; r.x = a.x * b.x - a.y * b.y; r.y = a.x * b.y + a.y * b.x; return r; }
__device__ __forceinline__ void s5_precompute(const Args& a, LAS unsigned char* lds, int wg, int nwg) {
    PHASE_IDS;
    LAS f32x2* apw = (LAS f32x2*)lds;
    LAS f32x2* bbl = apw + 2 * 17 * 64;
    LAS f32x2* ccl = bbl + 2 * 64 * 16;
    LAS float* ktab = (LAS float*)(ccl + 2 * 16 * 64);
    for (int item = wg; item < 2 * SG; item += nwg) {
        const int sl = item >> 7, g = item & 127;
        if (tid < 128) { const int d = tid >> 6, p = tid & 63, pg = (sl * 2 + d) * SG + g, i = pg * SP + p;
            const float dt = expf(a.in[I_SLDT][pg]), are = a.in[I_SARE][i], aim = a.in[I_SAIM][i];
            for (int l = 0; l <= 16; ++l) { const float e = expf((float)l * (dt * are)), th = (float)l * (dt * aim); f32x2 o; o.x = e * cosf(th); o.y = e * sinf(th); apw[(d * 17 + l) * 64 + p] = o; }
            const f32x2 ab = apw[(d * 17 + 1) * 64 + p];
            const float nr = ab.x - 1.0f, ni = ab.y, den = 1.0f / (are * are + aim * aim);
            f32x2 coef; coef.x = (nr * are + ni * aim) * den; coef.y = (ni * are - nr * aim) * den;
            for (int q = 0; q < SQ; ++q) { f32x2 bq; bq.x = a.in[I_SBRE][(size_t)i * SQ + q]; bq.y = a.in[I_SBIM][(size_t)i * SQ + q]; bbl[(d * 64 + p) * 16 + q] = cmul(coef, bq); }
            ((f32x2*)(a.ws + WS_A16))[i] = apw[(d * 17 + 16) * 64 + p]; }
        for (int e = tid; e < 2 * 16 * 64; e += NTHR) { const int d = e >> 10, q = (e >> 6) & 15, p = e & 63; const size_t ci = ((size_t)((sl * 2 + d) * SG + g) * SQ + q) * SP + p;
            f32x2 o; o.x = a.in[I_SCRE][ci]; o.y = a.in[I_SCIM][ci]; ccl[e] = o; }
        __syncthreads();
        for (int o = tid; o < 8192; o += NTHR) { const int d = o >> 12, l = (o >> 8) & 15, q = (o >> 4) & 15, qp = o & 15; float acc = 0.f;
            for (int p = 0; p < 64; ++p) { const f32x2 ca = cmul(ccl[(d * 16 + q) * 64 + p], apw[(d * 17 + l) * 64 + p]), bb = bbl[(d * 64 + p) * 16 + qp]; acc += ca.x * bb.x - ca.y * bb.y; }
            ktab[o] = acc; }
        __syncthreads();
        bf16* MoutT = (bf16*)(a.ws + WS_MOUTT) + (size_t)(sl * SG + g) * 256 * 512;
        bf16* M2T = (bf16*)(a.ws + WS_M2T) + (size_t)(sl * SG + g) * 256 * 256;
        for (int ch = tid; ch < 256 * 64; ch += NTHR) { const int n = ch >> 6, jj = ch & 63, t = n >> 4, q = n & 15; float v[8];
            if (jj < 32) { const int s = jj >> 1, q0 = 8 * (jj & 1);
#pragma unroll
                for (int e = 0; e < 8; ++e) { const int qp = q0 + e;
                    v[e] = s < t ? ktab[((0 * 16 + (t - s)) * 16 + q) * 16 + qp] : (s > t ? ktab[((1 * 16 + (s - t)) * 16 + q) * 16 + qp]
                         : ktab[(0 * 16 * 16 + q) * 16 + qp] + ktab[((16) * 16 + q) * 16 + qp] + (q == qp ? a.in[I_SD][sl * D + 16 * g + q] : 0.f)); }
            } else { const int j2 = jj - 32, d = j2 >> 4, p0 = (j2 & 15) * 4, ex = d == 0 ? t + 1 : 16 - t;
#pragma unroll
                for (int pp = 0; pp < 4; ++pp) { const f32x2 ca = cmul(ccl[(d * 16 + q) * 64 + p0 + pp], apw[(d * 17 + ex) * 64 + p0 + pp]); v[2 * pp] = ca.x; v[2 * pp + 1] = -ca.y; } }
            v4u w; w.x = pk2(v[0], v[1]); w.y = pk2(v[2], v[3]); w.z = pk2(v[4], v[5]); w.w = pk2(v[6], v[7]);
            *(GAS v4u*)(MoutT + (size_t)n * 512 + 8 * jj) = w; }
        for (int ch = tid; ch < 256 * 32; ch += NTHR) { const int n = ch >> 5, jj = ch & 31, d = n >> 7, p = (n & 127) >> 1, im = n & 1, s = jj >> 1, q0 = 8 * (jj & 1), ex = d == 0 ? 15 - s : s; float v[8];
            const f32x2 ap = apw[(d * 17 + ex) * 64 + p];
#pragma unroll
            for (int e = 0; e < 8; ++e) { const f32x2 r = cmul(ap, bbl[(d * 64 + p) * 16 + q0 + e]); v[e] = im ? r.y : r.x; }
            v4u w; w.x = pk2(v[0], v[1]); w.y = pk2(v[2], v[3]); w.z = pk2(v[4], v[5]); w.w = pk2(v[6], v[7]);
            *(GAS v4u*)(M2T + (size_t)n * 256 + 8 * jj) = w; }
        __syncthreads();
    }
}
template <bool OUT> __device__ __forceinline__ void s5_ctx_gemm(const Args& a, int sl, int wg, int nwg) {
    PHASE_IDS;
    constexpr int K = OUT ? 512 : 256;
    const int r = lane & 31, hh = lane >> 5;
    for (int g = wg; g < SG; g += nwg) {
        const GAS bf16x8* ap = (const GAS bf16x8*)((const bf16*)(a.ws + WS_XC) + (size_t)(g * 32 + r) * 512 + 8 * hh);
        const bf16* Bt = OUT ? (const bf16*)(a.ws + WS_MOUTT) + (size_t)(sl * SG + g) * 256 * 512 : (const bf16*)(a.ws + WS_M2T) + (size_t)(sl * SG + g) * 256 * 256;
        const GAS bf16x8* bp = (const GAS bf16x8*)(Bt + (size_t)(32 * wave + r) * K + 8 * hh);
        f32x16 acc;
#pragma unroll
        for (int i = 0; i < 16; ++i) acc[i] = 0.f;
#pragma unroll 8
        for (int ks = 0; ks < K / 16; ++ks) acc = __builtin_amdgcn_mfma_f32_32x32x16_bf16(ap[2 * ks], bp[2 * ks], acc, 0, 0, 0);
        const int n = 32 * wave + r;
#pragma unroll
        for (int i = 0; i < 16; ++i) { const int c = (i & 3) + 8 * (i >> 2) + 4 * hh;
            if (OUT) { const int t = n >> 4, q = n & 15; ((GAS bf16*)(a.ws + WS_Z))[(size_t)(ML + 16 * c + t) * D + 16 * g + q] = (bf16)f2bf(pg8::gelu_tanh_f(acc[i])); }
            else ((GAS bf16*)(a.ws + WS_SC))[(size_t)(g * 32 + c) * 256 + n] = (bf16)f2bf(acc[i]); }
    }
}
__device__ __forceinline__ void s5_carry_phase(const Args& a, int sl, LAS unsigned char* lds, int wg, int nwg) {
    PHASE_IDS;
    LAS f32x2* EX = (LAS f32x2*)lds;
    const int seg = wave;
    for (int item = wg; item < 2 * 2 * SG; item += nwg) {
        const int b = item & 1, d = (item >> 1) & 1, g = item >> 2;
        const f32x2 a16 = ((const f32x2*)(a.ws + WS_A16))[(size_t)((sl * 2 + d) * SG + g) * SP + lane];
        const int c0 = d ? 511 - seg * 64 : seg * 64;
        const long sst = d ? -128 : 128, xst = d ? -256 : 256;
        const GAS unsigned* sp = (const GAS unsigned*)(a.ws + WS_SL) + (size_t)(g * 1024 + b * 512 + c0) * 128 + d * 64 + lane;
        GAS unsigned* xp = (GAS unsigned*)(a.ws + WS_XL) + (size_t)(g * 1024 + b * 512 + c0) * 256 + 128 + d * 64 + lane;
        unsigned sw[64];
#pragma unroll
        for (int j = 0; j < 64; ++j) { sw[j] = *sp; sp += sst; asm volatile("" : "+v"(sp)); }
        float hr = 0.f, hi = 0.f;
#define S5_STEP(word) do { const float sr = __builtin_bit_cast(float, (word) << 16), si = __builtin_bit_cast(float, (word) & 0xffff0000u); \
            const float nr = a16.x * hr - a16.y * hi + sr, ni = a16.x * hi + a16.y * hr + si; hr = nr; hi = ni; } while (0)
        if (seg == 0) {
            const int cc0 = d ? 15 : 0;
            const GAS unsigned* cp = (const GAS unsigned*)(a.ws + WS_SC) + (size_t)(g * 32 + b * 16 + cc0) * 128 + d * 64 + lane;
            GAS unsigned* xcp = (GAS unsigned*)(a.ws + WS_XC) + (size_t)(g * 32 + b * 16 + cc0) * 256 + 128 + d * 64 + lane;
            unsigned cw[16];
#pragma unroll
            for (int j = 0; j < 16; ++j) { cw[j] = *cp; cp += sst; asm volatile("" : "+v"(cp)); }
#pragma unroll
            for (int j = 0; j < 16; ++j) { *xcp = pk2(hr, hi); xcp += xst; asm volatile("" : "+v"(xcp)); S5_STEP(cw[j]); }
#pragma unroll
            for (int j = 0; j < 64; ++j) { *xp = pk2(hr, hi); xp += xst; asm volatile("" : "+v"(xp)); S5_STEP(sw[j]); }
        } else {
#pragma unroll
            for (int j = 0; j < 64; ++j) S5_STEP(sw[j]);
        }
        { f32x2 o; o.x = hr; o.y = hi; EX[seg * 64 + lane] = o; }
        __syncthreads();
        if (seg != 0) {
            f32x2 P = a16;
#pragma unroll
            for (int q = 0; q < 6; ++q) P = cmul(P, P);
            f32x2 F = EX[lane];
            for (int k = 1; k < seg; ++k) { const f32x2 E = EX[k * 64 + lane]; const f32x2 pf = cmul(P, F); F.x = pf.x + E.x; F.y = pf.y + E.y; }
            hr = F.x; hi = F.y;
#pragma unroll
            for (int j = 0; j < 64; ++j) { *xp = pk2(hr, hi); xp += xst; asm volatile("" : "+v"(xp)); S5_STEP(sw[j]); }
        }
#undef S5_STEP
        __syncthreads();
    }
}
__device__ __forceinline__ void probe_flush(const Args& a, int vcu, int G) {
    PHASE_IDS; const int gt = vcu * NTHR + tid, ngt = G * NTHR;
    const GAS f32x4* p1 = (const GAS f32x4*)a.in[I_W1]; const GAS f32x4* p3 = (const GAS f32x4*)a.in[I_W3];
    f32x4 s = {0.f, 0.f, 0.f, 0.f};
    const int n4 = 4 * 2048 * 5632 / 4;
#pragma unroll 8
    for (int i = gt; i < n4; i += ngt) { s += p1[i]; s += p3[i]; }
    if (s.x + s.y + s.z + s.w == 1.2345e30f) ((float*)(a.ws + WS_CTL))[1000 + (tid & 7)] = s.x;
    __syncthreads();
}

#ifndef GEMM_ALIGN
#define GEMM_ALIGN true
#endif
#ifndef GEMM_SP2
#define GEMM_SP2 true
#endif
#ifndef MK_ONE_LAUNCH
#define MK_ONE_LAUNCH 1
#endif
constexpr int N_PHASES = 2 + 2 * 16;

__global__ void __launch_bounds__(NTHR, 2) fwd_kernel(Args args) {
    extern __shared__ __attribute__((aligned(16))) unsigned char lds_raw[];
    LAS unsigned char* lds = (LAS unsigned char*)lds_raw;
    const int tid = threadIdx.x;
    const int G = gridDim.x, bx = blockIdx.x;
    const int vcu = (G % 8 == 0) ? (bx % 8) * (G / 8) + bx / 8 : bx;
    unsigned char* ws = args.ws;
    volatile LAS unsigned* MISC = (volatile LAS unsigned*)(lds + MISC_OFF);
    for (int u = tid; u < (LDS_BYTES - LDSCTL_OFF) / 4; u += NTHR) ((LAS unsigned*)(lds + LDSCTL_OFF))[u] = 0u;
    __syncthreads();
    const int lo = args.ph_lo, hi = args.ph_hi;
    XcdBarrier bar; bar.bar = (unsigned*)(ws + WS_CTL) + CW_BAR; bar.x = 0; bar.st = nullptr;
    if (hi - lo > 1) bar = xcd_barrier_post((unsigned*)(ws + WS_CTL) + CW_BAR, MISC + 8);
#define RUN(k) (lo <= (k) && (k) < hi)
#ifndef PROBE_MASK
#define PROBE_MASK 0
#endif
#define REP(kind) for (int rep = 0, nrep = 1 + ((PROBE_MASK >> (kind)) & 1); rep < nrep; ++rep)
#ifndef PROBE_WET
#define PROBE_WET 0
#endif
#define GATE(p) ((PROBE_WET && rep) ? (const float*)(ws + WS_CTL + 512 * 1024) : (p))
#define DRY (PROBE_WET ? 0 : rep)
#ifndef PROBE_FLUSH
#define PROBE_FLUSH 0
#endif
#define REPSYNC() do { if (rep + 1 < nrep) { __syncthreads(); if (PROBE_FLUSH == 1) probe_flush(args, vcu, G); } else if (PROBE_FLUSH == 2) { __syncthreads(); probe_flush(args, vcu, G); } } while (0)
#define SEAM(k) do { if (RUN(k) && RUN((k) + 1)) { xcd_barrier(bar); if ((PROBE_MASK >> 12) & 1) xcd_barrier(bar); } } while (0)
    _Float16* H = (_Float16*)(ws + WS_H); pg8::bf16_t* XN = (pg8::bf16_t*)(ws + WS_XN);
    const float* MOD = (const float*)(ws + WS_MOD);

#ifndef NO_PRO
    if (RUN(0)) REP(0) {
        adaln_items(args, lds, vcu, G);
        transpose_items(args, lds, vcu, G);
        small_prologue(args, vcu, G);
#if !S5_NAIVE
        __syncthreads();
        s5_precompute(args, lds, vcu, G);
#endif
        REPSYNC();
    }
#endif
    SEAM(0);
    if (RUN(1)) REP(1) norm_phase<true>(args, args.in[I_N1G], MOD, 0, vcu, G);
    SEAM(1);

#ifdef UNROLL_LP
#pragma unroll
#else
#pragma unroll 1
#endif
    for (int lp = 0; lp < 2; ++lp) {
        const int pb = 2 + lp * 16;
        {
            const int layer = 2 * lp; const float* modl = MOD + (size_t)layer * 3 * 12288;
            if (RUN(pb + 0)) { REP(2) {
                pg8::Gemm g{XN, (const pg8::bf16_t*)(ws + WS_WGIN) + (size_t)lp * 8192 * 2048, M, 8192, D}; pg8::StaticOrder S; S.init(M, 8192, G, bx);
                pg8::EpiG1 E{(pg8::bf16_t*)(ws + WS_ZU), (pg8::bf16_t*)(ws + WS_ZV), (float*)(ws + WS_VSTAT)};
                pg8::gemm_phase<pg8::EpiG1, pg8::StaticOrder, GEMM_ALIGN, GEMM_SP2>(lds + RING_OFF, g, S, E);
                REPSYNC(); }
            }
            SEAM(pb + 0);
            #ifndef NO_SGU
            if (RUN(pb + 1)) REP(3) sgu_phase(args, lp, lds, bx, G, rep);
#endif
            SEAM(pb + 1);
            if (RUN(pb + 2)) { REP(4) {
                pg8::Gemm g{(const pg8::bf16_t*)(ws + WS_ZU), (const pg8::bf16_t*)(ws + WS_WGOUT) + (size_t)lp * 2048 * 4096, ML, D, EA}; pg8::StaticOrder S; S.init(ML, D, G, bx);
                pg8::EpiResid E{H, GATE(modl + 2 * D), DRY};
                pg8::gemm_phase<pg8::EpiResid, pg8::StaticOrder, GEMM_ALIGN, GEMM_SP2>(lds + RING_OFF, g, S, E);
                __syncthreads();
                pg8::Gemm gc{(const pg8::bf16_t*)(ws + WS_ZU), (const pg8::bf16_t*)(ws + WS_WGOUT) + (size_t)lp * 2048 * 4096, M, D, 512, EA, EA}; pg8::SliceOrder SS; SS.init(G, bx, 8, 512);
                pg8::EpiSlab ES{(float*)(ws + WS_SLAB), 1024};
                pg8::gemm_phase<pg8::EpiSlab, pg8::SliceOrder, GEMM_ALIGN, GEMM_SP2>(lds + RING_OFF, gc, SS, ES);
                REPSYNC(); }
            }
            SEAM(pb + 2);
            if (RUN(pb + 3)) REP(1) norm_phase<false>(args, args.in[I_N2G] + layer * D, modl, 1, vcu, G, rep ? 0 : 8, modl + 2 * 12288 + 2 * D);
            SEAM(pb + 3);
            if (RUN(pb + 4)) { REP(5) {
                pg8::Gemm g{XN, (const pg8::bf16_t*)(ws + WS_WF13) + (size_t)layer * 11264 * 2048, M, 2 * FF, D}; pg8::StaticOrder S; S.init(M, 2 * FF, G, bx);
                pg8::EpiSwiGLU E{(pg8::bf16_t*)(ws + WS_HID)};
                pg8::gemm_phase<pg8::EpiSwiGLU, pg8::StaticOrder, GEMM_ALIGN, GEMM_SP2>(lds + RING_OFF, g, S, E);
                REPSYNC(); }
            }
            SEAM(pb + 4);
            if (RUN(pb + 5)) { REP(6) {
                pg8::Gemm g{(const pg8::bf16_t*)(ws + WS_HID), (const pg8::bf16_t*)(ws + WS_WF2) + (size_t)layer * 2048 * 5632, ML, D, FF}; pg8::StaticOrder S; S.init(ML, D, G, bx);
                pg8::EpiResid E{H, GATE(modl + 5 * D), DRY};
                pg8::gemm_phase<pg8::EpiResid, pg8::StaticOrder, GEMM_ALIGN, GEMM_SP2>(lds + RING_OFF, g, S, E);
                if (true) { __syncthreads();
                pg8::Gemm gc{(const pg8::bf16_t*)(ws + WS_HID), (const pg8::bf16_t*)(ws + WS_WF2) + (size_t)layer * 2048 * 5632, M, D, 512, FF, FF}; pg8::SliceOrder SS; SS.init(G, bx, 11, 512);
                pg8::EpiSlab ES{(float*)(ws + WS_SLAB), 1024};
                pg8::gemm_phase<pg8::EpiSlab, pg8::SliceOrder, GEMM_ALIGN, GEMM_SP2>(lds + RING_OFF, gc, SS, ES); }
                REPSYNC(); }
            }
            SEAM(pb + 5);
            if (RUN(pb + 6)) REP(1) norm_phase<false>(args, args.in[I_N1G] + (layer + 1) * D, modl + 3 * 12288, 0, vcu, G, rep ? 0 : 11, modl + 2 * 12288 + 5 * D);
            SEAM(pb + 6);
        }
        {
            const int layer = 2 * lp + 1; const float* modl = MOD + (size_t)layer * 3 * 12288; const int ps = pb + 7;
            const int Mrows = lp == 0 ? M : ML;
#if S5_NAIVE
            if (RUN(ps + 0)) {
                pg8::Gemm g{XN, (const pg8::bf16_t*)(ws + WS_WSIN) + (size_t)lp * 2048 * 2048, M, D, D}; pg8::StaticOrder S; S.init(M, D, G, bx);
                pg8::EpiPlainBf16 E{(pg8::bf16_t*)(ws + WS_SU), D};
                pg8::gemm_phase<pg8::EpiPlainBf16, pg8::StaticOrder, GEMM_ALIGN, GEMM_SP2>(lds + RING_OFF, g, S, E);
            }
            SEAM(ps + 0);
            if (RUN(ps + 1)) s5_naive_phase(args, lp, bx, G);
            SEAM(ps + 1);
            if (RUN(ps + 2)) s5_combine_phase(args, lp, vcu, G);
            SEAM(ps + 2);
            SEAM(ps + 3);
#else
            if (RUN(ps + 0)) { REP(7) {
                pg8::Gemm g{XN, (const pg8::bf16_t*)(ws + WS_WSIN) + (size_t)lp * 2048 * 2048, M, D, D}; pg8::StaticOrder S; S.init(M, D, G, bx);
                pg8::EpiS5In E{(pg8::bf16_t*)(ws + WS_XL), (pg8::bf16_t*)(ws + WS_XC)};
                pg8::gemm_phase<pg8::EpiS5In, pg8::StaticOrder, GEMM_ALIGN, GEMM_SP2>(lds + RING_OFF, g, S, E);
                REPSYNC(); }
            }
            SEAM(ps + 0);
            if (RUN(ps + 1)) { REP(8) {
                pg8::Gemm g{(const pg8::bf16_t*)(ws + WS_XL), (const pg8::bf16_t*)(ws + WS_M2T) + (size_t)lp * SG * 256 * 256, SG * 1024, 256, 256, 512}; pg8::GroupOrder S; S.init(G, vcu);
                pg8::EpiS5State E{(pg8::bf16_t*)(ws + WS_SL)};
                pg8::gemm_phase<pg8::EpiS5State, pg8::GroupOrder, GEMM_ALIGN, GEMM_SP2>(lds + RING_OFF, g, S, E);
                s5_ctx_gemm<false>(args, lp, vcu, G);
                REPSYNC(); }
            }
            SEAM(ps + 1);
            if (RUN(ps + 2)) REP(9) s5_carry_phase(args, lp, lds, bx, G);
            SEAM(ps + 2);
            if (RUN(ps + 3)) { REP(10) {
                pg8::Gemm g{(const pg8::bf16_t*)(ws + WS_XL), (const pg8::bf16_t*)(ws + WS_MOUTT) + (size_t)lp * SG * 256 * 512, SG * 1024, 256, 512, 512}; pg8::GroupOrder S; S.init(G, vcu);
                pg8::EpiS5Out E{(pg8::bf16_t*)(ws + WS_Z)};
                pg8::gemm_phase<pg8::EpiS5Out, pg8::GroupOrder, GEMM_ALIGN, GEMM_SP2>(lds + RING_OFF, g, S, E);
                s5_ctx_gemm<true>(args, lp, vcu, G);
                REPSYNC(); }
            }
            SEAM(ps + 3);
#endif
            if (RUN(ps + 4)) { REP(11) {
                pg8::Gemm g{(const pg8::bf16_t*)(ws + WS_Z), (const pg8::bf16_t*)(ws + WS_WGLU) + (size_t)lp * 4096 * 2048, Mrows, 2 * D, D}; pg8::StaticOrder S; S.init(Mrows, 2 * D, G, bx);
                pg8::EpiGluResid E{H, GATE(modl + 2 * D), DRY};
                pg8::gemm_phase<pg8::EpiGluResid, pg8::StaticOrder, GEMM_ALIGN, GEMM_SP2>(lds + RING_OFF, g, S, E);
                REPSYNC(); }
            }
            SEAM(ps + 4);
            if (RUN(ps + 5)) REP(1) norm_phase<false>(args, args.in[I_N2G] + layer * D, modl, 1, vcu, G, 0, nullptr, Mrows);
            SEAM(ps + 5);
            if (RUN(ps + 6)) { REP(5) {
                pg8::Gemm g{XN, (const pg8::bf16_t*)(ws + WS_WF13) + (size_t)layer * 11264 * 2048, Mrows, 2 * FF, D}; pg8::StaticOrder S; S.init(Mrows, 2 * FF, G, bx);
                pg8::EpiSwiGLU E{(pg8::bf16_t*)(ws + WS_HID)};
                pg8::gemm_phase<pg8::EpiSwiGLU, pg8::StaticOrder, GEMM_ALIGN, GEMM_SP2>(lds + RING_OFF, g, S, E);
                REPSYNC(); }
            }
            SEAM(ps + 6);
            if (RUN(ps + 7)) { REP(6) {
                pg8::Gemm g{(const pg8::bf16_t*)(ws + WS_HID), (const pg8::bf16_t*)(ws + WS_WF2) + (size_t)layer * 2048 * 5632, ML, D, FF}; pg8::StaticOrder S; S.init(ML, D, G, bx);
                pg8::EpiResid E{H, GATE(modl + 5 * D), DRY};
                pg8::gemm_phase<pg8::EpiResid, pg8::StaticOrder, GEMM_ALIGN, GEMM_SP2>(lds + RING_OFF, g, S, E);
                if (lp == 0) { __syncthreads();
                pg8::Gemm gc{(const pg8::bf16_t*)(ws + WS_HID), (const pg8::bf16_t*)(ws + WS_WF2) + (size_t)layer * 2048 * 5632, M, D, 512, FF, FF}; pg8::SliceOrder SS; SS.init(G, bx, 11, 512);
                pg8::EpiSlab ES{(float*)(ws + WS_SLAB), 1024};
                pg8::gemm_phase<pg8::EpiSlab, pg8::SliceOrder, GEMM_ALIGN, GEMM_SP2>(lds + RING_OFF, gc, SS, ES); }
                REPSYNC(); }
            }
            SEAM(ps + 7);
            if (RUN(ps + 8)) {
                REP(1) if (lp == 0) norm_phase<false>(args, args.in[I_N1G] + (layer + 1) * D, modl + 3 * 12288, 0, vcu, G, rep ? 0 : 11, modl + 2 * 12288 + 5 * D);
                else final_phase(args, vcu, G);
            }
            SEAM(ps + 8);
        }
    }
#undef RUN
#undef SEAM
}

extern "C" void kernel_launch(void* const* d_in, const int* in_sizes, int n_in, void* d_out, int out_size, void* d_ws, size_t ws_size, hipStream_t stream) {
    static int grid = 0;
    if (grid == 0) {
        if (n_in != 28 || in_sizes[0] != ML * D || out_size != ML * D || ws_size < WS_END) {
            fprintf(stderr, "kernel_launch: unexpected problem (n_in %d, in0 %d, out %d, ws %zu, need ws >= %zu); nothing launched\n", n_in, n_in > 0 ? in_sizes[0] : -1, out_size, ws_size, (size_t)WS_END); grid = -1; return; }
        int dev = 0, cus = 0, per_cu = 0;
        if (hipGetDevice(&dev) != hipSuccess || hipDeviceGetAttribute(&cus, hipDeviceAttributeMultiprocessorCount, dev) != hipSuccess) { fprintf(stderr, "kernel_launch: device query failed\n"); grid = -1; return; }
        if (hipFuncSetAttribute((const void*)fwd_kernel, hipFuncAttributeMaxDynamicSharedMemorySize, LDS_BYTES) != hipSuccess) { fprintf(stderr, "kernel_launch: hipFuncSetAttribute failed\n"); grid = -1; return; }
        if (hipOccupancyMaxActiveBlocksPerMultiprocessor(&per_cu, (const void*)fwd_kernel, NTHR, LDS_BYTES) != hipSuccess || per_cu < 1) {
            fprintf(stderr, "kernel_launch: occupancy query reports %d workgroups per CU\n", per_cu); }
        (void)hipGetLastError();
        grid = cus;
    }
    if (grid < 0) return;
    if (hipMemsetAsync((char*)d_ws + WS_CTL, 0, CTL_ZERO_BYTES, stream) != hipSuccess) { fprintf(stderr, "kernel_launch: memset failed\n"); return; }
    Args a{};
    for (int i = 0; i < 28; ++i) a.in[i] = (const float*)d_in[i];
    a.out = (float*)d_out; a.ws = (unsigned char*)d_ws;
#if MK_ONE_LAUNCH
    a.ph_lo = 0; a.ph_hi = N_PHASES;
    hipLaunchKernelGGL(fwd_kernel, dim3(grid), dim3(NTHR), LDS_BYTES, stream, a);
#else
    for (int p = 0; p < N_PHASES; ++p) { a.ph_lo = p; a.ph_hi = p + 1; hipLaunchKernelGGL(fwd_kernel, dim3(grid), dim3(NTHR), LDS_BYTES, stream, a); }
#endif
    const hipError_t le = hipPeekAtLastError();
    if (le != hipSuccess) fprintf(stderr, "kernel_launch: launch failed: %s\n", hipGetErrorName(le));
}
```

```cpp
#include <hip/hip_runtime.h>
#include <cstdio>
#include <cstdint>
namespace pg8 {
#define PG8_LAS __attribute__((address_space(3)))
typedef unsigned short bf16_t;
typedef short bf16x8 __attribute__((ext_vector_type(8)));
typedef float f32x4 __attribute__((ext_vector_type(4)));
typedef unsigned u32x4 __attribute__((ext_vector_type(4)));
constexpr int BM = 256, BK = 64, HALF = 128, HTB = HALF * BK * 2  , STAGE_BYTES = 8 * HTB, NXCD = 8, WGM = 8;

__host__ __device__ __forceinline__ int lds_byte(int r, int c) { const int st = (r >> 4) * 2 + (c >> 5), rr = r & 15, cc = c & 31, ob = rr * 64 + cc * 2; return st * 1024 + (ob ^ (((ob >> 9) & 1) << 5)); }
__host__ __device__ __forceinline__ void stage_rc(int b, int& R, int& C) { const int st = b / 1024, sb = b % 1024, swz = sb ^ (((sb >> 9) & 1) << 5); R = (st >> 1) * 16 + swz / 64; C = (st & 1) * 32 + (swz % 64) / 2; }
__host__ __device__ __forceinline__ int perm32(int rho) { const int n = rho >> 4, i = rho & 15; return 8 * (i >> 2) + 4 * n + (i & 3); }

struct Unit { int pm, pn; int koff; };
struct Gemm { const bf16_t* A; const bf16_t* Bt; int M, N, K; int lda, ldb; };

struct StaticOrder {
    int nM, nN, nwg, G, c;
    __host__ __device__ void init(int M, int N, int G_, int c_) { nM = M / BM; nN = N / BM; nwg = nM * nN; G = G_; c = c_; }
    __host__ __device__ bool next(int i, Unit& u) const {
        const long L = (long)i * G + c; if (L >= nwg) return false;
        int wgid = (int)L; { const int q = nwg / NXCD, r = nwg % NXCD, xcd = wgid % NXCD, off = wgid / NXCD; wgid = (xcd < r ? xcd * (q + 1) : r * (q + 1) + (xcd - r) * q) + off; }
        const int nig = WGM * nN, gid = wgid / nig, fm = gid * WGM, gsz = (nM - fm) < WGM ? (nM - fm) : WGM;
        u.pm = fm + ((wgid % nig) % gsz); u.pn = (wgid % nig) / gsz; u.koff = 0; return true;
    }
    __device__ __forceinline__ void a_ready(const Unit&) const {}
    __device__ __forceinline__ void done(const Unit&) const {}
};

__device__ __forceinline__ unsigned cvt_pk_bf16(float lo, float hi) { unsigned r; asm volatile("v_cvt_pk_bf16_f32 %0, %1, %2" : "=v"(r) : "v"(lo), "v"(hi)); return r; }
typedef float f32x2 __attribute__((ext_vector_type(2)));
__device__ __forceinline__ f32x2 gelu_pk(f32x2 v) {
    const f32x2 av = __builtin_elementwise_abs(v), d = av * 0.2316418882f + 1.0f;
    f32x2 t; t.x = __builtin_amdgcn_rcpf(d.x); t.y = __builtin_amdgcn_rcpf(d.y);
    f32x2 q = t * 0.5307027145f + (-0.7265760135f); q = q * t + 0.7107068705f; q = q * t + (-0.142248368f); q = q * t + 0.127414796f; q = q * t;
    const f32x2 s = (v * v) * (-0.72134752044f);
    f32x2 e; e.x = __builtin_amdgcn_exp2f(s.x); e.y = __builtin_amdgcn_exp2f(s.y);
    const f32x2 m = v * (q * e), r = v - m;
    f32x2 o; o.x = v.x < 0.f ? m.x : r.x; o.y = v.y < 0.f ? m.y : r.y; return o;
}


__device__ __forceinline__ float sigmoid_f(float x) { return __builtin_amdgcn_rcpf(1.0f + __builtin_amdgcn_exp2f(-1.44269504f * x)); }
__device__ __forceinline__ float silu_f(float x) { return x * sigmoid_f(x); }
__device__ __forceinline__ float gelu_tanh_f(float x) { const float u = x * (1.0f + 0.044715f * x * x); return x * __builtin_amdgcn_rcpf(1.0f + __builtin_amdgcn_exp2f(-2.30220820f * u)); }
__device__ __forceinline__ f32x2 gelu_tanh_pk(f32x2 x) {
    f32x2 xc; xc.x = __builtin_amdgcn_fmed3f(x.x, -3.6f, 3.6f); xc.y = __builtin_amdgcn_fmed3f(x.y, -3.6f, 3.6f);
    const f32x2 z = xc * 0.277777778f, z2 = z * z;
    f32x2 p = z2 * (-0.707277966f) + 3.50913538f;
    p = p * z2 + (-7.72999719f); p = p * z2 + 10.1716655f; p = p * z2 + (-9.14213848f); p = p * z2 + 6.07337743f; p = p * z2 + (-3.11094742f); p = p * z2 + 1.43606059f;
    return x * (p * z + 0.5f);
}
__device__ __forceinline__ int row_set(int pm) { return pm < 32 ? 0 : (pm < 64 ? 1 : 2); }

struct EpiPlainBf16 {
    static constexpr bool PERM = true, AFTER_DRAIN = false;
    bf16_t* O; int ldc;
    __device__ __forceinline__ void operator()(const f32x4 (&acc)[2][2][4][2], const Unit& u, int wr, int wc, int fr, int fq) const {
        const int row0 = u.pm * BM + wr * 64 + fr, col0 = u.pn * BM + wc * 32 + 8 * fq;
#pragma unroll
        for (int ai = 0; ai < 2; ++ai)
#pragma unroll
            for (int m = 0; m < 4; ++m) { bf16_t* rowp = O + (size_t)(row0 + ai * HALF + m * 16) * ldc + col0;
#pragma unroll
                for (int bj = 0; bj < 2; ++bj) { const f32x4 v0 = acc[ai][bj][m][0], v1 = acc[ai][bj][m][1];
                    u32x4 w; w.x = cvt_pk_bf16(v0[0], v0[1]); w.y = cvt_pk_bf16(v0[2], v0[3]); w.z = cvt_pk_bf16(v1[0], v1[1]); w.w = cvt_pk_bf16(v1[2], v1[3]);
                    *(u32x4*)(rowp + bj * HALF) = w; } }
    }
};
struct EpiG1 {
    static constexpr bool PERM = true, AFTER_DRAIN = false;
    bf16_t* U; bf16_t* V; float* vstat; int dry;
    __device__ __forceinline__ void operator()(const f32x4 (&acc)[2][2][4][2], const Unit& u, int wr, int wc, int fr, int fq) const {
        if (dry) return;
        const bool isv = u.pn >= 16;
        const int row0 = u.pm * BM + wr * 64 + fr, col0 = (u.pn & 15) * BM + wc * 32 + 8 * fq;
        bf16_t* base = isv ? V : U;
#pragma unroll
        for (int ai = 0; ai < 2; ++ai)
#pragma unroll
            for (int m = 0; m < 4; ++m) { const int row = row0 + ai * HALF + m * 16; bf16_t* rowp = base + (size_t)row * 4096 + col0; float s = 0.f, ss = 0.f;
#pragma unroll
                for (int bj = 0; bj < 2; ++bj) { f32x4 v0 = acc[ai][bj][m][0], v1 = acc[ai][bj][m][1];
                    { const f32x2 a0 = gelu_tanh_pk((f32x2){v0[0], v0[1]}), a1 = gelu_tanh_pk((f32x2){v0[2], v0[3]}), a2 = gelu_tanh_pk((f32x2){v1[0], v1[1]}), a3 = gelu_tanh_pk((f32x2){v1[2], v1[3]});
                      v0 = (f32x4){a0.x, a0.y, a1.x, a1.y}; v1 = (f32x4){a2.x, a2.y, a3.x, a3.y}; }
                    if (isv) {
#pragma unroll
                        for (int e = 0; e < 4; ++e) { s += v0[e] + v1[e]; ss += v0[e] * v0[e] + v1[e] * v1[e]; } }
                    u32x4 w; w.x = cvt_pk_bf16(v0[0], v0[1]); w.y = cvt_pk_bf16(v0[2], v0[3]); w.z = cvt_pk_bf16(v1[0], v1[1]); w.w = cvt_pk_bf16(v1[2], v1[3]);
                    *(u32x4*)(rowp + bj * HALF) = w; }
                if (isv) { s += __shfl_xor(s, 16); s += __shfl_xor(s, 32); ss += __shfl_xor(ss, 16); ss += __shfl_xor(ss, 32);
                    if (fq == 0) { f32x2 o; o.x = s; o.y = ss; *(f32x2*)(vstat + ((size_t)row * 64 + (u.pn - 16) * 4 + wc) * 2) = o; } } }
    }
};
typedef _Float16 h16x8 __attribute__((ext_vector_type(8)));
struct EpiResid {
    static constexpr bool PERM = true, AFTER_DRAIN = false;
    _Float16* H; const float* gate; int dry;
    __device__ __forceinline__ void operator()(const f32x4 (&acc)[2][2][4][2], const Unit& u, int wr, int wc, int fr, int fq) const {
        if (dry) return;
        const int row0 = u.pm * BM + wr * 64 + fr, col0 = u.pn * BM + wc * 32 + 8 * fq;
        const float* g = gate + row_set(u.pm) * (6 * 2048) + col0;
        f32x4 gv[2][2];
#pragma unroll
        for (int bj = 0; bj < 2; ++bj)
#pragma unroll
            for (int n = 0; n < 2; ++n) gv[bj][n] = *(const f32x4*)(g + bj * HALF + n * 4);
#pragma unroll
        for (int ai = 0; ai < 2; ++ai)
#pragma unroll
            for (int m = 0; m < 4; ++m) { _Float16* rowp = H + (size_t)(row0 + ai * HALF + m * 16) * 2048 + col0;
#pragma unroll
                for (int bj = 0; bj < 2; ++bj) { h16x8* p = (h16x8*)(rowp + bj * HALF); h16x8 hv = *p;
#pragma unroll
                    for (int e = 0; e < 4; ++e) { hv[e] = (_Float16)((float)hv[e] + gv[bj][0][e] * acc[ai][bj][m][0][e]); hv[4 + e] = (_Float16)((float)hv[4 + e] + gv[bj][1][e] * acc[ai][bj][m][1][e]); }
                    *p = hv; } }
    }
};
struct EpiSwiGLU {
    static constexpr bool PERM = true, AFTER_DRAIN = false;
    bf16_t* O;
    __device__ __forceinline__ void operator()(const f32x4 (&acc)[2][2][4][2], const Unit& u, int wr, int wc, int fr, int fq) const {
        const int row0 = u.pm * BM + wr * 64 + fr, col0 = u.pn * HALF + wc * 32 + 8 * fq;
#pragma unroll
        for (int ai = 0; ai < 2; ++ai)
#pragma unroll
            for (int m = 0; m < 4; ++m) { bf16_t* rowp = O + (size_t)(row0 + ai * HALF + m * 16) * 5632 + col0;
                f32x4 a0 = acc[ai][0][m][0], a1 = acc[ai][0][m][1]; const f32x4 b0 = acc[ai][1][m][0], b1 = acc[ai][1][m][1];
#pragma unroll
                for (int e = 0; e < 4; ++e) { a0[e] = silu_f(a0[e]) * b0[e]; a1[e] = silu_f(a1[e]) * b1[e]; }
                u32x4 w; w.x = cvt_pk_bf16(a0[0], a0[1]); w.y = cvt_pk_bf16(a0[2], a0[3]); w.z = cvt_pk_bf16(a1[0], a1[1]); w.w = cvt_pk_bf16(a1[2], a1[3]);
                *(u32x4*)rowp = w; }
    }
};
struct EpiGluResid {
    static constexpr bool PERM = true, AFTER_DRAIN = false;
    _Float16* H; const float* gate; int dry;
    __device__ __forceinline__ void operator()(const f32x4 (&acc)[2][2][4][2], const Unit& u, int wr, int wc, int fr, int fq) const {
        if (dry) return;
        const int row0 = u.pm * BM + wr * 64 + fr, col0 = u.pn * HALF + wc * 32 + 8 * fq;
        const float* g = gate + row_set(u.pm) * (6 * 2048) + col0;
        f32x4 gv[2];
#pragma unroll
        for (int n = 0; n < 2; ++n) gv[n] = *(const f32x4*)(g + n * 4);
#pragma unroll
        for (int ai = 0; ai < 2; ++ai)
#pragma unroll
            for (int m = 0; m < 4; ++m) { h16x8* p = (h16x8*)(H + (size_t)(row0 + ai * HALF + m * 16) * 2048 + col0); h16x8 hv = *p;
#pragma unroll
                for (int n = 0; n < 2; ++n) { const f32x4 a = acc[ai][0][m][n], gg = acc[ai][1][m][n];
#pragma unroll
                    for (int e = 0; e < 4; ++e) hv[4 * n + e] = (_Float16)((float)hv[4 * n + e] + gv[n][e] * a[e] * sigmoid_f(gg[e])); }
                *p = hv; }
    }
};

struct GroupOrder {
    int G, c;
    __host__ __device__ void init(int G_, int c_) { G = G_; c = c_; }
    __host__ __device__ bool next(int i, Unit& u) const { const int L = i * G + c; if (L >= 512) return false; u.pm = L; u.pn = L >> 2; u.koff = 0; return true; }
    __device__ __forceinline__ void a_ready(const Unit&) const {}
    __device__ __forceinline__ void done(const Unit&) const {}
};
struct EpiS5In {
    static constexpr bool PERM = true, AFTER_DRAIN = false;
    bf16_t* XL; bf16_t* XC;
    __device__ __forceinline__ void operator()(const f32x4 (&acc)[2][2][4][2], const Unit& u, int wr, int wc, int fr, int fq) const {
        const int row0 = u.pm * BM + wr * 64 + fr;
#pragma unroll
        for (int ai = 0; ai < 2; ++ai)
#pragma unroll
            for (int m = 0; m < 4; ++m) { const int row = row0 + ai * HALF + m * 16;
#pragma unroll
                for (int bj = 0; bj < 2; ++bj) { const int col0 = u.pn * BM + bj * HALF + wc * 32 + 8 * fq, g = col0 >> 4, q0 = col0 & 15;
                    bf16_t* dst = row < 16384 ? XL + ((size_t)(g * 1024 + (row >> 4)) * 512 + 16 * (row & 15) + q0)
                                              : XC + ((size_t)(g * 32 + ((row - 16384) >> 4)) * 512 + 16 * (row & 15) + q0);
                    const f32x4 v0 = acc[ai][bj][m][0], v1 = acc[ai][bj][m][1];
                    u32x4 w; w.x = cvt_pk_bf16(v0[0], v0[1]); w.y = cvt_pk_bf16(v0[2], v0[3]); w.z = cvt_pk_bf16(v1[0], v1[1]); w.w = cvt_pk_bf16(v1[2], v1[3]);
                    *(u32x4*)dst = w; } }
    }
};
struct EpiS5State {
    static constexpr bool PERM = true, AFTER_DRAIN = false;
    bf16_t* SL;
    __device__ __forceinline__ void operator()(const f32x4 (&acc)[2][2][4][2], const Unit& u, int wr, int wc, int fr, int fq) const {
        const int row0 = u.pm * BM + wr * 64 + fr, col0 = wc * 32 + 8 * fq;
#pragma unroll
        for (int ai = 0; ai < 2; ++ai)
#pragma unroll
            for (int m = 0; m < 4; ++m) { bf16_t* rowp = SL + (size_t)(row0 + ai * HALF + m * 16) * 256 + col0;
#pragma unroll
                for (int bj = 0; bj < 2; ++bj) { const f32x4 v0 = acc[ai][bj][m][0], v1 = acc[ai][bj][m][1];
                    u32x4 w; w.x = cvt_pk_bf16(v0[0], v0[1]); w.y = cvt_pk_bf16(v0[2], v0[3]); w.z = cvt_pk_bf16(v1[0], v1[1]); w.w = cvt_pk_bf16(v1[2], v1[3]);
                    *(u32x4*)(rowp + bj * HALF) = w; } }
    }
};
struct EpiS5Out {
    static constexpr bool PERM = true, AFTER_DRAIN = false;
    bf16_t* Z;
    __device__ __forceinline__ void operator()(const f32x4 (&acc)[2][2][4][2], const Unit& u, int wr, int wc, int fr, int fq) const {
        const int c0 = (u.pm & 3) * BM + wr * 64 + fr, g = u.pn;
#pragma unroll
        for (int ai = 0; ai < 2; ++ai)
#pragma unroll
            for (int m = 0; m < 4; ++m) { const int c = c0 + ai * HALF + m * 16;
#pragma unroll
                for (int bj = 0; bj < 2; ++bj) { const int n0 = bj * HALF + wc * 32 + 8 * fq, t = n0 >> 4, q0 = n0 & 15;
                    f32x4 v0 = acc[ai][bj][m][0], v1 = acc[ai][bj][m][1];
#pragma unroll
                    for (int e = 0; e < 4; ++e) { v0[e] = gelu_tanh_f(v0[e]); v1[e] = gelu_tanh_f(v1[e]); }
                    u32x4 w; w.x = cvt_pk_bf16(v0[0], v0[1]); w.y = cvt_pk_bf16(v0[2], v0[3]); w.z = cvt_pk_bf16(v1[0], v1[1]); w.w = cvt_pk_bf16(v1[2], v1[3]);
                    *(u32x4*)(Z + (size_t)(16 * c + t) * 2048 + 16 * g + q0) = w; } }
    }
};

struct SliceOrder {
    int G, c, nsl, kbytes;
    __host__ __device__ void init(int G_, int c_, int nsl_, int kslice) { G = G_; c = c_; nsl = nsl_; kbytes = kslice * 2; }
    __host__ __device__ bool next(int i, Unit& u) const { const int L = i * G + c; if (L >= nsl * 16) return false; const int s = L >> 4, r = L & 15; u.pm = 64 + (r >> 3); u.pn = r & 7; u.koff = s * kbytes; return true; }
    __device__ __forceinline__ void a_ready(const Unit&) const {}
    __device__ __forceinline__ void done(const Unit&) const {}
};
struct EpiSlab {
    static constexpr bool PERM = false, AFTER_DRAIN = false;
    float* SLAB; int kbytes;
    __device__ __forceinline__ void operator()(const f32x4 (&acc)[2][2][4][2], const Unit& u, int wr, int wc, int fr, int fq) const {
        const int s = u.koff / kbytes, row0 = (u.pm - 64) * BM + wr * 64 + fr, col0 = u.pn * BM + wc * 32 + 4 * fq;
        float* base = SLAB + (size_t)s * 512 * 2048;
#pragma unroll
        for (int ai = 0; ai < 2; ++ai)
#pragma unroll
            for (int m = 0; m < 4; ++m) { float* rowp = base + (size_t)(row0 + ai * HALF + m * 16) * 2048 + col0;
#pragma unroll
                for (int bj = 0; bj < 2; ++bj)
#pragma unroll
                    for (int n = 0; n < 2; ++n) *(f32x4*)(rowp + bj * HALF + n * 16) = acc[ai][bj][m][n]; }
    }
};

template <class Epi, class Sched, bool ALIGN_EPI = false, bool SP2 = false>
__device__ __forceinline__ void gemm_phase(PG8_LAS unsigned char* lds, const Gemm g, const Sched& S, const Epi& E) {
    int tid_ = threadIdx.x; asm volatile("" : "+v"(tid_));
    const int tid = tid_, wid = __builtin_amdgcn_readfirstlane(tid >> 6), lane = tid & 63, wr = wid >> 2, wc = wid & 3, fr = lane & 15, fq = lane >> 4;
    const int K = g.K, nt = K / BK, lda = g.lda ? g.lda : K, ldb = g.ldb ? g.ldb : K;
    unsigned voffA[2], voffB[2];
#pragma unroll
    for (int i = 0; i < 2; ++i) { int R, C; stage_rc(tid * 16 + i * 8192, R, C); const int Rb = Epi::PERM ? ((R & ~31) + perm32(R & 31)) : R;
        voffA[i] = (unsigned)(R * lda + C) * 2u; voffB[i] = (unsigned)(Rb * ldb + C) * 2u; }
    const size_t kstep = (size_t)(BK * 2);
    const size_t hstepB = (size_t)HALF * ldb * 2, hstepA = (size_t)HALF * lda * 2;
    const size_t tstepB = 2 * hstepB, tstepA = 2 * hstepA;
    const unsigned ldsw = (unsigned)wid * 1024u;
    const int aoff = lds_byte(wr * 64 + fr, fq * 8), boff = lds_byte(wc * 32 + fr, fq * 8);
#define PG8_SA(b, h) (((b) * 2 + (h)) * HTB)
#define PG8_SB(b, h) ((4 + (b) * 2 + (h)) * HTB)
#define PG8_STAGE(bufoff, gbase, voff) do { _Pragma("unroll") for (int _i = 0; _i < 2; ++_i) \
        __builtin_amdgcn_global_load_lds((const unsigned*)((const char*)(gbase) + (voff)[_i]), (PG8_LAS unsigned*)(lds + (bufoff) + ldsw + _i * 8192), 16, 0, 0); } while (0)
#define PG8_LDA(dst, b, h) do { _Pragma("unroll") for (int m = 0; m < 4; ++m) _Pragma("unroll") for (int k = 0; k < 2; ++k) dst[m][k] = *(const PG8_LAS bf16x8*)(lds + PG8_SA(b, h) + aoff + m * 2048 + k * 1024); } while (0)
#define PG8_LDB(dst, b, h) do { _Pragma("unroll") for (int n = 0; n < 2; ++n) _Pragma("unroll") for (int k = 0; k < 2; ++k) dst[n][k] = *(const PG8_LAS bf16x8*)(lds + PG8_SB(b, h) + boff + n * 2048 + k * 1024); } while (0)
#define PG8_MMA(ai, bj, At, Bt) do { __builtin_amdgcn_s_setprio(1); _Pragma("unroll") for (int m = 0; m < 4; ++m) _Pragma("unroll") for (int n = 0; n < 2; ++n) _Pragma("unroll") for (int k = 0; k < 2; ++k) \
        acc[ai][bj][m][n] = __builtin_amdgcn_mfma_f32_16x16x32_bf16(Bt[n][k], At[m][k], acc[ai][bj][m][n], 0, 0, 0); __builtin_amdgcn_s_setprio(0); } while (0)
#define PG8_WAIT_V(n) asm volatile("s_waitcnt vmcnt(" #n ")" ::: "memory")
#define PG8_WAIT_L(n) asm volatile("s_waitcnt lgkmcnt(" #n ")" ::: "memory")
#define PG8_BAR __builtin_amdgcn_s_barrier()
#define PG8_SCHED __builtin_amdgcn_sched_barrier(0)
    Unit cur, nxt; int ui = 0;
    if (!S.next(0, cur)) return;
    f32x4 acc[2][2][4][2];
#pragma unroll
    for (int a = 0; a < 2; ++a)
#pragma unroll
        for (int b = 0; b < 2; ++b)
#pragma unroll
            for (int m = 0; m < 4; ++m)
#pragma unroll
                for (int n = 0; n < 2; ++n) acc[a][b][m][n] = (f32x4){0.f, 0.f, 0.f, 0.f};
    bf16x8 At[4][2], B0[2][2], B1[2][2];
    const char* cA = (const char*)g.A + (size_t)cur.pm * tstepA + cur.koff; const char* cB = (const char*)g.Bt + (size_t)cur.pn * tstepB + cur.koff;
    S.a_ready(cur);
    if constexpr (SP2) {
        PG8_STAGE(PG8_SB(0, 0), cB, voffB); PG8_STAGE(PG8_SB(0, 1), cB + hstepB, voffB); PG8_STAGE(PG8_SA(0, 0), cA, voffA); PG8_STAGE(PG8_SA(0, 1), cA + hstepA, voffA);
        if (wr == 1) PG8_BAR;
        PG8_WAIT_V(2); PG8_BAR;
        PG8_STAGE(PG8_SB(1, 0), cB + kstep, voffB); PG8_STAGE(PG8_SA(1, 0), cA + kstep, voffA); PG8_STAGE(PG8_SB(1, 1), cB + hstepB + kstep, voffB);
        PG8_WAIT_V(6); PG8_BAR;
    } else {
        PG8_STAGE(PG8_SB(0, 0), cB, voffB); PG8_STAGE(PG8_SA(0, 0), cA, voffA); PG8_STAGE(PG8_SB(0, 1), cB + hstepB, voffB); PG8_STAGE(PG8_SA(0, 1), cA + hstepA, voffA);
        if (wr == 1) PG8_BAR;
        PG8_WAIT_V(4); PG8_BAR;
        PG8_STAGE(PG8_SB(1, 0), cB + kstep, voffB); PG8_STAGE(PG8_SA(1, 0), cA + kstep, voffA); PG8_STAGE(PG8_SB(1, 1), cB + hstepB + kstep, voffB);
        PG8_WAIT_V(6); PG8_BAR;
    }
    for (;;) {
        const bool has_next = S.next(ui + 1, nxt);
        const char* nA = has_next ? (const char*)g.A + (size_t)nxt.pm * tstepA + nxt.koff : cA; const char* nB = has_next ? (const char*)g.Bt + (size_t)nxt.pn * tstepB + nxt.koff : cB;
#pragma unroll 1
        for (int t = 0; t < nt; t += 2) {
            const bool last = (t == nt - 2);
            const char* a1 = cA + (size_t)(t + 1) * kstep;
            const char* a2 = last ? nA : cA + (size_t)(t + 2) * kstep; const char* b2 = last ? nB : cB + (size_t)(t + 2) * kstep;
            const char* a3 = a2 + kstep; const char* b3 = b2 + kstep;
            if (last && has_next) S.a_ready(nxt);
            if constexpr (SP2) {
            PG8_LDB(B0, 0, 0); PG8_LDB(B1, 0, 1); PG8_SCHED; PG8_LDA(At, 0, 0); PG8_STAGE(PG8_SA(1, 1), a1 + hstepA, voffA);
            PG8_WAIT_V(8); PG8_WAIT_L(0); PG8_BAR; PG8_MMA(0, 0, At, B0); PG8_MMA(0, 1, At, B1); PG8_BAR; PG8_SCHED;
            PG8_LDA(At, 0, 1); PG8_STAGE(PG8_SB(0, 0), b2, voffB); PG8_STAGE(PG8_SB(0, 1), b2 + hstepB, voffB); PG8_STAGE(PG8_SA(0, 0), a2, voffA);
            PG8_WAIT_V(8); PG8_WAIT_L(0); PG8_BAR; PG8_MMA(1, 0, At, B0); PG8_MMA(1, 1, At, B1); PG8_BAR; PG8_SCHED;
            PG8_LDB(B0, 1, 0); PG8_LDB(B1, 1, 1); PG8_SCHED; PG8_LDA(At, 1, 0); PG8_STAGE(PG8_SA(0, 1), a2 + hstepA, voffA);
            PG8_WAIT_V(8); PG8_WAIT_L(0); PG8_BAR; PG8_MMA(0, 0, At, B0); PG8_MMA(0, 1, At, B1); PG8_BAR; PG8_SCHED;
            PG8_LDA(At, 1, 1); PG8_STAGE(PG8_SB(1, 0), b3, voffB); PG8_STAGE(PG8_SB(1, 1), b3 + hstepB, voffB); PG8_STAGE(PG8_SA(1, 0), a3, voffA);
            PG8_WAIT_V(8); PG8_WAIT_L(0); PG8_BAR; PG8_MMA(1, 0, At, B0); PG8_MMA(1, 1, At, B1); PG8_BAR; PG8_SCHED;
            } else {
            PG8_LDB(B0, 0, 0); PG8_SCHED; PG8_LDA(At, 0, 0); PG8_STAGE(PG8_SA(1, 1), a1 + hstepA, voffA);
            PG8_WAIT_L(8); PG8_BAR; PG8_WAIT_L(0); PG8_MMA(0, 0, At, B0); PG8_BAR; PG8_SCHED;
            PG8_LDB(B1, 0, 1); PG8_STAGE(PG8_SB(0, 0), b2, voffB);
            PG8_BAR; PG8_WAIT_L(0); PG8_MMA(0, 1, At, B1); PG8_BAR;
            PG8_LDA(At, 0, 1); PG8_STAGE(PG8_SA(0, 0), a2, voffA);
            PG8_BAR; PG8_WAIT_L(0); PG8_MMA(1, 0, At, B0); PG8_BAR; PG8_SCHED;
            PG8_STAGE(PG8_SB(0, 1), b2 + hstepB, voffB);
            PG8_WAIT_V(6); PG8_BAR; PG8_MMA(1, 1, At, B1); PG8_BAR;
            PG8_LDB(B0, 1, 0); PG8_SCHED; PG8_LDA(At, 1, 0); PG8_STAGE(PG8_SA(0, 1), a2 + hstepA, voffA);
            PG8_WAIT_L(8); PG8_BAR; PG8_WAIT_L(0); PG8_MMA(0, 0, At, B0); PG8_BAR; PG8_SCHED;
            PG8_LDB(B1, 1, 1); PG8_STAGE(PG8_SB(1, 0), b3, voffB);
            PG8_BAR; PG8_WAIT_L(0); PG8_MMA(0, 1, At, B1); PG8_BAR;
            PG8_LDA(At, 1, 1); PG8_STAGE(PG8_SA(1, 0), a3, voffA);
            PG8_BAR; PG8_WAIT_L(0); PG8_MMA(1, 0, At, B0); PG8_BAR; PG8_SCHED;
            PG8_STAGE(PG8_SB(1, 1), b3 + hstepB, voffB);
            PG8_WAIT_V(6); PG8_BAR; PG8_MMA(1, 1, At, B1); PG8_BAR;
            }
        }
        if constexpr (ALIGN_EPI) { if (wr == 0) PG8_BAR; }
        if constexpr (!Epi::AFTER_DRAIN) { E(acc, cur, wr, wc, fr, fq); S.done(cur); }
        if (!has_next) break;
#pragma unroll
        for (int a = 0; a < 2; ++a)
#pragma unroll
            for (int b = 0; b < 2; ++b)
#pragma unroll
                for (int m = 0; m < 4; ++m)
#pragma unroll
                    for (int n = 0; n < 2; ++n) acc[a][b][m][n] = (f32x4){0.f, 0.f, 0.f, 0.f};
        cur = nxt; cA = nA; cB = nB; ++ui;
        if constexpr (ALIGN_EPI) { if (wr == 1) PG8_BAR; }
    }
    PG8_WAIT_V(0);
    if constexpr (!ALIGN_EPI) { if (wr == 0) PG8_BAR; }
    PG8_BAR;
    if constexpr (Epi::AFTER_DRAIN) { E.fused(acc, cur, wr, wc, fr, fq, lds, wid, lane); S.done(cur); }
#undef PG8_SA
#undef PG8_SB
#undef PG8_STAGE
#undef PG8_LDA
#undef PG8_LDB
#undef PG8_MMA
#undef PG8_WAIT_V
#undef PG8_WAIT_L
#undef PG8_BAR
#undef PG8_SCHED
}
}

constexpr int NWAVES = 8, NTHR = NWAVES * 64;
constexpr int D = 2048, BATCH = 2, SEQ = 8192, ML = BATCH * SEQ, CTXL = 256, MC = BATCH * CTXL, M = ML + MC;
constexpr int FF = 5632, EA = 4096, NH = 16, HDIM = 256, CHUNK = 128, NCHUNK = M / CHUNK;
constexpr int SG = 128, SP = 64, SQ = 16;
constexpr int DEPTH = 4;
constexpr float EPS = 1e-6f;
static_assert(M % 256 == 0 && NCHUNK == 132, "row tiling");

constexpr size_t MiB = 1u << 20;
constexpr size_t WS_CTL = 0, CTL_ZERO_BYTES = 1 * MiB;
constexpr size_t WS_MOD = 1 * MiB;
constexpr size_t WS_S5A = 2 * MiB;
constexpr size_t WS_S5B = 3 * MiB;
constexpr size_t WS_WSB = 11 * MiB;
constexpr size_t WS_VSTAT = 12 * MiB;
constexpr size_t WS_WGIN = 32 * MiB;
constexpr size_t WS_WGOUT = 96 * MiB;
constexpr size_t WS_WF13 = 128 * MiB;
constexpr size_t WS_WF2 = 304 * MiB;
constexpr size_t WS_WSIN = 392 * MiB;
constexpr size_t WS_WGLU = 408 * MiB;
constexpr size_t WS_H = 440 * MiB;
constexpr size_t WS_XN = 572 * MiB;
constexpr size_t WS_BIG = 640 * MiB;
constexpr size_t WS_ZU = WS_BIG, WS_ZV = WS_BIG + 132 * MiB;
constexpr size_t WS_HID = WS_BIG;
constexpr size_t WS_SU = WS_BIG, WS_SZ = WS_BIG + 66 * MiB;
constexpr size_t WS_YF = WS_BIG + 132 * MiB, WS_YB = WS_BIG + 264 * MiB;
constexpr size_t WS_XL = WS_BIG, WS_XC = WS_BIG + 128 * MiB;
constexpr size_t WS_SL = WS_BIG + 132 * MiB, WS_SC = WS_BIG + 196 * MiB;
constexpr size_t WS_SZ2 = WS_BIG + 200 * MiB;
constexpr size_t WS_MOUTT = WS_BIG + 396 * MiB;
constexpr size_t WS_M2T = WS_MOUTT + 64 * MiB;
constexpr size_t WS_A16 = WS_M2T + 32 * MiB;
constexpr size_t WS_SLAB = WS_A16 + 2 * MiB;
constexpr size_t WS_END = WS_SLAB + 44 * MiB;
#ifndef S5_NAIVE
#define S5_NAIVE 0
#endif
constexpr size_t WS_Z = S5_NAIVE ? WS_SZ : WS_SZ2;
constexpr int CW_BAR = 4096;

constexpr int RING_OFF = 0, RING_BYTES = 131072;
constexpr int LDSCTL_OFF = RING_BYTES, MISC_OFF = LDSCTL_OFF + 320;
constexpr int LDS_BYTES = 147456;
static_assert(MISC_OFF + 128 <= LDS_BYTES, "LDS map");

#define GAS __attribute__((address_space(1)))
#define LAS __attribute__((address_space(3)))
typedef unsigned short bf16;
typedef unsigned v4u __attribute__((ext_vector_type(4)));
typedef unsigned v2u __attribute__((ext_vector_type(2)));
typedef float f32x4 __attribute__((ext_vector_type(4)));
typedef float f32x2 __attribute__((ext_vector_type(2)));
typedef float f32x16 __attribute__((ext_vector_type(16)));
typedef short bf16x8 __attribute__((ext_vector_type(8)));
typedef GAS unsigned gu32;
#define RLX_AGENT __ATOMIC_RELAXED, __HIP_MEMORY_SCOPE_AGENT
#define LDS_WAIT() asm volatile("s_waitcnt lgkmcnt(0)" ::: "memory")
__device__ __forceinline__ unsigned f2bf(float f) { unsigned u = __builtin_bit_cast(unsigned, f); return (u + 0x7fffu + ((u >> 16) & 1u)) >> 16; }
__device__ __forceinline__ unsigned pk2(float lo, float hi) { return f2bf(lo) | (f2bf(hi) << 16); }
__device__ __forceinline__ float bf2f(unsigned short b) { return __builtin_bit_cast(float, (unsigned)b << 16); }
__device__ __forceinline__ float wave_sum(float v) {
#pragma unroll
    for (int o = 1; o < 64; o <<= 1) v += __shfl_xor(v, o);
    return v;
}

#define XB_TMO      128
#define XB_XCNT(j)  (256  + 64 * (j))
#define XB_XSUB(j)  (1280 + 64 * (j))
#define XB_XGEN(j)  (2304 + 64 * (j))
#define XB_TOP      3328
#define XB_TOPGEN   3392
#define XCD_BAR_WORDS 3456
#define XB_SPIN_CAP (1u << 18)

__device__ __forceinline__ unsigned xb_ld(unsigned* p)              { return __hip_atomic_load(p, __ATOMIC_RELAXED, __HIP_MEMORY_SCOPE_AGENT); }
__device__ __forceinline__ unsigned xb_add(unsigned* p, unsigned v) { return __hip_atomic_fetch_add(p, v, __ATOMIC_RELAXED, __HIP_MEMORY_SCOPE_AGENT); }
__device__ __forceinline__ unsigned xb_xcc_id() { return (unsigned)__builtin_amdgcn_s_getreg((3 << 11) | 20) & 0xFu; }
#define XB_SPIN(cond, bar) do { unsigned _sp = 0; while (cond) { __builtin_amdgcn_s_sleep(1); \
    if ((++_sp & 255u) == 0u) { if (xb_ld(&(bar)[XB_TMO])) break; if (_sp > XB_SPIN_CAP) { atomicAdd(&(bar)[XB_TMO], 1u); break; } } } } while (0)

struct XcdBarrier {
    unsigned* bar; unsigned x;
    volatile LAS unsigned* st;
};

__device__ __forceinline__ XcdBarrier xcd_barrier_post(unsigned* bar, volatile LAS unsigned* st) {
    XcdBarrier b; b.bar = bar; b.x = xb_xcc_id(); b.st = st;
    if (threadIdx.x == 0) (void)xb_add(&bar[XB_XCNT(b.x)], 1u);
    return b;
}
__device__ __forceinline__ void xcd_barrier_complete(unsigned* bar, unsigned x, unsigned& nloc, unsigned& nx) {
    const unsigned G = gridDim.x * gridDim.y * gridDim.z;
    unsigned sum, cnt, mine, sp = 0u;
    for (;;) {
        sum = 0u; cnt = 0u; mine = 0u;
#pragma unroll
        for (unsigned j = 0; j < 16; ++j) { const unsigned c = xb_ld(&bar[XB_XCNT(j)]); sum += c; cnt += (c > 0u) ? 1u : 0u; mine = (j == x) ? c : mine; }
        if (sum == G) break;
        __builtin_amdgcn_s_sleep(1);
        if ((++sp & 255u) == 0u) { if (xb_ld(&bar[XB_TMO])) break; if (sp > XB_SPIN_CAP) { atomicAdd(&bar[XB_TMO], 1u); break; } }
    }
    nloc = mine > 0u ? mine : 1u; nx = cnt > 0u ? cnt : 1u;
}

__device__ __forceinline__ void xcd_barrier(const XcdBarrier& b) {
    asm volatile("s_waitcnt vmcnt(0)" ::: "memory");
    __syncthreads();
    if (threadIdx.x == 0) {
        unsigned* bar = b.bar;
        __builtin_amdgcn_s_waitcnt(0);
        unsigned nloc = b.st[0], nx = b.st[1];
        if (nloc == 0u) { xcd_barrier_complete(bar, b.x, nloc, nx); b.st[0] = nloc; b.st[1] = nx; }
        const unsigned old = xb_add(&bar[XB_XSUB(b.x)], 1u);
        const unsigned gen = old / nloc;
        if (old + 1u == (gen + 1u) * nloc) {
            __builtin_amdgcn_fence(__ATOMIC_RELEASE, "agent");
            asm volatile("s_waitcnt vmcnt(0)" ::: "memory");
            const unsigned og = xb_add(&bar[XB_TOP], 1u);
            const unsigned tg = og / nx;
            if (og + 1u == (tg + 1u) * nx) xb_add(&bar[XB_TOPGEN], 1u);
            else XB_SPIN(xb_ld(&bar[XB_TOPGEN]) == tg, bar);
            __builtin_amdgcn_fence(__ATOMIC_ACQUIRE, "agent");
            xb_add(&bar[XB_XGEN(b.x)], 1u);
            asm volatile("s_waitcnt vmcnt(0)" ::: "memory");
        } else {
            XB_SPIN(xb_ld(&bar[XB_XGEN(b.x)]) == gen, bar);
            __builtin_amdgcn_fence(__ATOMIC_ACQUIRE, "agent");
            asm volatile("s_waitcnt vmcnt(0)" ::: "memory");
        }
    }
    __syncthreads();
}

struct Args { const float* in[28]; float* out; unsigned char* ws; int ph_lo, ph_hi; };
enum InIdx { I_X = 0, I_C, I_CTX, I_CCTX, I_ADAW, I_ADAB, I_N1G, I_N2G, I_W1, I_W3, I_W2, I_GWIN, I_GLNG, I_GLNB, I_GWS, I_GBS, I_GWOUT,
             I_SWIN, I_SARE, I_SAIM, I_SLDT, I_SBRE, I_SBIM, I_SCRE, I_SCIM, I_SD, I_SWGLU, I_FING };

__device__ __forceinline__ int opaque_tid() { int t = threadIdx.x; asm volatile("" : "+v"(t)); return t; }
#define PHASE_IDS const int tid = opaque_tid(), lane = tid & 63, wave = __builtin_amdgcn_readfirstlane(tid >> 6); (void)tid; (void)lane; (void)wave

__device__ __forceinline__ void adaln_items(const Args& a, LAS unsigned char* lds, int wg, int nwg) {
    PHASE_IDS;
    LAS float* cs = (LAS float*)lds;
    LAS float* red = cs + 3 * 2048;
    const float* c = a.in[I_C]; const float* cc = a.in[I_CCTX];
    for (int i = tid; i < 3 * 2048; i += NTHR) { const int s = i >> 11, k = i & 2047; const float v = s < 2 ? c[s * 2048 + k] : cc[k]; cs[i] = v / (1.0f + expf(-v)); }
    __syncthreads();
    float* MOD = (float*)(a.ws + WS_MOD);
    const int cq = tid & 15, kg = tid >> 4;
    for (int item = wg; item < DEPTH * 192; item += nwg) {
        const int layer = item / 192, n0 = (item % 192) * 64;
        const float* W = a.in[I_ADAW] + (size_t)layer * 2048 * 12288 + n0 + 4 * cq;
        f32x4 a0 = {0.f, 0.f, 0.f, 0.f}, a1 = a0, a2 = a0;
#pragma unroll 8
        for (int k = kg; k < 2048; k += 32) { const f32x4 w = *(const GAS f32x4*)(W + (size_t)k * 12288); a0 += cs[k] * w; a1 += cs[2048 + k] * w; a2 += cs[4096 + k] * w; }
#pragma unroll
        for (int e = 0; e < 4; ++e) { red[(kg * 3 + 0) * 64 + 4 * cq + e] = a0[e]; red[(kg * 3 + 1) * 64 + 4 * cq + e] = a1[e]; red[(kg * 3 + 2) * 64 + 4 * cq + e] = a2[e]; }
        __syncthreads();
        if (tid < 192) { const int s = tid >> 6, col = tid & 63; float t = 0.f;
            for (int g = 0; g < 32; ++g) t += red[(g * 3 + s) * 64 + col];
            MOD[(size_t)(layer * 3 + s) * 12288 + n0 + col] = t + a.in[I_ADAB][layer * 12288 + n0 + col]; }
        __syncthreads();
    }
}
__device__ __forceinline__ void tr_item(const float* W, int ld, int K, int ncols, bf16* WT, int mode, LAS float* scr, int item, int lane) {
    const int nblk = ncols / 32, kb = item / nblk, nb = item % nblk, k0 = 64 * kb, n0 = 32 * nb;
    const int drow0 = mode == 0 ? n0 : (256 * (n0 >> 7) + (n0 & 127) + (mode == 2 ? 128 : 0));
    float tv[32];
#pragma unroll
    for (int i = 0; i < 32; ++i) { const int kk = 2 * i + (lane >> 5); tv[i] = W[(size_t)(k0 + kk) * ld + n0 + (lane & 31)]; }
#pragma unroll
    for (int i = 0; i < 32; ++i) { const int kk = 2 * i + (lane >> 5); scr[kk * 33 + (lane & 31)] = tv[i]; }
    LDS_WAIT(); asm volatile("" ::: "memory");
    const int c = lane & 7;
#pragma unroll
    for (int j = 0; j < 4; ++j) { const int n = (lane >> 3) + 8 * j; const LAS float* s = scr + (8 * c) * 33 + n;
        v4u o; o.x = pk2(s[0 * 33], s[1 * 33]); o.y = pk2(s[2 * 33], s[3 * 33]); o.z = pk2(s[4 * 33], s[5 * 33]); o.w = pk2(s[6 * 33], s[7 * 33]);
        *(GAS v4u*)(WT + (size_t)(drow0 + n) * K + k0 + 8 * c) = o; }
    LDS_WAIT(); asm volatile("" ::: "memory");
}
constexpr int TR_GIN = 2 * 8192, TR_GOUT = 2 * 4096, TR_FFN = 4 * 3 * 5632, TR_SIN = 2 * 2048, TR_GLU = 2 * 2 * 2048, TR_TOTAL = TR_GIN + TR_GOUT + TR_FFN + TR_SIN + TR_GLU;
__device__ __forceinline__ void transpose_items(const Args& a, LAS unsigned char* lds, int vcu, int G) {
    PHASE_IDS; const int gw = vcu * NWAVES + wave, ngw = G * NWAVES;
    LAS float* scr = (LAS float*)(lds + wave * 16384);
    unsigned char* ws = a.ws;
    for (int it0 = gw; it0 < TR_TOTAL; it0 += ngw) {
        int it = it0;
        if (it < TR_GIN) { const int j = it / 8192, r = it % 8192; tr_item(a.in[I_GWIN] + (size_t)j * 2048 * 8192, 8192, 2048, 8192, (bf16*)(ws + WS_WGIN) + (size_t)j * 8192 * 2048, 0, scr, r, lane); continue; } it -= TR_GIN;
        if (it < TR_GOUT) { const int j = it / 4096, r = it % 4096; tr_item(a.in[I_GWOUT] + (size_t)j * 4096 * 2048, 2048, 4096, 2048, (bf16*)(ws + WS_WGOUT) + (size_t)j * 2048 * 4096, 0, scr, r, lane); continue; } it -= TR_GOUT;
        if (it < TR_FFN) { const int i = it / 16896, r = it % 16896, which = r / 5632, rr = r % 5632;
            if (which == 0) tr_item(a.in[I_W1] + (size_t)i * 2048 * 5632, 5632, 2048, 5632, (bf16*)(ws + WS_WF13) + (size_t)i * 11264 * 2048, 1, scr, rr, lane);
            else if (which == 1) tr_item(a.in[I_W3] + (size_t)i * 2048 * 5632, 5632, 2048, 5632, (bf16*)(ws + WS_WF13) + (size_t)i * 11264 * 2048, 2, scr, rr, lane);
            else tr_item(a.in[I_W2] + (size_t)i * 5632 * 2048, 2048, 5632, 2048, (bf16*)(ws + WS_WF2) + (size_t)i * 2048 * 5632, 0, scr, rr, lane);
            continue; } it -= TR_FFN;
        if (it < TR_SIN) { const int j = it / 2048, r = it % 2048; tr_item(a.in[I_SWIN] + (size_t)j * 2048 * 2048, 2048, 2048, 2048, (bf16*)(ws + WS_WSIN) + (size_t)j * 2048 * 2048, 0, scr, r, lane); continue; } it -= TR_SIN;
        { const int j = it / 4096, r = it % 4096, half = r / 2048, rr = r % 2048;
          tr_item(a.in[I_SWGLU] + (size_t)j * 2048 * 4096 + half * 2048, 4096, 2048, 2048, (bf16*)(ws + WS_WGLU) + (size_t)j * 4096 * 2048, 1 + half, scr, rr, lane); }
    }
}
__device__ __forceinline__ void small_prologue(const Args& a, int vcu, int G) {
    PHASE_IDS; const int gtid = vcu * NTHR + tid, ngt = G * NTHR;
    bf16* WSB = (bf16*)(a.ws + WS_WSB);
    for (int i = gtid; i < 2 * 16 * 128 * 128; i += ngt) WSB[i] = (bf16)f2bf(a.in[I_GWS][i]);
    f32x2* S5A = (f32x2*)(a.ws + WS_S5A); f32x2* S5B = (f32x2*)(a.ws + WS_S5B);
    for (int i = gtid; i < 2 * 2 * SG * SP; i += ngt) {
        const int lg = i / SP;
        const float dt = expf(a.in[I_SLDT][lg]), are = a.in[I_SARE][i], aim = a.in[I_SAIM][i];
        const float e = expf(dt * are), th = dt * aim, abr = e * cosf(th), abi = e * sinf(th);
        f32x2 ab; ab.x = abr; ab.y = abi; S5A[i] = ab;
        const float nr = abr - 1.0f, ni = abi, den = 1.0f / (are * are + aim * aim);
        const float cr = (nr * are + ni * aim) * den, ci = (ni * are - nr * aim) * den;
        for (int q = 0; q < SQ; ++q) { const float br = a.in[I_SBRE][(size_t)i * SQ + q], bi = a.in[I_SBIM][(size_t)i * SQ + q];
            f32x2 o; o.x = cr * br - ci * bi; o.y = cr * bi + ci * br; S5B[(size_t)i * SQ + q] = o; }
    }
}

typedef _Float16 h16x8 __attribute__((ext_vector_type(8)));
template <bool INIT> __device__ __forceinline__ void norm_phase(const Args& a, const float* gain, const float* modl  , int which, int vcu, int G, int nslab = 0, const float* sgate = nullptr, int mrows = M) {
    PHASE_IDS; const int gw = vcu * NWAVES + wave, ngw = G * NWAVES;
    _Float16* H = (_Float16*)(a.ws + WS_H); bf16* XN = (bf16*)(a.ws + WS_XN);
    for (int row = gw; row < mrows; row += ngw) {
        const int set = row < ML ? (row >> 13) : 2;
        GAS h16x8* hr = (GAS h16x8*)(H + (size_t)row * D) + lane;
        float v[4][8];
        if (INIT) {
            const float* src = row < ML ? a.in[I_X] + (size_t)row * D : a.in[I_CTX] + (size_t)(row - ML) * D;
            const GAS f32x4* xr = (const GAS f32x4*)src + 2 * lane;
#pragma unroll
            for (int j = 0; j < 4; ++j) { const f32x4 x0 = xr[128 * j], x1 = xr[128 * j + 1];
#pragma unroll
                for (int e = 0; e < 4; ++e) { v[j][e] = x0[e]; v[j][4 + e] = x1[e]; } }
            if (row < ML) {
                const int t = row & (SEQ - 1); const float pr = (float)(t >> 6), pc = (float)(t & 63);
#pragma unroll
                for (int e = 0; e < 8; ++e) { const float om = exp2f(-(float)(8 * lane + e) * (13.287712379549449f / 512.0f)); const float ar = pr * om, ac = pc * om;
                    v[0][e] += sinf(ar); v[1][e] += cosf(ar); v[2][e] += sinf(ac); v[3][e] += cosf(ac); }
            }
        } else {
#pragma unroll
            for (int j = 0; j < 4; ++j) { const h16x8 hv = hr[64 * j];
#pragma unroll
                for (int e = 0; e < 8; ++e) v[j][e] = (float)hv[e]; }
            if (nslab > 0 && row >= ML) {
                const GAS f32x4* sp = (const GAS f32x4*)((const float*)(a.ws + WS_SLAB) + (size_t)(row - ML) * D) + 2 * lane; const GAS f32x4* gp2 = (const GAS f32x4*)sgate + 2 * lane;
                f32x4 t[4][2];
#pragma unroll
                for (int j = 0; j < 4; ++j) { t[j][0] = sp[128 * j]; t[j][1] = sp[128 * j + 1]; }
                for (int s = 1; s < nslab; ++s) {
#pragma unroll
                    for (int j = 0; j < 4; ++j) { t[j][0] += sp[(size_t)s * (512 * D / 4) + 128 * j]; t[j][1] += sp[(size_t)s * (512 * D / 4) + 128 * j + 1]; } }
#pragma unroll
                for (int j = 0; j < 4; ++j) { const f32x4 g0 = gp2[128 * j], g1 = gp2[128 * j + 1];
#pragma unroll
                    for (int e = 0; e < 4; ++e) { v[j][e] += g0[e] * t[j][0][e]; v[j][4 + e] += g1[e] * t[j][1][e]; } }
            }
        }
        if (INIT || (nslab > 0 && row >= ML)) {
#pragma unroll
            for (int j = 0; j < 4; ++j) { h16x8 hv;
#pragma unroll
                for (int e = 0; e < 8; ++e) { hv[e] = (_Float16)v[j][e]; v[j][e] = (float)hv[e]; }
                hr[64 * j] = hv; }
        }
        float ss = 0.f;
#pragma unroll
        for (int j = 0; j < 4; ++j)
#pragma unroll
            for (int e = 0; e < 8; ++e) ss += v[j][e] * v[j][e];
        const float rinv = 1.0f / sqrtf(wave_sum(ss) * (1.0f / D) + EPS);
        const GAS f32x4* gp = (const GAS f32x4*)gain + 2 * lane;
        const GAS f32x4* shp = (const GAS f32x4*)(modl + (size_t)set * 12288 + (which * 3 + 0) * D) + 2 * lane;
        const GAS f32x4* scp = (const GAS f32x4*)(modl + (size_t)set * 12288 + (which * 3 + 1) * D) + 2 * lane;
        GAS v4u* o16 = (GAS v4u*)(XN + (size_t)row * D) + lane;
#pragma unroll
        for (int j = 0; j < 4; ++j) { float y[8];
#pragma unroll
            for (int hlf = 0; hlf < 2; ++hlf) { const f32x4 g = gp[128 * j + hlf], sh = shp[128 * j + hlf], sc = scp[128 * j + hlf];
#pragma unroll
                for (int e = 0; e < 4; ++e) y[4 * hlf + e] = v[j][4 * hlf + e] * rinv * g[e] * (1.0f + sc[e]) + sh[e]; }
            v4u o; o.x = pk2(y[0], y[1]); o.y = pk2(y[2], y[3]); o.z = pk2(y[4], y[5]); o.w = pk2(y[6], y[7]); o16[64 * j] = o; }
    }
}
__device__ __forceinline__ void final_phase(const Args& a, int vcu, int G) {
    PHASE_IDS; const int gw = vcu * NWAVES + wave, ngw = G * NWAVES;
    const _Float16* H = (const _Float16*)(a.ws + WS_H);
    for (int row = gw; row < ML; row += ngw) {
        const GAS h16x8* hr = (const GAS h16x8*)(H + (size_t)row * D) + lane;
        float v[4][8]; float ss = 0.f;
#pragma unroll
        for (int j = 0; j < 4; ++j) { const h16x8 hv = hr[64 * j];
#pragma unroll
            for (int e = 0; e < 8; ++e) { v[j][e] = (float)hv[e]; ss += v[j][e] * v[j][e]; } }
        const float rinv = 1.0f / sqrtf(wave_sum(ss) * (1.0f / D) + EPS);
        const GAS f32x4* gp = (const GAS f32x4*)a.in[I_FING] + 2 * lane;
        GAS f32x4* o = (GAS f32x4*)(a.out + (size_t)row * D) + 2 * lane;
#pragma unroll
        for (int j = 0; j < 4; ++j)
#pragma unroll
            for (int hlf = 0; hlf < 2; ++hlf) { const f32x4 g = gp[128 * j + hlf]; f32x4 r;
#pragma unroll
                for (int e = 0; e < 4; ++e) r[e] = v[j][4 * hlf + e] * rinv * g[e];
                o[128 * j + hlf] = r; }
    }
}

__device__ __forceinline__ void sgu_phase(const Args& a, int gl  , LAS unsigned char* lds, int wg, int nwg, int dry) {
    PHASE_IDS;
    bf16* ZU = (bf16*)(a.ws + WS_ZU); const bf16* ZV = (const bf16*)(a.ws + WS_ZV); const float* VSTAT = (const float*)(a.ws + WS_VSTAT);
    const bf16* WSB = (const bf16*)(a.ws + WS_WSB) + (size_t)gl * 16 * 128 * 128;
    const float* bs = a.in[I_GBS] + gl * 16 * 128; const float* lng = a.in[I_GLNG] + gl * EA; const float* lnb = a.in[I_GLNB] + gl * EA;
    LAS f32x2* st = (LAS f32x2*)lds;
    const int n = lane & 31, h = lane >> 5;
    for (int unit = wg; unit < NCHUNK * NH; unit += nwg) {
        const int c = unit / NH, hd = unit % NH, r0 = c * CHUNK;
        { const int j = tid >> 2, part = tid & 3; const GAS f32x4* p = (const GAS f32x4*)(VSTAT + ((size_t)(r0 + j) * 64 + part * 16) * 2);
          float s = 0.f, ss = 0.f;
#pragma unroll
          for (int q = 0; q < 8; ++q) { const f32x4 w = p[q]; s += w.x + w.z; ss += w.y + w.w; }
          s += __shfl_xor(s, 1); s += __shfl_xor(s, 2); ss += __shfl_xor(ss, 1); ss += __shfl_xor(ss, 2);
          if (part == 0) { const float mean = s * (1.0f / EA), var = ss * (1.0f / EA) - mean * mean; f32x2 o; o.x = mean; o.y = 1.0f / sqrtf(var + EPS); st[j] = o; } }
        __syncthreads();
        const int gcol = hd * HDIM + 32 * wave + n;
        const float lg = lng[gcol], lb = lnb[gcol];
        const GAS bf16* vp = (const GAS bf16*)ZV + (size_t)r0 * EA + gcol;
        unsigned short raw[8][8];
#pragma unroll
        for (int ks = 0; ks < 8; ++ks)
#pragma unroll
            for (int e = 0; e < 8; ++e) raw[ks][e] = vp[(size_t)(16 * ks + 8 * h + e) * EA];
        bf16x8 Bf[8];
#pragma unroll
        for (int ks = 0; ks < 8; ++ks) { float f[8];
#pragma unroll
            for (int e = 0; e < 8; ++e) { const f32x2 m = st[16 * ks + 8 * h + e]; f[e] = (bf2f(raw[ks][e]) - m.x) * m.y * lg + lb; }
            v4u w; w.x = pk2(f[0], f[1]); w.y = pk2(f[2], f[3]); w.z = pk2(f[4], f[5]); w.w = pk2(f[6], f[7]); Bf[ks] = __builtin_bit_cast(bf16x8, w); }
#pragma unroll 1
        for (int ib = 0; ib < 4; ++ib) {
            f32x16 acc;
#pragma unroll
            for (int r = 0; r < 16; ++r) acc[r] = 0.f;
            const GAS bf16x8* ap = (const GAS bf16x8*)(WSB + ((size_t)hd * 128 + 32 * ib + n) * 128 + 8 * h);
#pragma unroll
            for (int ks = 0; ks < 8; ++ks) { const bf16x8 Af = ap[2 * ks]; acc = __builtin_amdgcn_mfma_f32_32x32x16_bf16(Af, Bf[ks], acc, 0, 0, 0); }
#pragma unroll
            for (int r = 0; r < 16; ++r) { const int i = 32 * ib + (r & 3) + 8 * (r >> 2) + 4 * h; const float s = acc[r] + bs[hd * 128 + i];
                GAS bf16* up = (GAS bf16*)ZU + (size_t)(r0 + i) * EA + gcol; const bf16 nv = (bf16)f2bf(bf2f(*up) * s); if (!dry) *up = nv; }
        }
        __syncthreads();
    }
}

__device__ __forceinline__ void s5_naive_phase(const Args& a, int sl  , int wg, int nwg) {
    PHASE_IDS;
    if (wave >= 2) return;
    const bf16* U = (const bf16*)(a.ws + WS_SU);
    for (int item = wg * 2 + wave; item < 2 * 2 * SG; item += nwg * 2) {
        const int b = item & 1, k = (item >> 1) & 1, g = item >> 2;
        const int pg = ((sl * 2 + k) * SG + g);
        const f32x2 ab = ((const f32x2*)(a.ws + WS_S5A))[(size_t)pg * SP + lane];
        float bre[16], bim[16], cr[16], ci[16];
#pragma unroll
        for (int q = 0; q < 16; ++q) { const f32x2 bb = ((const f32x2*)(a.ws + WS_S5B))[((size_t)pg * SP + lane) * SQ + q]; bre[q] = bb.x; bim[q] = bb.y;
            cr[q] = a.in[I_SCRE][((size_t)pg * SQ + q) * SP + lane]; ci[q] = a.in[I_SCIM][((size_t)pg * SQ + q) * SP + lane]; }
        float* Y = (float*)(a.ws + (k ? WS_YB : WS_YF));
        float hr = 0.f, hi = 0.f;
#pragma unroll 1
        for (int seg = 0; seg < 2; ++seg) {
            const int L = seg ? SEQ : CTXL, base = seg ? b * SEQ : ML + b * CTXL;
#pragma unroll 1
            for (int blk = 0; blk < L; blk += 64) {
                const int myt = k ? (L - 1 - (blk + lane)) : (blk + lane);
                const size_t row = (size_t)(base + myt);
                const GAS v4u* up = (const GAS v4u*)(U + row * D + 16 * g);
                const v4u u0 = up[0], u1 = up[1];
                float keep[16];
#pragma unroll
                for (int q = 0; q < 16; ++q) keep[q] = 0.f;
#pragma unroll 1
                for (int s = 0; s < 64; ++s) {
                    unsigned w[8];
                    w[0] = __builtin_amdgcn_readlane(u0.x, s); w[1] = __builtin_amdgcn_readlane(u0.y, s); w[2] = __builtin_amdgcn_readlane(u0.z, s); w[3] = __builtin_amdgcn_readlane(u0.w, s);
                    w[4] = __builtin_amdgcn_readlane(u1.x, s); w[5] = __builtin_amdgcn_readlane(u1.y, s); w[6] = __builtin_amdgcn_readlane(u1.z, s); w[7] = __builtin_amdgcn_readlane(u1.w, s);
                    float br = 0.f, bi = 0.f;
#pragma unroll
                    for (int q2 = 0; q2 < 8; ++q2) { const float ulo = __builtin_bit_cast(float, w[q2] << 16), uhi = __builtin_bit_cast(float, w[q2] & 0xffff0000u);
                        br += bre[2 * q2] * ulo + bre[2 * q2 + 1] * uhi; bi += bim[2 * q2] * ulo + bim[2 * q2 + 1] * uhi; }
                    const float nhr = ab.x * hr - ab.y * hi + br, nhi = ab.x * hi + ab.y * hr + bi; hr = nhr; hi = nhi;
#pragma unroll
                    for (int q = 0; q < 16; ++q) { const float y = wave_sum(cr[q] * hr - ci[q] * hi); keep[q] = (lane == s) ? y : keep[q]; }
                }
                GAS f32x4* yp = (GAS f32x4*)(Y + row * D + 16 * g);
#pragma unroll
                for (int q4 = 0; q4 < 4; ++q4) { f32x4 o; o.x = keep[4 * q4]; o.y = keep[4 * q4 + 1]; o.z = keep[4 * q4 + 2]; o.w = keep[4 * q4 + 3]; yp[q4] = o; }
            }
        }
    }
}
__device__ __forceinline__ void s5_combine_phase(const Args& a, int sl, int vcu, int G) {
    PHASE_IDS; const int gw = vcu * NWAVES + wave, ngw = G * NWAVES;
    const float* YF = (const float*)(a.ws + WS_YF); const float* YB = (const float*)(a.ws + WS_YB); const bf16* U = (const bf16*)(a.ws + WS_SU); bf16* Z = (bf16*)(a.ws + WS_SZ);
    const GAS f32x4* dp = (const GAS f32x4*)(a.in[I_SD] + sl * D) + lane;
    for (int row = gw; row < M; row += ngw) {
        const GAS f32x4* yf = (const GAS f32x4*)(YF + (size_t)row * D) + lane; const GAS f32x4* yb = (const GAS f32x4*)(YB + (size_t)row * D) + lane;
        const GAS v2u* up = (const GAS v2u*)(U + (size_t)row * D) + lane; GAS v2u* zp = (GAS v2u*)(Z + (size_t)row * D) + lane;
#pragma unroll
        for (int j = 0; j < 8; ++j) { const f32x4 f = yf[64 * j], bk = yb[64 * j], dd = dp[64 * j]; const v2u uu = up[64 * j];
            f32x4 u4; u4.x = __builtin_bit_cast(float, uu.x << 16); u4.y = __builtin_bit_cast(float, uu.x & 0xffff0000u); u4.z = __builtin_bit_cast(float, uu.y << 16); u4.w = __builtin_bit_cast(float, uu.y & 0xffff0000u);
            const f32x4 y = f + bk + u4 * dd;
            v2u o; o.x = pk2(pg8::gelu_tanh_f(y.x), pg8::gelu_tanh_f(y.y)); o.y = pk2(pg8::gelu_tanh_f(y.z), pg8::gelu_tanh_f(y.w)); zp[64 * j] = o; }
    }
}

__device__ __forceinline__ f32x2 cmul(f32x2 a, f32x2 b) { f32x2 r; r.x = a.x * b.x - a.y * b.y; r.y = a.x * b.y + a.y * b.x; return r; }
__device__ __forceinline__ void s5_precompute(const Args& a, LAS unsigned char* lds, int wg, int nwg) {
    PHASE_IDS;
    LAS f32x2* apw = (LAS f32x2*)lds;
    LAS f32x2* bbl = apw + 2 * 17 * 64;
    LAS f32x2* ccl = bbl + 2 * 64 * 16;
    LAS float* ktab = (LAS float*)(ccl + 2 * 16 * 64);
    for (int item = wg; item < 2 * SG; item += nwg) {
        const int sl = item >> 7, g = item & 127;
        if (tid < 128) { const int d = tid >> 6, p = tid & 63, pg = (sl * 2 + d) * SG + g, i = pg * SP + p;
            const float dt = expf(a.in[I_SLDT][pg]), are = a.in[I_SARE][i], aim = a.in[I_SAIM][i];
            for (int l = 0; l <= 16; ++l) { const float e = expf((float)l * (dt * are)), th = (float)l * (dt * aim); f32x2 o; o.x = e * cosf(th); o.y = e * sinf(th); apw[(d * 17 + l) * 64 + p] = o; }
            const f32x2 ab = apw[(d * 17 + 1) * 64 + p];
            const float nr = ab.x - 1.0f, ni = ab.y, den = 1.0f / (are * are + aim * aim);
            f32x2 coef; coef.x = (nr * are + ni * aim) * den; coef.y = (ni * are - nr * aim) * den;
            for (int q = 0; q < SQ; ++q) { f32x2 bq; bq.x = a.in[I_SBRE][(size_t)i * SQ + q]; bq.y = a.in[I_SBIM][(size_t)i * SQ + q]; bbl[(d * 64 + p) * 16 + q] = cmul(coef, bq); }
            ((f32x2*)(a.ws + WS_A16))[i] = apw[(d * 17 + 16) * 64 + p]; }
        for (int e = tid; e < 2 * 16 * 64; e += NTHR) { const int d = e >> 10, q = (e >> 6) & 15, p = e & 63; const size_t ci = ((size_t)((sl * 2 + d) * SG + g) * SQ + q) * SP + p;
            f32x2 o; o.x = a.in[I_SCRE][ci]; o.y = a.in[I_SCIM][ci]; ccl[e] = o; }
        __syncthreads();
        for (int o = tid; o < 8192; o += NTHR) { const int d = o >> 12, l = (o >> 8) & 15, q = (o >> 4) & 15, qp = o & 15; float acc = 0.f;
            for (int p = 0; p < 64; ++p) { const f32x2 ca = cmul(ccl[(d * 16 + q) * 64 + p], apw[(d * 17 + l) * 64 + p]), bb = bbl[(d * 64 + p) * 16 + qp]; acc += ca.x * bb.x - ca.y * bb.y; }
            ktab[o] = acc; }
        __syncthreads();
        bf16* MoutT = (bf16*)(a.ws + WS_MOUTT) + (size_t)(sl * SG + g) * 256 * 512;
        bf16* M2T = (bf16*)(a.ws + WS_M2T) + (size_t)(sl * SG + g) * 256 * 256;
        for (int ch = tid; ch < 256 * 64; ch += NTHR) { const int n = ch >> 6, jj = ch & 63, t = n >> 4, q = n & 15; float v[8];
            if (jj < 32) { const int s = jj >> 1, q0 = 8 * (jj & 1);
#pragma unroll
                for (int e = 0; e < 8; ++e) { const int qp = q0 + e;
                    v[e] = s < t ? ktab[((0 * 16 + (t - s)) * 16 + q) * 16 + qp] : (s > t ? ktab[((1 * 16 + (s - t)) * 16 + q) * 16 + qp]
                         : ktab[(0 * 16 * 16 + q) * 16 + qp] + ktab[((16) * 16 + q) * 16 + qp] + (q == qp ? a.in[I_SD][sl * D + 16 * g + q] : 0.f)); }
            } else { const int j2 = jj - 32, d = j2 >> 4, p0 = (j2 & 15) * 4, ex = d == 0 ? t + 1 : 16 - t;
#pragma unroll
                for (int pp = 0; pp < 4; ++pp) { const f32x2 ca = cmul(ccl[(d * 16 + q) * 64 + p0 + pp], apw[(d * 17 + ex) * 64 + p0 + pp]); v[2 * pp] = ca.x; v[2 * pp + 1] = -ca.y; } }
            v4u w; w.x = pk2(v[0], v[1]); w.y = pk2(v[2], v[3]); w.z = pk2(v[4], v[5]); w.w = pk2(v[6], v[7]);
            *(GAS v4u*)(MoutT + (size_t)n * 512 + 8 * jj) = w; }
        for (int ch = tid; ch < 256 * 32; ch += NTHR) { const int n = ch >> 5, jj = ch & 31, d = n >> 7, p = (n & 127) >> 1, im = n & 1, s = jj >> 1, q0 = 8 * (jj & 1), ex = d == 0 ? 15 - s : s; float v[8];
            const f32x2 ap = apw[(d * 17 + ex) * 64 + p];
#pragma unroll
            for (int e = 0; e < 8; ++e) { const f32x2 r = cmul(ap, bbl[(d * 64 + p) * 16 + q0 + e]); v[e] = im ? r.y : r.x; }
            v4u w; w.x = pk2(v[0], v[1]); w.y = pk2(v[2], v[3]); w.z = pk2(v[4], v[5]); w.w = pk2(v[6], v[7]);
            *(GAS v4u*)(M2T + (size_t)n * 256 + 8 * jj) = w; }
        __syncthreads();
    }
}
template <bool OUT> __device__ __forceinline__ void s5_ctx_gemm(const Args& a, int sl, int wg, int nwg) {
    PHASE_IDS;
    constexpr int K = OUT ? 512 : 256;
    const int r = lane & 31, hh = lane >> 5;
    for (int g = wg; g < SG; g += nwg) {
        const GAS bf16x8* ap = (const GAS bf16x8*)((const bf16*)(a.ws + WS_XC) + (size_t)(g * 32 + r) * 512 + 8 * hh);
        const bf16* Bt = OUT ? (const bf16*)(a.ws + WS_MOUTT) + (size_t)(sl * SG + g) * 256 * 512 : (const bf16*)(a.ws + WS_M2T) + (size_t)(sl * SG + g) * 256 * 256;
        const GAS bf16x8* bp = (const GAS bf16x8*)(Bt + (size_t)(32 * wave + r) * K + 8 * hh);
        f32x16 acc;
#pragma unroll
        for (int i = 0; i < 16; ++i) acc[i] = 0.f;
#pragma unroll 8
        for (int ks = 0; ks < K / 16; ++ks) acc = __builtin_amdgcn_mfma_f32_32x32x16_bf16(ap[2 * ks], bp[2 * ks], acc, 0, 0, 0);
        const int n = 32 * wave + r;
#pragma unroll
        for (int i = 0; i < 16; ++i) { const int c = (i & 3) + 8 * (i >> 2) + 4 * hh;
            if (OUT) { const int t = n >> 4, q = n & 15; ((GAS bf16*)(a.ws + WS_Z))[(size_t)(ML + 16 * c + t) * D + 16 * g + q] = (bf16)f2bf(pg8::gelu_tanh_f(acc[i])); }
            else ((GAS bf16*)(a.ws + WS_SC))[(size_t)(g * 32 + c) * 256 + n] = (bf16)f2bf(acc[i]); }
    }
}
__device__ __forceinline__ void s5_carry_phase(const Args& a, int sl, LAS unsigned char* lds, int wg, int nwg) {
    PHASE_IDS;
    LAS f32x2* EX = (LAS f32x2*)lds;
    const int seg = wave;
    for (int item = wg; item < 2 * 2 * SG; item += nwg) {
        const int b = item & 1, d = (item >> 1) & 1, g = item >> 2;
        const f32x2 a16 = ((const f32x2*)(a.ws + WS_A16))[(size_t)((sl * 2 + d) * SG + g) * SP + lane];
        const int c0 = d ? 511 - seg * 64 : seg * 64;
        const long sst = d ? -128 : 128, xst = d ? -256 : 256;
        const GAS unsigned* sp = (const GAS unsigned*)(a.ws + WS_SL) + (size_t)(g * 1024 + b * 512 + c0) * 128 + d * 64 + lane;
        GAS unsigned* xp = (GAS unsigned*)(a.ws + WS_XL) + (size_t)(g * 1024 + b * 512 + c0) * 256 + 128 + d * 64 + lane;
        unsigned sw[64];
#pragma unroll
        for (int j = 0; j < 64; ++j) { sw[j] = *sp; sp += sst; asm volatile("" : "+v"(sp)); }
        float hr = 0.f, hi = 0.f;
#define S5_STEP(word) do { const float sr = __builtin_bit_cast(float, (word) << 16), si = __builtin_bit_cast(float, (word) & 0xffff0000u); \
            const float nr = a16.x * hr - a16.y * hi + sr, ni = a16.x * hi + a16.y * hr + si; hr = nr; hi = ni; } while (0)
        if (seg == 0) {
            const int cc0 = d ? 15 : 0;
            const GAS unsigned* cp = (const GAS unsigned*)(a.ws + WS_SC) + (size_t)(g * 32 + b * 16 + cc0) * 128 + d * 64 + lane;
            GAS unsigned* xcp = (GAS unsigned*)(a.ws + WS_XC) + (size_t)(g * 32 + b * 16 + cc0) * 256 + 128 + d * 64 + lane;
            unsigned cw[16];
#pragma unroll
            for (int j = 0; j < 16; ++j) { cw[j] = *cp; cp += sst; asm volatile("" : "+v"(cp)); }
#pragma unroll
            for (int j = 0; j < 16; ++j) { *xcp = pk2(hr, hi); xcp += xst; asm volatile("" : "+v"(xcp)); S5_STEP(cw[j]); }
#pragma unroll
            for (int j = 0; j < 64; ++j) { *xp = pk2(hr, hi); xp += xst; asm volatile("" : "+v"(xp)); S5_STEP(sw[j]); }
        } else {
#pragma unroll
            for (int j = 0; j < 64; ++j) S5_STEP(sw[j]);
        }
        { f32x2 o; o.x = hr; o.y = hi; EX[seg * 64 + lane] = o; }
        __syncthreads();
        if (seg != 0) {
            f32x2 P = a16;
#pragma unroll
            for (int q = 0; q < 6; ++q) P = cmul(P, P);
            f32x2 F = EX[lane];
            for (int k = 1; k < seg; ++k) { const f32x2 E = EX[k * 64 + lane]; const f32x2 pf = cmul(P, F); F.x = pf.x + E.x; F.y = pf.y + E.y; }
            hr = F.x; hi = F.y;
#pragma unroll
            for (int j = 0; j < 64; ++j) { *xp = pk2(hr, hi); xp += xst; asm volatile("" : "+v"(xp)); S5_STEP(sw[j]); }
        }
#undef S5_STEP
        __syncthreads();
    }
}
__device__ __forceinline__ void probe_flush(const Args& a, int vcu, int G) {
    PHASE_IDS; const int gt = vcu * NTHR + tid, ngt = G * NTHR;
    const GAS f32x4* p1 = (const GAS f32x4*)a.in[I_W1]; const GAS f32x4* p3 = (const GAS f32x4*)a.in[I_W3];
    f32x4 s = {0.f, 0.f, 0.f, 0.f};
    const int n4 = 4 * 2048 * 5632 / 4;
#pragma unroll 8
    for (int i = gt; i < n4; i += ngt) { s += p1[i]; s += p3[i]; }
    if (s.x + s.y + s.z + s.w == 1.2345e30f) ((float*)(a.ws + WS_CTL))[1000 + (tid & 7)] = s.x;
    __syncthreads();
}

#ifndef GEMM_ALIGN
#define GEMM_ALIGN true
#endif
#ifndef GEMM_SP2
#define GEMM_SP2 true
#endif
#ifndef MK_ONE_LAUNCH
#define MK_ONE_LAUNCH 1
#endif
constexpr int N_PHASES = 2 + 2 * 16;

__global__ void __launch_bounds__(NTHR, 2) fwd_kernel(Args args) {
    extern __shared__ __attribute__((aligned(16))) unsigned char lds_raw[];
    LAS unsigned char* lds = (LAS unsigned char*)lds_raw;
    const int tid = threadIdx.x;
    const int G = gridDim.x, bx = blockIdx.x;
    const int vcu = (G % 8 == 0) ? (bx % 8) * (G / 8) + bx / 8 : bx;
    unsigned char* ws = args.ws;
    volatile LAS unsigned* MISC = (volatile LAS unsigned*)(lds + MISC_OFF);
    for (int u = tid; u < (LDS_BYTES - LDSCTL_OFF) / 4; u += NTHR) ((LAS unsigned*)(lds + LDSCTL_OFF))[u] = 0u;
    __syncthreads();
    const int lo = args.ph_lo, hi = args.ph_hi;
    XcdBarrier bar; bar.bar = (unsigned*)(ws + WS_CTL) + CW_BAR; bar.x = 0; bar.st = nullptr;
    if (hi - lo > 1) bar = xcd_barrier_post((unsigned*)(ws + WS_CTL) + CW_BAR, MISC + 8);
#define RUN(k) (lo <= (k) && (k) < hi)
#ifndef PROBE_MASK
#define PROBE_MASK 0
#endif
#define REP(kind) for (int rep = 0, nrep = 1 + ((PROBE_MASK >> (kind)) & 1); rep < nrep; ++rep)
#ifndef PROBE_WET
#define PROBE_WET 0
#endif
#define GATE(p) ((PROBE_WET && rep) ? (const float*)(ws + WS_CTL + 512 * 1024) : (p))
#define DRY (PROBE_WET ? 0 : rep)
#ifndef PROBE_FLUSH
#define PROBE_FLUSH 0
#endif
#define REPSYNC() do { if (rep + 1 < nrep) { __syncthreads(); if (PROBE_FLUSH == 1) probe_flush(args, vcu, G); } else if (PROBE_FLUSH == 2) { __syncthreads(); probe_flush(args, vcu, G); } } while (0)
#define SEAM(k) do { if (RUN(k) && RUN((k) + 1)) { xcd_barrier(bar); if ((PROBE_MASK >> 12) & 1) xcd_barrier(bar); } } while (0)
    _Float16* H = (_Float16*)(ws + WS_H); pg8::bf16_t* XN = (pg8::bf16_t*)(ws + WS_XN);
    const float* MOD = (const float*)(ws + WS_MOD);

#ifndef NO_PRO
    if (RUN(0)) REP(0) {
        adaln_items(args, lds, vcu, G);
        transpose_items(args, lds, vcu, G);
        small_prologue(args, vcu, G);
#if !S5_NAIVE
        __syncthreads();
        s5_precompute(args, lds, vcu, G);
#endif
        REPSYNC();
    }
#endif
    SEAM(0);
    if (RUN(1)) REP(1) norm_phase<true>(args, args.in[I_N1G], MOD, 0, vcu, G);
    SEAM(1);

#ifdef UNROLL_LP
#pragma unroll
#else
#pragma unroll 1
#endif
    for (int lp = 0; lp < 2; ++lp) {
        const int pb = 2 + lp * 16;
        {
            const int layer = 2 * lp; const float* modl = MOD + (size_t)layer * 3 * 12288;
            if (RUN(pb + 0)) { REP(2) {
                pg8::Gemm g{XN, (const pg8::bf16_t*)(ws + WS_WGIN) + (size_t)lp * 8192 * 2048, M, 8192, D}; pg8::StaticOrder S; S.init(M, 8192, G, bx);
                pg8::EpiG1 E{(pg8::bf16_t*)(ws + WS_ZU), (pg8::bf16_t*)(ws + WS_ZV), (float*)(ws + WS_VSTAT), 0};
                pg8::gemm_phase<pg8::EpiG1, pg8::StaticOrder, GEMM_ALIGN, GEMM_SP2>(lds + RING_OFF, g, S, E);
                REPSYNC(); }
            }
            SEAM(pb + 0);
            #ifndef NO_SGU
            if (RUN(pb + 1)) REP(3) sgu_phase(args, lp, lds, bx, G, rep);
#endif
            SEAM(pb + 1);
            if (RUN(pb + 2)) { REP(4) {
                pg8::Gemm g{(const pg8::bf16_t*)(ws + WS_ZU), (const pg8::bf16_t*)(ws + WS_WGOUT) + (size_t)lp * 2048 * 4096, ML, D, EA}; pg8::StaticOrder S; S.init(ML, D, G, bx);
                pg8::EpiResid E{H, GATE(modl + 2 * D), DRY};
                pg8::gemm_phase<pg8::EpiResid, pg8::StaticOrder, GEMM_ALIGN, GEMM_SP2>(lds + RING_OFF, g, S, E);
                __syncthreads();
                pg8::Gemm gc{(const pg8::bf16_t*)(ws + WS_ZU), (const pg8::bf16_t*)(ws + WS_WGOUT) + (size_t)lp * 2048 * 4096, M, D, 512, EA, EA}; pg8::SliceOrder SS; SS.init(G, bx, 8, 512);
                pg8::EpiSlab ES{(float*)(ws + WS_SLAB), 1024};
                pg8::gemm_phase<pg8::EpiSlab, pg8::SliceOrder, GEMM_ALIGN, GEMM_SP2>(lds + RING_OFF, gc, SS, ES);
                REPSYNC(); }
            }
            SEAM(pb + 2);
            if (RUN(pb + 3)) REP(1) norm_phase<false>(args, args.in[I_N2G] + layer * D, modl, 1, vcu, G, rep ? 0 : 8, modl + 2 * 12288 + 2 * D);
            SEAM(pb + 3);
            if (RUN(pb + 4)) { REP(5) {
                pg8::Gemm g{XN, (const pg8::bf16_t*)(ws + WS_WF13) + (size_t)layer * 11264 * 2048, M, 2 * FF, D}; pg8::StaticOrder S; S.init(M, 2 * FF, G, bx);
                pg8::EpiSwiGLU E{(pg8::bf16_t*)(ws + WS_HID)};
                pg8::gemm_phase<pg8::EpiSwiGLU, pg8::StaticOrder, GEMM_ALIGN, GEMM_SP2>(lds + RING_OFF, g, S, E);
                REPSYNC(); }
            }
            SEAM(pb + 4);
            if (RUN(pb + 5)) { REP(6) {
                pg8::Gemm g{(const pg8::bf16_t*)(ws + WS_HID), (const pg8::bf16_t*)(ws + WS_WF2) + (size_t)layer * 2048 * 5632, ML, D, FF}; pg8::StaticOrder S; S.init(ML, D, G, bx);
                pg8::EpiResid E{H, GATE(modl + 5 * D), DRY};
                pg8::gemm_phase<pg8::EpiResid, pg8::StaticOrder, GEMM_ALIGN, GEMM_SP2>(lds + RING_OFF, g, S, E);
                if (true) { __syncthreads();
                pg8::Gemm gc{(const pg8::bf16_t*)(ws + WS_HID), (const pg8::bf16_t*)(ws + WS_WF2) + (size_t)layer * 2048 * 5632, M, D, 512, FF, FF}; pg8::SliceOrder SS; SS.init(G, bx, 11, 512);
                pg8::EpiSlab ES{(float*)(ws + WS_SLAB), 1024};
                pg8::gemm_phase<pg8::EpiSlab, pg8::SliceOrder, GEMM_ALIGN, GEMM_SP2>(lds + RING_OFF, gc, SS, ES); }
                REPSYNC(); }
            }
            SEAM(pb + 5);
            if (RUN(pb + 6)) REP(1) norm_phase<false>(args, args.in[I_N1G] + (layer + 1) * D, modl + 3 * 12288, 0, vcu, G, rep ? 0 : 11, modl + 2 * 12288 + 5 * D);
            SEAM(pb + 6);
        }
        {
            const int layer = 2 * lp + 1; const float* modl = MOD + (size_t)layer * 3 * 12288; const int ps = pb + 7;
            const int Mrows = lp == 0 ? M : ML;
#if S5_NAIVE
            if (RUN(ps + 0)) {
                pg8::Gemm g{XN, (const pg8::bf16_t*)(ws + WS_WSIN) + (size_t)lp * 2048 * 2048, M, D, D}; pg8::StaticOrder S; S.init(M, D, G, bx);
                pg8::EpiPlainBf16 E{(pg8::bf16_t*)(ws + WS_SU), D};
                pg8::gemm_phase<pg8::EpiPlainBf16, pg8::StaticOrder, GEMM_ALIGN, GEMM_SP2>(lds + RING_OFF, g, S, E);
            }
            SEAM(ps + 0);
            if (RUN(ps + 1)) s5_naive_phase(args, lp, bx, G);
            SEAM(ps + 1);
            if (RUN(ps + 2)) s5_combine_phase(args, lp, vcu, G);
            SEAM(ps + 2);
            SEAM(ps + 3);
#else
            if (RUN(ps + 0)) { REP(7) {
                pg8::Gemm g{XN, (const pg8::bf16_t*)(ws + WS_WSIN) + (size_t)lp * 2048 * 2048, M, D, D}; pg8::StaticOrder S; S.init(M, D, G, bx);
                pg8::EpiS5In E{(pg8::bf16_t*)(ws + WS_XL), (pg8::bf16_t*)(ws + WS_XC)};
                pg8::gemm_phase<pg8::EpiS5In, pg8::StaticOrder, GEMM_ALIGN, GEMM_SP2>(lds + RING_OFF, g, S, E);
                REPSYNC(); }
            }
            SEAM(ps + 0);
            if (RUN(ps + 1)) { REP(8) {
                pg8::Gemm g{(const pg8::bf16_t*)(ws + WS_XL), (const pg8::bf16_t*)(ws + WS_M2T) + (size_t)lp * SG * 256 * 256, SG * 1024, 256, 256, 512}; pg8::GroupOrder S; S.init(G, vcu);
                pg8::EpiS5State E{(pg8::bf16_t*)(ws + WS_SL)};
                pg8::gemm_phase<pg8::EpiS5State, pg8::GroupOrder, GEMM_ALIGN, GEMM_SP2>(lds + RING_OFF, g, S, E);
                s5_ctx_gemm<false>(args, lp, vcu, G);
                REPSYNC(); }
            }
            SEAM(ps + 1);
            if (RUN(ps + 2)) REP(9) s5_carry_phase(args, lp, lds, bx, G);
            SEAM(ps + 2);
            if (RUN(ps + 3)) { REP(10) {
                pg8::Gemm g{(const pg8::bf16_t*)(ws + WS_XL), (const pg8::bf16_t*)(ws + WS_MOUTT) + (size_t)lp * SG * 256 * 512, SG * 1024, 256, 512, 512}; pg8::GroupOrder S; S.init(G, vcu);
                pg8::EpiS5Out E{(pg8::bf16_t*)(ws + WS_Z)};
                pg8::gemm_phase<pg8::EpiS5Out, pg8::GroupOrder, GEMM_ALIGN, GEMM_SP2>(lds + RING_OFF, g, S, E);
                s5_ctx_gemm<true>(args, lp, vcu, G);
                REPSYNC(); }
            }
            SEAM(ps + 3);
#endif
            if (RUN(ps + 4)) { REP(11) {
                pg8::Gemm g{(const pg8::bf16_t*)(ws + WS_Z), (const pg8::bf16_t*)(ws + WS_WGLU) + (size_t)lp * 4096 * 2048, Mrows, 2 * D, D}; pg8::StaticOrder S; S.init(Mrows, 2 * D, G, bx);
                pg8::EpiGluResid E{H, GATE(modl + 2 * D), DRY};
                pg8::gemm_phase<pg8::EpiGluResid, pg8::StaticOrder, GEMM_ALIGN, GEMM_SP2>(lds + RING_OFF, g, S, E);
                REPSYNC(); }
            }
            SEAM(ps + 4);
            if (RUN(ps + 5)) REP(1) norm_phase<false>(args, args.in[I_N2G] + layer * D, modl, 1, vcu, G, 0, nullptr, Mrows);
            SEAM(ps + 5);
            if (RUN(ps + 6)) { REP(5) {
                pg8::Gemm g{XN, (const pg8::bf16_t*)(ws + WS_WF13) + (size_t)layer * 11264 * 2048, Mrows, 2 * FF, D}; pg8::StaticOrder S; S.init(Mrows, 2 * FF, G, bx);
                pg8::EpiSwiGLU E{(pg8::bf16_t*)(ws + WS_HID)};
                pg8::gemm_phase<pg8::EpiSwiGLU, pg8::StaticOrder, GEMM_ALIGN, GEMM_SP2>(lds + RING_OFF, g, S, E);
                REPSYNC(); }
            }
            SEAM(ps + 6);
            if (RUN(ps + 7)) { REP(6) {
                pg8::Gemm g{(const pg8::bf16_t*)(ws + WS_HID), (const pg8::bf16_t*)(ws + WS_WF2) + (size_t)layer * 2048 * 5632, ML, D, FF}; pg8::StaticOrder S; S.init(ML, D, G, bx);
                pg8::EpiResid E{H, GATE(modl + 5 * D), DRY};
                pg8::gemm_phase<pg8::EpiResid, pg8::StaticOrder, GEMM_ALIGN, GEMM_SP2>(lds + RING_OFF, g, S, E);
                if (lp == 0) { __syncthreads();
                pg8::Gemm gc{(const pg8::bf16_t*)(ws + WS_HID), (const pg8::bf16_t*)(ws + WS_WF2) + (size_t)layer * 2048 * 5632, M, D, 512, FF, FF}; pg8::SliceOrder SS; SS.init(G, bx, 11, 512);
                pg8::EpiSlab ES{(float*)(ws + WS_SLAB), 1024};
                pg8::gemm_phase<pg8::EpiSlab, pg8::SliceOrder, GEMM_ALIGN, GEMM_SP2>(lds + RING_OFF, gc, SS, ES); }
                REPSYNC(); }
            }
            SEAM(ps + 7);
            if (RUN(ps + 8)) {
                REP(1) if (lp == 0) norm_phase<false>(args, args.in[I_N1G] + (layer + 1) * D, modl + 3 * 12288, 0, vcu, G, rep ? 0 : 11, modl + 2 * 12288 + 5 * D);
                else final_phase(args, vcu, G);
            }
            SEAM(ps + 8);
        }
    }
#undef RUN
#undef SEAM
}

extern "C" void kernel_launch(void* const* d_in, const int* in_sizes, int n_in, void* d_out, int out_size, void* d_ws, size_t ws_size, hipStream_t stream) {
    static int grid = 0;
    if (grid == 0) {
        if (n_in != 28 || in_sizes[0] != ML * D || out_size != ML * D || ws_size < WS_END) {
            fprintf(stderr, "kernel_launch: unexpected problem (n_in %d, in0 %d, out %d, ws %zu, need ws >= %zu); nothing launched\n", n_in, n_in > 0 ? in_sizes[0] : -1, out_size, ws_size, (size_t)WS_END); grid = -1; return; }
        int dev = 0, cus = 0, per_cu = 0;
        if (hipGetDevice(&dev) != hipSuccess || hipDeviceGetAttribute(&cus, hipDeviceAttributeMultiprocessorCount, dev) != hipSuccess) { fprintf(stderr, "kernel_launch: device query failed\n"); grid = -1; return; }
        if (hipFuncSetAttribute((const void*)fwd_kernel, hipFuncAttributeMaxDynamicSharedMemorySize, LDS_BYTES) != hipSuccess) { fprintf(stderr, "kernel_launch: hipFuncSetAttribute failed\n"); grid = -1; return; }
        if (hipOccupancyMaxActiveBlocksPerMultiprocessor(&per_cu, (const void*)fwd_kernel, NTHR, LDS_BYTES) != hipSuccess || per_cu < 1) {
            fprintf(stderr, "kernel_launch: occupancy query reports %d workgroups per CU\n", per_cu); }
        (void)hipGetLastError();
        grid = cus;
    }
    if (grid < 0) return;
    if (hipMemsetAsync((char*)d_ws + WS_CTL, 0, (PROBE_MASK || PROBE_WET) ? CTL_ZERO_BYTES : 64 * 1024, stream) != hipSuccess) { fprintf(stderr, "kernel_launch: memset failed\n"); return; }
    Args a{};
    for (int i = 0; i < 28; ++i) a.in[i] = (const float*)d_in[i];
    a.out = (float*)d_out; a.ws = (unsigned char*)d_ws;
#if MK_ONE_LAUNCH
    a.ph_lo = 0; a.ph_hi = N_PHASES;
    hipLaunchKernelGGL(fwd_kernel, dim3(grid), dim3(NTHR), LDS_BYTES, stream, a);
#else
    for (int p = 0; p < N_PHASES; ++p) { a.ph_lo = p; a.ph_hi = p + 1; hipLaunchKernelGGL(fwd_kernel, dim3(grid), dim3(NTHR), LDS_BYTES, stream, a); }
#endif
    const hipError_t le = hipPeekAtLastError();
    if (le != hipSuccess) fprintf(stderr, "kernel_launch: launch failed: %s\n", hipGetErrorName(le));
}
```

```cpp
#include <hip/hip_runtime.h>
#include <cstdio>
#include <cstdint>
namespace pg8 {
#define PG8_LAS __attribute__((address_space(3)))
typedef unsigned short bf16_t;
typedef short bf16x8 __attribute__((ext_vector_type(8)));
typedef float f32x4 __attribute__((ext_vector_type(4)));
typedef unsigned u32x4 __attribute__((ext_vector_type(4)));
constexpr int BM = 256, BK = 64, HALF = 128, HTB = HALF * BK * 2  , STAGE_BYTES = 8 * HTB, NXCD = 8, WGM = 8;

__host__ __device__ __forceinline__ int lds_byte(int r, int c) { const int st = (r >> 4) * 2 + (c >> 5), rr = r & 15, cc = c & 31, ob = rr * 64 + cc * 2; return st * 1024 + (ob ^ (((ob >> 9) & 1) << 5)); }
__host__ __device__ __forceinline__ void stage_rc(int b, int& R, int& C) { const int st = b / 1024, sb = b % 1024, swz = sb ^ (((sb >> 9) & 1) << 5); R = (st >> 1) * 16 + swz / 64; C = (st & 1) * 32 + (swz % 64) / 2; }
__host__ __device__ __forceinline__ int perm32(int rho) { const int n = rho >> 4, i = rho & 15; return 8 * (i >> 2) + 4 * n + (i & 3); }

struct Unit { int pm, pn; int koff; };
struct Gemm { const bf16_t* A; const bf16_t* Bt; int M, N, K; int lda, ldb; };

struct StaticOrder {
    int nM, nN, nwg, G, c;
    __host__ __device__ void init(int M, int N, int G_, int c_) { nM = M / BM; nN = N / BM; nwg = nM * nN; G = G_; c = c_; }
    __host__ __device__ bool next(int i, Unit& u) const {
        const long L = (long)i * G + c; if (L >= nwg) return false;
        int wgid = (int)L; { const int q = nwg / NXCD, r = nwg % NXCD, xcd = wgid % NXCD, off = wgid / NXCD; wgid = (xcd < r ? xcd * (q + 1) : r * (q + 1) + (xcd - r) * q) + off; }
        const int nig = WGM * nN, gid = wgid / nig, fm = gid * WGM, gsz = (nM - fm) < WGM ? (nM - fm) : WGM;
        u.pm = fm + ((wgid % nig) % gsz); u.pn = (wgid % nig) / gsz; u.koff = 0; return true;
    }
    __device__ __forceinline__ void a_ready(const Unit&) const {}
    __device__ __forceinline__ void done(const Unit&) const {}
};

__device__ __forceinline__ unsigned cvt_pk_bf16(float lo, float hi) { unsigned r; asm volatile("v_cvt_pk_bf16_f32 %0, %1, %2" : "=v"(r) : "v"(lo), "v"(hi)); return r; }
typedef float f32x2 __attribute__((ext_vector_type(2)));
__device__ __forceinline__ f32x2 gelu_pk(f32x2 v) {
    const f32x2 av = __builtin_elementwise_abs(v), d = av * 0.2316418882f + 1.0f;
    f32x2 t; t.x = __builtin_amdgcn_rcpf(d.x); t.y = __builtin_amdgcn_rcpf(d.y);
    f32x2 q = t * 0.5307027145f + (-0.7265760135f); q = q * t + 0.7107068705f; q = q * t + (-0.142248368f); q = q * t + 0.127414796f; q = q * t;
    const f32x2 s = (v * v) * (-0.72134752044f);
    f32x2 e; e.x = __builtin_amdgcn_exp2f(s.x); e.y = __builtin_amdgcn_exp2f(s.y);
    const f32x2 m = v * (q * e), r = v - m;
    f32x2 o; o.x = v.x < 0.f ? m.x : r.x; o.y = v.y < 0.f ? m.y : r.y; return o;
}


__device__ __forceinline__ float sigmoid_f(float x) { return __builtin_amdgcn_rcpf(1.0f + __builtin_amdgcn_exp2f(-1.44269504f * x)); }
__device__ __forceinline__ float silu_f(float x) { return x * sigmoid_f(x); }
__device__ __forceinline__ float gelu_tanh_f(float x) { const float u = x * (1.0f + 0.044715f * x * x); return x * __builtin_amdgcn_rcpf(1.0f + __builtin_amdgcn_exp2f(-2.30220820f * u)); }
__device__ __forceinline__ f32x2 gelu_tanh_pk(f32x2 x) {
    f32x2 xc; xc.x = __builtin_amdgcn_fmed3f(x.x, -3.6f, 3.6f); xc.y = __builtin_amdgcn_fmed3f(x.y, -3.6f, 3.6f);
    const f32x2 z = xc * 0.277777778f, z2 = z * z;
    f32x2 p = z2 * (-0.707277966f) + 3.50913538f;
    p = p * z2 + (-7.72999719f); p = p * z2 + 10.1716655f; p = p * z2 + (-9.14213848f); p = p * z2 + 6.07337743f; p = p * z2 + (-3.11094742f); p = p * z2 + 1.43606059f;
    return x * (p * z + 0.5f);
}
__device__ __forceinline__ int row_set(int pm) { return pm < 32 ? 0 : (pm < 64 ? 1 : 2); }

struct EpiPlainBf16 {
    static constexpr bool PERM = true, AFTER_DRAIN = false;
    bf16_t* O; int ldc;
    __device__ __forceinline__ void operator()(const f32x4 (&acc)[2][2][4][2], const Unit& u, int wr, int wc, int fr, int fq) const {
        const int row0 = u.pm * BM + wr * 64 + fr, col0 = u.pn * BM + wc * 32 + 8 * fq;
#pragma unroll
        for (int ai = 0; ai < 2; ++ai)
#pragma unroll
            for (int m = 0; m < 4; ++m) { bf16_t* rowp = O + (size_t)(row0 + ai * HALF + m * 16) * ldc + col0;
#pragma unroll
                for (int bj = 0; bj < 2; ++bj) { const f32x4 v0 = acc[ai][bj][m][0], v1 = acc[ai][bj][m][1];
                    u32x4 w; w.x = cvt_pk_bf16(v0[0], v0[1]); w.y = cvt_pk_bf16(v0[2], v0[3]); w.z = cvt_pk_bf16(v1[0], v1[1]); w.w = cvt_pk_bf16(v1[2], v1[3]);
                    *(u32x4*)(rowp + bj * HALF) = w; } }
    }
};
struct EpiG1 {
    static constexpr bool PERM = true, AFTER_DRAIN = false;
    bf16_t* U; bf16_t* V; float* vstat; int dry;
    __device__ __forceinline__ void operator()(const f32x4 (&acc)[2][2][4][2], const Unit& u, int wr, int wc, int fr, int fq) const {
        if (dry) return;
        const bool isv = u.pn >= 16;
        const int row0 = u.pm * BM + wr * 64 + fr, col0 = (u.pn & 15) * BM + wc * 32 + 8 * fq;
        bf16_t* base = isv ? V : U;
#pragma unroll
        for (int ai = 0; ai < 2; ++ai)
#pragma unroll
            for (int m = 0; m < 4; ++m) { const int row = row0 + ai * HALF + m * 16; bf16_t* rowp = base + (size_t)row * 4096 + col0; float s = 0.f, ss = 0.f;
#pragma unroll
                for (int bj = 0; bj < 2; ++bj) { f32x4 v0 = acc[ai][bj][m][0], v1 = acc[ai][bj][m][1];
                    { const f32x2 a0 = gelu_tanh_pk((f32x2){v0[0], v0[1]}), a1 = gelu_tanh_pk((f32x2){v0[2], v0[3]}), a2 = gelu_tanh_pk((f32x2){v1[0], v1[1]}), a3 = gelu_tanh_pk((f32x2){v1[2], v1[3]});
                      v0 = (f32x4){a0.x, a0.y, a1.x, a1.y}; v1 = (f32x4){a2.x, a2.y, a3.x, a3.y}; }
                    if (isv) {
#pragma unroll
                        for (int e = 0; e < 4; ++e) { s += v0[e] + v1[e]; ss += v0[e] * v0[e] + v1[e] * v1[e]; } }
                    u32x4 w; w.x = cvt_pk_bf16(v0[0], v0[1]); w.y = cvt_pk_bf16(v0[2], v0[3]); w.z = cvt_pk_bf16(v1[0], v1[1]); w.w = cvt_pk_bf16(v1[2], v1[3]);
                    *(u32x4*)(rowp + bj * HALF) = w; }
                if (isv) { s += __shfl_xor(s, 16); s += __shfl_xor(s, 32); ss += __shfl_xor(ss, 16); ss += __shfl_xor(ss, 32);
                    if (fq == 0) { f32x2 o; o.x = s; o.y = ss; *(f32x2*)(vstat + ((size_t)row * 64 + (u.pn - 16) * 4 + wc) * 2) = o; } } }
    }
};
typedef _Float16 h16x8 __attribute__((ext_vector_type(8)));
struct EpiResid {
    static constexpr bool PERM = true, AFTER_DRAIN = false;
    _Float16* H; const float* gate; int dry;
    __device__ __forceinline__ void operator()(const f32x4 (&acc)[2][2][4][2], const Unit& u, int wr, int wc, int fr, int fq) const {
        if (dry) return;
        const int row0 = u.pm * BM + wr * 64 + fr, col0 = u.pn * BM + wc * 32 + 8 * fq;
        const float* g = gate + row_set(u.pm) * (6 * 2048) + col0;
        f32x4 gv[2][2];
#pragma unroll
        for (int bj = 0; bj < 2; ++bj)
#pragma unroll
            for (int n = 0; n < 2; ++n) gv[bj][n] = *(const f32x4*)(g + bj * HALF + n * 4);
#pragma unroll
        for (int ai = 0; ai < 2; ++ai)
#pragma unroll
            for (int m = 0; m < 4; ++m) { _Float16* rowp = H + (size_t)(row0 + ai * HALF + m * 16) * 2048 + col0;
#pragma unroll
                for (int bj = 0; bj < 2; ++bj) { h16x8* p = (h16x8*)(rowp + bj * HALF); h16x8 hv = *p;
#pragma unroll
                    for (int e = 0; e < 4; ++e) { hv[e] = (_Float16)((float)hv[e] + gv[bj][0][e] * acc[ai][bj][m][0][e]); hv[4 + e] = (_Float16)((float)hv[4 + e] + gv[bj][1][e] * acc[ai][bj][m][1][e]); }
                    *p = hv; } }
    }
};
struct EpiSwiGLU {
    static constexpr bool PERM = true, AFTER_DRAIN = false;
    bf16_t* O;
    __device__ __forceinline__ void operator()(const f32x4 (&acc)[2][2][4][2], const Unit& u, int wr, int wc, int fr, int fq) const {
        const int row0 = u.pm * BM + wr * 64 + fr, col0 = u.pn * HALF + wc * 32 + 8 * fq;
#pragma unroll
        for (int ai = 0; ai < 2; ++ai)
#pragma unroll
            for (int m = 0; m < 4; ++m) { bf16_t* rowp = O + (size_t)(row0 + ai * HALF + m * 16) * 5632 + col0;
                f32x4 a0 = acc[ai][0][m][0], a1 = acc[ai][0][m][1]; const f32x4 b0 = acc[ai][1][m][0], b1 = acc[ai][1][m][1];
#pragma unroll
                for (int e = 0; e < 4; ++e) { a0[e] = silu_f(a0[e]) * b0[e]; a1[e] = silu_f(a1[e]) * b1[e]; }
                u32x4 w; w.x = cvt_pk_bf16(a0[0], a0[1]); w.y = cvt_pk_bf16(a0[2], a0[3]); w.z = cvt_pk_bf16(a1[0], a1[1]); w.w = cvt_pk_bf16(a1[2], a1[3]);
                *(u32x4*)rowp = w; }
    }
};
struct EpiGluResid {
    static constexpr bool PERM = true, AFTER_DRAIN = false;
    _Float16* H; const float* gate; int dry;
    __device__ __forceinline__ void operator()(const f32x4 (&acc)[2][2][4][2], const Unit& u, int wr, int wc, int fr, int fq) const {
        if (dry) return;
        const int row0 = u.pm * BM + wr * 64 + fr, col0 = u.pn * HALF + wc * 32 + 8 * fq;
        const float* g = gate + row_set(u.pm) * (6 * 2048) + col0;
        f32x4 gv[2];
#pragma unroll
        for (int n = 0; n < 2; ++n) gv[n] = *(const f32x4*)(g + n * 4);
#pragma unroll
        for (int ai = 0; ai < 2; ++ai)
#pragma unroll
            for (int m = 0; m < 4; ++m) { h16x8* p = (h16x8*)(H + (size_t)(row0 + ai * HALF + m * 16) * 2048 + col0); h16x8 hv = *p;
#pragma unroll
                for (int n = 0; n < 2; ++n) { const f32x4 a = acc[ai][0][m][n], gg = acc[ai][1][m][n];
#pragma unroll
                    for (int e = 0; e < 4; ++e) hv[4 * n + e] = (_Float16)((float)hv[4 * n + e] + gv[n][e] * a[e] * sigmoid_f(gg[e])); }
                *p = hv; }
    }
};

struct GroupOrder {
    int G, c;
    __host__ __device__ void init(int G_, int c_) { G = G_; c = c_; }
    __host__ __device__ bool next(int i, Unit& u) const { const int L = i * G + c; if (L >= 512) return false; u.pm = L; u.pn = L >> 2; u.koff = 0; return true; }
    __device__ __forceinline__ void a_ready(const Unit&) const {}
    __device__ __forceinline__ void done(const Unit&) const {}
};
struct EpiS5In {
    static constexpr bool PERM = true, AFTER_DRAIN = false;
    bf16_t* XL; bf16_t* XC;
    __device__ __forceinline__ void operator()(const f32x4 (&acc)[2][2][4][2], const Unit& u, int wr, int wc, int fr, int fq) const {
        const int row0 = u.pm * BM + wr * 64 + fr;
#pragma unroll
        for (int ai = 0; ai < 2; ++ai)
#pragma unroll
            for (int m = 0; m < 4; ++m) { const int row = row0 + ai * HALF + m * 16;
#pragma unroll
                for (int bj = 0; bj < 2; ++bj) { const int col0 = u.pn * BM + bj * HALF + wc * 32 + 8 * fq, g = col0 >> 4, q0 = col0 & 15;
                    bf16_t* dst = row < 16384 ? XL + ((size_t)(g * 1024 + (row >> 4)) * 512 + 16 * (row & 15) + q0)
                                              : XC + ((size_t)(g * 32 + ((row - 16384) >> 4)) * 512 + 16 * (row & 15) + q0);
                    const f32x4 v0 = acc[ai][bj][m][0], v1 = acc[ai][bj][m][1];
                    u32x4 w; w.x = cvt_pk_bf16(v0[0], v0[1]); w.y = cvt_pk_bf16(v0[2], v0[3]); w.z = cvt_pk_bf16(v1[0], v1[1]); w.w = cvt_pk_bf16(v1[2], v1[3]);
                    *(u32x4*)dst = w; } }
    }
};
struct EpiS5State {
    static constexpr bool PERM = true, AFTER_DRAIN = false;
    bf16_t* SL;
    __device__ __forceinline__ void operator()(const f32x4 (&acc)[2][2][4][2], const Unit& u, int wr, int wc, int fr, int fq) const {
        const int row0 = u.pm * BM + wr * 64 + fr, col0 = wc * 32 + 8 * fq;
#pragma unroll
        for (int ai = 0; ai < 2; ++ai)
#pragma unroll
            for (int m = 0; m < 4; ++m) { bf16_t* rowp = SL + (size_t)(row0 + ai * HALF + m * 16) * 256 + col0;
#pragma unroll
                for (int bj = 0; bj < 2; ++bj) { const f32x4 v0 = acc[ai][bj][m][0], v1 = acc[ai][bj][m][1];
                    u32x4 w; w.x = cvt_pk_bf16(v0[0], v0[1]); w.y = cvt_pk_bf16(v0[2], v0[3]); w.z = cvt_pk_bf16(v1[0], v1[1]); w.w = cvt_pk_bf16(v1[2], v1[3]);
                    *(u32x4*)(rowp + bj * HALF) = w; } }
    }
};
struct EpiS5Out {
    static constexpr bool PERM = true, AFTER_DRAIN = false;
    bf16_t* Z;
    __device__ __forceinline__ void operator()(const f32x4 (&acc)[2][2][4][2], const Unit& u, int wr, int wc, int fr, int fq) const {
        const int c0 = (u.pm & 3) * BM + wr * 64 + fr, g = u.pn;
#pragma unroll
        for (int ai = 0; ai < 2; ++ai)
#pragma unroll
            for (int m = 0; m < 4; ++m) { const int c = c0 + ai * HALF + m * 16;
#pragma unroll
                for (int bj = 0; bj < 2; ++bj) { const int n0 = bj * HALF + wc * 32 + 8 * fq, t = n0 >> 4, q0 = n0 & 15;
                    f32x4 v0 = acc[ai][bj][m][0], v1 = acc[ai][bj][m][1];
#pragma unroll
                    for (int e = 0; e < 4; ++e) { v0[e] = gelu_tanh_f(v0[e]); v1[e] = gelu_tanh_f(v1[e]); }
                    u32x4 w; w.x = cvt_pk_bf16(v0[0], v0[1]); w.y = cvt_pk_bf16(v0[2], v0[3]); w.z = cvt_pk_bf16(v1[0], v1[1]); w.w = cvt_pk_bf16(v1[2], v1[3]);
                    *(u32x4*)(Z + (size_t)(16 * c + t) * 2048 + 16 * g + q0) = w; } }
    }
};

struct SliceOrder {
    int G, c, nsl, kbytes;
    __host__ __device__ void init(int G_, int c_, int nsl_, int kslice) { G = G_; c = c_; nsl = nsl_; kbytes = kslice * 2; }
    __host__ __device__ bool next(int i, Unit& u) const { const int L = i * G + c; if (L >= nsl * 16) return false; const int s = L >> 4, r = L & 15; u.pm = 64 + (r >> 3); u.pn = r & 7; u.koff = s * kbytes; return true; }
    __device__ __forceinline__ void a_ready(const Unit&) const {}
    __device__ __forceinline__ void done(const Unit&) const {}
};
struct EpiSlab {
    static constexpr bool PERM = false, AFTER_DRAIN = false;
    float* SLAB; int kbytes;
    __device__ __forceinline__ void operator()(const f32x4 (&acc)[2][2][4][2], const Unit& u, int wr, int wc, int fr, int fq) const {
        const int s = u.koff / kbytes, row0 = (u.pm - 64) * BM + wr * 64 + fr, col0 = u.pn * BM + wc * 32 + 4 * fq;
        float* base = SLAB + (size_t)s * 512 * 2048;
#pragma unroll
        for (int ai = 0; ai < 2; ++ai)
#pragma unroll
            for (int m = 0; m < 4; ++m) { float* rowp = base + (size_t)(row0 + ai * HALF + m * 16) * 2048 + col0;
#pragma unroll
                for (int bj = 0; bj < 2; ++bj)
#pragma unroll
                    for (int n = 0; n < 2; ++n) *(f32x4*)(rowp + bj * HALF + n * 16) = acc[ai][bj][m][n]; }
    }
};

template <class Epi, class Sched, bool ALIGN_EPI = false, bool SP2 = false>
__device__ __forceinline__ void gemm_phase(PG8_LAS unsigned char* lds, const Gemm g, const Sched& S, const Epi& E) {
    int tid_ = threadIdx.x; asm volatile("" : "+v"(tid_));
    const int tid = tid_, wid = __builtin_amdgcn_readfirstlane(tid >> 6), lane = tid & 63, wr = wid >> 2, wc = wid & 3, fr = lane & 15, fq = lane >> 4;
    const int K = g.K, nt = K / BK, lda = g.lda ? g.lda : K, ldb = g.ldb ? g.ldb : K;
    unsigned voffA[2], voffB[2];
#pragma unroll
    for (int i = 0; i < 2; ++i) { int R, C; stage_rc(tid * 16 + i * 8192, R, C); const int Rb = Epi::PERM ? ((R & ~31) + perm32(R & 31)) : R;
        voffA[i] = (unsigned)(R * lda + C) * 2u; voffB[i] = (unsigned)(Rb * ldb + C) * 2u; }
    const size_t kstep = (size_t)(BK * 2);
    const size_t hstepB = (size_t)HALF * ldb * 2, hstepA = (size_t)HALF * lda * 2;
    const size_t tstepB = 2 * hstepB, tstepA = 2 * hstepA;
    const unsigned ldsw = (unsigned)wid * 1024u;
    const int aoff = lds_byte(wr * 64 + fr, fq * 8), boff = lds_byte(wc * 32 + fr, fq * 8);
#define PG8_SA(b, h) (((b) * 2 + (h)) * HTB)
#define PG8_SB(b, h) ((4 + (b) * 2 + (h)) * HTB)
#define PG8_STAGE(bufoff, gbase, voff) do { _Pragma("unroll") for (int _i = 0; _i < 2; ++_i) \
        __builtin_amdgcn_global_load_lds((const unsigned*)((const char*)(gbase) + (voff)[_i]), (PG8_LAS unsigned*)(lds + (bufoff) + ldsw + _i * 8192), 16, 0, 0); } while (0)
#define PG8_LDA(dst, b, h) do { _Pragma("unroll") for (int m = 0; m < 4; ++m) _Pragma("unroll") for (int k = 0; k < 2; ++k) dst[m][k] = *(const PG8_LAS bf16x8*)(lds + PG8_SA(b, h) + aoff + m * 2048 + k * 1024); } while (0)
#define PG8_LDB(dst, b, h) do { _Pragma("unroll") for (int n = 0; n < 2; ++n) _Pragma("unroll") for (int k = 0; k < 2; ++k) dst[n][k] = *(const PG8_LAS bf16x8*)(lds + PG8_SB(b, h) + boff + n * 2048 + k * 1024); } while (0)
#define PG8_MMA(ai, bj, At, Bt) do { __builtin_amdgcn_s_setprio(1); _Pragma("unroll") for (int m = 0; m < 4; ++m) _Pragma("unroll") for (int n = 0; n < 2; ++n) _Pragma("unroll") for (int k = 0; k < 2; ++k) \
        acc[ai][bj][m][n] = __builtin_amdgcn_mfma_f32_16x16x32_bf16(Bt[n][k], At[m][k], acc[ai][bj][m][n], 0, 0, 0); __builtin_amdgcn_s_setprio(0); } while (0)
#define PG8_WAIT_V(n) asm volatile("s_waitcnt vmcnt(" #n ")" ::: "memory")
#define PG8_WAIT_L(n) asm volatile("s_waitcnt lgkmcnt(" #n ")" ::: "memory")
#define PG8_BAR __builtin_amdgcn_s_barrier()
#define PG8_SCHED __builtin_amdgcn_sched_barrier(0)
    Unit cur, nxt; int ui = 0;
    if (!S.next(0, cur)) return;
    f32x4 acc[2][2][4][2];
#pragma unroll
    for (int a = 0; a < 2; ++a)
#pragma unroll
        for (int b = 0; b < 2; ++b)
#pragma unroll
            for (int m = 0; m < 4; ++m)
#pragma unroll
                for (int n = 0; n < 2; ++n) acc[a][b][m][n] = (f32x4){0.f, 0.f, 0.f, 0.f};
    bf16x8 At[4][2], B0[2][2], B1[2][2];
    const char* cA = (const char*)g.A + (size_t)cur.pm * tstepA + cur.koff; const char* cB = (const char*)g.Bt + (size_t)cur.pn * tstepB + cur.koff;
    S.a_ready(cur);
    if constexpr (SP2) {
        PG8_STAGE(PG8_SB(0, 0), cB, voffB); PG8_STAGE(PG8_SB(0, 1), cB + hstepB, voffB); PG8_STAGE(PG8_SA(0, 0), cA, voffA); PG8_STAGE(PG8_SA(0, 1), cA + hstepA, voffA);
        if (wr == 1) PG8_BAR;
        PG8_WAIT_V(2); PG8_BAR;
        PG8_STAGE(PG8_SB(1, 0), cB + kstep, voffB); PG8_STAGE(PG8_SA(1, 0), cA + kstep, voffA); PG8_STAGE(PG8_SB(1, 1), cB + hstepB + kstep, voffB);
        PG8_WAIT_V(6); PG8_BAR;
    } else {
        PG8_STAGE(PG8_SB(0, 0), cB, voffB); PG8_STAGE(PG8_SA(0, 0), cA, voffA); PG8_STAGE(PG8_SB(0, 1), cB + hstepB, voffB); PG8_STAGE(PG8_SA(0, 1), cA + hstepA, voffA);
        if (wr == 1) PG8_BAR;
        PG8_WAIT_V(4); PG8_BAR;
        PG8_STAGE(PG8_SB(1, 0), cB + kstep, voffB); PG8_STAGE(PG8_SA(1, 0), cA + kstep, voffA); PG8_STAGE(PG8_SB(1, 1), cB + hstepB + kstep, voffB);
        PG8_WAIT_V(6); PG8_BAR;
    }
    for (;;) {
        const bool has_next = S.next(ui + 1, nxt);
        const char* nA = has_next ? (const char*)g.A + (size_t)nxt.pm * tstepA + nxt.koff : cA; const char* nB = has_next ? (const char*)g.Bt + (size_t)nxt.pn * tstepB + nxt.koff : cB;
#pragma unroll 1
        for (int t = 0; t < nt; t += 2) {
            const bool last = (t == nt - 2);
            const char* a1 = cA + (size_t)(t + 1) * kstep;
            const char* a2 = last ? nA : cA + (size_t)(t + 2) * kstep; const char* b2 = last ? nB : cB + (size_t)(t + 2) * kstep;
            const char* a3 = a2 + kstep; const char* b3 = b2 + kstep;
            if (last && has_next) S.a_ready(nxt);
            if constexpr (SP2) {
            PG8_LDB(B0, 0, 0); PG8_LDB(B1, 0, 1); PG8_SCHED; PG8_LDA(At, 0, 0); PG8_STAGE(PG8_SA(1, 1), a1 + hstepA, voffA);
            PG8_WAIT_V(8); PG8_WAIT_L(0); PG8_BAR; PG8_MMA(0, 0, At, B0); PG8_MMA(0, 1, At, B1); PG8_BAR; PG8_SCHED;
            PG8_LDA(At, 0, 1); PG8_STAGE(PG8_SB(0, 0), b2, voffB); PG8_STAGE(PG8_SB(0, 1), b2 + hstepB, voffB); PG8_STAGE(PG8_SA(0, 0), a2, voffA);
            PG8_WAIT_V(8); PG8_WAIT_L(0); PG8_BAR; PG8_MMA(1, 0, At, B0); PG8_MMA(1, 1, At, B1); PG8_BAR; PG8_SCHED;
            PG8_LDB(B0, 1, 0); PG8_LDB(B1, 1, 1); PG8_SCHED; PG8_LDA(At, 1, 0); PG8_STAGE(PG8_SA(0, 1), a2 + hstepA, voffA);
            PG8_WAIT_V(8); PG8_WAIT_L(0); PG8_BAR; PG8_MMA(0, 0, At, B0); PG8_MMA(0, 1, At, B1); PG8_BAR; PG8_SCHED;
            PG8_LDA(At, 1, 1); PG8_STAGE(PG8_SB(1, 0), b3, voffB); PG8_STAGE(PG8_SB(1, 1), b3 + hstepB, voffB); PG8_STAGE(PG8_SA(1, 0), a3, voffA);
            PG8_WAIT_V(8); PG8_WAIT_L(0); PG8_BAR; PG8_MMA(1, 0, At, B0); PG8_MMA(1, 1, At, B1); PG8_BAR; PG8_SCHED;
            } else {
            PG8_LDB(B0, 0, 0); PG8_SCHED; PG8_LDA(At, 0, 0); PG8_STAGE(PG8_SA(1, 1), a1 + hstepA, voffA);
            PG8_WAIT_L(8); PG8_BAR; PG8_WAIT_L(0); PG8_MMA(0, 0, At, B0); PG8_BAR; PG8_SCHED;
            PG8_LDB(B1, 0, 1); PG8_STAGE(PG8_SB(0, 0), b2, voffB);
            PG8_BAR; PG8_WAIT_L(0); PG8_MMA(0, 1, At, B1); PG8_BAR;
            PG8_LDA(At, 0, 1); PG8_STAGE(PG8_SA(0, 0), a2, voffA);
            PG8_BAR; PG8_WAIT_L(0); PG8_MMA(1, 0, At, B0); PG8_BAR; PG8_SCHED;
            PG8_STAGE(PG8_SB(0, 1), b2 + hstepB, voffB);
            PG8_WAIT_V(6); PG8_BAR; PG8_MMA(1, 1, At, B1); PG8_BAR;
            PG8_LDB(B0, 1, 0); PG8_SCHED; PG8_LDA(At, 1, 0); PG8_STAGE(PG8_SA(0, 1), a2 + hstepA, voffA);
            PG8_WAIT_L(8); PG8_BAR; PG8_WAIT_L(0); PG8_MMA(0, 0, At, B0); PG8_BAR; PG8_SCHED;
            PG8_LDB(B1, 1, 1); PG8_STAGE(PG8_SB(1, 0), b3, voffB);
            PG8_BAR; PG8_WAIT_L(0); PG8_MMA(0, 1, At, B1); PG8_BAR;
            PG8_LDA(At, 1, 1); PG8_STAGE(PG8_SA(1, 0), a3, voffA);
            PG8_BAR; PG8_WAIT_L(0); PG8_MMA(1, 0, At, B0); PG8_BAR; PG8_SCHED;
            PG8_STAGE(PG8_SB(1, 1), b3 + hstepB, voffB);
            PG8_WAIT_V(6); PG8_BAR; PG8_MMA(1, 1, At, B1); PG8_BAR;
            }
        }
        if constexpr (ALIGN_EPI) { if (wr == 0) PG8_BAR; }
        if constexpr (!Epi::AFTER_DRAIN) { E(acc, cur, wr, wc, fr, fq); S.done(cur); }
        if (!has_next) break;
#pragma unroll
        for (int a = 0; a < 2; ++a)
#pragma unroll
            for (int b = 0; b < 2; ++b)
#pragma unroll
                for (int m = 0; m < 4; ++m)
#pragma unroll
                    for (int n = 0; n < 2; ++n) acc[a][b][m][n] = (f32x4){0.f, 0.f, 0.f, 0.f};
        cur = nxt; cA = nA; cB = nB; ++ui;
        if constexpr (ALIGN_EPI) { if (wr == 1) PG8_BAR; }
    }
    PG8_WAIT_V(0);
    if constexpr (!ALIGN_EPI) { if (wr == 0) PG8_BAR; }
    PG8_BAR;
    if constexpr (Epi::AFTER_DRAIN) { E.fused(acc, cur, wr, wc, fr, fq, lds, wid, lane); S.done(cur); }
#undef PG8_SA
#undef PG8_SB
#undef PG8_STAGE
#undef PG8_LDA
#undef PG8_LDB
#undef PG8_MMA
#undef PG8_WAIT_V
#undef PG8_WAIT_L
#undef PG8_BAR
#undef PG8_SCHED
}
}

constexpr int NWAVES = 8, NTHR = NWAVES * 64;
constexpr int D = 2048, BATCH = 2, SEQ = 8192, ML = BATCH * SEQ, CTXL = 256, MC = BATCH * CTXL, M = ML + MC;
constexpr int FF = 5632, EA = 4096, NH = 16, HDIM = 256, CHUNK = 128, NCHUNK = M / CHUNK;
constexpr int SG = 128, SP = 64, SQ = 16;
constexpr int DEPTH = 4;
constexpr float EPS = 1e-6f;
static_assert(M % 256 == 0 && NCHUNK == 132, "row tiling");

constexpr size_t MiB = 1u << 20;
constexpr size_t WS_CTL = 0, CTL_ZERO_BYTES = 1 * MiB;
constexpr size_t WS_MOD = 1 * MiB;
constexpr size_t WS_S5A = 2 * MiB;
constexpr size_t WS_S5B = 3 * MiB;
constexpr size_t WS_WSB = 11 * MiB;
constexpr size_t WS_VSTAT = 12 * MiB;
constexpr size_t WS_WGIN = 32 * MiB;
constexpr size_t WS_WGOUT = 96 * MiB;
constexpr size_t WS_WF13 = 128 * MiB;
constexpr size_t WS_WF2 = 304 * MiB;
constexpr size_t WS_WSIN = 392 * MiB;
constexpr size_t WS_WGLU = 408 * MiB;
constexpr size_t WS_H = 440 * MiB;
constexpr size_t WS_XN = 572 * MiB;
constexpr size_t WS_BIG = 640 * MiB;
constexpr size_t WS_ZU = WS_BIG, WS_ZV = WS_BIG + 132 * MiB;
constexpr size_t WS_HID = WS_BIG;
constexpr size_t WS_SU = WS_BIG, WS_SZ = WS_BIG + 66 * MiB;
constexpr size_t WS_YF = WS_BIG + 132 * MiB, WS_YB = WS_BIG + 264 * MiB;
constexpr size_t WS_XL = WS_BIG, WS_XC = WS_BIG + 128 * MiB;
constexpr size_t WS_SL = WS_BIG + 132 * MiB, WS_SC = WS_BIG + 196 * MiB;
constexpr size_t WS_SZ2 = WS_BIG + 200 * MiB;
constexpr size_t WS_MOUTT = WS_BIG + 396 * MiB;
constexpr size_t WS_M2T = WS_MOUTT + 64 * MiB;
constexpr size_t WS_A16 = WS_M2T + 32 * MiB;
constexpr size_t WS_SLAB = WS_A16 + 2 * MiB;
constexpr size_t WS_END = WS_SLAB + 44 * MiB;
#ifndef S5_NAIVE
#define S5_NAIVE 0
#endif
constexpr size_t WS_Z = S5_NAIVE ? WS_SZ : WS_SZ2;
constexpr int CW_BAR = 4096;

constexpr int RING_OFF = 0, RING_BYTES = 131072;
constexpr int LDSCTL_OFF = RING_BYTES, MISC_OFF = LDSCTL_OFF + 320;
constexpr int LDS_BYTES = 147456;
static_assert(MISC_OFF + 128 <= LDS_BYTES, "LDS map");

#define GAS __attribute__((address_space(1)))
#define LAS __attribute__((address_space(3)))
typedef unsigned short bf16;
typedef unsigned v4u __attribute__((ext_vector_type(4)));
typedef unsigned v2u __attribute__((ext_vector_type(2)));
typedef float f32x4 __attribute__((ext_vector_type(4)));
typedef float f32x2 __attribute__((ext_vector_type(2)));
typedef float f32x16 __attribute__((ext_vector_type(16)));
typedef short bf16x8 __attribute__((ext_vector_type(8)));
typedef GAS unsigned gu32;
#define RLX_AGENT __ATOMIC_RELAXED, __HIP_MEMORY_SCOPE_AGENT
#define LDS_WAIT() asm volatile("s_waitcnt lgkmcnt(0)" ::: "memory")
__device__ __forceinline__ unsigned f2bf(float f) { unsigned u = __builtin_bit_cast(unsigned, f); return (u + 0x7fffu + ((u >> 16) & 1u)) >> 16; }
__device__ __forceinline__ unsigned pk2(float lo, float hi) { return f2bf(lo) | (f2bf(hi) << 16); }
__device__ __forceinline__ float bf2f(unsigned short b) { return __builtin_bit_cast(float, (unsigned)b << 16); }
__device__ __forceinline__ float wave_sum(float v) {
#pragma unroll
    for (int o = 1; o < 64; o <<= 1) v += __shfl_xor(v, o);
    return v;
}

#define XB_TMO      128
#define XB_XCNT(j)  (256  + 64 * (j))
#define XB_XSUB(j)  (1280 + 64 * (j))
#define XB_XGEN(j)  (2304 + 64 * (j))
#define XB_TOP      3328
#define XB_TOPGEN   3392
#define XCD_BAR_WORDS 3456
#define XB_SPIN_CAP (1u << 18)

__device__ __forceinline__ unsigned xb_ld(unsigned* p)              { return __hip_atomic_load(p, __ATOMIC_RELAXED, __HIP_MEMORY_SCOPE_AGENT); }
__device__ __forceinline__ unsigned xb_add(unsigned* p, unsigned v) { return __hip_atomic_fetch_add(p, v, __ATOMIC_RELAXED, __HIP_MEMORY_SCOPE_AGENT); }
__device__ __forceinline__ unsigned xb_xcc_id() { return (unsigned)__builtin_amdgcn_s_getreg((3 << 11) | 20) & 0xFu; }
#define XB_SPIN(cond, bar) do { unsigned _sp = 0; while (cond) { __builtin_amdgcn_s_sleep(1); \
    if ((++_sp & 255u) == 0u) { if (xb_ld(&(bar)[XB_TMO])) break; if (_sp > XB_SPIN_CAP) { atomicAdd(&(bar)[XB_TMO], 1u); break; } } } } while (0)

struct XcdBarrier {
    unsigned* bar; unsigned x;
    volatile LAS unsigned* st;
};

__device__ __forceinline__ XcdBarrier xcd_barrier_post(unsigned* bar, volatile LAS unsigned* st) {
    XcdBarrier b; b.bar = bar; b.x = xb_xcc_id(); b.st = st;
    if (threadIdx.x == 0) (void)xb_add(&bar[XB_XCNT(b.x)], 1u);
    return b;
}
__device__ __forceinline__ void xcd_barrier_complete(unsigned* bar, unsigned x, unsigned& nloc, unsigned& nx) {
    const unsigned G = gridDim.x * gridDim.y * gridDim.z;
    unsigned sum, cnt, mine, sp = 0u;
    for (;;) {
        sum = 0u; cnt = 0u; mine = 0u;
#pragma unroll
        for (unsigned j = 0; j < 16; ++j) { const unsigned c = xb_ld(&bar[XB_XCNT(j)]); sum += c; cnt += (c > 0u) ? 1u : 0u; mine = (j == x) ? c : mine; }
        if (sum == G) break;
        __builtin_amdgcn_s_sleep(1);
        if ((++sp & 255u) == 0u) { if (xb_ld(&bar[XB_TMO])) break; if (sp > XB_SPIN_CAP) { atomicAdd(&bar[XB_TMO], 1u); break; } }
    }
    nloc = mine > 0u ? mine : 1u; nx = cnt > 0u ? cnt : 1u;
}

__device__ __forceinline__ void xcd_barrier(const XcdBarrier& b) {
    asm volatile("s_waitcnt vmcnt(0)" ::: "memory");
    __syncthreads();
    if (threadIdx.x == 0) {
        unsigned* bar = b.bar;
        __builtin_amdgcn_s_waitcnt(0);
        unsigned nloc = b.st[0], nx = b.st[1];
        if (nloc == 0u) { xcd_barrier_complete(bar, b.x, nloc, nx); b.st[0] = nloc; b.st[1] = nx; }
        const unsigned old = xb_add(&bar[XB_XSUB(b.x)], 1u);
        const unsigned gen = old / nloc;
        if (old + 1u == (gen + 1u) * nloc) {
            __builtin_amdgcn_fence(__ATOMIC_RELEASE, "agent");
            asm volatile("s_waitcnt vmcnt(0)" ::: "memory");
            const unsigned og = xb_add(&bar[XB_TOP], 1u);
            const unsigned tg = og / nx;
            if (og + 1u == (tg + 1u) * nx) xb_add(&bar[XB_TOPGEN], 1u);
            else XB_SPIN(xb_ld(&bar[XB_TOPGEN]) == tg, bar);
            __builtin_amdgcn_fence(__ATOMIC_ACQUIRE, "agent");
            xb_add(&bar[XB_XGEN(b.x)], 1u);
            asm volatile("s_waitcnt vmcnt(0)" ::: "memory");
        } else {
            XB_SPIN(xb_ld(&bar[XB_XGEN(b.x)]) == gen, bar);
            __builtin_amdgcn_fence(__ATOMIC_ACQUIRE, "agent");
            asm volatile("s_waitcnt vmcnt(0)" ::: "memory");
        }
    }
    __syncthreads();
}

struct Args { const float* in[28]; float* out; unsigned char* ws; int ph_lo, ph_hi; };
enum InIdx { I_X = 0, I_C, I_CTX, I_CCTX, I_ADAW, I_ADAB, I_N1G, I_N2G, I_W1, I_W3, I_W2, I_GWIN, I_GLNG, I_GLNB, I_GWS, I_GBS, I_GWOUT,
             I_SWIN, I_SARE, I_SAIM, I_SLDT, I_SBRE, I_SBIM, I_SCRE, I_SCIM, I_SD, I_SWGLU, I_FING };

__device__ __forceinline__ int opaque_tid() { int t = threadIdx.x; asm volatile("" : "+v"(t)); return t; }
#define PHASE_IDS const int tid = opaque_tid(), lane = tid & 63, wave = __builtin_amdgcn_readfirstlane(tid >> 6); (void)tid; (void)lane; (void)wave

__device__ __forceinline__ void adaln_items(const Args& a, LAS unsigned char* lds, int wg, int nwg) {
    PHASE_IDS;
    LAS float* cs = (LAS float*)lds;
    LAS float* red = cs + 3 * 2048;
    const float* c = a.in[I_C]; const float* cc = a.in[I_CCTX];
    for (int i = tid; i < 3 * 2048; i += NTHR) { const int s = i >> 11, k = i & 2047; const float v = s < 2 ? c[s * 2048 + k] : cc[k]; cs[i] = v / (1.0f + expf(-v)); }
    __syncthreads();
    float* MOD = (float*)(a.ws + WS_MOD);
    const int cq = tid & 15, kg = tid >> 4;
    for (int item = wg; item < DEPTH * 192; item += nwg) {
        const int layer = item / 192, n0 = (item % 192) * 64;
        const float* W = a.in[I_ADAW] + (size_t)layer * 2048 * 12288 + n0 + 4 * cq;
        f32x4 a0 = {0.f, 0.f, 0.f, 0.f}, a1 = a0, a2 = a0;
#pragma unroll 8
        for (int k = kg; k < 2048; k += 32) { const f32x4 w = *(const GAS f32x4*)(W + (size_t)k * 12288); a0 += cs[k] * w; a1 += cs[2048 + k] * w; a2 += cs[4096 + k] * w; }
#pragma unroll
        for (int e = 0; e < 4; ++e) { red[(kg * 3 + 0) * 64 + 4 * cq + e] = a0[e]; red[(kg * 3 + 1) * 64 + 4 * cq + e] = a1[e]; red[(kg * 3 + 2) * 64 + 4 * cq + e] = a2[e]; }
        __syncthreads();
        if (tid < 192) { const int s = tid >> 6, col = tid & 63; float t = 0.f;
            for (int g = 0; g < 32; ++g) t += red[(g * 3 + s) * 64 + col];
            MOD[(size_t)(layer * 3 + s) * 12288 + n0 + col] = t + a.in[I_ADAB][layer * 12288 + n0 + col]; }
        __syncthreads();
    }
}
__device__ __forceinline__ void tr_item(const float* W, int ld, int K, int ncols, bf16* WT, int mode, LAS float* scr, int item, int lane) {
    const int nblk = ncols / 32, kb = item / nblk, nb = item % nblk, k0 = 64 * kb, n0 = 32 * nb;
    const int drow0 = mode == 0 ? n0 : (256 * (n0 >> 7) + (n0 & 127) + (mode == 2 ? 128 : 0));
    float tv[32];
#pragma unroll
    for (int i = 0; i < 32; ++i) { const int kk = 2 * i + (lane >> 5); tv[i] = W[(size_t)(k0 + kk) * ld + n0 + (lane & 31)]; }
#pragma unroll
    for (int i = 0; i < 32; ++i) { const int kk = 2 * i + (lane >> 5); scr[kk * 33 + (lane & 31)] = tv[i]; }
    LDS_WAIT(); asm volatile("" ::: "memory");
    const int c = lane & 7;
#pragma unroll
    for (int j = 0; j < 4; ++j) { const int n = (lane >> 3) + 8 * j; const LAS float* s = scr + (8 * c) * 33 + n;
        v4u o; o.x = pk2(s[0 * 33], s[1 * 33]); o.y = pk2(s[2 * 33], s[3 * 33]); o.z = pk2(s[4 * 33], s[5 * 33]); o.w = pk2(s[6 * 33], s[7 * 33]);
        *(GAS v4u*)(WT + (size_t)(drow0 + n) * K + k0 + 8 * c) = o; }
    LDS_WAIT(); asm volatile("" ::: "memory");
}
constexpr int TR_GIN = 2 * 8192, TR_GOUT = 2 * 4096, TR_FFN = 4 * 3 * 5632, TR_SIN = 2 * 2048, TR_GLU = 2 * 2 * 2048, TR_TOTAL = TR_GIN + TR_GOUT + TR_FFN + TR_SIN + TR_GLU;
__device__ __forceinline__ void transpose_items(const Args& a, LAS unsigned char* lds, int vcu, int G) {
    PHASE_IDS; const int gw = vcu * NWAVES + wave, ngw = G * NWAVES;
    LAS float* scr = (LAS float*)(lds + wave * 16384);
    unsigned char* ws = a.ws;
    for (int it0 = gw; it0 < TR_TOTAL; it0 += ngw) {
        int it = it0;
        if (it < TR_GIN) { const int j = it / 8192, r = it % 8192; tr_item(a.in[I_GWIN] + (size_t)j * 2048 * 8192, 8192, 2048, 8192, (bf16*)(ws + WS_WGIN) + (size_t)j * 8192 * 2048, 0, scr, r, lane); continue; } it -= TR_GIN;
        if (it < TR_GOUT) { const int j = it / 4096, r = it % 4096; tr_item(a.in[I_GWOUT] + (size_t)j * 4096 * 2048, 2048, 4096, 2048, (bf16*)(ws + WS_WGOUT) + (size_t)j * 2048 * 4096, 0, scr, r, lane); continue; } it -= TR_GOUT;
        if (it < TR_FFN) { const int i = it / 16896, r = it % 16896, which = r / 5632, rr = r % 5632;
            if (which == 0) tr_item(a.in[I_W1] + (size_t)i * 2048 * 5632, 5632, 2048, 5632, (bf16*)(ws + WS_WF13) + (size_t)i * 11264 * 2048, 1, scr, rr, lane);
            else if (which == 1) tr_item(a.in[I_W3] + (size_t)i * 2048 * 5632, 5632, 2048, 5632, (bf16*)(ws + WS_WF13) + (size_t)i * 11264 * 2048, 2, scr, rr, lane);
            else tr_item(a.in[I_W2] + (size_t)i * 5632 * 2048, 2048, 5632, 2048, (bf16*)(ws + WS_WF2) + (size_t)i * 2048 * 5632, 0, scr, rr, lane);
            continue; } it -= TR_FFN;
        if (it < TR_SIN) { const int j = it / 2048, r = it % 2048; tr_item(a.in[I_SWIN] + (size_t)j * 2048 * 2048, 2048, 2048, 2048, (bf16*)(ws + WS_WSIN) + (size_t)j * 2048 * 2048, 0, scr, r, lane); continue; } it -= TR_SIN;
        { const int j = it / 4096, r = it % 4096, half = r / 2048, rr = r % 2048;
          tr_item(a.in[I_SWGLU] + (size_t)j * 2048 * 4096 + half * 2048, 4096, 2048, 2048, (bf16*)(ws + WS_WGLU) + (size_t)j * 4096 * 2048, 1 + half, scr, rr, lane); }
    }
}
__device__ __forceinline__ void small_prologue(const Args& a, int vcu, int G) {
    PHASE_IDS; const int gtid = vcu * NTHR + tid, ngt = G * NTHR;
    bf16* WSB = (bf16*)(a.ws + WS_WSB);
    for (int i = gtid; i < 2 * 16 * 128 * 128; i += ngt) WSB[i] = (bf16)f2bf(a.in[I_GWS][i]);
    f32x2* S5A = (f32x2*)(a.ws + WS_S5A); f32x2* S5B = (f32x2*)(a.ws + WS_S5B);
    for (int i = gtid; i < 2 * 2 * SG * SP; i += ngt) {
        const int lg = i / SP;
        const float dt = expf(a.in[I_SLDT][lg]), are = a.in[I_SARE][i], aim = a.in[I_SAIM][i];
        const float e = expf(dt * are), th = dt * aim, abr = e * cosf(th), abi = e * sinf(th);
        f32x2 ab; ab.x = abr; ab.y = abi; S5A[i] = ab;
        const float nr = abr - 1.0f, ni = abi, den = 1.0f / (are * are + aim * aim);
        const float cr = (nr * are + ni * aim) * den, ci = (ni * are - nr * aim) * den;
        for (int q = 0; q < SQ; ++q) { const float br = a.in[I_SBRE][(size_t)i * SQ + q], bi = a.in[I_SBIM][(size_t)i * SQ + q];
            f32x2 o; o.x = cr * br - ci * bi; o.y = cr * bi + ci * br; S5B[(size_t)i * SQ + q] = o; }
    }
}

typedef _Float16 h16x8 __attribute__((ext_vector_type(8)));
template <bool INIT> __device__ __forceinline__ void norm_phase(const Args& a, const float* gain, const float* modl  , int which, int vcu, int G, int nslab = 0, const float* sgate = nullptr, int mrows = M) {
    PHASE_IDS; const int gw = vcu * NWAVES + wave, ngw = G * NWAVES;
    _Float16* H = (_Float16*)(a.ws + WS_H); bf16* XN = (bf16*)(a.ws + WS_XN);
    f32x4 xc[8], xn[8]; h16x8 hc[4], hn[4];
#define NP_LOAD(row_, xd, hd) do { if (INIT) { const float* src_ = (row_) < ML ? a.in[I_X] + (size_t)(row_) * D : a.in[I_CTX] + (size_t)((row_) - ML) * D; const GAS f32x4* xr_ = (const GAS f32x4*)src_ + 2 * lane; \
        _Pragma("unroll") for (int j = 0; j < 4; ++j) { xd[2 * j] = xr_[128 * j]; xd[2 * j + 1] = xr_[128 * j + 1]; } } \
      else { const GAS h16x8* hr_ = (const GAS h16x8*)(H + (size_t)(row_) * D) + lane; _Pragma("unroll") for (int j = 0; j < 4; ++j) hd[j] = hr_[64 * j]; } } while (0)
    int cset = -1; float gg[4][8], shv[4][8];
    if (gw < mrows) NP_LOAD(gw, xc, hc);
    for (int row = gw; row < mrows; row += ngw) {
        const int set = row < ML ? (row >> 13) : 2;
        const int nrow = row + ngw;
        if (nrow < mrows) NP_LOAD(nrow, xn, hn);
        if (!INIT && set != cset) { cset = set;
            const GAS f32x4* gp = (const GAS f32x4*)gain + 2 * lane;
            const GAS f32x4* shp = (const GAS f32x4*)(modl + (size_t)set * 12288 + (which * 3 + 0) * D) + 2 * lane;
            const GAS f32x4* scp = (const GAS f32x4*)(modl + (size_t)set * 12288 + (which * 3 + 1) * D) + 2 * lane;
#pragma unroll
            for (int j = 0; j < 4; ++j)
#pragma unroll
                for (int hlf = 0; hlf < 2; ++hlf) { const f32x4 g = gp[128 * j + hlf], sh = shp[128 * j + hlf], sc = scp[128 * j + hlf];
#pragma unroll
                    for (int e = 0; e < 4; ++e) { gg[j][4 * hlf + e] = g[e] * (1.0f + sc[e]); shv[j][4 * hlf + e] = sh[e]; } } }
        GAS h16x8* hr = (GAS h16x8*)(H + (size_t)row * D) + lane;
        float v[4][8];
        if (INIT) {
#pragma unroll
            for (int j = 0; j < 4; ++j)
#pragma unroll
                for (int e = 0; e < 4; ++e) { v[j][e] = xc[2 * j][e]; v[j][4 + e] = xc[2 * j + 1][e]; }
            if (row < ML) {
                const int t = row & (SEQ - 1); const float pr = (float)(t >> 6), pc = (float)(t & 63);
#pragma unroll
                for (int e = 0; e < 8; ++e) { const float om = exp2f(-(float)(8 * lane + e) * (13.287712379549449f / 512.0f)); const float ar = pr * om, ac = pc * om;
                    v[0][e] += sinf(ar); v[1][e] += cosf(ar); v[2][e] += sinf(ac); v[3][e] += cosf(ac); }
            }
        } else {
#pragma unroll
            for (int j = 0; j < 4; ++j)
#pragma unroll
                for (int e = 0; e < 8; ++e) v[j][e] = (float)hc[j][e];
            if (nslab > 0 && row >= ML) {
                const GAS f32x4* sp = (const GAS f32x4*)((const float*)(a.ws + WS_SLAB) + (size_t)(row - ML) * D) + 2 * lane; const GAS f32x4* gp2 = (const GAS f32x4*)sgate + 2 * lane;
                f32x4 t[4][2];
#pragma unroll
                for (int j = 0; j < 4; ++j) { t[j][0] = sp[128 * j]; t[j][1] = sp[128 * j + 1]; }
                for (int s = 1; s < nslab; ++s) {
#pragma unroll
                    for (int j = 0; j < 4; ++j) { t[j][0] += sp[(size_t)s * (512 * D / 4) + 128 * j]; t[j][1] += sp[(size_t)s * (512 * D / 4) + 128 * j + 1]; } }
#pragma unroll
                for (int j = 0; j < 4; ++j) { const f32x4 g0 = gp2[128 * j], g1 = gp2[128 * j + 1];
#pragma unroll
                    for (int e = 0; e < 4; ++e) { v[j][e] += g0[e] * t[j][0][e]; v[j][4 + e] += g1[e] * t[j][1][e]; } }
            }
        }
        if (INIT || (nslab > 0 && row >= ML)) {
#pragma unroll
            for (int j = 0; j < 4; ++j) { h16x8 hv;
#pragma unroll
                for (int e = 0; e < 8; ++e) { hv[e] = (_Float16)v[j][e]; v[j][e] = (float)hv[e]; }
                hr[64 * j] = hv; }
        }
        float ss = 0.f;
#pragma unroll
        for (int j = 0; j < 4; ++j)
#pragma unroll
            for (int e = 0; e < 8; ++e) ss += v[j][e] * v[j][e];
        const float rinv = 1.0f / sqrtf(wave_sum(ss) * (1.0f / D) + EPS);
        GAS v4u* o16 = (GAS v4u*)(XN + (size_t)row * D) + lane;
#pragma unroll
        for (int j = 0; j < 4; ++j) { float y[8];
            if (INIT) {
                const GAS f32x4* gp = (const GAS f32x4*)gain + 2 * lane;
                const GAS f32x4* shp = (const GAS f32x4*)(modl + (size_t)set * 12288 + (which * 3 + 0) * D) + 2 * lane;
                const GAS f32x4* scp = (const GAS f32x4*)(modl + (size_t)set * 12288 + (which * 3 + 1) * D) + 2 * lane;
#pragma unroll
                for (int hlf = 0; hlf < 2; ++hlf) { const f32x4 g = gp[128 * j + hlf], sh = shp[128 * j + hlf], sc = scp[128 * j + hlf];
#pragma unroll
                    for (int e = 0; e < 4; ++e) y[4 * hlf + e] = v[j][4 * hlf + e] * rinv * g[e] * (1.0f + sc[e]) + sh[e]; }
            } else {
#pragma unroll
                for (int e = 0; e < 8; ++e) y[e] = v[j][e] * rinv * gg[j][e] + shv[j][e]; }
            v4u o; o.x = pk2(y[0], y[1]); o.y = pk2(y[2], y[3]); o.z = pk2(y[4], y[5]); o.w = pk2(y[6], y[7]); o16[64 * j] = o; }
#pragma unroll
        for (int j = 0; j < 8; ++j) xc[j] = xn[j];
#pragma unroll
        for (int j = 0; j < 4; ++j) hc[j] = hn[j];
    }
#undef NP_LOAD
}
__device__ __forceinline__ void final_phase(const Args& a, int vcu, int G) {
    PHASE_IDS; const int gw = vcu * NWAVES + wave, ngw = G * NWAVES;
    const _Float16* H = (const _Float16*)(a.ws + WS_H);
    float gv[4][8];
    { const GAS f32x4* gp = (const GAS f32x4*)a.in[I_FING] + 2 * lane;
#pragma unroll
      for (int j = 0; j < 4; ++j)
#pragma unroll
          for (int hlf = 0; hlf < 2; ++hlf) { const f32x4 g = gp[128 * j + hlf];
#pragma unroll
              for (int e = 0; e < 4; ++e) gv[j][4 * hlf + e] = g[e]; } }
    h16x8 hc[4], hn[4];
    if (gw < ML) { const GAS h16x8* hr = (const GAS h16x8*)(H + (size_t)gw * D) + lane;
#pragma unroll
        for (int j = 0; j < 4; ++j) hc[j] = hr[64 * j]; }
    for (int row = gw; row < ML; row += ngw) {
        if (row + ngw < ML) { const GAS h16x8* hr = (const GAS h16x8*)(H + (size_t)(row + ngw) * D) + lane;
#pragma unroll
            for (int j = 0; j < 4; ++j) hn[j] = hr[64 * j]; }
        float v[4][8]; float ss = 0.f;
#pragma unroll
        for (int j = 0; j < 4; ++j)
#pragma unroll
            for (int e = 0; e < 8; ++e) { v[j][e] = (float)hc[j][e]; ss += v[j][e] * v[j][e]; }
        const float rinv = 1.0f / sqrtf(wave_sum(ss) * (1.0f / D) + EPS);
        GAS f32x4* o = (GAS f32x4*)(a.out + (size_t)row * D) + 2 * lane;
#pragma unroll
        for (int j = 0; j < 4; ++j)
#pragma unroll
            for (int hlf = 0; hlf < 2; ++hlf) { f32x4 r;
#pragma unroll
                for (int e = 0; e < 4; ++e) r[e] = v[j][4 * hlf + e] * rinv * gv[j][4 * hlf + e];
                o[128 * j + hlf] = r; }
#pragma unroll
        for (int j = 0; j < 4; ++j) hc[j] = hn[j];
    }
}

__device__ __forceinline__ void sgu_phase(const Args& a, int gl  , LAS unsigned char* lds, int wg, int nwg, int dry) {
    PHASE_IDS;
    bf16* ZU = (bf16*)(a.ws + WS_ZU); const bf16* ZV = (const bf16*)(a.ws + WS_ZV); const float* VSTAT = (const float*)(a.ws + WS_VSTAT);
    const bf16* WSB = (const bf16*)(a.ws + WS_WSB) + (size_t)gl * 16 * 128 * 128;
    const float* bs = a.in[I_GBS] + gl * 16 * 128; const float* lng = a.in[I_GLNG] + gl * EA; const float* lnb = a.in[I_GLNB] + gl * EA;
    LAS f32x2* st = (LAS f32x2*)lds;
    const int n = lane & 31, h = lane >> 5;
    for (int unit = wg; unit < NCHUNK * NH; unit += nwg) {
        const int c = unit / NH, hd = unit % NH, r0 = c * CHUNK;
        { const int j = tid >> 2, part = tid & 3; const GAS f32x4* p = (const GAS f32x4*)(VSTAT + ((size_t)(r0 + j) * 64 + part * 16) * 2);
          float s = 0.f, ss = 0.f;
#pragma unroll
          for (int q = 0; q < 8; ++q) { const f32x4 w = p[q]; s += w.x + w.z; ss += w.y + w.w; }
          s += __shfl_xor(s, 1); s += __shfl_xor(s, 2); ss += __shfl_xor(ss, 1); ss += __shfl_xor(ss, 2);
          if (part == 0) { const float mean = s * (1.0f / EA), var = ss * (1.0f / EA) - mean * mean; f32x2 o; o.x = mean; o.y = 1.0f / sqrtf(var + EPS); st[j] = o; } }
        __syncthreads();
        const int gcol = hd * HDIM + 32 * wave + n;
        const float lg = lng[gcol], lb = lnb[gcol];
        const GAS bf16* vp = (const GAS bf16*)ZV + (size_t)r0 * EA + gcol;
        unsigned short raw[8][8];
#pragma unroll
        for (int ks = 0; ks < 8; ++ks)
#pragma unroll
            for (int e = 0; e < 8; ++e) raw[ks][e] = vp[(size_t)(16 * ks + 8 * h + e) * EA];
        bf16x8 Bf[8];
#pragma unroll
        for (int ks = 0; ks < 8; ++ks) { float f[8];
#pragma unroll
            for (int e = 0; e < 8; ++e) { const f32x2 m = st[16 * ks + 8 * h + e]; f[e] = (bf2f(raw[ks][e]) - m.x) * m.y * lg + lb; }
            v4u w; w.x = pk2(f[0], f[1]); w.y = pk2(f[2], f[3]); w.z = pk2(f[4], f[5]); w.w = pk2(f[6], f[7]); Bf[ks] = __builtin_bit_cast(bf16x8, w); }
        unsigned short uraw[4][16];
#define SGU_ULOAD(ib_) do { _Pragma("unroll") for (int r = 0; r < 16; ++r) uraw[ib_][r] = ((const GAS bf16*)ZU)[(size_t)(r0 + 32 * (ib_) + (r & 3) + 8 * (r >> 2) + 4 * h) * EA + gcol]; } while (0)
        SGU_ULOAD(0);
#pragma unroll
        for (int ib = 0; ib < 4; ++ib) {
            asm volatile("" ::: "memory");
            if (ib + 1 < 4) SGU_ULOAD(ib + 1);
            f32x16 acc;
#pragma unroll
            for (int r = 0; r < 16; ++r) acc[r] = 0.f;
            const GAS bf16x8* ap = (const GAS bf16x8*)(WSB + ((size_t)hd * 128 + 32 * ib + n) * 128 + 8 * h);
#pragma unroll
            for (int ks = 0; ks < 8; ++ks) { const bf16x8 Af = ap[2 * ks]; acc = __builtin_amdgcn_mfma_f32_32x32x16_bf16(Af, Bf[ks], acc, 0, 0, 0); }
#pragma unroll
            for (int r = 0; r < 16; ++r) { const int i = 32 * ib + (r & 3) + 8 * (r >> 2) + 4 * h; const float s = acc[r] + bs[hd * 128 + i];
                GAS bf16* up = (GAS bf16*)ZU + (size_t)(r0 + i) * EA + gcol; const bf16 nv = (bf16)f2bf(bf2f(uraw[ib][r]) * s); if (!dry) *up = nv; }
        }
        __syncthreads();
    }
#undef SGU_ULOAD
}

__device__ __forceinline__ void s5_naive_phase(const Args& a, int sl  , int wg, int nwg) {
    PHASE_IDS;
    if (wave >= 2) return;
    const bf16* U = (const bf16*)(a.ws + WS_SU);
    for (int item = wg * 2 + wave; item < 2 * 2 * SG; item += nwg * 2) {
        const int b = item & 1, k = (item >> 1) & 1, g = item >> 2;
        const int pg = ((sl * 2 + k) * SG + g);
        const f32x2 ab = ((const f32x2*)(a.ws + WS_S5A))[(size_t)pg * SP + lane];
        float bre[16], bim[16], cr[16], ci[16];
#pragma unroll
        for (int q = 0; q < 16; ++q) { const f32x2 bb = ((const f32x2*)(a.ws + WS_S5B))[((size_t)pg * SP + lane) * SQ + q]; bre[q] = bb.x; bim[q] = bb.y;
            cr[q] = a.in[I_SCRE][((size_t)pg * SQ + q) * SP + lane]; ci[q] = a.in[I_SCIM][((size_t)pg * SQ + q) * SP + lane]; }
        float* Y = (float*)(a.ws + (k ? WS_YB : WS_YF));
        float hr = 0.f, hi = 0.f;
#pragma unroll 1
        for (int seg = 0; seg < 2; ++seg) {
            const int L = seg ? SEQ : CTXL, base = seg ? b * SEQ : ML + b * CTXL;
#pragma unroll 1
            for (int blk = 0; blk < L; blk += 64) {
                const int myt = k ? (L - 1 - (blk + lane)) : (blk + lane);
                const size_t row = (size_t)(base + myt);
                const GAS v4u* up = (const GAS v4u*)(U + row * D + 16 * g);
                const v4u u0 = up[0], u1 = up[1];
                float keep[16];
#pragma unroll
                for (int q = 0; q < 16; ++q) keep[q] = 0.f;
#pragma unroll 1
                for (int s = 0; s < 64; ++s) {
                    unsigned w[8];
                    w[0] = __builtin_amdgcn_readlane(u0.x, s); w[1] = __builtin_amdgcn_readlane(u0.y, s); w[2] = __builtin_amdgcn_readlane(u0.z, s); w[3] = __builtin_amdgcn_readlane(u0.w, s);
                    w[4] = __builtin_amdgcn_readlane(u1.x, s); w[5] = __builtin_amdgcn_readlane(u1.y, s); w[6] = __builtin_amdgcn_readlane(u1.z, s); w[7] = __builtin_amdgcn_readlane(u1.w, s);
                    float br = 0.f, bi = 0.f;
#pragma unroll
                    for (int q2 = 0; q2 < 8; ++q2) { const float ulo = __builtin_bit_cast(float, w[q2] << 16), uhi = __builtin_bit_cast(float, w[q2] & 0xffff0000u);
                        br += bre[2 * q2] * ulo + bre[2 * q2 + 1] * uhi; bi += bim[2 * q2] * ulo + bim[2 * q2 + 1] * uhi; }
                    const float nhr = ab.x * hr - ab.y * hi + br, nhi = ab.x * hi + ab.y * hr + bi; hr = nhr; hi = nhi;
#pragma unroll
                    for (int q = 0; q < 16; ++q) { const float y = wave_sum(cr[q] * hr - ci[q] * hi); keep[q] = (lane == s) ? y : keep[q]; }
                }
                GAS f32x4* yp = (GAS f32x4*)(Y + row * D + 16 * g);
#pragma unroll
                for (int q4 = 0; q4 < 4; ++q4) { f32x4 o; o.x = keep[4 * q4]; o.y = keep[4 * q4 + 1]; o.z = keep[4 * q4 + 2]; o.w = keep[4 * q4 + 3]; yp[q4] = o; }
            }
        }
    }
}
__device__ __forceinline__ void s5_combine_phase(const Args& a, int sl, int vcu, int G) {
    PHASE_IDS; const int gw = vcu * NWAVES + wave, ngw = G * NWAVES;
    const float* YF = (const float*)(a.ws + WS_YF); const float* YB = (const float*)(a.ws + WS_YB); const bf16* U = (const bf16*)(a.ws + WS_SU); bf16* Z = (bf16*)(a.ws + WS_SZ);
    const GAS f32x4* dp = (const GAS f32x4*)(a.in[I_SD] + sl * D) + lane;
    for (int row = gw; row < M; row += ngw) {
        const GAS f32x4* yf = (const GAS f32x4*)(YF + (size_t)row * D) + lane; const GAS f32x4* yb = (const GAS f32x4*)(YB + (size_t)row * D) + lane;
        const GAS v2u* up = (const GAS v2u*)(U + (size_t)row * D) + lane; GAS v2u* zp = (GAS v2u*)(Z + (size_t)row * D) + lane;
#pragma unroll
        for (int j = 0; j < 8; ++j) { const f32x4 f = yf[64 * j], bk = yb[64 * j], dd = dp[64 * j]; const v2u uu = up[64 * j];
            f32x4 u4; u4.x = __builtin_bit_cast(float, uu.x << 16); u4.y = __builtin_bit_cast(float, uu.x & 0xffff0000u); u4.z = __builtin_bit_cast(float, uu.y << 16); u4.w = __builtin_bit_cast(float, uu.y & 0xffff0000u);
            const f32x4 y = f + bk + u4 * dd;
            v2u o; o.x = pk2(pg8::gelu_tanh_f(y.x), pg8::gelu_tanh_f(y.y)); o.y = pk2(pg8::gelu_tanh_f(y.z), pg8::gelu_tanh_f(y.w)); zp[64 * j] = o; }
    }
}

__device__ __forceinline__ f32x2 cmul(f32x2 a, f32x2 b) { f32x2 r; r.x = a.x * b.x - a.y * b.y; r.y = a.x * b.y + a.y * b.x; return r; }
__device__ __forceinline__ void s5_precompute(const Args& a, LAS unsigned char* lds, int wg, int nwg) {
    PHASE_IDS;
    LAS f32x2* apw = (LAS f32x2*)lds;
    LAS f32x2* bbl = apw + 2 * 17 * 64;
    LAS f32x2* ccl = bbl + 2 * 64 * 16;
    LAS float* ktab = (LAS float*)(ccl + 2 * 16 * 64);
    for (int item = wg; item < 2 * SG; item += nwg) {
        const int sl = item >> 7, g = item & 127;
        if (tid < 128) { const int d = tid >> 6, p = tid & 63, pg = (sl * 2 + d) * SG + g, i = pg * SP + p;
            const float dt = expf(a.in[I_SLDT][pg]), are = a.in[I_SARE][i], aim = a.in[I_SAIM][i];
            for (int l = 0; l <= 16; ++l) { const float e = expf((float)l * (dt * are)), th = (float)l * (dt * aim); f32x2 o; o.x = e * cosf(th); o.y = e * sinf(th); apw[(d * 17 + l) * 64 + p] = o; }
            const f32x2 ab = apw[(d * 17 + 1) * 64 + p];
            const float nr = ab.x - 1.0f, ni = ab.y, den = 1.0f / (are * are + aim * aim);
            f32x2 coef; coef.x = (nr * are + ni * aim) * den; coef.y = (ni * are - nr * aim) * den;
            for (int q = 0; q < SQ; ++q) { f32x2 bq; bq.x = a.in[I_SBRE][(size_t)i * SQ + q]; bq.y = a.in[I_SBIM][(size_t)i * SQ + q]; bbl[(d * 64 + p) * 16 + q] = cmul(coef, bq); }
            ((f32x2*)(a.ws + WS_A16))[i] = apw[(d * 17 + 16) * 64 + p]; }
        for (int e = tid; e < 2 * 16 * 64; e += NTHR) { const int d = e >> 10, q = (e >> 6) & 15, p = e & 63; const size_t ci = ((size_t)((sl * 2 + d) * SG + g) * SQ + q) * SP + p;
            f32x2 o; o.x = a.in[I_SCRE][ci]; o.y = a.in[I_SCIM][ci]; ccl[e] = o; }
        __syncthreads();
        for (int o = tid; o < 8192; o += NTHR) { const int d = o >> 12, l = (o >> 8) & 15, q = (o >> 4) & 15, qp = o & 15; float acc = 0.f;
            for (int p = 0; p < 64; ++p) { const f32x2 ca = cmul(ccl[(d * 16 + q) * 64 + p], apw[(d * 17 + l) * 64 + p]), bb = bbl[(d * 64 + p) * 16 + qp]; acc += ca.x * bb.x - ca.y * bb.y; }
            ktab[o] = acc; }
        __syncthreads();
        bf16* MoutT = (bf16*)(a.ws + WS_MOUTT) + (size_t)(sl * SG + g) * 256 * 512;
        bf16* M2T = (bf16*)(a.ws + WS_M2T) + (size_t)(sl * SG + g) * 256 * 256;
        for (int ch = tid; ch < 256 * 64; ch += NTHR) { const int n = ch >> 6, jj = ch & 63, t = n >> 4, q = n & 15; float v[8];
            if (jj < 32) { const int s = jj >> 1, q0 = 8 * (jj & 1);
#pragma unroll
                for (int e = 0; e < 8; ++e) { const int qp = q0 + e;
                    v[e] = s < t ? ktab[((0 * 16 + (t - s)) * 16 + q) * 16 + qp] : (s > t ? ktab[((1 * 16 + (s - t)) * 16 + q) * 16 + qp]
                         : ktab[(0 * 16 * 16 + q) * 16 + qp] + ktab[((16) * 16 + q) * 16 + qp] + (q == qp ? a.in[I_SD][sl * D + 16 * g + q] : 0.f)); }
            } else { const int j2 = jj - 32, d = j2 >> 4, p0 = (j2 & 15) * 4, ex = d == 0 ? t + 1 : 16 - t;
#pragma unroll
                for (int pp = 0; pp < 4; ++pp) { const f32x2 ca = cmul(ccl[(d * 16 + q) * 64 + p0 + pp], apw[(d * 17 + ex) * 64 + p0 + pp]); v[2 * pp] = ca.x; v[2 * pp + 1] = -ca.y; } }
            v4u w; w.x = pk2(v[0], v[1]); w.y = pk2(v[2], v[3]); w.z = pk2(v[4], v[5]); w.w = pk2(v[6], v[7]);
            *(GAS v4u*)(MoutT + (size_t)n * 512 + 8 * jj) = w; }
        for (int ch = tid; ch < 256 * 32; ch += NTHR) { const int n = ch >> 5, jj = ch & 31, d = n >> 7, p = (n & 127) >> 1, im = n & 1, s = jj >> 1, q0 = 8 * (jj & 1), ex = d == 0 ? 15 - s : s; float v[8];
            const f32x2 ap = apw[(d * 17 + ex) * 64 + p];
#pragma unroll
            for (int e = 0; e < 8; ++e) { const f32x2 r = cmul(ap, bbl[(d * 64 + p) * 16 + q0 + e]); v[e] = im ? r.y : r.x; }
            v4u w; w.x = pk2(v[0], v[1]); w.y = pk2(v[2], v[3]); w.z = pk2(v[4], v[5]); w.w = pk2(v[6], v[7]);
            *(GAS v4u*)(M2T + (size_t)n * 256 + 8 * jj) = w; }
        __syncthreads();
    }
}
template <bool OUT> __device__ __forceinline__ void s5_ctx_gemm(const Args& a, int sl, int wg, int nwg) {
    PHASE_IDS;
    constexpr int K = OUT ? 512 : 256;
    const int r = lane & 31, hh = lane >> 5;
    for (int g = wg; g < SG; g += nwg) {
        const GAS bf16x8* ap = (const GAS bf16x8*)((const bf16*)(a.ws + WS_XC) + (size_t)(g * 32 + r) * 512 + 8 * hh);
        const bf16* Bt = OUT ? (const bf16*)(a.ws + WS_MOUTT) + (size_t)(sl * SG + g) * 256 * 512 : (const bf16*)(a.ws + WS_M2T) + (size_t)(sl * SG + g) * 256 * 256;
        const GAS bf16x8* bp = (const GAS bf16x8*)(Bt + (size_t)(32 * wave + r) * K + 8 * hh);
        f32x16 acc;
#pragma unroll
        for (int i = 0; i < 16; ++i) acc[i] = 0.f;
#pragma unroll 8
        for (int ks = 0; ks < K / 16; ++ks) acc = __builtin_amdgcn_mfma_f32_32x32x16_bf16(ap[2 * ks], bp[2 * ks], acc, 0, 0, 0);
        const int n = 32 * wave + r;
#pragma unroll
        for (int i = 0; i < 16; ++i) { const int c = (i & 3) + 8 * (i >> 2) + 4 * hh;
            if (OUT) { const int t = n >> 4, q = n & 15; ((GAS bf16*)(a.ws + WS_Z))[(size_t)(ML + 16 * c + t) * D + 16 * g + q] = (bf16)f2bf(pg8::gelu_tanh_f(acc[i])); }
            else ((GAS bf16*)(a.ws + WS_SC))[(size_t)(g * 32 + c) * 256 + n] = (bf16)f2bf(acc[i]); }
    }
}
__device__ __forceinline__ void s5_carry_phase(const Args& a, int sl, LAS unsigned char* lds, int wg, int nwg) {
    PHASE_IDS;
    LAS f32x2* EX = (LAS f32x2*)lds;
    const int seg = wave;
    for (int item = wg; item < 2 * 2 * SG; item += nwg) {
        const int b = item & 1, d = (item >> 1) & 1, g = item >> 2;
        const f32x2 a16 = ((const f32x2*)(a.ws + WS_A16))[(size_t)((sl * 2 + d) * SG + g) * SP + lane];
        const int c0 = d ? 511 - seg * 64 : seg * 64;
        const long sst = d ? -128 : 128, xst = d ? -256 : 256;
        const GAS unsigned* sp = (const GAS unsigned*)(a.ws + WS_SL) + (size_t)(g * 1024 + b * 512 + c0) * 128 + d * 64 + lane;
        GAS unsigned* xp = (GAS unsigned*)(a.ws + WS_XL) + (size_t)(g * 1024 + b * 512 + c0) * 256 + 128 + d * 64 + lane;
        unsigned sw[64];
#pragma unroll
        for (int j = 0; j < 64; ++j) { sw[j] = *sp; sp += sst; asm volatile("" : "+v"(sp)); }
        float hr = 0.f, hi = 0.f;
#define S5_STEP(word) do { const float sr = __builtin_bit_cast(float, (word) << 16), si = __builtin_bit_cast(float, (word) & 0xffff0000u); \
            const float nr = a16.x * hr - a16.y * hi + sr, ni = a16.x * hi + a16.y * hr + si; hr = nr; hi = ni; } while (0)
        if (seg == 0) {
            const int cc0 = d ? 15 : 0;
            const GAS unsigned* cp = (const GAS unsigned*)(a.ws + WS_SC) + (size_t)(g * 32 + b * 16 + cc0) * 128 + d * 64 + lane;
            GAS unsigned* xcp = (GAS unsigned*)(a.ws + WS_XC) + (size_t)(g * 32 + b * 16 + cc0) * 256 + 128 + d * 64 + lane;
            unsigned cw[16];
#pragma unroll
            for (int j = 0; j < 16; ++j) { cw[j] = *cp; cp += sst; asm volatile("" : "+v"(cp)); }
#pragma unroll
            for (int j = 0; j < 16; ++j) { *xcp = pk2(hr, hi); xcp += xst; asm volatile("" : "+v"(xcp)); S5_STEP(cw[j]); }
#pragma unroll
            for (int j = 0; j < 64; ++j) { *xp = pk2(hr, hi); xp += xst; asm volatile("" : "+v"(xp)); S5_STEP(sw[j]); }
        } else {
#pragma unroll
            for (int j = 0; j < 64; ++j) S5_STEP(sw[j]);
        }
        { f32x2 o; o.x = hr; o.y = hi; EX[seg * 64 + lane] = o; }
        __syncthreads();
        if (seg != 0) {
            f32x2 P = a16;
#pragma unroll
            for (int q = 0; q < 6; ++q) P = cmul(P, P);
            f32x2 F = EX[lane];
            for (int k = 1; k < seg; ++k) { const f32x2 E = EX[k * 64 + lane]; const f32x2 pf = cmul(P, F); F.x = pf.x + E.x; F.y = pf.y + E.y; }
            hr = F.x; hi = F.y;
#pragma unroll
            for (int j = 0; j < 64; ++j) { *xp = pk2(hr, hi); xp += xst; asm volatile("" : "+v"(xp)); S5_STEP(sw[j]); }
        }
#undef S5_STEP
        __syncthreads();
    }
}
__device__ __forceinline__ void probe_flush(const Args& a, int vcu, int G) {
    PHASE_IDS; const int gt = vcu * NTHR + tid, ngt = G * NTHR;
    const GAS f32x4* p1 = (const GAS f32x4*)a.in[I_W1]; const GAS f32x4* p3 = (const GAS f32x4*)a.in[I_W3];
    f32x4 s = {0.f, 0.f, 0.f, 0.f};
    const int n4 = 4 * 2048 * 5632 / 4;
#pragma unroll 8
    for (int i = gt; i < n4; i += ngt) { s += p1[i]; s += p3[i]; }
    if (s.x + s.y + s.z + s.w == 1.2345e30f) ((float*)(a.ws + WS_CTL))[1000 + (tid & 7)] = s.x;
    __syncthreads();
}

#ifndef GEMM_ALIGN
#define GEMM_ALIGN true
#endif
#ifndef GEMM_SP2
#define GEMM_SP2 true
#endif
#ifndef MK_ONE_LAUNCH
#define MK_ONE_LAUNCH 1
#endif
constexpr int N_PHASES = 2 + 2 * 16;

__global__ void __launch_bounds__(NTHR, 2) fwd_kernel(Args args) {
    extern __shared__ __attribute__((aligned(16))) unsigned char lds_raw[];
    LAS unsigned char* lds = (LAS unsigned char*)lds_raw;
    const int tid = threadIdx.x;
    const int G = gridDim.x, bx = blockIdx.x;
    const int vcu = (G % 8 == 0) ? (bx % 8) * (G / 8) + bx / 8 : bx;
    unsigned char* ws = args.ws;
    volatile LAS unsigned* MISC = (volatile LAS unsigned*)(lds + MISC_OFF);
    for (int u = tid; u < (LDS_BYTES - LDSCTL_OFF) / 4; u += NTHR) ((LAS unsigned*)(lds + LDSCTL_OFF))[u] = 0u;
    __syncthreads();
    const int lo = args.ph_lo, hi = args.ph_hi;
    XcdBarrier bar; bar.bar = (unsigned*)(ws + WS_CTL) + CW_BAR; bar.x = 0; bar.st = nullptr;
    if (hi - lo > 1) bar = xcd_barrier_post((unsigned*)(ws + WS_CTL) + CW_BAR, MISC + 8);
#define RUN(k) (lo <= (k) && (k) < hi)
#ifndef PROBE_MASK
#define PROBE_MASK 0
#endif
#define REP(kind) for (int rep = 0, nrep = 1 + ((PROBE_MASK >> (kind)) & 1); rep < nrep; ++rep)
#ifndef PROBE_WET
#define PROBE_WET 0
#endif
#define GATE(p) ((PROBE_WET && rep) ? (const float*)(ws + WS_CTL + 512 * 1024) : (p))
#define DRY (PROBE_WET ? 0 : rep)
#ifndef PROBE_FLUSH
#define PROBE_FLUSH 0
#endif
#define REPSYNC() do { if (rep + 1 < nrep) { __syncthreads(); if (PROBE_FLUSH == 1) probe_flush(args, vcu, G); } else if (PROBE_FLUSH == 2) { __syncthreads(); probe_flush(args, vcu, G); } } while (0)
#define SEAM(k) do { if (RUN(k) && RUN((k) + 1)) { xcd_barrier(bar); if ((PROBE_MASK >> 12) & 1) xcd_barrier(bar); } } while (0)
    _Float16* H = (_Float16*)(ws + WS_H); pg8::bf16_t* XN = (pg8::bf16_t*)(ws + WS_XN);
    const float* MOD = (const float*)(ws + WS_MOD);

#ifndef NO_PRO
    if (RUN(0)) REP(0) {
        adaln_items(args, lds, vcu, G);
        transpose_items(args, lds, vcu, G);
        small_prologue(args, vcu, G);
#if !S5_NAIVE
        __syncthreads();
        s5_precompute(args, lds, vcu, G);
#endif
        REPSYNC();
    }
#endif
    SEAM(0);
    if (RUN(1)) REP(1) norm_phase<true>(args, args.in[I_N1G], MOD, 0, vcu, G);
    SEAM(1);

#ifdef UNROLL_LP
#pragma unroll
#else
#pragma unroll 1
#endif
    for (int lp = 0; lp < 2; ++lp) {
        const int pb = 2 + lp * 16;
        {
            const int layer = 2 * lp; const float* modl = MOD + (size_t)layer * 3 * 12288;
            if (RUN(pb + 0)) { REP(2) {
                pg8::Gemm g{XN, (const pg8::bf16_t*)(ws + WS_WGIN) + (size_t)lp * 8192 * 2048, M, 8192, D}; pg8::StaticOrder S; S.init(M, 8192, G, bx);
                pg8::EpiG1 E{(pg8::bf16_t*)(ws + WS_ZU), (pg8::bf16_t*)(ws + WS_ZV), (float*)(ws + WS_VSTAT), 0};
                pg8::gemm_phase<pg8::EpiG1, pg8::StaticOrder, GEMM_ALIGN, GEMM_SP2>(lds + RING_OFF, g, S, E);
                REPSYNC(); }
            }
            SEAM(pb + 0);
            #ifndef NO_SGU
            if (RUN(pb + 1)) REP(3) sgu_phase(args, lp, lds, bx, G, rep);
#endif
            SEAM(pb + 1);
            if (RUN(pb + 2)) { REP(4) {
                pg8::Gemm g{(const pg8::bf16_t*)(ws + WS_ZU), (const pg8::bf16_t*)(ws + WS_WGOUT) + (size_t)lp * 2048 * 4096, ML, D, EA}; pg8::StaticOrder S; S.init(ML, D, G, bx);
                pg8::EpiResid E{H, GATE(modl + 2 * D), DRY};
                pg8::gemm_phase<pg8::EpiResid, pg8::StaticOrder, GEMM_ALIGN, GEMM_SP2>(lds + RING_OFF, g, S, E);
                __syncthreads();
                pg8::Gemm gc{(const pg8::bf16_t*)(ws + WS_ZU), (const pg8::bf16_t*)(ws + WS_WGOUT) + (size_t)lp * 2048 * 4096, M, D, 512, EA, EA}; pg8::SliceOrder SS; SS.init(G, bx, 8, 512);
                pg8::EpiSlab ES{(float*)(ws + WS_SLAB), 1024};
                pg8::gemm_phase<pg8::EpiSlab, pg8::SliceOrder, GEMM_ALIGN, GEMM_SP2>(lds + RING_OFF, gc, SS, ES);
                REPSYNC(); }
            }
            SEAM(pb + 2);
            if (RUN(pb + 3)) REP(1) norm_phase<false>(args, args.in[I_N2G] + layer * D, modl, 1, vcu, G, rep ? 0 : 8, modl + 2 * 12288 + 2 * D);
            SEAM(pb + 3);
            if (RUN(pb + 4)) { REP(5) {
                pg8::Gemm g{XN, (const pg8::bf16_t*)(ws + WS_WF13) + (size_t)layer * 11264 * 2048, M, 2 * FF, D}; pg8::StaticOrder S; S.init(M, 2 * FF, G, bx);
                pg8::EpiSwiGLU E{(pg8::bf16_t*)(ws + WS_HID)};
                pg8::gemm_phase<pg8::EpiSwiGLU, pg8::StaticOrder, GEMM_ALIGN, GEMM_SP2>(lds + RING_OFF, g, S, E);
                REPSYNC(); }
            }
            SEAM(pb + 4);
            if (RUN(pb + 5)) { REP(6) {
                pg8::Gemm g{(const pg8::bf16_t*)(ws + WS_HID), (const pg8::bf16_t*)(ws + WS_WF2) + (size_t)layer * 2048 * 5632, ML, D, FF}; pg8::StaticOrder S; S.init(ML, D, G, bx);
                pg8::EpiResid E{H, GATE(modl + 5 * D), DRY};
                pg8::gemm_phase<pg8::EpiResid, pg8::StaticOrder, GEMM_ALIGN, GEMM_SP2>(lds + RING_OFF, g, S, E);
                if (true) { __syncthreads();
                pg8::Gemm gc{(const pg8::bf16_t*)(ws + WS_HID), (const pg8::bf16_t*)(ws + WS_WF2) + (size_t)layer * 2048 * 5632, M, D, 512, FF, FF}; pg8::SliceOrder SS; SS.init(G, bx, 11, 512);
                pg8::EpiSlab ES{(float*)(ws + WS_SLAB), 1024};
                pg8::gemm_phase<pg8::EpiSlab, pg8::SliceOrder, GEMM_ALIGN, GEMM_SP2>(lds + RING_OFF, gc, SS, ES); }
                REPSYNC(); }
            }
            SEAM(pb + 5);
            if (RUN(pb + 6)) REP(1) norm_phase<false>(args, args.in[I_N1G] + (layer + 1) * D, modl + 3 * 12288, 0, vcu, G, rep ? 0 : 11, modl + 2 * 12288 + 5 * D);
            SEAM(pb + 6);
        }
        {
            const int layer = 2 * lp + 1; const float* modl = MOD + (size_t)layer * 3 * 12288; const int ps = pb + 7;
            const int Mrows = lp == 0 ? M : ML;
#if S5_NAIVE
            if (RUN(ps + 0)) {
                pg8::Gemm g{XN, (const pg8::bf16_t*)(ws + WS_WSIN) + (size_t)lp * 2048 * 2048, M, D, D}; pg8::StaticOrder S; S.init(M, D, G, bx);
                pg8::EpiPlainBf16 E{(pg8::bf16_t*)(ws + WS_SU), D};
                pg8::gemm_phase<pg8::EpiPlainBf16, pg8::StaticOrder, GEMM_ALIGN, GEMM_SP2>(lds + RING_OFF, g, S, E);
            }
            SEAM(ps + 0);
            if (RUN(ps + 1)) s5_naive_phase(args, lp, bx, G);
            SEAM(ps + 1);
            if (RUN(ps + 2)) s5_combine_phase(args, lp, vcu, G);
            SEAM(ps + 2);
            SEAM(ps + 3);
#else
            if (RUN(ps + 0)) { REP(7) {
                pg8::Gemm g{XN, (const pg8::bf16_t*)(ws + WS_WSIN) + (size_t)lp * 2048 * 2048, M, D, D}; pg8::StaticOrder S; S.init(M, D, G, bx);
                pg8::EpiS5In E{(pg8::bf16_t*)(ws + WS_XL), (pg8::bf16_t*)(ws + WS_XC)};
                pg8::gemm_phase<pg8::EpiS5In, pg8::StaticOrder, GEMM_ALIGN, GEMM_SP2>(lds + RING_OFF, g, S, E);
                REPSYNC(); }
            }
            SEAM(ps + 0);
            if (RUN(ps + 1)) { REP(8) {
                pg8::Gemm g{(const pg8::bf16_t*)(ws + WS_XL), (const pg8::bf16_t*)(ws + WS_M2T) + (size_t)lp * SG * 256 * 256, SG * 1024, 256, 256, 512}; pg8::GroupOrder S; S.init(G, vcu);
                pg8::EpiS5State E{(pg8::bf16_t*)(ws + WS_SL)};
                pg8::gemm_phase<pg8::EpiS5State, pg8::GroupOrder, GEMM_ALIGN, GEMM_SP2>(lds + RING_OFF, g, S, E);
                s5_ctx_gemm<false>(args, lp, vcu, G);
                REPSYNC(); }
            }
            SEAM(ps + 1);
            if (RUN(ps + 2)) REP(9) s5_carry_phase(args, lp, lds, bx, G);
            SEAM(ps + 2);
            if (RUN(ps + 3)) { REP(10) {
                pg8::Gemm g{(const pg8::bf16_t*)(ws + WS_XL), (const pg8::bf16_t*)(ws + WS_MOUTT) + (size_t)lp * SG * 256 * 512, SG * 1024, 256, 512, 512}; pg8::GroupOrder S; S.init(G, vcu);
                pg8::EpiS5Out E{(pg8::bf16_t*)(ws + WS_Z)};
                pg8::gemm_phase<pg8::EpiS5Out, pg8::GroupOrder, GEMM_ALIGN, GEMM_SP2>(lds + RING_OFF, g, S, E);
                s5_ctx_gemm<true>(args, lp, vcu, G);
                REPSYNC(); }
            }
            SEAM(ps + 3);
#endif
            if (RUN(ps + 4)) { REP(11) {
                pg8::Gemm g{(const pg8::bf16_t*)(ws + WS_Z), (const pg8::bf16_t*)(ws + WS_WGLU) + (size_t)lp * 4096 * 2048, Mrows, 2 * D, D}; pg8::StaticOrder S; S.init(Mrows, 2 * D, G, bx);
                pg8::EpiGluResid E{H, GATE(modl + 2 * D), DRY};
                pg8::gemm_phase<pg8::EpiGluResid, pg8::StaticOrder, GEMM_ALIGN, GEMM_SP2>(lds + RING_OFF, g, S, E);
                REPSYNC(); }
            }
            SEAM(ps + 4);
            if (RUN(ps + 5)) REP(1) norm_phase<false>(args, args.in[I_N2G] + layer * D, modl, 1, vcu, G, 0, nullptr, Mrows);
            SEAM(ps + 5);
            if (RUN(ps + 6)) { REP(5) {
                pg8::Gemm g{XN, (const pg8::bf16_t*)(ws + WS_WF13) + (size_t)layer * 11264 * 2048, Mrows, 2 * FF, D}; pg8::StaticOrder S; S.init(Mrows, 2 * FF, G, bx);
                pg8::EpiSwiGLU E{(pg8::bf16_t*)(ws + WS_HID)};
                pg8::gemm_phase<pg8::EpiSwiGLU, pg8::StaticOrder, GEMM_ALIGN, GEMM_SP2>(lds + RING_OFF, g, S, E);
                REPSYNC(); }
            }
            SEAM(ps + 6);
            if (RUN(ps + 7)) { REP(6) {
                pg8::Gemm g{(const pg8::bf16_t*)(ws + WS_HID), (const pg8::bf16_t*)(ws + WS_WF2) + (size_t)layer * 2048 * 5632, ML, D, FF}; pg8::StaticOrder S; S.init(ML, D, G, bx);
                pg8::EpiResid E{H, GATE(modl + 5 * D), DRY};
                pg8::gemm_phase<pg8::EpiResid, pg8::StaticOrder, GEMM_ALIGN, GEMM_SP2>(lds + RING_OFF, g, S, E);
                if (lp == 0) { __syncthreads();
                pg8::Gemm gc{(const pg8::bf16_t*)(ws + WS_HID), (const pg8::bf16_t*)(ws + WS_WF2) + (size_t)layer * 2048 * 5632, M, D, 512, FF, FF}; pg8::SliceOrder SS; SS.init(G, bx, 11, 512);
                pg8::EpiSlab ES{(float*)(ws + WS_SLAB), 1024};
                pg8::gemm_phase<pg8::EpiSlab, pg8::SliceOrder, GEMM_ALIGN, GEMM_SP2>(lds + RING_OFF, gc, SS, ES); }
                REPSYNC(); }
            }
            SEAM(ps + 7);
            if (RUN(ps + 8)) {
                REP(1) if (lp == 0) norm_phase<false>(args, args.in[I_N1G] + (layer + 1) * D, modl + 3 * 12288, 0, vcu, G, rep ? 0 : 11, modl + 2 * 12288 + 5 * D);
                else final_phase(args, vcu, G);
            }
            SEAM(ps + 8);
        }
    }
#undef RUN
#undef SEAM
}

extern "C" void kernel_launch(void* const* d_in, const int* in_sizes, int n_in, void* d_out, int out_size, void* d_ws, size_t ws_size, hipStream_t stream) {
    static int grid = 0;
    if (grid == 0) {
        if (n_in != 28 || in_sizes[0] != ML * D || out_size != ML * D || ws_size < WS_END) {
            fprintf(stderr, "kernel_launch: unexpected problem (n_in %d, in0 %d, out %d, ws %zu, need ws >= %zu); nothing launched\n", n_in, n_in > 0 ? in_sizes[0] : -1, out_size, ws_size, (size_t)WS_END); grid = -1; return; }
        int dev = 0, cus = 0, per_cu = 0;
        if (hipGetDevice(&dev) != hipSuccess || hipDeviceGetAttribute(&cus, hipDeviceAttributeMultiprocessorCount, dev) != hipSuccess) { fprintf(stderr, "kernel_launch: device query failed\n"); grid = -1; return; }
        if (hipFuncSetAttribute((const void*)fwd_kernel, hipFuncAttributeMaxDynamicSharedMemorySize, LDS_BYTES) != hipSuccess) { fprintf(stderr, "kernel_launch: hipFuncSetAttribute failed\n"); grid = -1; return; }
        if (hipOccupancyMaxActiveBlocksPerMultiprocessor(&per_cu, (const void*)fwd_kernel, NTHR, LDS_BYTES) != hipSuccess || per_cu < 1) {
            fprintf(stderr, "kernel_launch: occupancy query reports %d workgroups per CU\n", per_cu); }
        (void)hipGetLastError();
        grid = cus;
    }
    if (grid < 0) return;
    if (hipMemsetAsync((char*)d_ws + WS_CTL, 0, (PROBE_MASK || PROBE_WET) ? CTL_ZERO_BYTES : 64 * 1024, stream) != hipSuccess) { fprintf(stderr, "kernel_launch: memset failed\n"); return; }
    Args a{};
    for (int i = 0; i < 28; ++i) a.in[i] = (const float*)d_in[i];
    a.out = (float*)d_out; a.ws = (unsigned char*)d_ws;
#if MK_ONE_LAUNCH
    a.ph_lo = 0; a.ph_hi = N_PHASES;
    hipLaunchKernelGGL(fwd_kernel, dim3(grid), dim3(NTHR), LDS_BYTES, stream, a);
#else
    for (int p = 0; p < N_PHASES; ++p) { a.ph_lo = p; a.ph_hi = p + 1; hipLaunchKernelGGL(fwd_kernel, dim3(grid), dim3(NTHR), LDS_BYTES, stream, a); }
#endif
    const hipError_t le = hipPeekAtLastError();
    if (le != hipSuccess) fprintf(stderr, "kernel_launch: launch failed: %s\n", hipGetErrorName(le));
}
```

```cpp
#include <hip/hip_runtime.h>
#include <cstdio>
#include <cstdint>
namespace pg8 {
#define PG8_LAS __attribute__((address_space(3)))
typedef unsigned short bf16_t;
typedef short bf16x8 __attribute__((ext_vector_type(8)));
typedef float f32x4 __attribute__((ext_vector_type(4)));
typedef unsigned u32x4 __attribute__((ext_vector_type(4)));
constexpr int BM = 256, BK = 64, HALF = 128, HTB = HALF * BK * 2  , STAGE_BYTES = 8 * HTB, NXCD = 8, WGM = 8;

__host__ __device__ __forceinline__ int lds_byte(int r, int c) { const int st = (r >> 4) * 2 + (c >> 5), rr = r & 15, cc = c & 31, ob = rr * 64 + cc * 2; return st * 1024 + (ob ^ (((ob >> 9) & 1) << 5)); }
__host__ __device__ __forceinline__ void stage_rc(int b, int& R, int& C) { const int st = b / 1024, sb = b % 1024, swz = sb ^ (((sb >> 9) & 1) << 5); R = (st >> 1) * 16 + swz / 64; C = (st & 1) * 32 + (swz % 64) / 2; }
__host__ __device__ __forceinline__ int perm32(int rho) { const int n = rho >> 4, i = rho & 15; return 8 * (i >> 2) + 4 * n + (i & 3); }

struct Unit { int pm, pn; int koff; };
struct Gemm { const bf16_t* A; const bf16_t* Bt; int M, N, K; int lda, ldb; };

struct StaticOrder {
    int nM, nN, nwg, G, c;
    __host__ __device__ void init(int M, int N, int G_, int c_) { nM = M / BM; nN = N / BM; nwg = nM * nN; G = G_; c = c_; }
    __host__ __device__ bool next(int i, Unit& u) const {
        const long L = (long)i * G + c; if (L >= nwg) return false;
        int wgid = (int)L; { const int q = nwg / NXCD, r = nwg % NXCD, xcd = wgid % NXCD, off = wgid / NXCD; wgid = (xcd < r ? xcd * (q + 1) : r * (q + 1) + (xcd - r) * q) + off; }
        const int nig = WGM * nN, gid = wgid / nig, fm = gid * WGM, gsz = (nM - fm) < WGM ? (nM - fm) : WGM;
        u.pm = fm + ((wgid % nig) % gsz); u.pn = (wgid % nig) / gsz; u.koff = 0; return true;
    }
    __device__ __forceinline__ void a_ready(const Unit&) const {}
    __device__ __forceinline__ void done(const Unit&) const {}
};

__device__ __forceinline__ unsigned cvt_pk_bf16(float lo, float hi) { unsigned r; asm volatile("v_cvt_pk_bf16_f32 %0, %1, %2" : "=v"(r) : "v"(lo), "v"(hi)); return r; }
typedef float f32x2 __attribute__((ext_vector_type(2)));
__device__ __forceinline__ f32x2 gelu_pk(f32x2 v) {
    const f32x2 av = __builtin_elementwise_abs(v), d = av * 0.2316418882f + 1.0f;
    f32x2 t; t.x = __builtin_amdgcn_rcpf(d.x); t.y = __builtin_amdgcn_rcpf(d.y);
    f32x2 q = t * 0.5307027145f + (-0.7265760135f); q = q * t + 0.7107068705f; q = q * t + (-0.142248368f); q = q * t + 0.127414796f; q = q * t;
    const f32x2 s = (v * v) * (-0.72134752044f);
    f32x2 e; e.x = __builtin_amdgcn_exp2f(s.x); e.y = __builtin_amdgcn_exp2f(s.y);
    const f32x2 m = v * (q * e), r = v - m;
    f32x2 o; o.x = v.x < 0.f ? m.x : r.x; o.y = v.y < 0.f ? m.y : r.y; return o;
}


__device__ __forceinline__ float sigmoid_f(float x) { return __builtin_amdgcn_rcpf(1.0f + __builtin_amdgcn_exp2f(-1.44269504f * x)); }
__device__ __forceinline__ float silu_f(float x) { return x * sigmoid_f(x); }
__device__ __forceinline__ float gelu_tanh_f(float x) { const float u = x * (1.0f + 0.044715f * x * x); return x * __builtin_amdgcn_rcpf(1.0f + __builtin_amdgcn_exp2f(-2.30220820f * u)); }
__device__ __forceinline__ f32x2 gelu_tanh_pk(f32x2 x) {
    f32x2 xc; xc.x = __builtin_amdgcn_fmed3f(x.x, -3.6f, 3.6f); xc.y = __builtin_amdgcn_fmed3f(x.y, -3.6f, 3.6f);
    const f32x2 z = xc * 0.277777778f, z2 = z * z;
    f32x2 p = z2 * (-0.707277966f) + 3.50913538f;
    p = p * z2 + (-7.72999719f); p = p * z2 + 10.1716655f; p = p * z2 + (-9.14213848f); p = p * z2 + 6.07337743f; p = p * z2 + (-3.11094742f); p = p * z2 + 1.43606059f;
    return x * (p * z + 0.5f);
}
__device__ __forceinline__ int row_set(int pm) { return pm < 32 ? 0 : (pm < 64 ? 1 : 2); }

struct EpiPlainBf16 {
    static constexpr bool PERM = true, AFTER_DRAIN = false;
    bf16_t* O; int ldc;
    __device__ __forceinline__ void operator()(const f32x4 (&acc)[2][2][4][2], const Unit& u, int wr, int wc, int fr, int fq) const {
        const int row0 = u.pm * BM + wr * 64 + fr, col0 = u.pn * BM + wc * 32 + 8 * fq;
#pragma unroll
        for (int ai = 0; ai < 2; ++ai)
#pragma unroll
            for (int m = 0; m < 4; ++m) { bf16_t* rowp = O + (size_t)(row0 + ai * HALF + m * 16) * ldc + col0;
#pragma unroll
                for (int bj = 0; bj < 2; ++bj) { const f32x4 v0 = acc[ai][bj][m][0], v1 = acc[ai][bj][m][1];
                    u32x4 w; w.x = cvt_pk_bf16(v0[0], v0[1]); w.y = cvt_pk_bf16(v0[2], v0[3]); w.z = cvt_pk_bf16(v1[0], v1[1]); w.w = cvt_pk_bf16(v1[2], v1[3]);
                    *(u32x4*)(rowp + bj * HALF) = w; } }
    }
};
struct EpiG1 {
    static constexpr bool PERM = true, AFTER_DRAIN = false;
    bf16_t* U; bf16_t* V; float* vstat; int dry;
    __device__ __forceinline__ void operator()(const f32x4 (&acc)[2][2][4][2], const Unit& u, int wr, int wc, int fr, int fq) const {
        if (dry) return;
        const bool isv = u.pn >= 16;
        const int row0 = u.pm * BM + wr * 64 + fr, col0 = (u.pn & 15) * BM + wc * 32 + 8 * fq;
        bf16_t* base = isv ? V : U;
#pragma unroll
        for (int ai = 0; ai < 2; ++ai)
#pragma unroll
            for (int m = 0; m < 4; ++m) { const int row = row0 + ai * HALF + m * 16; bf16_t* rowp = base + (size_t)row * 4096 + col0; float s = 0.f, ss = 0.f;
#pragma unroll
                for (int bj = 0; bj < 2; ++bj) { f32x4 v0 = acc[ai][bj][m][0], v1 = acc[ai][bj][m][1];
                    { const f32x2 a0 = gelu_tanh_pk((f32x2){v0[0], v0[1]}), a1 = gelu_tanh_pk((f32x2){v0[2], v0[3]}), a2 = gelu_tanh_pk((f32x2){v1[0], v1[1]}), a3 = gelu_tanh_pk((f32x2){v1[2], v1[3]});
                      v0 = (f32x4){a0.x, a0.y, a1.x, a1.y}; v1 = (f32x4){a2.x, a2.y, a3.x, a3.y}; }
                    if (isv) {
#pragma unroll
                        for (int e = 0; e < 4; ++e) { s += v0[e] + v1[e]; ss += v0[e] * v0[e] + v1[e] * v1[e]; } }
                    u32x4 w; w.x = cvt_pk_bf16(v0[0], v0[1]); w.y = cvt_pk_bf16(v0[2], v0[3]); w.z = cvt_pk_bf16(v1[0], v1[1]); w.w = cvt_pk_bf16(v1[2], v1[3]);
                    *(u32x4*)(rowp + bj * HALF) = w; }
                if (isv) { s += __shfl_xor(s, 16); s += __shfl_xor(s, 32); ss += __shfl_xor(ss, 16); ss += __shfl_xor(ss, 32);
                    if (fq == 0) { f32x2 o; o.x = s; o.y = ss; *(f32x2*)(vstat + ((size_t)row * 64 + (u.pn - 16) * 4 + wc) * 2) = o; } } }
    }
};
typedef _Float16 h16x8 __attribute__((ext_vector_type(8)));
struct EpiResid {
    static constexpr bool PERM = true, AFTER_DRAIN = false;
    _Float16* H; const float* gate; int dry;
    __device__ __forceinline__ void operator()(const f32x4 (&acc)[2][2][4][2], const Unit& u, int wr, int wc, int fr, int fq) const {
        if (dry) return;
        const int row0 = u.pm * BM + wr * 64 + fr, col0 = u.pn * BM + wc * 32 + 8 * fq;
        const float* g = gate + row_set(u.pm) * (6 * 2048) + col0;
        f32x4 gv[2][2];
#pragma unroll
        for (int bj = 0; bj < 2; ++bj)
#pragma unroll
            for (int n = 0; n < 2; ++n) gv[bj][n] = *(const f32x4*)(g + bj * HALF + n * 4);
        h16x8 hv[2][4][2];
#pragma unroll
        for (int ai = 0; ai < 2; ++ai)
#pragma unroll
            for (int m = 0; m < 4; ++m)
#pragma unroll
                for (int bj = 0; bj < 2; ++bj) hv[ai][m][bj] = *(const h16x8*)(H + (size_t)(row0 + ai * HALF + m * 16) * 2048 + col0 + bj * HALF);
        __builtin_amdgcn_sched_barrier(0);
#pragma unroll
        for (int ai = 0; ai < 2; ++ai)
#pragma unroll
            for (int m = 0; m < 4; ++m)
#pragma unroll
                for (int bj = 0; bj < 2; ++bj) { h16x8 h = hv[ai][m][bj];
#pragma unroll
                    for (int e = 0; e < 4; ++e) { h[e] = (_Float16)((float)h[e] + gv[bj][0][e] * acc[ai][bj][m][0][e]); h[4 + e] = (_Float16)((float)h[4 + e] + gv[bj][1][e] * acc[ai][bj][m][1][e]); }
                    *(h16x8*)(H + (size_t)(row0 + ai * HALF + m * 16) * 2048 + col0 + bj * HALF) = h; }
    }
};
struct EpiSwiGLU {
    static constexpr bool PERM = true, AFTER_DRAIN = false;
    bf16_t* O;
    __device__ __forceinline__ void operator()(const f32x4 (&acc)[2][2][4][2], const Unit& u, int wr, int wc, int fr, int fq) const {
        const int row0 = u.pm * BM + wr * 64 + fr, col0 = u.pn * HALF + wc * 32 + 8 * fq;
#pragma unroll
        for (int ai = 0; ai < 2; ++ai)
#pragma unroll
            for (int m = 0; m < 4; ++m) { bf16_t* rowp = O + (size_t)(row0 + ai * HALF + m * 16) * 5632 + col0;
                f32x4 a0 = acc[ai][0][m][0], a1 = acc[ai][0][m][1]; const f32x4 b0 = acc[ai][1][m][0], b1 = acc[ai][1][m][1];
#pragma unroll
                for (int e = 0; e < 4; ++e) { a0[e] = silu_f(a0[e]) * b0[e]; a1[e] = silu_f(a1[e]) * b1[e]; }
                u32x4 w; w.x = cvt_pk_bf16(a0[0], a0[1]); w.y = cvt_pk_bf16(a0[2], a0[3]); w.z = cvt_pk_bf16(a1[0], a1[1]); w.w = cvt_pk_bf16(a1[2], a1[3]);
                *(u32x4*)rowp = w; }
    }
};
struct EpiGluResid {
    static constexpr bool PERM = true, AFTER_DRAIN = false;
    _Float16* H; const float* gate; int dry;
    __device__ __forceinline__ void operator()(const f32x4 (&acc)[2][2][4][2], const Unit& u, int wr, int wc, int fr, int fq) const {
        if (dry) return;
        const int row0 = u.pm * BM + wr * 64 + fr, col0 = u.pn * HALF + wc * 32 + 8 * fq;
        const float* g = gate + row_set(u.pm) * (6 * 2048) + col0;
        f32x4 gv[2];
#pragma unroll
        for (int n = 0; n < 2; ++n) gv[n] = *(const f32x4*)(g + n * 4);
        h16x8 hv[2][4];
#pragma unroll
        for (int ai = 0; ai < 2; ++ai)
#pragma unroll
            for (int m = 0; m < 4; ++m) hv[ai][m] = *(const h16x8*)(H + (size_t)(row0 + ai * HALF + m * 16) * 2048 + col0);
        __builtin_amdgcn_sched_barrier(0);
#pragma unroll
        for (int ai = 0; ai < 2; ++ai)
#pragma unroll
            for (int m = 0; m < 4; ++m) { h16x8 h = hv[ai][m];
#pragma unroll
                for (int n = 0; n < 2; ++n) { const f32x4 a = acc[ai][0][m][n], gg = acc[ai][1][m][n];
#pragma unroll
                    for (int e = 0; e < 4; ++e) h[4 * n + e] = (_Float16)((float)h[4 * n + e] + gv[n][e] * a[e] * sigmoid_f(gg[e])); }
                *(h16x8*)(H + (size_t)(row0 + ai * HALF + m * 16) * 2048 + col0) = h; }
    }
};

struct GroupOrder {
    int G, c, adj;
    __host__ __device__ void init(int G_, int c_, int adj_ = 0) { G = G_; c = c_; adj = adj_; }
    __host__ __device__ bool next(int i, Unit& u) const { const int L = i * G + c; if (L >= 512) return false;
        if (adj) { const int grp = 4 * (L >> 4) + (L & 3), rt = (L >> 2) & 3; u.pm = 4 * grp + rt; u.pn = grp; } else { u.pm = L; u.pn = L >> 2; }
        u.koff = 0; return true; }
    __device__ __forceinline__ void a_ready(const Unit&) const {}
    __device__ __forceinline__ void done(const Unit&) const {}
};
struct EpiS5In {
    static constexpr bool PERM = true, AFTER_DRAIN = false;
    bf16_t* XL; bf16_t* XC;
    __device__ __forceinline__ void operator()(const f32x4 (&acc)[2][2][4][2], const Unit& u, int wr, int wc, int fr, int fq) const {
        const int row0 = u.pm * BM + wr * 64 + fr;
#pragma unroll
        for (int ai = 0; ai < 2; ++ai)
#pragma unroll
            for (int m = 0; m < 4; ++m) { const int row = row0 + ai * HALF + m * 16;
#pragma unroll
                for (int bj = 0; bj < 2; ++bj) { const int col0 = u.pn * BM + bj * HALF + wc * 32 + 8 * fq, g = col0 >> 4, q0 = col0 & 15;
                    bf16_t* dst = row < 16384 ? XL + ((size_t)(g * 1024 + (row >> 4)) * 512 + 16 * (row & 15) + q0)
                                              : XC + ((size_t)(g * 32 + ((row - 16384) >> 4)) * 512 + 16 * (row & 15) + q0);
                    const f32x4 v0 = acc[ai][bj][m][0], v1 = acc[ai][bj][m][1];
                    u32x4 w; w.x = cvt_pk_bf16(v0[0], v0[1]); w.y = cvt_pk_bf16(v0[2], v0[3]); w.z = cvt_pk_bf16(v1[0], v1[1]); w.w = cvt_pk_bf16(v1[2], v1[3]);
                    *(u32x4*)dst = w; } }
    }
};
struct EpiS5State {
    static constexpr bool PERM = true, AFTER_DRAIN = false;
    bf16_t* SL;
    __device__ __forceinline__ void operator()(const f32x4 (&acc)[2][2][4][2], const Unit& u, int wr, int wc, int fr, int fq) const {
        const int row0 = u.pm * BM + wr * 64 + fr, col0 = wc * 32 + 8 * fq;
#pragma unroll
        for (int ai = 0; ai < 2; ++ai)
#pragma unroll
            for (int m = 0; m < 4; ++m) { bf16_t* rowp = SL + (size_t)(row0 + ai * HALF + m * 16) * 256 + col0;
#pragma unroll
                for (int bj = 0; bj < 2; ++bj) { const f32x4 v0 = acc[ai][bj][m][0], v1 = acc[ai][bj][m][1];
                    u32x4 w; w.x = cvt_pk_bf16(v0[0], v0[1]); w.y = cvt_pk_bf16(v0[2], v0[3]); w.z = cvt_pk_bf16(v1[0], v1[1]); w.w = cvt_pk_bf16(v1[2], v1[3]);
                    *(u32x4*)(rowp + bj * HALF) = w; } }
    }
};
struct EpiS5Out {
    static constexpr bool PERM = true, AFTER_DRAIN = false;
    bf16_t* Z;
    __device__ __forceinline__ void operator()(const f32x4 (&acc)[2][2][4][2], const Unit& u, int wr, int wc, int fr, int fq) const {
        const int c0 = (u.pm & 3) * BM + wr * 64 + fr, g = u.pn;
#pragma unroll
        for (int ai = 0; ai < 2; ++ai)
#pragma unroll
            for (int m = 0; m < 4; ++m) { const int c = c0 + ai * HALF + m * 16;
#pragma unroll
                for (int bj = 0; bj < 2; ++bj) { const int n0 = bj * HALF + wc * 32 + 8 * fq, t = n0 >> 4, q0 = n0 & 15;
                    f32x4 v0 = acc[ai][bj][m][0], v1 = acc[ai][bj][m][1];
#pragma unroll
                    for (int e = 0; e < 4; ++e) { v0[e] = gelu_tanh_f(v0[e]); v1[e] = gelu_tanh_f(v1[e]); }
                    u32x4 w; w.x = cvt_pk_bf16(v0[0], v0[1]); w.y = cvt_pk_bf16(v0[2], v0[3]); w.z = cvt_pk_bf16(v1[0], v1[1]); w.w = cvt_pk_bf16(v1[2], v1[3]);
                    *(u32x4*)(Z + (size_t)(16 * c + t) * 2048 + 16 * g + q0) = w; } }
    }
};

struct SliceOrder {
    int G, c, nsl, kbytes;
    __host__ __device__ void init(int G_, int c_, int nsl_, int kslice) { G = G_; c = c_; nsl = nsl_; kbytes = kslice * 2; }
    __host__ __device__ bool next(int i, Unit& u) const { const int L = i * G + c; if (L >= nsl * 16) return false; const int s = L >> 4, r = L & 15; u.pm = 64 + (r >> 3); u.pn = r & 7; u.koff = s * kbytes; return true; }
    __device__ __forceinline__ void a_ready(const Unit&) const {}
    __device__ __forceinline__ void done(const Unit&) const {}
};
struct EpiSlab {
    static constexpr bool PERM = false, AFTER_DRAIN = false;
    float* SLAB; int kbytes;
    __device__ __forceinline__ void operator()(const f32x4 (&acc)[2][2][4][2], const Unit& u, int wr, int wc, int fr, int fq) const {
        const int s = u.koff / kbytes, row0 = (u.pm - 64) * BM + wr * 64 + fr, col0 = u.pn * BM + wc * 32 + 4 * fq;
        float* base = SLAB + (size_t)s * 512 * 2048;
#pragma unroll
        for (int ai = 0; ai < 2; ++ai)
#pragma unroll
            for (int m = 0; m < 4; ++m) { float* rowp = base + (size_t)(row0 + ai * HALF + m * 16) * 2048 + col0;
#pragma unroll
                for (int bj = 0; bj < 2; ++bj)
#pragma unroll
                    for (int n = 0; n < 2; ++n) *(f32x4*)(rowp + bj * HALF + n * 16) = acc[ai][bj][m][n]; }
    }
};

template <class Epi, class Sched, bool ALIGN_EPI = false, bool SP2 = false>
__device__ __forceinline__ void gemm_phase(PG8_LAS unsigned char* lds, const Gemm g, const Sched& S, const Epi& E) {
    int tid_ = threadIdx.x; asm volatile("" : "+v"(tid_));
    const int tid = tid_, wid = __builtin_amdgcn_readfirstlane(tid >> 6), lane = tid & 63, wr = wid >> 2, wc = wid & 3, fr = lane & 15, fq = lane >> 4;
    const int K = g.K, nt = K / BK, lda = g.lda ? g.lda : K, ldb = g.ldb ? g.ldb : K;
    unsigned voffA[2], voffB[2];
#pragma unroll
    for (int i = 0; i < 2; ++i) { int R, C; stage_rc(tid * 16 + i * 8192, R, C); const int Rb = Epi::PERM ? ((R & ~31) + perm32(R & 31)) : R;
        voffA[i] = (unsigned)(R * lda + C) * 2u; voffB[i] = (unsigned)(Rb * ldb + C) * 2u; }
    const size_t kstep = (size_t)(BK * 2);
    const size_t hstepB = (size_t)HALF * ldb * 2, hstepA = (size_t)HALF * lda * 2;
    const size_t tstepB = 2 * hstepB, tstepA = 2 * hstepA;
    const unsigned ldsw = (unsigned)wid * 1024u;
    const int aoff = lds_byte(wr * 64 + fr, fq * 8), boff = lds_byte(wc * 32 + fr, fq * 8);
#define PG8_SA(b, h) (((b) * 2 + (h)) * HTB)
#define PG8_SB(b, h) ((4 + (b) * 2 + (h)) * HTB)
#define PG8_STAGE(bufoff, gbase, voff) do { _Pragma("unroll") for (int _i = 0; _i < 2; ++_i) \
        __builtin_amdgcn_global_load_lds((const unsigned*)((const char*)(gbase) + (voff)[_i]), (PG8_LAS unsigned*)(lds + (bufoff) + ldsw + _i * 8192), 16, 0, 0); } while (0)
#define PG8_LDA(dst, b, h) do { _Pragma("unroll") for (int m = 0; m < 4; ++m) _Pragma("unroll") for (int k = 0; k < 2; ++k) dst[m][k] = *(const PG8_LAS bf16x8*)(lds + PG8_SA(b, h) + aoff + m * 2048 + k * 1024); } while (0)
#define PG8_LDB(dst, b, h) do { _Pragma("unroll") for (int n = 0; n < 2; ++n) _Pragma("unroll") for (int k = 0; k < 2; ++k) dst[n][k] = *(const PG8_LAS bf16x8*)(lds + PG8_SB(b, h) + boff + n * 2048 + k * 1024); } while (0)
#define PG8_MMA(ai, bj, At, Bt) do { __builtin_amdgcn_s_setprio(1); _Pragma("unroll") for (int m = 0; m < 4; ++m) _Pragma("unroll") for (int n = 0; n < 2; ++n) _Pragma("unroll") for (int k = 0; k < 2; ++k) \
        acc[ai][bj][m][n] = __builtin_amdgcn_mfma_f32_16x16x32_bf16(Bt[n][k], At[m][k], acc[ai][bj][m][n], 0, 0, 0); __builtin_amdgcn_s_setprio(0); } while (0)
#define PG8_WAIT_V(n) asm volatile("s_waitcnt vmcnt(" #n ")" ::: "memory")
#define PG8_WAIT_L(n) asm volatile("s_waitcnt lgkmcnt(" #n ")" ::: "memory")
#define PG8_BAR __builtin_amdgcn_s_barrier()
#define PG8_SCHED __builtin_amdgcn_sched_barrier(0)
    Unit cur, nxt; int ui = 0;
    if (!S.next(0, cur)) return;
    f32x4 acc[2][2][4][2];
#pragma unroll
    for (int a = 0; a < 2; ++a)
#pragma unroll
        for (int b = 0; b < 2; ++b)
#pragma unroll
            for (int m = 0; m < 4; ++m)
#pragma unroll
                for (int n = 0; n < 2; ++n) acc[a][b][m][n] = (f32x4){0.f, 0.f, 0.f, 0.f};
    bf16x8 At[4][2], B0[2][2], B1[2][2];
    const char* cA = (const char*)g.A + (size_t)cur.pm * tstepA + cur.koff; const char* cB = (const char*)g.Bt + (size_t)cur.pn * tstepB + cur.koff;
    S.a_ready(cur);
    if constexpr (SP2) {
        PG8_STAGE(PG8_SB(0, 0), cB, voffB); PG8_STAGE(PG8_SB(0, 1), cB + hstepB, voffB); PG8_STAGE(PG8_SA(0, 0), cA, voffA); PG8_STAGE(PG8_SA(0, 1), cA + hstepA, voffA);
        if (wr == 1) PG8_BAR;
        PG8_WAIT_V(2); PG8_BAR;
        PG8_STAGE(PG8_SB(1, 0), cB + kstep, voffB); PG8_STAGE(PG8_SA(1, 0), cA + kstep, voffA); PG8_STAGE(PG8_SB(1, 1), cB + hstepB + kstep, voffB);
        PG8_WAIT_V(6); PG8_BAR;
    } else {
        PG8_STAGE(PG8_SB(0, 0), cB, voffB); PG8_STAGE(PG8_SA(0, 0), cA, voffA); PG8_STAGE(PG8_SB(0, 1), cB + hstepB, voffB); PG8_STAGE(PG8_SA(0, 1), cA + hstepA, voffA);
        if (wr == 1) PG8_BAR;
        PG8_WAIT_V(4); PG8_BAR;
        PG8_STAGE(PG8_SB(1, 0), cB + kstep, voffB); PG8_STAGE(PG8_SA(1, 0), cA + kstep, voffA); PG8_STAGE(PG8_SB(1, 1), cB + hstepB + kstep, voffB);
        PG8_WAIT_V(6); PG8_BAR;
    }
    for (;;) {
        const bool has_next = S.next(ui + 1, nxt);
        const char* nA = has_next ? (const char*)g.A + (size_t)nxt.pm * tstepA + nxt.koff : cA; const char* nB = has_next ? (const char*)g.Bt + (size_t)nxt.pn * tstepB + nxt.koff : cB;
#pragma unroll 1
        for (int t = 0; t < nt; t += 2) {
            const bool last = (t == nt - 2);
            const char* a1 = cA + (size_t)(t + 1) * kstep;
            const char* a2 = last ? nA : cA + (size_t)(t + 2) * kstep; const char* b2 = last ? nB : cB + (size_t)(t + 2) * kstep;
            const char* a3 = a2 + kstep; const char* b3 = b2 + kstep;
            if (last && has_next) S.a_ready(nxt);
            if constexpr (SP2) {
            PG8_LDB(B0, 0, 0); PG8_LDB(B1, 0, 1); PG8_SCHED; PG8_LDA(At, 0, 0); PG8_STAGE(PG8_SA(1, 1), a1 + hstepA, voffA);
            PG8_WAIT_V(8); PG8_WAIT_L(0); PG8_BAR; PG8_MMA(0, 0, At, B0); PG8_MMA(0, 1, At, B1); PG8_BAR; PG8_SCHED;
            PG8_LDA(At, 0, 1); PG8_STAGE(PG8_SB(0, 0), b2, voffB); PG8_STAGE(PG8_SB(0, 1), b2 + hstepB, voffB); PG8_STAGE(PG8_SA(0, 0), a2, voffA);
            PG8_WAIT_V(8); PG8_WAIT_L(0); PG8_BAR; PG8_MMA(1, 0, At, B0); PG8_MMA(1, 1, At, B1); PG8_BAR; PG8_SCHED;
            PG8_LDB(B0, 1, 0); PG8_LDB(B1, 1, 1); PG8_SCHED; PG8_LDA(At, 1, 0); PG8_STAGE(PG8_SA(0, 1), a2 + hstepA, voffA);
            PG8_WAIT_V(8); PG8_WAIT_L(0); PG8_BAR; PG8_MMA(0, 0, At, B0); PG8_MMA(0, 1, At, B1); PG8_BAR; PG8_SCHED;
            PG8_LDA(At, 1, 1); PG8_STAGE(PG8_SB(1, 0), b3, voffB); PG8_STAGE(PG8_SB(1, 1), b3 + hstepB, voffB); PG8_STAGE(PG8_SA(1, 0), a3, voffA);
            PG8_WAIT_V(8); PG8_WAIT_L(0); PG8_BAR; PG8_MMA(1, 0, At, B0); PG8_MMA(1, 1, At, B1); PG8_BAR; PG8_SCHED;
            } else {
            PG8_LDB(B0, 0, 0); PG8_SCHED; PG8_LDA(At, 0, 0); PG8_STAGE(PG8_SA(1, 1), a1 + hstepA, voffA);
            PG8_WAIT_L(8); PG8_BAR; PG8_WAIT_L(0); PG8_MMA(0, 0, At, B0); PG8_BAR; PG8_SCHED;
            PG8_LDB(B1, 0, 1); PG8_STAGE(PG8_SB(0, 0), b2, voffB);
            PG8_BAR; PG8_WAIT_L(0); PG8_MMA(0, 1, At, B1); PG8_BAR;
            PG8_LDA(At, 0, 1); PG8_STAGE(PG8_SA(0, 0), a2, voffA);
            PG8_BAR; PG8_WAIT_L(0); PG8_MMA(1, 0, At, B0); PG8_BAR; PG8_SCHED;
            PG8_STAGE(PG8_SB(0, 1), b2 + hstepB, voffB);
            PG8_WAIT_V(6); PG8_BAR; PG8_MMA(1, 1, At, B1); PG8_BAR;
            PG8_LDB(B0, 1, 0); PG8_SCHED; PG8_LDA(At, 1, 0); PG8_STAGE(PG8_SA(0, 1), a2 + hstepA, voffA);
            PG8_WAIT_L(8); PG8_BAR; PG8_WAIT_L(0); PG8_MMA(0, 0, At, B0); PG8_BAR; PG8_SCHED;
            PG8_LDB(B1, 1, 1); PG8_STAGE(PG8_SB(1, 0), b3, voffB);
            PG8_BAR; PG8_WAIT_L(0); PG8_MMA(0, 1, At, B1); PG8_BAR;
            PG8_LDA(At, 1, 1); PG8_STAGE(PG8_SA(1, 0), a3, voffA);
            PG8_BAR; PG8_WAIT_L(0); PG8_MMA(1, 0, At, B0); PG8_BAR; PG8_SCHED;
            PG8_STAGE(PG8_SB(1, 1), b3 + hstepB, voffB);
            PG8_WAIT_V(6); PG8_BAR; PG8_MMA(1, 1, At, B1); PG8_BAR;
            }
        }
        if constexpr (ALIGN_EPI) { if (wr == 0) PG8_BAR; }
        if constexpr (!Epi::AFTER_DRAIN) { E(acc, cur, wr, wc, fr, fq); S.done(cur); }
        if (!has_next) break;
#pragma unroll
        for (int a = 0; a < 2; ++a)
#pragma unroll
            for (int b = 0; b < 2; ++b)
#pragma unroll
                for (int m = 0; m < 4; ++m)
#pragma unroll
                    for (int n = 0; n < 2; ++n) acc[a][b][m][n] = (f32x4){0.f, 0.f, 0.f, 0.f};
        cur = nxt; cA = nA; cB = nB; ++ui;
        if constexpr (ALIGN_EPI) { if (wr == 1) PG8_BAR; }
    }
    PG8_WAIT_V(0);
    if constexpr (!ALIGN_EPI) { if (wr == 0) PG8_BAR; }
    PG8_BAR;
    if constexpr (Epi::AFTER_DRAIN) { E.fused(acc, cur, wr, wc, fr, fq, lds, wid, lane); S.done(cur); }
#undef PG8_SA
#undef PG8_SB
#undef PG8_STAGE
#undef PG8_LDA
#undef PG8_LDB
#undef PG8_MMA
#undef PG8_WAIT_V
#undef PG8_WAIT_L
#undef PG8_BAR
#undef PG8_SCHED
}
}

constexpr int NWAVES = 8, NTHR = NWAVES * 64;
constexpr int D = 2048, BATCH = 2, SEQ = 8192, ML = BATCH * SEQ, CTXL = 256, MC = BATCH * CTXL, M = ML + MC;
constexpr int FF = 5632, EA = 4096, NH = 16, HDIM = 256, CHUNK = 128, NCHUNK = M / CHUNK;
constexpr int SG = 128, SP = 64, SQ = 16;
constexpr int DEPTH = 4;
constexpr float EPS = 1e-6f;
static_assert(M % 256 == 0 && NCHUNK == 132, "row tiling");

constexpr size_t MiB = 1u << 20;
constexpr size_t WS_CTL = 0, CTL_ZERO_BYTES = 1 * MiB;
constexpr size_t WS_MOD = 1 * MiB;
constexpr size_t WS_S5A = 2 * MiB;
constexpr size_t WS_S5B = 3 * MiB;
constexpr size_t WS_WSB = 11 * MiB;
constexpr size_t WS_VSTAT = 12 * MiB;
constexpr size_t WS_RSTAT = 21 * MiB;
constexpr size_t WS_WGIN = 32 * MiB;
constexpr size_t WS_WGOUT = 96 * MiB;
constexpr size_t WS_WF13 = 128 * MiB;
constexpr size_t WS_WF2 = 304 * MiB;
constexpr size_t WS_WSIN = 392 * MiB;
constexpr size_t WS_WGLU = 408 * MiB;
constexpr size_t WS_H = 440 * MiB;
constexpr size_t WS_XN = 572 * MiB;
constexpr size_t WS_BIG = 640 * MiB;
constexpr size_t WS_ZU = WS_BIG, WS_ZV = WS_BIG + 132 * MiB;
constexpr size_t WS_HID = WS_BIG;
constexpr size_t WS_SU = WS_BIG, WS_SZ = WS_BIG + 66 * MiB;
constexpr size_t WS_YF = WS_BIG + 132 * MiB, WS_YB = WS_BIG + 264 * MiB;
constexpr size_t WS_XL = WS_BIG, WS_XC = WS_BIG + 128 * MiB;
constexpr size_t WS_SL = WS_BIG + 132 * MiB, WS_SC = WS_BIG + 196 * MiB;
constexpr size_t WS_SZ2 = WS_BIG + 200 * MiB;
constexpr size_t WS_MOUTT = WS_BIG + 396 * MiB;
constexpr size_t WS_M2T = WS_MOUTT + 64 * MiB;
constexpr size_t WS_A16 = WS_M2T + 32 * MiB;
constexpr size_t WS_SLAB = WS_A16 + 2 * MiB;
constexpr size_t WS_END = WS_SLAB + 44 * MiB;
#ifndef S5_NAIVE
#define S5_NAIVE 0
#endif
constexpr size_t WS_Z = S5_NAIVE ? WS_SZ : WS_SZ2;
constexpr int CW_BAR = 4096;

constexpr int RING_OFF = 0, RING_BYTES = 131072;
constexpr int LDSCTL_OFF = RING_BYTES, MISC_OFF = LDSCTL_OFF + 320;
constexpr int LDS_BYTES = 147456;
static_assert(MISC_OFF + 128 <= LDS_BYTES, "LDS map");

#define GAS __attribute__((address_space(1)))
#define LAS __attribute__((address_space(3)))
typedef unsigned short bf16;
typedef unsigned v4u __attribute__((ext_vector_type(4)));
typedef unsigned v2u __attribute__((ext_vector_type(2)));
typedef float f32x4 __attribute__((ext_vector_type(4)));
typedef float f32x2 __attribute__((ext_vector_type(2)));
typedef float f32x16 __attribute__((ext_vector_type(16)));
typedef short bf16x8 __attribute__((ext_vector_type(8)));
typedef GAS unsigned gu32;
#define RLX_AGENT __ATOMIC_RELAXED, __HIP_MEMORY_SCOPE_AGENT
#define LDS_WAIT() asm volatile("s_waitcnt lgkmcnt(0)" ::: "memory")
__device__ __forceinline__ unsigned f2bf(float f) { unsigned u = __builtin_bit_cast(unsigned, f); return (u + 0x7fffu + ((u >> 16) & 1u)) >> 16; }
__device__ __forceinline__ unsigned pk2(float lo, float hi) { return f2bf(lo) | (f2bf(hi) << 16); }
__device__ __forceinline__ float bf2f(unsigned short b) { return __builtin_bit_cast(float, (unsigned)b << 16); }
__device__ __forceinline__ float wave_sum(float v) {
#pragma unroll
    for (int o = 1; o < 64; o <<= 1) v += __shfl_xor(v, o);
    return v;
}

#define XB_TMO      128
#define XB_XCNT(j)  (256  + 64 * (j))
#define XB_XSUB(j)  (1280 + 64 * (j))
#define XB_XGEN(j)  (2304 + 64 * (j))
#define XB_TOP      3328
#define XB_TOPGEN   3392
#define XCD_BAR_WORDS 3456
#define XB_SPIN_CAP (1u << 18)

__device__ __forceinline__ unsigned xb_ld(unsigned* p)              { return __hip_atomic_load(p, __ATOMIC_RELAXED, __HIP_MEMORY_SCOPE_AGENT); }
__device__ __forceinline__ unsigned xb_add(unsigned* p, unsigned v) { return __hip_atomic_fetch_add(p, v, __ATOMIC_RELAXED, __HIP_MEMORY_SCOPE_AGENT); }
__device__ __forceinline__ unsigned xb_xcc_id() { return (unsigned)__builtin_amdgcn_s_getreg((3 << 11) | 20) & 0xFu; }
#define XB_SPIN(cond, bar) do { unsigned _sp = 0; while (cond) { __builtin_amdgcn_s_sleep(1); \
    if ((++_sp & 255u) == 0u) { if (xb_ld(&(bar)[XB_TMO])) break; if (_sp > XB_SPIN_CAP) { atomicAdd(&(bar)[XB_TMO], 1u); break; } } } } while (0)

struct XcdBarrier {
    unsigned* bar; unsigned x;
    volatile LAS unsigned* st;
};

__device__ __forceinline__ XcdBarrier xcd_barrier_post(unsigned* bar, volatile LAS unsigned* st) {
    XcdBarrier b; b.bar = bar; b.x = xb_xcc_id(); b.st = st;
    if (threadIdx.x == 0) (void)xb_add(&bar[XB_XCNT(b.x)], 1u);
    return b;
}
__device__ __forceinline__ void xcd_barrier_complete(unsigned* bar, unsigned x, unsigned& nloc, unsigned& nx) {
    const unsigned G = gridDim.x * gridDim.y * gridDim.z;
    unsigned sum, cnt, mine, sp = 0u;
    for (;;) {
        sum = 0u; cnt = 0u; mine = 0u;
        unsigned c16[16];
#pragma unroll
        for (unsigned j = 0; j < 16; ++j) c16[j] = xb_ld(&bar[XB_XCNT(j)]);
        __builtin_amdgcn_sched_barrier(0);
#pragma unroll
        for (unsigned j = 0; j < 16; ++j) { const unsigned c = c16[j]; sum += c; cnt += (c > 0u) ? 1u : 0u; mine = (j == x) ? c : mine; }
        if (sum == G) break;
        __builtin_amdgcn_s_sleep(1);
        if ((++sp & 255u) == 0u) { if (xb_ld(&bar[XB_TMO])) break; if (sp > XB_SPIN_CAP) { atomicAdd(&bar[XB_TMO], 1u); break; } }
    }
    nloc = mine > 0u ? mine : 1u; nx = cnt > 0u ? cnt : 1u;
}

__device__ __forceinline__ void xcd_barrier(const XcdBarrier& b) {
    asm volatile("s_waitcnt vmcnt(0)" ::: "memory");
    __syncthreads();
    if (threadIdx.x == 0) {
        unsigned* bar = b.bar; asm volatile("" : "+s"(bar));
        unsigned xq = __builtin_amdgcn_readfirstlane(b.x); asm volatile("" : "+s"(xq));
        __builtin_amdgcn_s_waitcnt(0);
        unsigned nloc = b.st[0], nx = b.st[1];
        if (nloc == 0u) { xcd_barrier_complete(bar, xq, nloc, nx); b.st[0] = nloc; b.st[1] = nx; }
        const unsigned old = xb_add(&bar[XB_XSUB(xq)], 1u);
        const unsigned gen = old / nloc;
        if (old + 1u == (gen + 1u) * nloc) {
            __builtin_amdgcn_fence(__ATOMIC_RELEASE, "agent");
            asm volatile("s_waitcnt vmcnt(0)" ::: "memory");
            const unsigned og = xb_add(&bar[XB_TOP], 1u);
            const unsigned tg = og / nx;
            if (og + 1u == (tg + 1u) * nx) xb_add(&bar[XB_TOPGEN], 1u);
            else XB_SPIN(xb_ld(&bar[XB_TOPGEN]) == tg, bar);
            __builtin_amdgcn_fence(__ATOMIC_ACQUIRE, "agent");
            xb_add(&bar[XB_XGEN(xq)], 1u);
            asm volatile("s_waitcnt vmcnt(0)" ::: "memory");
        } else {
            XB_SPIN(xb_ld(&bar[XB_XGEN(xq)]) == gen, bar);
            __builtin_amdgcn_fence(__ATOMIC_ACQUIRE, "agent");
            asm volatile("s_waitcnt vmcnt(0)" ::: "memory");
        }
    }
    __syncthreads();
}

struct Args { const float* in[28]; float* out; unsigned char* ws; int ph_lo, ph_hi; };
enum InIdx { I_X = 0, I_C, I_CTX, I_CCTX, I_ADAW, I_ADAB, I_N1G, I_N2G, I_W1, I_W3, I_W2, I_GWIN, I_GLNG, I_GLNB, I_GWS, I_GBS, I_GWOUT,
             I_SWIN, I_SARE, I_SAIM, I_SLDT, I_SBRE, I_SBIM, I_SCRE, I_SCIM, I_SD, I_SWGLU, I_FING };

__device__ __forceinline__ int opaque_tid() { int t = threadIdx.x; asm volatile("" : "+v"(t)); return t; }
#define PHASE_IDS const int tid = opaque_tid(), lane = tid & 63, wave = __builtin_amdgcn_readfirstlane(tid >> 6); (void)tid; (void)lane; (void)wave

__device__ __forceinline__ void adaln_items(const Args& a, LAS unsigned char* lds, int wg, int nwg) {
    PHASE_IDS;
    LAS float* cs = (LAS float*)lds;
    LAS float* red = cs + 3 * 2048;
    const float* c = a.in[I_C]; const float* cc = a.in[I_CCTX];
    for (int i = tid; i < 3 * 2048; i += NTHR) { const int s = i >> 11, k = i & 2047; const float v = s < 2 ? c[s * 2048 + k] : cc[k]; cs[i] = v / (1.0f + expf(-v)); }
    __syncthreads();
    float* MOD = (float*)(a.ws + WS_MOD);
    const int cq = tid & 15, kg = tid >> 4;
    for (int item = wg; item < DEPTH * 192; item += nwg) {
        const int layer = item / 192, n0 = (item % 192) * 64;
        const float* W = a.in[I_ADAW] + (size_t)layer * 2048 * 12288 + n0 + 4 * cq;
        f32x4 a0 = {0.f, 0.f, 0.f, 0.f}, a1 = a0, a2 = a0;
#define ADA_LD(dst, p) asm volatile("global_load_dwordx4 %0, %1, off" : "=v"(dst) : "v"(p) : "memory")
#define ADA_WAIT(n, r) asm volatile("s_waitcnt vmcnt(" #n ")" : "+v"(r[0]), "+v"(r[1]), "+v"(r[2]), "+v"(r[3]) :: "memory")
        const GAS f32x4* wp = (const GAS f32x4*)(W + (size_t)kg * 12288);
        constexpr size_t KST = (size_t)32 * 12288 / 4;
        f32x4 wa[4], wc[4];
        asm volatile("s_waitcnt vmcnt(0)" ::: "memory");
#pragma unroll
        for (int j = 0; j < 4; ++j) ADA_LD(wa[j], wp + j * KST);
        wp += 4 * KST;
#pragma unroll 1
        for (int b = 0; b < 16; b += 2) {
#pragma unroll
            for (int j = 0; j < 4; ++j) ADA_LD(wc[j], wp + j * KST);
            const GAS f32x4* wn = wp + (b + 2 < 16 ? 4 * KST : 0);
            ADA_WAIT(4, wa);
#pragma unroll
            for (int j = 0; j < 4; ++j) { const int k = kg + 32 * (4 * b + j); a0 += cs[k] * wa[j]; a1 += cs[2048 + k] * wa[j]; a2 += cs[4096 + k] * wa[j]; }
            asm volatile("" : "+v"(a0), "+v"(a1), "+v"(a2));
#pragma unroll
            for (int j = 0; j < 4; ++j) ADA_LD(wa[j], wn + j * KST);
            wp = wn + (b + 2 < 16 ? 4 * KST : 0);
            ADA_WAIT(4, wc);
#pragma unroll
            for (int j = 0; j < 4; ++j) { const int k = kg + 32 * (4 * (b + 1) + j); a0 += cs[k] * wc[j]; a1 += cs[2048 + k] * wc[j]; a2 += cs[4096 + k] * wc[j]; }
            asm volatile("" : "+v"(a0), "+v"(a1), "+v"(a2));
        }
        ADA_WAIT(0, wa);
#undef ADA_LD
#undef ADA_WAIT
#pragma unroll
        for (int e = 0; e < 4; ++e) { red[(kg * 3 + 0) * 64 + 4 * cq + e] = a0[e]; red[(kg * 3 + 1) * 64 + 4 * cq + e] = a1[e]; red[(kg * 3 + 2) * 64 + 4 * cq + e] = a2[e]; }
        __syncthreads();
        if (tid < 192) { const int s = tid >> 6, col = tid & 63; float t = 0.f;
            for (int g = 0; g < 32; ++g) t += red[(g * 3 + s) * 64 + col];
            MOD[(size_t)(layer * 3 + s) * 12288 + n0 + col] = t + a.in[I_ADAB][layer * 12288 + n0 + col]; }
        __syncthreads();
    }
}
__device__ __forceinline__ void tr_item(const float* W, int ld, int K, int ncols, bf16* WT, int mode, LAS float* scr, int item, int lane) {
    const int nblk = ncols / 32, kb = item / nblk, nb = item % nblk, k0 = 64 * kb, n0 = 32 * nb;
    const int drow0 = mode == 0 ? n0 : (256 * (n0 >> 7) + (n0 & 127) + (mode == 2 ? 128 : 0));
    float tv[32];
#pragma unroll
    for (int i = 0; i < 32; ++i) { const int kk = 2 * i + (lane >> 5); tv[i] = W[(size_t)(k0 + kk) * ld + n0 + (lane & 31)]; }
#pragma unroll
    for (int i = 0; i < 32; ++i) { const int kk = 2 * i + (lane >> 5); scr[kk * 33 + (lane & 31)] = tv[i]; }
    LDS_WAIT(); asm volatile("" ::: "memory");
    const int c = lane & 7;
#pragma unroll
    for (int j = 0; j < 4; ++j) { const int n = (lane >> 3) + 8 * j; const LAS float* s = scr + (8 * c) * 33 + n;
        v4u o; o.x = pk2(s[0 * 33], s[1 * 33]); o.y = pk2(s[2 * 33], s[3 * 33]); o.z = pk2(s[4 * 33], s[5 * 33]); o.w = pk2(s[6 * 33], s[7 * 33]);
        *(GAS v4u*)(WT + (size_t)(drow0 + n) * K + k0 + 8 * c) = o; }
    LDS_WAIT(); asm volatile("" ::: "memory");
}
constexpr int TR_GIN = 2 * 8192, TR_GOUT = 2 * 4096, TR_FFN = 4 * 3 * 5632, TR_SIN = 2 * 2048, TR_GLU = 2 * 2 * 2048, TR_TOTAL = TR_GIN + TR_GOUT + TR_FFN + TR_SIN + TR_GLU;
__device__ __forceinline__ void tr_dispatch(const Args& a, LAS float* scr, int it, int lane) {
    unsigned char* ws = a.ws;
    if (it < TR_GIN) { const int j = it / 8192, r = it % 8192; tr_item(a.in[I_GWIN] + (size_t)j * 2048 * 8192, 8192, 2048, 8192, (bf16*)(ws + WS_WGIN) + (size_t)j * 8192 * 2048, 0, scr, r, lane); return; } it -= TR_GIN;
    if (it < TR_GOUT) { const int j = it / 4096, r = it % 4096; tr_item(a.in[I_GWOUT] + (size_t)j * 4096 * 2048, 2048, 4096, 2048, (bf16*)(ws + WS_WGOUT) + (size_t)j * 2048 * 4096, 0, scr, r, lane); return; } it -= TR_GOUT;
    if (it < TR_FFN) { const int i = it / 16896, r = it % 16896, which = r / 5632, rr = r % 5632;
        if (which == 0) tr_item(a.in[I_W1] + (size_t)i * 2048 * 5632, 5632, 2048, 5632, (bf16*)(ws + WS_WF13) + (size_t)i * 11264 * 2048, 1, scr, rr, lane);
        else if (which == 1) tr_item(a.in[I_W3] + (size_t)i * 2048 * 5632, 5632, 2048, 5632, (bf16*)(ws + WS_WF13) + (size_t)i * 11264 * 2048, 2, scr, rr, lane);
        else tr_item(a.in[I_W2] + (size_t)i * 5632 * 2048, 2048, 5632, 2048, (bf16*)(ws + WS_WF2) + (size_t)i * 2048 * 5632, 0, scr, rr, lane);
        return; } it -= TR_FFN;
    if (it < TR_SIN) { const int j = it / 2048, r = it % 2048; tr_item(a.in[I_SWIN] + (size_t)j * 2048 * 2048, 2048, 2048, 2048, (bf16*)(ws + WS_WSIN) + (size_t)j * 2048 * 2048, 0, scr, r, lane); return; } it -= TR_SIN;
    { const int j = it / 4096, r = it % 4096, half = r / 2048, rr = r % 2048;
      tr_item(a.in[I_SWGLU] + (size_t)j * 2048 * 4096 + half * 2048, 4096, 2048, 2048, (bf16*)(ws + WS_WGLU) + (size_t)j * 4096 * 2048, 1 + half, scr, rr, lane); }
}
__device__ __forceinline__ int need_to_item(int q) {
    if (q < 8192) return q;               q -= 8192;
    if (q < 4096) return 16384 + q;       q -= 4096;
    if (q < 16896) return 24576 + q;      q -= 16896;
    if (q < 2048) return 92160 + q;       q -= 2048;
    if (q < 4096) return 96256 + q;       q -= 4096;
    if (q < 16896) return 41472 + q;      q -= 16896;
    if (q < 8192) return 8192 + q;        q -= 8192;
    if (q < 4096) return 20480 + q;       q -= 4096;
    if (q < 16896) return 58368 + q;      q -= 16896;
    if (q < 2048) return 94208 + q;       q -= 2048;
    if (q < 4096) return 100352 + q;      q -= 4096;
    return 75264 + q;
}
#ifndef CV_IPW
#define CV_IPW 6
#endif
constexpr int CV_CAP1 = 192 * 8 * CV_IPW, CV_CAP2 = 168 * 8 * CV_IPW, CV_CAP3 = 240 * 8 * CV_IPW, CV_CAP4 = 224 * 8 * CV_IPW;
constexpr int CV_D1 = 8192, CV_D2 = 23552, CV_D3 = 31232, CV_D4 = 35328, CV_D5 = 46592, CV_D6 = 60416, CV_D7 = 75776, CV_D8 = 83456;
constexpr int cv_max(int a, int b) { return a > b ? a : b; }
constexpr int CV_O2 = CV_CAP1, CV_O3 = CV_O2 + CV_CAP2, CV_O4 = CV_O3 + CV_CAP3, CV_O5 = CV_O4 + CV_CAP4, CV_O6 = CV_O5 + CV_CAP2, CV_O7 = CV_O6 + CV_CAP1, CV_O8 = CV_O7 + CV_CAP2, CV_O9 = CV_O8 + CV_CAP3;
constexpr int CV_P1 = cv_max(cv_max(cv_max(CV_D1, CV_D2 - CV_O2), cv_max(CV_D3 - CV_O3, CV_D4 - CV_O4)), cv_max(cv_max(CV_D5 - CV_O5, CV_D6 - CV_O6), cv_max(CV_D7 - CV_O7, CV_D8 - CV_O8)));
constexpr int CV_L1 = CV_P1, CV_L2 = CV_P1 + CV_O2, CV_L3 = CV_P1 + CV_O3, CV_L4 = CV_P1 + CV_O4, CV_L5 = CV_P1 + CV_O5, CV_L6 = CV_P1 + CV_O6, CV_L7 = CV_P1 + CV_O7, CV_L8 = CV_P1 + CV_O8;
constexpr int CV_T = (CV_P1 + CV_O9) < TR_TOTAL ? (CV_P1 + CV_O9) : TR_TOTAL;
static_assert(CV_L1 >= CV_D1 && CV_L2 >= CV_D2 && CV_L3 >= CV_D3 && CV_L4 >= CV_D4 && CV_L5 >= CV_D5 && CV_L6 >= CV_D6 && CV_L7 >= CV_D7 && CV_L8 >= CV_D8 && CV_L8 <= TR_TOTAL, "conversion slots");
__device__ __forceinline__ void transpose_items(const Args& a, LAS unsigned char* lds, int vcu, int G) {
    PHASE_IDS; const int gw = vcu * NWAVES + wave, ngw = G * NWAVES;
    LAS float* scr = (LAS float*)(lds + wave * 16384);
    for (int r = gw; r < CV_P1 + (TR_TOTAL - CV_T); r += ngw) tr_dispatch(a, scr, need_to_item(r < CV_P1 ? r : r - CV_P1 + CV_T), lane);
}
__device__ __forceinline__ void conv_slot(const Args& a, LAS unsigned char* lds, int c, int G, int units, int lo, int hi) {
    PHASE_IDS; const int R = units % G, nidle = R ? G - R : G, idx = R ? c - R : c;
    if (idx < 0) return;
    LAS float* scr = (LAS float*)(lds + wave * 16384);
    if (hi > TR_TOTAL) hi = TR_TOTAL;
    for (int q = lo + idx * NWAVES + wave; q < hi; q += nidle * NWAVES) tr_dispatch(a, scr, need_to_item(q), lane);
}
__device__ __forceinline__ void small_prologue(const Args& a, int vcu, int G) {
    PHASE_IDS; const int gtid = vcu * NTHR + tid, ngt = G * NTHR;
    bf16* WSB = (bf16*)(a.ws + WS_WSB);
    for (int i = gtid; i < 2 * 16 * 128 * 128; i += ngt) WSB[i] = (bf16)f2bf(a.in[I_GWS][i]);
#if S5_NAIVE
    f32x2* S5A = (f32x2*)(a.ws + WS_S5A); f32x2* S5B = (f32x2*)(a.ws + WS_S5B);
    for (int i = gtid; i < 2 * 2 * SG * SP; i += ngt) {
        const int lg = i / SP;
        const float dt = expf(a.in[I_SLDT][lg]), are = a.in[I_SARE][i], aim = a.in[I_SAIM][i];
        const float e = expf(dt * are), th = dt * aim, abr = e * cosf(th), abi = e * sinf(th);
        f32x2 ab; ab.x = abr; ab.y = abi; S5A[i] = ab;
        const float nr = abr - 1.0f, ni = abi, den = 1.0f / (are * are + aim * aim);
        const float cr = (nr * are + ni * aim) * den, ci = (ni * are - nr * aim) * den;
        for (int q = 0; q < SQ; ++q) { const float br = a.in[I_SBRE][(size_t)i * SQ + q], bi = a.in[I_SBIM][(size_t)i * SQ + q];
            f32x2 o; o.x = cr * br - ci * bi; o.y = cr * bi + ci * br; S5B[(size_t)i * SQ + q] = o; }
    }
#endif
}

typedef _Float16 h16x8 __attribute__((ext_vector_type(8)));
template <bool INIT> __device__ __forceinline__ void norm_phase(const Args& a, const float* gain, const float* modl  , int which, int vcu, int G, int nslab = 0, const float* sgate = nullptr, int mrows = M) {
    PHASE_IDS; const int gw = vcu * NWAVES + wave, ngw = G * NWAVES;
    _Float16* H = (_Float16*)(a.ws + WS_H); bf16* XN = (bf16*)(a.ws + WS_XN);
    f32x4 xc[8], xn[8]; h16x8 hc[4], hn[4];
#define NP_LOAD(row_, xd, hd) do { if (INIT) { const float* src_ = (row_) < ML ? a.in[I_X] + (size_t)(row_) * D : a.in[I_CTX] + (size_t)((row_) - ML) * D; const GAS f32x4* xr_ = (const GAS f32x4*)src_ + 2 * lane; \
        _Pragma("unroll") for (int j = 0; j < 4; ++j) { xd[2 * j] = xr_[128 * j]; xd[2 * j + 1] = xr_[128 * j + 1]; } } \
      else { const GAS h16x8* hr_ = (const GAS h16x8*)(H + (size_t)(row_) * D) + lane; _Pragma("unroll") for (int j = 0; j < 4; ++j) hd[j] = hr_[64 * j]; } } while (0)
    int cset = -1; float gg[4][8], shv[4][8];
    if (gw < mrows) NP_LOAD(gw, xc, hc);
    for (int row = gw; row < mrows; row += ngw) {
        const int set = row < ML ? (row >> 13) : 2;
        const int nrow = row + ngw;
        if (nrow < mrows) NP_LOAD(nrow, xn, hn);
        if (!INIT && set != cset) { cset = set;
            const GAS f32x4* gp = (const GAS f32x4*)gain + 2 * lane;
            const GAS f32x4* shp = (const GAS f32x4*)(modl + (size_t)set * 12288 + (which * 3 + 0) * D) + 2 * lane;
            const GAS f32x4* scp = (const GAS f32x4*)(modl + (size_t)set * 12288 + (which * 3 + 1) * D) + 2 * lane;
#pragma unroll
            for (int j = 0; j < 4; ++j)
#pragma unroll
                for (int hlf = 0; hlf < 2; ++hlf) { const f32x4 g = gp[128 * j + hlf], sh = shp[128 * j + hlf], sc = scp[128 * j + hlf];
#pragma unroll
                    for (int e = 0; e < 4; ++e) { gg[j][4 * hlf + e] = g[e] * (1.0f + sc[e]); shv[j][4 * hlf + e] = sh[e]; } } }
        GAS h16x8* hr = (GAS h16x8*)(H + (size_t)row * D) + lane;
        float v[4][8];
        if (INIT) {
#pragma unroll
            for (int j = 0; j < 4; ++j)
#pragma unroll
                for (int e = 0; e < 4; ++e) { v[j][e] = xc[2 * j][e]; v[j][4 + e] = xc[2 * j + 1][e]; }
            if (row < ML) {
                const int t = row & (SEQ - 1); const float pr = (float)(t >> 6), pc = (float)(t & 63);
#pragma unroll
                for (int e = 0; e < 8; ++e) { const float om = exp2f(-(float)(8 * lane + e) * (13.287712379549449f / 512.0f)); const float ar = pr * om, ac = pc * om;
                    v[0][e] += sinf(ar); v[1][e] += cosf(ar); v[2][e] += sinf(ac); v[3][e] += cosf(ac); }
            }
        } else {
#pragma unroll
            for (int j = 0; j < 4; ++j)
#pragma unroll
                for (int e = 0; e < 8; ++e) v[j][e] = (float)hc[j][e];
            if (nslab > 0 && row >= ML) {
                const GAS f32x4* sp = (const GAS f32x4*)((const float*)(a.ws + WS_SLAB) + (size_t)(row - ML) * D) + 2 * lane; const GAS f32x4* gp2 = (const GAS f32x4*)sgate + 2 * lane;
                f32x4 t[4][2];
#pragma unroll
                for (int j = 0; j < 4; ++j) { t[j][0] = sp[128 * j]; t[j][1] = sp[128 * j + 1]; }
                for (int s = 1; s < nslab; ++s) {
#pragma unroll
                    for (int jh = 0; jh < 4; jh += 2) { f32x4 u0[2][2];
#pragma unroll
                        for (int j = 0; j < 2; ++j) { u0[j][0] = sp[(size_t)s * (512 * D / 4) + 128 * (jh + j)]; u0[j][1] = sp[(size_t)s * (512 * D / 4) + 128 * (jh + j) + 1]; }
                        __builtin_amdgcn_sched_barrier(0);
#pragma unroll
                        for (int j = 0; j < 2; ++j) { t[jh + j][0] += u0[j][0]; t[jh + j][1] += u0[j][1]; }
                        __builtin_amdgcn_sched_barrier(0); } }
#pragma unroll
                for (int j = 0; j < 4; ++j) { const f32x4 g0 = gp2[128 * j], g1 = gp2[128 * j + 1];
#pragma unroll
                    for (int e = 0; e < 4; ++e) { v[j][e] += g0[e] * t[j][0][e]; v[j][4 + e] += g1[e] * t[j][1][e]; } }
            }
        }
        if (INIT || (nslab > 0 && row >= ML)) {
#pragma unroll
            for (int j = 0; j < 4; ++j) { h16x8 hv;
#pragma unroll
                for (int e = 0; e < 8; ++e) { hv[e] = (_Float16)v[j][e]; v[j][e] = (float)hv[e]; }
                hr[64 * j] = hv; }
        }
        float ss = 0.f;
#pragma unroll
        for (int j = 0; j < 4; ++j)
#pragma unroll
            for (int e = 0; e < 8; ++e) ss += v[j][e] * v[j][e];
        const float rinv = 1.0f / sqrtf(wave_sum(ss) * (1.0f / D) + EPS);
        GAS v4u* o16 = (GAS v4u*)(XN + (size_t)row * D) + lane;
#pragma unroll
        for (int j = 0; j < 4; ++j) { float y[8];
            if (INIT) {
                const GAS f32x4* gp = (const GAS f32x4*)gain + 2 * lane;
                const GAS f32x4* shp = (const GAS f32x4*)(modl + (size_t)set * 12288 + (which * 3 + 0) * D) + 2 * lane;
                const GAS f32x4* scp = (const GAS f32x4*)(modl + (size_t)set * 12288 + (which * 3 + 1) * D) + 2 * lane;
#pragma unroll
                for (int hlf = 0; hlf < 2; ++hlf) { const f32x4 g = gp[128 * j + hlf], sh = shp[128 * j + hlf], sc = scp[128 * j + hlf];
#pragma unroll
                    for (int e = 0; e < 4; ++e) y[4 * hlf + e] = v[j][4 * hlf + e] * rinv * g[e] * (1.0f + sc[e]) + sh[e]; }
            } else {
#pragma unroll
                for (int e = 0; e < 8; ++e) y[e] = v[j][e] * rinv * gg[j][e] + shv[j][e]; }
            v4u o; o.x = pk2(y[0], y[1]); o.y = pk2(y[2], y[3]); o.z = pk2(y[4], y[5]); o.w = pk2(y[6], y[7]); o16[64 * j] = o; }
#pragma unroll
        for (int j = 0; j < 8; ++j) xc[j] = xn[j];
#pragma unroll
        for (int j = 0; j < 4; ++j) hc[j] = hn[j];
    }
#undef NP_LOAD
}
__device__ __forceinline__ void final_phase(const Args& a, int vcu, int G) {
    PHASE_IDS; const int gw = vcu * NWAVES + wave, ngw = G * NWAVES;
    const _Float16* H = (const _Float16*)(a.ws + WS_H);
    float gv[4][8];
    { const GAS f32x4* gp = (const GAS f32x4*)a.in[I_FING] + 2 * lane;
#pragma unroll
      for (int j = 0; j < 4; ++j)
#pragma unroll
          for (int hlf = 0; hlf < 2; ++hlf) { const f32x4 g = gp[128 * j + hlf];
#pragma unroll
              for (int e = 0; e < 4; ++e) gv[j][4 * hlf + e] = g[e]; } }
    h16x8 hc[4], hn[4];
    if (gw < ML) { const GAS h16x8* hr = (const GAS h16x8*)(H + (size_t)gw * D) + lane;
#pragma unroll
        for (int j = 0; j < 4; ++j) hc[j] = hr[64 * j]; }
    for (int row = gw; row < ML; row += ngw) {
        if (row + ngw < ML) { const GAS h16x8* hr = (const GAS h16x8*)(H + (size_t)(row + ngw) * D) + lane;
#pragma unroll
            for (int j = 0; j < 4; ++j) hn[j] = hr[64 * j]; }
        float v[4][8]; float ss = 0.f;
#pragma unroll
        for (int j = 0; j < 4; ++j)
#pragma unroll
            for (int e = 0; e < 8; ++e) { v[j][e] = (float)hc[j][e]; ss += v[j][e] * v[j][e]; }
        const float rinv = 1.0f / sqrtf(wave_sum(ss) * (1.0f / D) + EPS);
        GAS f32x4* o = (GAS f32x4*)(a.out + (size_t)row * D) + 2 * lane;
#pragma unroll
        for (int j = 0; j < 4; ++j)
#pragma unroll
            for (int hlf = 0; hlf < 2; ++hlf) { f32x4 r;
#pragma unroll
                for (int e = 0; e < 4; ++e) r[e] = v[j][4 * hlf + e] * rinv * gv[j][4 * hlf + e];
                o[128 * j + hlf] = r; }
#pragma unroll
        for (int j = 0; j < 4; ++j) hc[j] = hn[j];
    }
}

__device__ __forceinline__ void vstat_phase(const Args& a, int vcu, int G) {
    PHASE_IDS; const int gw = vcu * NWAVES + wave, ngw = G * NWAVES;
    const f32x2* VS = (const f32x2*)(a.ws + WS_VSTAT); f32x2* RS = (f32x2*)(a.ws + WS_RSTAT);
    for (int row = gw; row < M; row += ngw) { const f32x2 p = VS[(size_t)row * 64 + lane];
        const float s = wave_sum(p.x), ss = wave_sum(p.y), mean = s * (1.0f / EA), var = ss * (1.0f / EA) - mean * mean;
        if (lane == 0) { f32x2 o; o.x = mean; o.y = 1.0f / sqrtf(var + EPS); RS[row] = o; } }
}

__device__ __forceinline__ void sgu_phase(const Args& a, int gl  , LAS unsigned char* lds, int wg, int nwg, int dry) {
    PHASE_IDS;
    bf16* ZU = (bf16*)(a.ws + WS_ZU); const bf16* ZV = (const bf16*)(a.ws + WS_ZV);
    const bf16* WSB = (const bf16*)(a.ws + WS_WSB) + (size_t)gl * 16 * 128 * 128;
    const float* bs = a.in[I_GBS] + gl * 16 * 128; const float* lng = a.in[I_GLNG] + gl * EA; const float* lnb = a.in[I_GLNB] + gl * EA;
    constexpr int VP = 528;
    constexpr int SP4 = 36;
    constexpr int WP = 272;
    LAS unsigned char* vl = lds;
    LAS f32x2* st = (LAS f32x2*)(lds + 128 * VP);
    LAS unsigned char* wl = lds + 73728;
    LAS float* sstrip = (LAS float*)(lds + wave * (64 * SP4 * 4));
    LAS float* bl = (LAS float*)(lds + 73728 + 128 * WP);
    const int n = lane & 31, h = lane >> 5, c4 = lane & 3, rb = lane >> 2;
    v4u vraw[8], ucur[8]; f32x2 srow;
#define SGU_PREFETCH(unit_) do { const int c_ = (unit_) / NH, hd_ = (unit_) % NH, r0_ = c_ * CHUNK; \
        _Pragma("unroll") for (int t = 0; t < 8; ++t) { const int q = tid + 512 * t, j = q >> 5, dc = q & 31; vraw[t] = *(const GAS v4u*)(ZV + (size_t)(r0_ + j) * EA + hd_ * HDIM + 8 * dc); } \
        srow = ((const GAS f32x2*)(a.ws + WS_RSTAT))[r0_ + (tid & 127)]; } while (0)
#define SGU_UPREFETCH(unit_) do { const int c_ = (unit_) / NH, hd_ = (unit_) % NH, r0_ = c_ * CHUNK; const GAS v4u* up_ = (const GAS v4u*)(ZU + (size_t)(r0_ + rb) * EA + hd_ * HDIM + 32 * wave + 8 * c4); \
        _Pragma("unroll") for (int p = 0; p < 8; ++p) ucur[p] = up_[(size_t)p * (16 * EA / 8)]; } while (0)
    int cur_hd = -1; float lg = 0.f, lb = 0.f;
    if (wg < NCHUNK * NH) { SGU_PREFETCH(wg); SGU_UPREFETCH(wg); }
    for (int unit = wg; unit < NCHUNK * NH; unit += nwg) {
        const int c = unit / NH, hd = unit % NH, r0 = c * CHUNK;
        if (hd != cur_hd) { cur_hd = hd; v4u wimg[4];
#pragma unroll
            for (int t = 0; t < 4; ++t) { const int q = tid + 512 * t, i2 = q >> 4, kc = q & 15; wimg[t] = *(const GAS v4u*)(WSB + ((size_t)hd * 128 + i2) * 128 + 8 * kc); }
            const float bv_ = bs[hd * 128 + (tid & 127)];
            lg = lng[hd * HDIM + 32 * wave + n]; lb = lnb[hd * HDIM + 32 * wave + n];
            __builtin_amdgcn_sched_barrier(0);
#pragma unroll
            for (int t = 0; t < 4; ++t) { const int q = tid + 512 * t, i2 = q >> 4, kc = q & 15; *(LAS v4u*)(wl + i2 * WP + 16 * kc) = wimg[t]; }
            if (tid < 128) bl[tid] = bv_; }
        if (tid < 128) st[tid] = srow;
#pragma unroll
        for (int t = 0; t < 8; ++t) { const int q = tid + 512 * t, j = q >> 5, dc = q & 31; *(LAS v4u*)(vl + j * VP + 16 * dc) = vraw[t]; }
        __syncthreads();
        if (unit + nwg < NCHUNK * NH) SGU_PREFETCH(unit + nwg);
        bf16x8 Bf[8];
#pragma unroll
        for (int ks = 0; ks < 8; ++ks) { float f[8];
#pragma unroll
            for (int e = 0; e < 8; ++e) { const int j = 16 * ks + 8 * h + e; const f32x2 m = st[j]; f[e] = (bf2f(*(const LAS unsigned short*)(vl + j * VP + 2 * (32 * wave + n))) - m.x) * m.y * lg + lb; }
            v4u w; w.x = pk2(f[0], f[1]); w.y = pk2(f[2], f[3]); w.z = pk2(f[4], f[5]); w.w = pk2(f[6], f[7]); Bf[ks] = __builtin_bit_cast(bf16x8, w); }
        __syncthreads();
        GAS v4u* up = (GAS v4u*)(ZU + (size_t)(r0 + rb) * EA + hd * HDIM + 32 * wave + 8 * c4);
#pragma unroll
        for (int hf = 0; hf < 2; ++hf) {
#pragma unroll
            for (int ib2 = 0; ib2 < 2; ++ib2) { const int ib = 2 * hf + ib2;
                f32x16 acc;
#pragma unroll
                for (int r = 0; r < 16; ++r) acc[r] = 0.f;
                const LAS unsigned char* ap = wl + (32 * ib + n) * WP + 16 * h;
#pragma unroll
                for (int ks = 0; ks < 8; ++ks) { const bf16x8 Af = *(const LAS bf16x8*)(ap + 32 * ks); acc = __builtin_amdgcn_mfma_f32_32x32x16_bf16(Af, Bf[ks], acc, 0, 0, 0); }
#pragma unroll
                for (int r = 0; r < 16; ++r) { const int il = 32 * ib2 + (r & 3) + 8 * (r >> 2) + 4 * h; sstrip[il * SP4 + n] = acc[r] + bl[64 * hf + il]; }
            }
            LDS_WAIT(); asm volatile("" ::: "memory");
#pragma unroll
            for (int p2 = 0; p2 < 4; ++p2) { const int il = 16 * p2 + rb, p = 4 * hf + p2;
                const f32x4 s0 = *(const LAS f32x4*)(sstrip + il * SP4 + 8 * c4), s1 = *(const LAS f32x4*)(sstrip + il * SP4 + 8 * c4 + 4);
                const v4u u = ucur[p]; v4u o;
                o.x = pk2(__builtin_bit_cast(float, u.x << 16) * s0[0], __builtin_bit_cast(float, u.x & 0xffff0000u) * s0[1]);
                o.y = pk2(__builtin_bit_cast(float, u.y << 16) * s0[2], __builtin_bit_cast(float, u.y & 0xffff0000u) * s0[3]);
                o.z = pk2(__builtin_bit_cast(float, u.z << 16) * s1[0], __builtin_bit_cast(float, u.z & 0xffff0000u) * s1[1]);
                o.w = pk2(__builtin_bit_cast(float, u.w << 16) * s1[2], __builtin_bit_cast(float, u.w & 0xffff0000u) * s1[3]);
                if (!dry) up[(size_t)p * (16 * EA / 8)] = o; }
            LDS_WAIT(); asm volatile("" ::: "memory");
        }
        if (unit + nwg < NCHUNK * NH) SGU_UPREFETCH(unit + nwg);
        __syncthreads();
    }
#undef SGU_PREFETCH
#undef SGU_UPREFETCH
}

__device__ __forceinline__ void s5_naive_phase(const Args& a, int sl  , int wg, int nwg) {
    PHASE_IDS;
    if (wave >= 2) return;
    const bf16* U = (const bf16*)(a.ws + WS_SU);
    for (int item = wg * 2 + wave; item < 2 * 2 * SG; item += nwg * 2) {
        const int b = item & 1, k = (item >> 1) & 1, g = item >> 2;
        const int pg = ((sl * 2 + k) * SG + g);
        const f32x2 ab = ((const f32x2*)(a.ws + WS_S5A))[(size_t)pg * SP + lane];
        float bre[16], bim[16], cr[16], ci[16];
#pragma unroll
        for (int q = 0; q < 16; ++q) { const f32x2 bb = ((const f32x2*)(a.ws + WS_S5B))[((size_t)pg * SP + lane) * SQ + q]; bre[q] = bb.x; bim[q] = bb.y;
            cr[q] = a.in[I_SCRE][((size_t)pg * SQ + q) * SP + lane]; ci[q] = a.in[I_SCIM][((size_t)pg * SQ + q) * SP + lane]; }
        float* Y = (float*)(a.ws + (k ? WS_YB : WS_YF));
        float hr = 0.f, hi = 0.f;
#pragma unroll 1
        for (int seg = 0; seg < 2; ++seg) {
            const int L = seg ? SEQ : CTXL, base = seg ? b * SEQ : ML + b * CTXL;
#pragma unroll 1
            for (int blk = 0; blk < L; blk += 64) {
                const int myt = k ? (L - 1 - (blk + lane)) : (blk + lane);
                const size_t row = (size_t)(base + myt);
                const GAS v4u* up = (const GAS v4u*)(U + row * D + 16 * g);
                const v4u u0 = up[0], u1 = up[1];
                float keep[16];
#pragma unroll
                for (int q = 0; q < 16; ++q) keep[q] = 0.f;
#pragma unroll 1
                for (int s = 0; s < 64; ++s) {
                    unsigned w[8];
                    w[0] = __builtin_amdgcn_readlane(u0.x, s); w[1] = __builtin_amdgcn_readlane(u0.y, s); w[2] = __builtin_amdgcn_readlane(u0.z, s); w[3] = __builtin_amdgcn_readlane(u0.w, s);
                    w[4] = __builtin_amdgcn_readlane(u1.x, s); w[5] = __builtin_amdgcn_readlane(u1.y, s); w[6] = __builtin_amdgcn_readlane(u1.z, s); w[7] = __builtin_amdgcn_readlane(u1.w, s);
                    float br = 0.f, bi = 0.f;
#pragma unroll
                    for (int q2 = 0; q2 < 8; ++q2) { const float ulo = __builtin_bit_cast(float, w[q2] << 16), uhi = __builtin_bit_cast(float, w[q2] & 0xffff0000u);
                        br += bre[2 * q2] * ulo + bre[2 * q2 + 1] * uhi; bi += bim[2 * q2] * ulo + bim[2 * q2 + 1] * uhi; }
                    const float nhr = ab.x * hr - ab.y * hi + br, nhi = ab.x * hi + ab.y * hr + bi; hr = nhr; hi = nhi;
#pragma unroll
                    for (int q = 0; q < 16; ++q) { const float y = wave_sum(cr[q] * hr - ci[q] * hi); keep[q] = (lane == s) ? y : keep[q]; }
                }
                GAS f32x4* yp = (GAS f32x4*)(Y + row * D + 16 * g);
#pragma unroll
                for (int q4 = 0; q4 < 4; ++q4) { f32x4 o; o.x = keep[4 * q4]; o.y = keep[4 * q4 + 1]; o.z = keep[4 * q4 + 2]; o.w = keep[4 * q4 + 3]; yp[q4] = o; }
            }
        }
    }
}
__device__ __forceinline__ void s5_combine_phase(const Args& a, int sl, int vcu, int G) {
    PHASE_IDS; const int gw = vcu * NWAVES + wave, ngw = G * NWAVES;
    const float* YF = (const float*)(a.ws + WS_YF); const float* YB = (const float*)(a.ws + WS_YB); const bf16* U = (const bf16*)(a.ws + WS_SU); bf16* Z = (bf16*)(a.ws + WS_SZ);
    const GAS f32x4* dp = (const GAS f32x4*)(a.in[I_SD] + sl * D) + lane;
    for (int row = gw; row < M; row += ngw) {
        const GAS f32x4* yf = (const GAS f32x4*)(YF + (size_t)row * D) + lane; const GAS f32x4* yb = (const GAS f32x4*)(YB + (size_t)row * D) + lane;
        const GAS v2u* up = (const GAS v2u*)(U + (size_t)row * D) + lane; GAS v2u* zp = (GAS v2u*)(Z + (size_t)row * D) + lane;
#pragma unroll
        for (int j = 0; j < 8; ++j) { const f32x4 f = yf[64 * j], bk = yb[64 * j], dd = dp[64 * j]; const v2u uu = up[64 * j];
            f32x4 u4; u4.x = __builtin_bit_cast(float, uu.x << 16); u4.y = __builtin_bit_cast(float, uu.x & 0xffff0000u); u4.z = __builtin_bit_cast(float, uu.y << 16); u4.w = __builtin_bit_cast(float, uu.y & 0xffff0000u);
            const f32x4 y = f + bk + u4 * dd;
            v2u o; o.x = pk2(pg8::gelu_tanh_f(y.x), pg8::gelu_tanh_f(y.y)); o.y = pk2(pg8::gelu_tanh_f(y.z), pg8::gelu_tanh_f(y.w)); zp[64 * j] = o; }
    }
}

__device__ __forceinline__ f32x2 cmul(f32x2 a, f32x2 b) { f32x2 r; r.x = a.x * b.x - a.y * b.y; r.y = a.x * b.y + a.y * b.x; return r; }
#ifndef PROBE_S5P
#define PROBE_S5P 0
#endif
#define S5P_MARK(k) do { if (PROBE_S5P) { __syncthreads(); const unsigned long long tn_ = __builtin_amdgcn_s_memrealtime(); if (PROBE_S5P == (k)) *pticks += tn_ - tprev; tprev = tn_; } } while (0)
__device__ __forceinline__ void s5_precompute(const Args& a, LAS unsigned char* lds, int wg, int nwg, unsigned long long* pticks = nullptr) {
    PHASE_IDS; unsigned long long tprev = PROBE_S5P ? __builtin_amdgcn_s_memrealtime() : 0ull; (void)tprev;
    LAS f32x2* apw = (LAS f32x2*)lds;
    LAS f32x2* bbl = apw + 2 * 17 * 64;
    constexpr int CP = 65;
    LAS f32x2* ccl = bbl + 2 * 64 * 16;
    constexpr int KP = 260;
    LAS float* ktab = (LAS float*)(ccl + 2 * 16 * CP);
    LAS float* sdl = ktab + 2 * 16 * KP;
    for (int item = wg; item < 2 * SG; item += nwg) {
        const int sl = item >> 7, g = item & 127;
        for (int e = tid; e < 2 * 17 * 64; e += NTHR) { const int d = e / (17 * 64), l = (e / 64) % 17, p = e & 63, pg = (sl * 2 + d) * SG + g, i = pg * SP + p;
            const float dt = expf(a.in[I_SLDT][pg]), are = a.in[I_SARE][i], aim = a.in[I_SAIM][i];
            const float ex = expf((float)l * (dt * are)), th = (float)l * (dt * aim); f32x2 o; o.x = ex * cosf(th); o.y = ex * sinf(th); apw[e] = o;
            if (l == 16) ((f32x2*)(a.ws + WS_A16))[i] = o; }
        if (tid < 16) sdl[tid] = a.in[I_SD][sl * D + 16 * g + tid];
        for (int e = tid; e < 2 * 16 * 64; e += NTHR) { const int d = e >> 10, q = (e >> 6) & 15, p = e & 63; const size_t ci = ((size_t)((sl * 2 + d) * SG + g) * SQ + q) * SP + p;
            f32x2 o; o.x = a.in[I_SCRE][ci]; o.y = a.in[I_SCIM][ci]; ccl[(d * 16 + q) * CP + p] = o; }
        __syncthreads();
        for (int e = tid; e < 2 * 64 * 16; e += NTHR) { const int d = e >> 10, p = (e >> 4) & 63, q = e & 15, i = ((sl * 2 + d) * SG + g) * SP + p;
            const float are = a.in[I_SARE][i], aim = a.in[I_SAIM][i]; const f32x2 ab = apw[(d * 17 + 1) * 64 + p];
            const float nr = ab.x - 1.0f, ni = ab.y, den = 1.0f / (are * are + aim * aim);
            f32x2 coef; coef.x = (nr * are + ni * aim) * den; coef.y = (ni * are - nr * aim) * den;
            f32x2 bq; bq.x = a.in[I_SBRE][(size_t)i * SQ + q]; bq.y = a.in[I_SBIM][(size_t)i * SQ + q]; bbl[e] = cmul(coef, bq); }
        __syncthreads();
        S5P_MARK(1);
        for (int o4 = tid; o4 < 2048; o4 += NTHR) {
            const int d = o4 >> 10, l = (o4 >> 6) & 15, q = (o4 >> 2) & 15, qp0 = 4 * (o4 & 3); f32x4 acc = {0.f, 0.f, 0.f, 0.f};
#pragma unroll 4
            for (int p = 0; p < 64; ++p) { const f32x2 ca = cmul(ccl[(d * 16 + q) * CP + p], apw[(d * 17 + l) * 64 + p]);
                const LAS f32x4* bp = (const LAS f32x4*)(bbl + (d * 64 + p) * 16 + qp0); const f32x4 b01 = bp[0], b23 = bp[1];
                acc[0] += ca.x * b01[0] - ca.y * b01[1]; acc[1] += ca.x * b01[2] - ca.y * b01[3]; acc[2] += ca.x * b23[0] - ca.y * b23[1]; acc[3] += ca.x * b23[2] - ca.y * b23[3]; }
            *(LAS f32x4*)(ktab + ((d * 16 + l) * KP + q * 16 + qp0)) = acc; }
        __syncthreads();
        S5P_MARK(2);
        bf16* MoutT = (bf16*)(a.ws + WS_MOUTT) + (size_t)(sl * SG + g) * 256 * 512;
        bf16* M2T = (bf16*)(a.ws + WS_M2T) + (size_t)(sl * SG + g) * 256 * 256;
        for (int ch = tid; ch < 256 * 32; ch += NTHR) { const int n = ch >> 5, jj = ch & 31, t = n >> 4, q = n & 15, s = jj >> 1, q0 = 8 * (jj & 1);
            const LAS float* kp = ktab + ((s <= t ? (t - s) : (16 + s - t)) * KP + q * 16 + q0);
            f32x4 v0 = *(const LAS f32x4*)kp, v1 = *(const LAS f32x4*)(kp + 4);
            if (s == t) { const LAS float* kb = ktab + (16 * KP + q * 16 + q0); v0 += *(const LAS f32x4*)kb; v1 += *(const LAS f32x4*)(kb + 4);
                const float dsk = sdl[q];
#pragma unroll
                for (int e = 0; e < 4; ++e) { v0[e] += (q == q0 + e) ? dsk : 0.f; v1[e] += (q == q0 + 4 + e) ? dsk : 0.f; } }
            v4u w; w.x = pk2(v0[0], v0[1]); w.y = pk2(v0[2], v0[3]); w.z = pk2(v1[0], v1[1]); w.w = pk2(v1[2], v1[3]);
            *(GAS v4u*)(MoutT + (size_t)n * 512 + 8 * jj) = w; }
        for (int ch = tid; ch < 256 * 32; ch += NTHR) { const int n = ch >> 5, j2 = ch & 31, t = n >> 4, q = n & 15, d = j2 >> 4, p0 = (j2 & 15) * 4, ex = d == 0 ? t + 1 : 16 - t; float v[8];
#pragma unroll
            for (int pp = 0; pp < 4; ++pp) { const f32x2 ca = cmul(ccl[(d * 16 + q) * CP + p0 + pp], apw[(d * 17 + ex) * 64 + p0 + pp]); v[2 * pp] = ca.x; v[2 * pp + 1] = -ca.y; }
            v4u w; w.x = pk2(v[0], v[1]); w.y = pk2(v[2], v[3]); w.z = pk2(v[4], v[5]); w.w = pk2(v[6], v[7]);
            *(GAS v4u*)(MoutT + (size_t)n * 512 + 8 * (32 + j2)) = w; }
        S5P_MARK(3);
        for (int ch = tid; ch < 256 * 32; ch += NTHR) { const int n = ch >> 5, jj = ch & 31, d = n >> 7, p = (n & 127) >> 1, im = n & 1, s = jj >> 1, q0 = 8 * (jj & 1), ex = d == 0 ? 15 - s : s; float v[8];
            const f32x2 ap = apw[(d * 17 + ex) * 64 + p];
#pragma unroll
            for (int e = 0; e < 8; ++e) { const f32x2 r = cmul(ap, bbl[(d * 64 + p) * 16 + q0 + e]); v[e] = im ? r.y : r.x; }
            v4u w; w.x = pk2(v[0], v[1]); w.y = pk2(v[2], v[3]); w.z = pk2(v[4], v[5]); w.w = pk2(v[6], v[7]);
            *(GAS v4u*)(M2T + (size_t)n * 256 + 8 * jj) = w; }
        S5P_MARK(4);
        __syncthreads();
    }
}
template <bool OUT> __device__ __forceinline__ void s5_ctx_gemm(const Args& a, int sl, int wg, int nwg) {
    PHASE_IDS;
    constexpr int K = OUT ? 512 : 256;
    const int r = lane & 31, hh = lane >> 5;
    for (int g = wg; g < SG; g += nwg) {
        const GAS bf16x8* ap = (const GAS bf16x8*)((const bf16*)(a.ws + WS_XC) + (size_t)(g * 32 + r) * 512 + 8 * hh);
        const bf16* Bt = OUT ? (const bf16*)(a.ws + WS_MOUTT) + (size_t)(sl * SG + g) * 256 * 512 : (const bf16*)(a.ws + WS_M2T) + (size_t)(sl * SG + g) * 256 * 256;
        const GAS bf16x8* bp = (const GAS bf16x8*)(Bt + (size_t)(32 * wave + r) * K + 8 * hh);
        f32x16 acc;
#pragma unroll
        for (int i = 0; i < 16; ++i) acc[i] = 0.f;
        constexpr int NCH = K / 16 / 8;
        bf16x8 av[2][8], bv[2][8];
#pragma unroll
        for (int j = 0; j < 8; ++j) { av[0][j] = ap[2 * j]; bv[0][j] = bp[2 * j]; }
#pragma unroll
        for (int c = 0; c < NCH; ++c) {
            if (c + 1 < NCH) {
#pragma unroll
                for (int j = 0; j < 8; ++j) { av[(c + 1) & 1][j] = ap[2 * (8 * (c + 1) + j)]; bv[(c + 1) & 1][j] = bp[2 * (8 * (c + 1) + j)]; } }
            __builtin_amdgcn_sched_barrier(0);
#pragma unroll
            for (int j = 0; j < 8; ++j) acc = __builtin_amdgcn_mfma_f32_32x32x16_bf16(av[c & 1][j], bv[c & 1][j], acc, 0, 0, 0);
            __builtin_amdgcn_sched_barrier(0);
        }
        const int n = 32 * wave + r;
#pragma unroll
        for (int i = 0; i < 16; ++i) { const int c = (i & 3) + 8 * (i >> 2) + 4 * hh;
            if (OUT) { const int t = n >> 4, q = n & 15; ((GAS bf16*)(a.ws + WS_Z))[(size_t)(ML + 16 * c + t) * D + 16 * g + q] = (bf16)f2bf(pg8::gelu_tanh_f(acc[i])); }
            else ((GAS bf16*)(a.ws + WS_SC))[(size_t)(g * 32 + c) * 256 + n] = (bf16)f2bf(acc[i]); }
    }
}
__device__ __forceinline__ void s5_carry_phase(const Args& a, int sl, LAS unsigned char* lds, int wg, int nwg) {
    PHASE_IDS;
    LAS f32x2* EX = (LAS f32x2*)lds;
    const int seg = wave;
    for (int item = wg; item < 2 * 2 * SG; item += nwg) {
        const int b = item & 1, d = (item >> 1) & 1, g = item >> 2;
        const f32x2 a16 = ((const f32x2*)(a.ws + WS_A16))[(size_t)((sl * 2 + d) * SG + g) * SP + lane];
        const int c0 = d ? 511 - seg * 64 : seg * 64;
        const long sst = d ? -128 : 128, xst = d ? -256 : 256;
        const GAS unsigned* sp = (const GAS unsigned*)(a.ws + WS_SL) + (size_t)(g * 1024 + b * 512 + c0) * 128 + d * 64 + lane;
        GAS unsigned* xp = (GAS unsigned*)(a.ws + WS_XL) + (size_t)(g * 1024 + b * 512 + c0) * 256 + 128 + d * 64 + lane;
        unsigned sw[64];
#pragma unroll
        for (int j = 0; j < 64; ++j) { sw[j] = *sp; sp += sst; asm volatile("" : "+v"(sp)); }
        float hr = 0.f, hi = 0.f;
#define S5_STEP(word) do { const float sr = __builtin_bit_cast(float, (word) << 16), si = __builtin_bit_cast(float, (word) & 0xffff0000u); \
            const float nr = a16.x * hr - a16.y * hi + sr, ni = a16.x * hi + a16.y * hr + si; hr = nr; hi = ni; } while (0)
        if (seg == 0) {
            const int cc0 = d ? 15 : 0;
            const GAS unsigned* cp = (const GAS unsigned*)(a.ws + WS_SC) + (size_t)(g * 32 + b * 16 + cc0) * 128 + d * 64 + lane;
            GAS unsigned* xcp = (GAS unsigned*)(a.ws + WS_XC) + (size_t)(g * 32 + b * 16 + cc0) * 256 + 128 + d * 64 + lane;
            unsigned cw[16];
#pragma unroll
            for (int j = 0; j < 16; ++j) { cw[j] = *cp; cp += sst; asm volatile("" : "+v"(cp)); }
#pragma unroll
            for (int j = 0; j < 16; ++j) { *xcp = pk2(hr, hi); xcp += xst; asm volatile("" : "+v"(xcp)); S5_STEP(cw[j]); }
#pragma unroll
            for (int j = 0; j < 64; ++j) { *xp = pk2(hr, hi); xp += xst; asm volatile("" : "+v"(xp)); S5_STEP(sw[j]); }
        } else {
#pragma unroll
            for (int j = 0; j < 64; ++j) S5_STEP(sw[j]);
        }
        { f32x2 o; o.x = hr; o.y = hi; EX[seg * 64 + lane] = o; }
        __syncthreads();
        if (seg != 0) {
            f32x2 P = a16;
#pragma unroll
            for (int q = 0; q < 6; ++q) P = cmul(P, P);
            f32x2 F = EX[lane];
            for (int k = 1; k < seg; ++k) { const f32x2 E = EX[k * 64 + lane]; const f32x2 pf = cmul(P, F); F.x = pf.x + E.x; F.y = pf.y + E.y; }
            hr = F.x; hi = F.y;
#pragma unroll
            for (int j = 0; j < 64; ++j) { *xp = pk2(hr, hi); xp += xst; asm volatile("" : "+v"(xp)); S5_STEP(sw[j]); }
        }
#undef S5_STEP
        __syncthreads();
    }
}
__device__ __forceinline__ void probe_flush(const Args& a, int vcu, int G) {
    PHASE_IDS; const int gt = vcu * NTHR + tid, ngt = G * NTHR;
    const GAS f32x4* p1 = (const GAS f32x4*)a.in[I_W1]; const GAS f32x4* p3 = (const GAS f32x4*)a.in[I_W3];
    f32x4 s = {0.f, 0.f, 0.f, 0.f};
    const int n4 = 4 * 2048 * 5632 / 4;
#pragma unroll 8
    for (int i = gt; i < n4; i += ngt) { s += p1[i]; s += p3[i]; }
    if (s.x + s.y + s.z + s.w == 1.2345e30f) ((float*)(a.ws + WS_CTL))[1000 + (tid & 7)] = s.x;
    __syncthreads();
}

#ifndef GEMM_ALIGN
#define GEMM_ALIGN true
#endif
#ifndef GEMM_SP2
#define GEMM_SP2 true
#endif
#ifndef MK_ONE_LAUNCH
#define MK_ONE_LAUNCH 1
#endif
constexpr int N_PHASES = 2 + 2 * 17;

__global__ void __launch_bounds__(NTHR, 2) fwd_kernel(Args args) {
    extern __shared__ __attribute__((aligned(16))) unsigned char lds_raw[];
    LAS unsigned char* lds = (LAS unsigned char*)lds_raw;
    const int tid = threadIdx.x;
    const int G = gridDim.x, bx = blockIdx.x;
    const int vcu = (G % 8 == 0) ? (bx % 8) * (G / 8) + bx / 8 : bx;
    unsigned char* ws = args.ws;
    volatile LAS unsigned* MISC = (volatile LAS unsigned*)(lds + MISC_OFF);
    for (int u = tid; u < (LDS_BYTES - LDSCTL_OFF) / 4; u += NTHR) ((LAS unsigned*)(lds + LDSCTL_OFF))[u] = 0u;
    __syncthreads();
    const int lo = args.ph_lo, hi = args.ph_hi; (void)lo; (void)hi;
#ifdef PROBE_WALL0
    const unsigned long long probe_t00 = __builtin_amdgcn_s_memrealtime();
#endif
    XcdBarrier bar; bar.bar = (unsigned*)(ws + WS_CTL) + CW_BAR; bar.x = 0; bar.st = nullptr;
    if (MK_ONE_LAUNCH || hi - lo > 1) bar = xcd_barrier_post((unsigned*)(ws + WS_CTL) + CW_BAR, MISC + 8);
#if MK_ONE_LAUNCH
#define RUN(k) true
#else
#define RUN(k) (lo <= (k) && (k) < hi)
#endif
#ifndef PROBE_MASK
#define PROBE_MASK 0
#endif
#define REP(kind) for (int rep = 0, nrep = 1 + ((PROBE_MASK >> (kind)) & 1); rep < nrep; ++rep)
#ifndef PROBE_WET
#define PROBE_WET 0
#endif
#define GATE(p) ((PROBE_WET && rep) ? (const float*)(ws + WS_CTL + 512 * 1024) : (p))
#define DRY (PROBE_WET ? 0 : rep)
#ifndef PROBE_FLUSH
#define PROBE_FLUSH 0
#endif
#define REPSYNC() do { if (rep + 1 < nrep) { __syncthreads(); if (PROBE_FLUSH == 1) probe_flush(args, vcu, G); } else if (PROBE_FLUSH == 2) { __syncthreads(); probe_flush(args, vcu, G); } } while (0)
#ifndef PROBE_BARTIME
#define PROBE_BARTIME 0
#endif
#ifndef PROBE_KIND
#define PROBE_KIND 0
#endif
#ifndef PROBE_PRO
#define PROBE_PRO 0
#endif
    unsigned long long probe_ticks = 0, probe_prev = (PROBE_KIND || PROBE_BARTIME || PROBE_PRO || PROBE_S5P) ? __builtin_amdgcn_s_memrealtime() : 0ull;
#define PRO_MARK(k) do { if (PROBE_PRO) { __syncthreads(); const unsigned long long tn_ = __builtin_amdgcn_s_memrealtime(); if (PROBE_PRO == (k)) probe_ticks += tn_ - probe_prev; probe_prev = tn_; } } while (0)
#define PHASE_KIND(k) ((k) == 0 ? 0 : (k) == 1 ? 1 : (((k) - 2) % 17) == 0 ? 2 : (((k) - 2) % 17) == 1 ? 12 : (((k) - 2) % 17) == 2 ? 3 : (((k) - 2) % 17) == 3 ? 4 : (((k) - 2) % 17) == 4 ? 1 : (((k) - 2) % 17) == 5 ? 5 : (((k) - 2) % 17) == 6 ? 6 : \
        (((k) - 2) % 17) == 7 ? 1 : (((k) - 2) % 17) == 8 ? 7 : (((k) - 2) % 17) == 9 ? 8 : (((k) - 2) % 17) == 10 ? 9 : (((k) - 2) % 17) == 11 ? 10 : (((k) - 2) % 17) == 12 ? 11 : (((k) - 2) % 17) == 13 ? 1 : (((k) - 2) % 17) == 14 ? 5 : (((k) - 2) % 17) == 15 ? 6 : 1)
#define SEAM(k) do { if (PROBE_KIND) { const unsigned long long tn_ = __builtin_amdgcn_s_memrealtime(); if (PHASE_KIND(k) == PROBE_KIND - 1) probe_ticks += tn_ - probe_prev; } \
        if (RUN(k) && RUN((k) + 1)) { const unsigned long long tb_ = PROBE_BARTIME ? __builtin_amdgcn_s_memrealtime() : 0ull; xcd_barrier(bar); if ((PROBE_MASK >> 12) & 1) xcd_barrier(bar); \
        if (PROBE_BARTIME) probe_ticks += __builtin_amdgcn_s_memrealtime() - tb_; } \
        if (PROBE_KIND) probe_prev = __builtin_amdgcn_s_memrealtime(); } while (0)
    _Float16* H = (_Float16*)(ws + WS_H); pg8::bf16_t* XN = (pg8::bf16_t*)(ws + WS_XN);
    const float* MOD = (const float*)(ws + WS_MOD);

#ifndef NO_PRO
    if (RUN(0)) REP(0) {
#ifndef PRO_ALT
#define PRO_ALT 1
#endif
#pragma unroll 1
        for (int step = 0; step < 2; ++step) {
            if ((step == 0) != (PRO_ALT && (vcu & 1) != 0)) {
                adaln_items(args, lds, vcu, G); PRO_MARK(1);
                transpose_items(args, lds, vcu, G); PRO_MARK(2);
                small_prologue(args, vcu, G);
            } else {
#if !S5_NAIVE
                s5_precompute(args, lds, vcu, G, &probe_ticks); PRO_MARK(4);
#endif
            }
            __syncthreads();
        }
        REPSYNC();
    }
#endif
    SEAM(0);
#ifdef PROBE_WALL0
    probe_ticks = __builtin_amdgcn_s_memrealtime() - probe_t00;
#endif
    if (RUN(1)) REP(1) norm_phase<true>(args, args.in[I_N1G], MOD, 0, vcu, G);
    SEAM(1);

#ifdef UNROLL_LP
#pragma unroll
#else
#pragma unroll 1
#endif
    for (int lp = 0; lp < 2; ++lp) {
        const int pb = 2 + lp * 17;
        {
            const int layer = 2 * lp; const float* modl = MOD + (size_t)layer * 3 * 12288;
            if (RUN(pb + 0)) { REP(2) {
                pg8::Gemm g{XN, (const pg8::bf16_t*)(ws + WS_WGIN) + (size_t)lp * 8192 * 2048, M, 8192, D}; pg8::StaticOrder S; S.init(M, 8192, G, bx);
                pg8::EpiG1 E{(pg8::bf16_t*)(ws + WS_ZU), (pg8::bf16_t*)(ws + WS_ZV), (float*)(ws + WS_VSTAT), 0};
                pg8::gemm_phase<pg8::EpiG1, pg8::StaticOrder, GEMM_ALIGN, GEMM_SP2>(lds + RING_OFF, g, S, E);
                if (rep == 0) conv_slot(args, lds, bx, G, (M / 256) * 32, lp == 0 ? CV_L1 : CV_L6, lp == 0 ? CV_L2 : CV_L7);
                REPSYNC(); }
            }
            SEAM(pb + 0);
            if (RUN(pb + 1)) vstat_phase(args, vcu, G);
            SEAM(pb + 1);
            #ifndef NO_SGU
            if (RUN(pb + 2)) REP(3) sgu_phase(args, lp, lds, bx, G, rep);
#endif
            SEAM(pb + 2);
            if (RUN(pb + 3)) { REP(4) {
                pg8::Gemm g{(const pg8::bf16_t*)(ws + WS_ZU), (const pg8::bf16_t*)(ws + WS_WGOUT) + (size_t)lp * 2048 * 4096, ML, D, EA}; pg8::StaticOrder S; S.init(ML, D, G, bx);
                pg8::EpiResid E{H, GATE(modl + 2 * D), DRY};
                pg8::gemm_phase<pg8::EpiResid, pg8::StaticOrder, GEMM_ALIGN, GEMM_SP2>(lds + RING_OFF, g, S, E);
                __syncthreads();
                pg8::Gemm gc{(const pg8::bf16_t*)(ws + WS_ZU), (const pg8::bf16_t*)(ws + WS_WGOUT) + (size_t)lp * 2048 * 4096, M, D, 512, EA, EA}; pg8::SliceOrder SS; SS.init(G, bx, 8, 512);
                pg8::EpiSlab ES{(float*)(ws + WS_SLAB), 1024};
                pg8::gemm_phase<pg8::EpiSlab, pg8::SliceOrder, GEMM_ALIGN, GEMM_SP2>(lds + RING_OFF, gc, SS, ES);
                REPSYNC(); }
            }
            SEAM(pb + 3);
            if (RUN(pb + 4)) REP(1) norm_phase<false>(args, args.in[I_N2G] + layer * D, modl, 1, vcu, G, rep ? 0 : 8, modl + 2 * 12288 + 2 * D);
            SEAM(pb + 4);
            if (RUN(pb + 5)) { REP(5) {
                pg8::Gemm g{XN, (const pg8::bf16_t*)(ws + WS_WF13) + (size_t)layer * 11264 * 2048, M, 2 * FF, D}; pg8::StaticOrder S; S.init(M, 2 * FF, G, bx);
                pg8::EpiSwiGLU E{(pg8::bf16_t*)(ws + WS_HID)};
                pg8::gemm_phase<pg8::EpiSwiGLU, pg8::StaticOrder, GEMM_ALIGN, GEMM_SP2>(lds + RING_OFF, g, S, E);
                if (rep == 0) conv_slot(args, lds, bx, G, (M / 256) * 44, lp == 0 ? CV_L2 : CV_L7, lp == 0 ? CV_L3 : CV_L8);
                REPSYNC(); }
            }
            SEAM(pb + 5);
            if (RUN(pb + 6)) { REP(6) {
                pg8::Gemm g{(const pg8::bf16_t*)(ws + WS_HID), (const pg8::bf16_t*)(ws + WS_WF2) + (size_t)layer * 2048 * 5632, ML, D, FF}; pg8::StaticOrder S; S.init(ML, D, G, bx);
                pg8::EpiResid E{H, GATE(modl + 5 * D), DRY};
                pg8::gemm_phase<pg8::EpiResid, pg8::StaticOrder, GEMM_ALIGN, GEMM_SP2>(lds + RING_OFF, g, S, E);
                if (true) { __syncthreads();
                pg8::Gemm gc{(const pg8::bf16_t*)(ws + WS_HID), (const pg8::bf16_t*)(ws + WS_WF2) + (size_t)layer * 2048 * 5632, M, D, 512, FF, FF}; pg8::SliceOrder SS; SS.init(G, bx, 11, 512);
                pg8::EpiSlab ES{(float*)(ws + WS_SLAB), 1024};
                pg8::gemm_phase<pg8::EpiSlab, pg8::SliceOrder, GEMM_ALIGN, GEMM_SP2>(lds + RING_OFF, gc, SS, ES); }
                REPSYNC(); }
            }
            SEAM(pb + 6);
            if (RUN(pb + 7)) REP(1) norm_phase<false>(args, args.in[I_N1G] + (layer + 1) * D, modl + 3 * 12288, 0, vcu, G, rep ? 0 : 11, modl + 2 * 12288 + 5 * D);
            SEAM(pb + 7);
        }
        {
            const int layer = 2 * lp + 1; const float* modl = MOD + (size_t)layer * 3 * 12288; const int ps = pb + 8;
            const int Mrows = lp == 0 ? M : ML;
#if S5_NAIVE
            if (RUN(ps + 0)) {
                pg8::Gemm g{XN, (const pg8::bf16_t*)(ws + WS_WSIN) + (size_t)lp * 2048 * 2048, M, D, D}; pg8::StaticOrder S; S.init(M, D, G, bx);
                pg8::EpiPlainBf16 E{(pg8::bf16_t*)(ws + WS_SU), D};
                pg8::gemm_phase<pg8::EpiPlainBf16, pg8::StaticOrder, GEMM_ALIGN, GEMM_SP2>(lds + RING_OFF, g, S, E);
            }
            SEAM(ps + 0);
            if (RUN(ps + 1)) s5_naive_phase(args, lp, bx, G);
            SEAM(ps + 1);
            if (RUN(ps + 2)) s5_combine_phase(args, lp, vcu, G);
            SEAM(ps + 2);
            SEAM(ps + 3);
#else
            if (RUN(ps + 0)) { REP(7) {
                pg8::Gemm g{XN, (const pg8::bf16_t*)(ws + WS_WSIN) + (size_t)lp * 2048 * 2048, M, D, D}; pg8::StaticOrder S; S.init(M, D, G, bx);
                pg8::EpiS5In E{(pg8::bf16_t*)(ws + WS_XL), (pg8::bf16_t*)(ws + WS_XC)};
                pg8::gemm_phase<pg8::EpiS5In, pg8::StaticOrder, GEMM_ALIGN, GEMM_SP2>(lds + RING_OFF, g, S, E);
                if (rep == 0) conv_slot(args, lds, bx, G, (M / 256) * 8, lp == 0 ? CV_L3 : CV_L8, lp == 0 ? CV_L4 : CV_T);
                REPSYNC(); }
            }
            SEAM(ps + 0);
            if (RUN(ps + 1)) { REP(8) {
                pg8::Gemm g{(const pg8::bf16_t*)(ws + WS_XL), (const pg8::bf16_t*)(ws + WS_M2T) + (size_t)lp * SG * 256 * 256, SG * 1024, 256, 256, 512}; pg8::GroupOrder S; S.init(G, vcu);
                pg8::EpiS5State E{(pg8::bf16_t*)(ws + WS_SL)};
                pg8::gemm_phase<pg8::EpiS5State, pg8::GroupOrder, GEMM_ALIGN, GEMM_SP2>(lds + RING_OFF, g, S, E);
                s5_ctx_gemm<false>(args, lp, vcu, G);
                REPSYNC(); }
            }
            SEAM(ps + 1);
            if (RUN(ps + 2)) REP(9) s5_carry_phase(args, lp, lds, bx, G);
            SEAM(ps + 2);
            if (RUN(ps + 3)) { REP(10) {
                pg8::Gemm g{(const pg8::bf16_t*)(ws + WS_XL), (const pg8::bf16_t*)(ws + WS_MOUTT) + (size_t)lp * SG * 256 * 512, SG * 1024, 256, 512, 512}; pg8::GroupOrder S; S.init(G, vcu);
                pg8::EpiS5Out E{(pg8::bf16_t*)(ws + WS_Z)};
                pg8::gemm_phase<pg8::EpiS5Out, pg8::GroupOrder, GEMM_ALIGN, GEMM_SP2>(lds + RING_OFF, g, S, E);
                s5_ctx_gemm<true>(args, lp, vcu, G);
                REPSYNC(); }
            }
            SEAM(ps + 3);
#endif
            if (RUN(ps + 4)) { REP(11) {
                pg8::Gemm g{(const pg8::bf16_t*)(ws + WS_Z), (const pg8::bf16_t*)(ws + WS_WGLU) + (size_t)lp * 4096 * 2048, Mrows, 2 * D, D}; pg8::StaticOrder S; S.init(Mrows, 2 * D, G, bx);
                pg8::EpiGluResid E{H, GATE(modl + 2 * D), DRY};
                pg8::gemm_phase<pg8::EpiGluResid, pg8::StaticOrder, GEMM_ALIGN, GEMM_SP2>(lds + RING_OFF, g, S, E);
                if (rep == 0 && lp == 0) conv_slot(args, lds, bx, G, (M / 256) * 16, CV_L4, CV_L5);
                REPSYNC(); }
            }
            SEAM(ps + 4);
            if (RUN(ps + 5)) REP(1) norm_phase<false>(args, args.in[I_N2G] + layer * D, modl, 1, vcu, G, 0, nullptr, Mrows);
            SEAM(ps + 5);
            if (RUN(ps + 6)) { REP(5) {
                pg8::Gemm g{XN, (const pg8::bf16_t*)(ws + WS_WF13) + (size_t)layer * 11264 * 2048, Mrows, 2 * FF, D}; pg8::StaticOrder S; S.init(Mrows, 2 * FF, G, bx);
                pg8::EpiSwiGLU E{(pg8::bf16_t*)(ws + WS_HID)};
                pg8::gemm_phase<pg8::EpiSwiGLU, pg8::StaticOrder, GEMM_ALIGN, GEMM_SP2>(lds + RING_OFF, g, S, E);
                if (rep == 0 && lp == 0) conv_slot(args, lds, bx, G, (M / 256) * 44, CV_L5, CV_L6);
                REPSYNC(); }
            }
            SEAM(ps + 6);
            if (RUN(ps + 7)) { REP(6) {
                pg8::Gemm g{(const pg8::bf16_t*)(ws + WS_HID), (const pg8::bf16_t*)(ws + WS_WF2) + (size_t)layer * 2048 * 5632, ML, D, FF}; pg8::StaticOrder S; S.init(ML, D, G, bx);
                pg8::EpiResid E{H, GATE(modl + 5 * D), DRY};
                pg8::gemm_phase<pg8::EpiResid, pg8::StaticOrder, GEMM_ALIGN, GEMM_SP2>(lds + RING_OFF, g, S, E);
                if (lp == 0) { __syncthreads();
                pg8::Gemm gc{(const pg8::bf16_t*)(ws + WS_HID), (const pg8::bf16_t*)(ws + WS_WF2) + (size_t)layer * 2048 * 5632, M, D, 512, FF, FF}; pg8::SliceOrder SS; SS.init(G, bx, 11, 512);
                pg8::EpiSlab ES{(float*)(ws + WS_SLAB), 1024};
                pg8::gemm_phase<pg8::EpiSlab, pg8::SliceOrder, GEMM_ALIGN, GEMM_SP2>(lds + RING_OFF, gc, SS, ES); }
                REPSYNC(); }
            }
            SEAM(ps + 7);
            if (RUN(ps + 8)) {
                REP(1) if (lp == 0) norm_phase<false>(args, args.in[I_N1G] + (layer + 1) * D, modl + 3 * 12288, 0, vcu, G, rep ? 0 : 11, modl + 2 * 12288 + 5 * D);
                else final_phase(args, vcu, G);
            }
            SEAM(ps + 8);
        }
    }
#ifdef PROBE_WALL0
    if (blockIdx.x == 0 && threadIdx.x == 0) { const unsigned long long t0 = __builtin_amdgcn_s_memrealtime(); while (__builtin_amdgcn_s_memrealtime() - t0 < 10ull * probe_ticks) __builtin_amdgcn_s_sleep(8); }
#endif
    if (((PROBE_KIND || PROBE_PRO || PROBE_S5P) ? blockIdx.x == 0 : (PROBE_BARTIME && (int)blockIdx.x == PROBE_BARTIME - 1)) && threadIdx.x == 0) { const unsigned long long t0 = __builtin_amdgcn_s_memrealtime(); while (__builtin_amdgcn_s_memrealtime() - t0 < 10ull * probe_ticks) __builtin_amdgcn_s_sleep(8); }
#undef RUN
#undef SEAM
}

extern "C" void kernel_launch(void* const* d_in, const int* in_sizes, int n_in, void* d_out, int out_size, void* d_ws, size_t ws_size, hipStream_t stream) {
    static int grid = 0;
    if (grid == 0) {
        if (n_in != 28 || in_sizes[0] != ML * D || out_size != ML * D || ws_size < WS_END) {
            fprintf(stderr, "kernel_launch: unexpected problem (n_in %d, in0 %d, out %d, ws %zu, need ws >= %zu); nothing launched\n", n_in, n_in > 0 ? in_sizes[0] : -1, out_size, ws_size, (size_t)WS_END); grid = -1; return; }
        int dev = 0, cus = 0, per_cu = 0;
        if (hipGetDevice(&dev) != hipSuccess || hipDeviceGetAttribute(&cus, hipDeviceAttributeMultiprocessorCount, dev) != hipSuccess) { fprintf(stderr, "kernel_launch: device query failed\n"); grid = -1; return; }
        if (hipFuncSetAttribute((const void*)fwd_kernel, hipFuncAttributeMaxDynamicSharedMemorySize, LDS_BYTES) != hipSuccess) { fprintf(stderr, "kernel_launch: hipFuncSetAttribute failed\n"); grid = -1; return; }
        if (hipOccupancyMaxActiveBlocksPerMultiprocessor(&per_cu, (const void*)fwd_kernel, NTHR, LDS_BYTES) != hipSuccess || per_cu < 1) {
            fprintf(stderr, "kernel_launch: occupancy query reports %d workgroups per CU\n", per_cu); }
        (void)hipGetLastError();
        grid = cus;
    }
    if (grid < 0) return;
    if (hipMemsetAsync((char*)d_ws + WS_CTL, 0, (PROBE_MASK || PROBE_WET) ? CTL_ZERO_BYTES : 64 * 1024, stream) != hipSuccess) { fprintf(stderr, "kernel_launch: memset failed\n"); return; }
    Args a{};
    for (int i = 0; i < 28; ++i) a.in[i] = (const float*)d_in[i];
    a.out = (float*)d_out; a.ws = (unsigned char*)d_ws;
#if MK_ONE_LAUNCH
    a.ph_lo = 0; a.ph_hi = N_PHASES;
    hipLaunchKernelGGL(fwd_kernel, dim3(grid), dim3(NTHR), LDS_BYTES, stream, a);
#else
    for (int p = 0; p < N_PHASES; ++p) { a.ph_lo = p; a.ph_hi = p + 1; hipLaunchKernelGGL(fwd_kernel, dim3(grid), dim3(NTHR), LDS_BYTES, stream, a); }
#endif
    const hipError_t le = hipPeekAtLastError();
    if (le != hipSuccess) fprintf(stderr, "kernel_launch: launch failed: %s\n", hipGetErrorName(le));
}
```

```cpp
#include <hip/hip_runtime.h>
#include <cstdio>
#include <cstdint>
namespace pg8 {
#define PG8_LAS __attribute__((address_space(3)))
typedef unsigned short bf16_t;
typedef short bf16x8 __attribute__((ext_vector_type(8)));
typedef float f32x4 __attribute__((ext_vector_type(4)));
typedef unsigned u32x4 __attribute__((ext_vector_type(4)));
constexpr int BM = 256, BK = 64, HALF = 128, HTB = HALF * BK * 2  , STAGE_BYTES = 8 * HTB, NXCD = 8, WGM = 8;

__host__ __device__ __forceinline__ int lds_byte(int r, int c) { const int st = (r >> 4) * 2 + (c >> 5), rr = r & 15, cc = c & 31, ob = rr * 64 + cc * 2; return st * 1024 + (ob ^ (((ob >> 9) & 1) << 5)); }
__host__ __device__ __forceinline__ void stage_rc(int b, int& R, int& C) { const int st = b / 1024, sb = b % 1024, swz = sb ^ (((sb >> 9) & 1) << 5); R = (st >> 1) * 16 + swz / 64; C = (st & 1) * 32 + (swz % 64) / 2; }
__host__ __device__ __forceinline__ int perm32(int rho) { const int n = rho >> 4, i = rho & 15; return 8 * (i >> 2) + 4 * n + (i & 3); }

struct Unit { int pm, pn; int koff; };
struct Gemm { const bf16_t* A; const bf16_t* Bt; int M, N, K; int lda, ldb; };

struct StaticOrder {
    int nM, nN, nwg, G, c;
    __host__ __device__ void init(int M, int N, int G_, int c_) { nM = M / BM; nN = N / BM; nwg = nM * nN; G = G_; c = c_; }
    __host__ __device__ bool next(int i, Unit& u) const {
        const long L = (long)i * G + c; if (L >= nwg) return false;
        int wgid = (int)L; { const int q = nwg / NXCD, r = nwg % NXCD, xcd = wgid % NXCD, off = wgid / NXCD; wgid = (xcd < r ? xcd * (q + 1) : r * (q + 1) + (xcd - r) * q) + off; }
        const int nig = WGM * nN, gid = wgid / nig, fm = gid * WGM, gsz = (nM - fm) < WGM ? (nM - fm) : WGM;
        u.pm = fm + ((wgid % nig) % gsz); u.pn = (wgid % nig) / gsz; u.koff = 0; return true;
    }
    __device__ __forceinline__ void a_ready(const Unit&) const {}
    __device__ __forceinline__ void done(const Unit&) const {}
};

__device__ __forceinline__ unsigned cvt_pk_bf16(float lo, float hi) { unsigned r; asm volatile("v_cvt_pk_bf16_f32 %0, %1, %2" : "=v"(r) : "v"(lo), "v"(hi)); return r; }
typedef float f32x2 __attribute__((ext_vector_type(2)));
__device__ __forceinline__ f32x2 gelu_pk(f32x2 v) {
    const f32x2 av = __builtin_elementwise_abs(v), d = av * 0.2316418882f + 1.0f;
    f32x2 t; t.x = __builtin_amdgcn_rcpf(d.x); t.y = __builtin_amdgcn_rcpf(d.y);
    f32x2 q = t * 0.5307027145f + (-0.7265760135f); q = q * t + 0.7107068705f; q = q * t + (-0.142248368f); q = q * t + 0.127414796f; q = q * t;
    const f32x2 s = (v * v) * (-0.72134752044f);
    f32x2 e; e.x = __builtin_amdgcn_exp2f(s.x); e.y = __builtin_amdgcn_exp2f(s.y);
    const f32x2 m = v * (q * e), r = v - m;
    f32x2 o; o.x = v.x < 0.f ? m.x : r.x; o.y = v.y < 0.f ? m.y : r.y; return o;
}


__device__ __forceinline__ float sigmoid_f(float x) { return __builtin_amdgcn_rcpf(1.0f + __builtin_amdgcn_exp2f(-1.44269504f * x)); }
__device__ __forceinline__ float silu_f(float x) { return x * sigmoid_f(x); }
__device__ __forceinline__ float gelu_tanh_f(float x) { const float u = x * (1.0f + 0.044715f * x * x); return x * __builtin_amdgcn_rcpf(1.0f + __builtin_amdgcn_exp2f(-2.30220820f * u)); }
__device__ __forceinline__ f32x2 gelu_tanh_pk(f32x2 x) {
    f32x2 xc; xc.x = __builtin_amdgcn_fmed3f(x.x, -3.6f, 3.6f); xc.y = __builtin_amdgcn_fmed3f(x.y, -3.6f, 3.6f);
    const f32x2 z = xc * 0.277777778f, z2 = z * z;
    f32x2 p = z2 * (-0.707277966f) + 3.50913538f;
    p = p * z2 + (-7.72999719f); p = p * z2 + 10.1716655f; p = p * z2 + (-9.14213848f); p = p * z2 + 6.07337743f; p = p * z2 + (-3.11094742f); p = p * z2 + 1.43606059f;
    return x * (p * z + 0.5f);
}
__device__ __forceinline__ int row_set(int pm) { return pm < 32 ? 0 : (pm < 64 ? 1 : 2); }

struct EpiPlainBf16 {
    static constexpr bool PERM = true, AFTER_DRAIN = false;
    bf16_t* O; int ldc;
    __device__ __forceinline__ void operator()(const f32x4 (&acc)[2][2][4][2], const Unit& u, int wr, int wc, int fr, int fq) const {
        const int row0 = u.pm * BM + wr * 64 + fr, col0 = u.pn * BM + wc * 32 + 8 * fq;
#pragma unroll
        for (int ai = 0; ai < 2; ++ai)
#pragma unroll
            for (int m = 0; m < 4; ++m) { bf16_t* rowp = O + (size_t)(row0 + ai * HALF + m * 16) * ldc + col0;
#pragma unroll
                for (int bj = 0; bj < 2; ++bj) { const f32x4 v0 = acc[ai][bj][m][0], v1 = acc[ai][bj][m][1];
                    u32x4 w; w.x = cvt_pk_bf16(v0[0], v0[1]); w.y = cvt_pk_bf16(v0[2], v0[3]); w.z = cvt_pk_bf16(v1[0], v1[1]); w.w = cvt_pk_bf16(v1[2], v1[3]);
                    *(u32x4*)(rowp + bj * HALF) = w; } }
    }
};
struct EpiG1 {
    static constexpr bool PERM = true, AFTER_DRAIN = false;
    bf16_t* U; bf16_t* V; float* vstat; int dry;
    __device__ __forceinline__ void operator()(const f32x4 (&acc)[2][2][4][2], const Unit& u, int wr, int wc, int fr, int fq) const {
        if (dry) return;
        const bool isv = u.pn >= 16;
        const int row0 = u.pm * BM + wr * 64 + fr, col0 = (u.pn & 15) * BM + wc * 32 + 8 * fq;
        bf16_t* base = isv ? V : U;
#pragma unroll
        for (int ai = 0; ai < 2; ++ai)
#pragma unroll
            for (int m = 0; m < 4; ++m) { const int row = row0 + ai * HALF + m * 16; bf16_t* rowp = base + (size_t)row * 4096 + col0; float s = 0.f, ss = 0.f;
#pragma unroll
                for (int bj = 0; bj < 2; ++bj) { f32x4 v0 = acc[ai][bj][m][0], v1 = acc[ai][bj][m][1];
                    { const f32x2 a0 = gelu_tanh_pk((f32x2){v0[0], v0[1]}), a1 = gelu_tanh_pk((f32x2){v0[2], v0[3]}), a2 = gelu_tanh_pk((f32x2){v1[0], v1[1]}), a3 = gelu_tanh_pk((f32x2){v1[2], v1[3]});
                      v0 = (f32x4){a0.x, a0.y, a1.x, a1.y}; v1 = (f32x4){a2.x, a2.y, a3.x, a3.y}; }
                    if (isv) {
#pragma unroll
                        for (int e = 0; e < 4; ++e) { s += v0[e] + v1[e]; ss += v0[e] * v0[e] + v1[e] * v1[e]; } }
                    u32x4 w; w.x = cvt_pk_bf16(v0[0], v0[1]); w.y = cvt_pk_bf16(v0[2], v0[3]); w.z = cvt_pk_bf16(v1[0], v1[1]); w.w = cvt_pk_bf16(v1[2], v1[3]);
                    *(u32x4*)(rowp + bj * HALF) = w; }
                if (isv) { s += __shfl_xor(s, 16); s += __shfl_xor(s, 32); ss += __shfl_xor(ss, 16); ss += __shfl_xor(ss, 32);
                    if (fq == 0) { f32x2 o; o.x = s; o.y = ss; *(f32x2*)(vstat + ((size_t)row * 64 + (u.pn - 16) * 4 + wc) * 2) = o; } } }
    }
};
typedef _Float16 h16x8 __attribute__((ext_vector_type(8)));
struct EpiResid {
    static constexpr bool PERM = true, AFTER_DRAIN = false;
    _Float16* H; const float* gate; int dry;
    __device__ __forceinline__ void operator()(const f32x4 (&acc)[2][2][4][2], const Unit& u, int wr, int wc, int fr, int fq) const {
        if (dry) return;
        const int row0 = u.pm * BM + wr * 64 + fr, col0 = u.pn * BM + wc * 32 + 8 * fq;
        const float* g = gate + row_set(u.pm) * (6 * 2048) + col0;
        f32x4 gv[2][2];
#pragma unroll
        for (int bj = 0; bj < 2; ++bj)
#pragma unroll
            for (int n = 0; n < 2; ++n) gv[bj][n] = *(const f32x4*)(g + bj * HALF + n * 4);
        h16x8 hv[2][4][2];
#pragma unroll
        for (int ai = 0; ai < 2; ++ai)
#pragma unroll
            for (int m = 0; m < 4; ++m)
#pragma unroll
                for (int bj = 0; bj < 2; ++bj) hv[ai][m][bj] = *(const h16x8*)(H + (size_t)(row0 + ai * HALF + m * 16) * 2048 + col0 + bj * HALF);
        __builtin_amdgcn_sched_barrier(0);
#pragma unroll
        for (int ai = 0; ai < 2; ++ai)
#pragma unroll
            for (int m = 0; m < 4; ++m)
#pragma unroll
                for (int bj = 0; bj < 2; ++bj) { h16x8 h = hv[ai][m][bj];
#pragma unroll
                    for (int e = 0; e < 4; ++e) { h[e] = (_Float16)((float)h[e] + gv[bj][0][e] * acc[ai][bj][m][0][e]); h[4 + e] = (_Float16)((float)h[4 + e] + gv[bj][1][e] * acc[ai][bj][m][1][e]); }
                    *(h16x8*)(H + (size_t)(row0 + ai * HALF + m * 16) * 2048 + col0 + bj * HALF) = h; }
    }
};
struct EpiSwiGLU {
    static constexpr bool PERM = true, AFTER_DRAIN = false;
    bf16_t* O;
    __device__ __forceinline__ void operator()(const f32x4 (&acc)[2][2][4][2], const Unit& u, int wr, int wc, int fr, int fq) const {
        const int row0 = u.pm * BM + wr * 64 + fr, col0 = u.pn * HALF + wc * 32 + 8 * fq;
#pragma unroll
        for (int ai = 0; ai < 2; ++ai)
#pragma unroll
            for (int m = 0; m < 4; ++m) { bf16_t* rowp = O + (size_t)(row0 + ai * HALF + m * 16) * 5632 + col0;
                f32x4 a0 = acc[ai][0][m][0], a1 = acc[ai][0][m][1]; const f32x4 b0 = acc[ai][1][m][0], b1 = acc[ai][1][m][1];
#pragma unroll
                for (int e = 0; e < 4; ++e) { a0[e] = silu_f(a0[e]) * b0[e]; a1[e] = silu_f(a1[e]) * b1[e]; }
                u32x4 w; w.x = cvt_pk_bf16(a0[0], a0[1]); w.y = cvt_pk_bf16(a0[2], a0[3]); w.z = cvt_pk_bf16(a1[0], a1[1]); w.w = cvt_pk_bf16(a1[2], a1[3]);
                *(u32x4*)rowp = w; }
    }
};
struct EpiGluResid {
    static constexpr bool PERM = true, AFTER_DRAIN = false;
    _Float16* H; const float* gate; int dry;
    __device__ __forceinline__ void operator()(const f32x4 (&acc)[2][2][4][2], const Unit& u, int wr, int wc, int fr, int fq) const {
        if (dry) return;
        const int row0 = u.pm * BM + wr * 64 + fr, col0 = u.pn * HALF + wc * 32 + 8 * fq;
        const float* g = gate + row_set(u.pm) * (6 * 2048) + col0;
        f32x4 gv[2];
#pragma unroll
        for (int n = 0; n < 2; ++n) gv[n] = *(const f32x4*)(g + n * 4);
        h16x8 hv[2][4];
#pragma unroll
        for (int ai = 0; ai < 2; ++ai)
#pragma unroll
            for (int m = 0; m < 4; ++m) hv[ai][m] = *(const h16x8*)(H + (size_t)(row0 + ai * HALF + m * 16) * 2048 + col0);
        __builtin_amdgcn_sched_barrier(0);
#pragma unroll
        for (int ai = 0; ai < 2; ++ai)
#pragma unroll
            for (int m = 0; m < 4; ++m) { h16x8 h = hv[ai][m];
#pragma unroll
                for (int n = 0; n < 2; ++n) { const f32x4 a = acc[ai][0][m][n], gg = acc[ai][1][m][n];
#pragma unroll
                    for (int e = 0; e < 4; ++e) h[4 * n + e] = (_Float16)((float)h[4 * n + e] + gv[n][e] * a[e] * sigmoid_f(gg[e])); }
                *(h16x8*)(H + (size_t)(row0 + ai * HALF + m * 16) * 2048 + col0) = h; }
    }
};

struct GroupOrder {
    int G, c, adj;
    __host__ __device__ void init(int G_, int c_, int adj_ = 0) { G = G_; c = c_; adj = adj_; }
    __host__ __device__ bool next(int i, Unit& u) const { const int L = i * G + c; if (L >= 512) return false;
        if (adj) { const int grp = 4 * (L >> 4) + (L & 3), rt = (L >> 2) & 3; u.pm = 4 * grp + rt; u.pn = grp; } else { u.pm = L; u.pn = L >> 2; }
        u.koff = 0; return true; }
    __device__ __forceinline__ void a_ready(const Unit&) const {}
    __device__ __forceinline__ void done(const Unit&) const {}
};
struct EpiS5In {
    static constexpr bool PERM = true, AFTER_DRAIN = false;
    bf16_t* XL; bf16_t* XC;
    __device__ __forceinline__ void operator()(const f32x4 (&acc)[2][2][4][2], const Unit& u, int wr, int wc, int fr, int fq) const {
        const int row0 = u.pm * BM + wr * 64 + fr;
#pragma unroll
        for (int ai = 0; ai < 2; ++ai)
#pragma unroll
            for (int m = 0; m < 4; ++m) { const int row = row0 + ai * HALF + m * 16;
#pragma unroll
                for (int bj = 0; bj < 2; ++bj) { const int col0 = u.pn * BM + bj * HALF + wc * 32 + 8 * fq, g = col0 >> 4, q0 = col0 & 15;
                    bf16_t* dst = row < 16384 ? XL + ((size_t)(g * 1024 + (row >> 4)) * 512 + 16 * (row & 15) + q0)
                                              : XC + ((size_t)(g * 32 + ((row - 16384) >> 4)) * 512 + 16 * (row & 15) + q0);
                    const f32x4 v0 = acc[ai][bj][m][0], v1 = acc[ai][bj][m][1];
                    u32x4 w; w.x = cvt_pk_bf16(v0[0], v0[1]); w.y = cvt_pk_bf16(v0[2], v0[3]); w.z = cvt_pk_bf16(v1[0], v1[1]); w.w = cvt_pk_bf16(v1[2], v1[3]);
                    *(u32x4*)dst = w; } }
    }
};
struct EpiS5State {
    static constexpr bool PERM = true, AFTER_DRAIN = false;
    bf16_t* SL;
    __device__ __forceinline__ void operator()(const f32x4 (&acc)[2][2][4][2], const Unit& u, int wr, int wc, int fr, int fq) const {
        const int row0 = u.pm * BM + wr * 64 + fr, col0 = wc * 32 + 8 * fq;
#pragma unroll
        for (int ai = 0; ai < 2; ++ai)
#pragma unroll
            for (int m = 0; m < 4; ++m) { bf16_t* rowp = SL + (size_t)(row0 + ai * HALF + m * 16) * 256 + col0;
#pragma unroll
                for (int bj = 0; bj < 2; ++bj) { const f32x4 v0 = acc[ai][bj][m][0], v1 = acc[ai][bj][m][1];
                    u32x4 w; w.x = cvt_pk_bf16(v0[0], v0[1]); w.y = cvt_pk_bf16(v0[2], v0[3]); w.z = cvt_pk_bf16(v1[0], v1[1]); w.w = cvt_pk_bf16(v1[2], v1[3]);
                    *(u32x4*)(rowp + bj * HALF) = w; } }
    }
};
struct EpiS5Out {
    static constexpr bool PERM = true, AFTER_DRAIN = false;
    bf16_t* Z;
    __device__ __forceinline__ void operator()(const f32x4 (&acc)[2][2][4][2], const Unit& u, int wr, int wc, int fr, int fq) const {
        const int c0 = (u.pm & 3) * BM + wr * 64 + fr, g = u.pn;
#pragma unroll
        for (int ai = 0; ai < 2; ++ai)
#pragma unroll
            for (int m = 0; m < 4; ++m) { const int c = c0 + ai * HALF + m * 16;
#pragma unroll
                for (int bj = 0; bj < 2; ++bj) { const int n0 = bj * HALF + wc * 32 + 8 * fq, t = n0 >> 4, q0 = n0 & 15;
                    f32x4 v0 = acc[ai][bj][m][0], v1 = acc[ai][bj][m][1];
#pragma unroll
                    for (int e = 0; e < 4; ++e) { v0[e] = gelu_tanh_f(v0[e]); v1[e] = gelu_tanh_f(v1[e]); }
                    u32x4 w; w.x = cvt_pk_bf16(v0[0], v0[1]); w.y = cvt_pk_bf16(v0[2], v0[3]); w.z = cvt_pk_bf16(v1[0], v1[1]); w.w = cvt_pk_bf16(v1[2], v1[3]);
                    *(u32x4*)(Z + (size_t)(16 * c + t) * 2048 + 16 * g + q0) = w; } }
    }
};

struct SliceOrder {
    int G, c, nsl, kbytes;
    __host__ __device__ void init(int G_, int c_, int nsl_, int kslice) { G = G_; c = c_; nsl = nsl_; kbytes = kslice * 2; }
    __host__ __device__ bool next(int i, Unit& u) const { const int L = i * G + c; if (L >= nsl * 16) return false; const int s = L >> 4, r = L & 15; u.pm = 64 + (r >> 3); u.pn = r & 7; u.koff = s * kbytes; return true; }
    __device__ __forceinline__ void a_ready(const Unit&) const {}
    __device__ __forceinline__ void done(const Unit&) const {}
};
struct EpiSlab {
    static constexpr bool PERM = false, AFTER_DRAIN = false;
    float* SLAB; int kbytes;
    __device__ __forceinline__ void operator()(const f32x4 (&acc)[2][2][4][2], const Unit& u, int wr, int wc, int fr, int fq) const {
        const int s = u.koff / kbytes, row0 = (u.pm - 64) * BM + wr * 64 + fr, col0 = u.pn * BM + wc * 32 + 4 * fq;
        float* base = SLAB + (size_t)s * 512 * 2048;
#pragma unroll
        for (int ai = 0; ai < 2; ++ai)
#pragma unroll
            for (int m = 0; m < 4; ++m) { float* rowp = base + (size_t)(row0 + ai * HALF + m * 16) * 2048 + col0;
#pragma unroll
                for (int bj = 0; bj < 2; ++bj)
#pragma unroll
                    for (int n = 0; n < 2; ++n) *(f32x4*)(rowp + bj * HALF + n * 16) = acc[ai][bj][m][n]; }
    }
};

template <class Epi, class Sched, bool ALIGN_EPI = false, bool SP2 = false>
__device__ __forceinline__ void gemm_phase(PG8_LAS unsigned char* lds, const Gemm g, const Sched& S, const Epi& E) {
    int tid_ = threadIdx.x; asm volatile("" : "+v"(tid_));
    const int tid = tid_, wid = __builtin_amdgcn_readfirstlane(tid >> 6), lane = tid & 63, wr = wid >> 2, wc = wid & 3, fr = lane & 15, fq = lane >> 4;
    const int K = g.K, nt = K / BK, lda = g.lda ? g.lda : K, ldb = g.ldb ? g.ldb : K;
    unsigned voffA[2], voffB[2];
#pragma unroll
    for (int i = 0; i < 2; ++i) { int R, C; stage_rc(tid * 16 + i * 8192, R, C); const int Rb = Epi::PERM ? ((R & ~31) + perm32(R & 31)) : R;
        voffA[i] = (unsigned)(R * lda + C) * 2u; voffB[i] = (unsigned)(Rb * ldb + C) * 2u; }
    const size_t kstep = (size_t)(BK * 2);
    const size_t hstepB = (size_t)HALF * ldb * 2, hstepA = (size_t)HALF * lda * 2;
    const size_t tstepB = 2 * hstepB, tstepA = 2 * hstepA;
    const unsigned ldsw = (unsigned)wid * 1024u;
    const int aoff = lds_byte(wr * 64 + fr, fq * 8), boff = lds_byte(wc * 32 + fr, fq * 8);
#define PG8_SA(b, h) (((b) * 2 + (h)) * HTB)
#define PG8_SB(b, h) ((4 + (b) * 2 + (h)) * HTB)
#define PG8_STAGE(bufoff, gbase, voff) do { _Pragma("unroll") for (int _i = 0; _i < 2; ++_i) \
        __builtin_amdgcn_global_load_lds((const unsigned*)((const char*)(gbase) + (voff)[_i]), (PG8_LAS unsigned*)(lds + (bufoff) + ldsw + _i * 8192), 16, 0, 0); } while (0)
#define PG8_LDA(dst, b, h) do { _Pragma("unroll") for (int m = 0; m < 4; ++m) _Pragma("unroll") for (int k = 0; k < 2; ++k) dst[m][k] = *(const PG8_LAS bf16x8*)(lds + PG8_SA(b, h) + aoff + m * 2048 + k * 1024); } while (0)
#define PG8_LDB(dst, b, h) do { _Pragma("unroll") for (int n = 0; n < 2; ++n) _Pragma("unroll") for (int k = 0; k < 2; ++k) dst[n][k] = *(const PG8_LAS bf16x8*)(lds + PG8_SB(b, h) + boff + n * 2048 + k * 1024); } while (0)
#define PG8_MMA(ai, bj, At, Bt) do { __builtin_amdgcn_s_setprio(1); _Pragma("unroll") for (int m = 0; m < 4; ++m) _Pragma("unroll") for (int n = 0; n < 2; ++n) _Pragma("unroll") for (int k = 0; k < 2; ++k) \
        acc[ai][bj][m][n] = __builtin_amdgcn_mfma_f32_16x16x32_bf16(Bt[n][k], At[m][k], acc[ai][bj][m][n], 0, 0, 0); __builtin_amdgcn_s_setprio(0); } while (0)
#define PG8_WAIT_V(n) asm volatile("s_waitcnt vmcnt(" #n ")" ::: "memory")
#define PG8_WAIT_L(n) asm volatile("s_waitcnt lgkmcnt(" #n ")" ::: "memory")
#define PG8_BAR __builtin_amdgcn_s_barrier()
#define PG8_SCHED __builtin_amdgcn_sched_barrier(0)
    Unit cur, nxt; int ui = 0;
    if (!S.next(0, cur)) return;
    f32x4 acc[2][2][4][2];
#pragma unroll
    for (int a = 0; a < 2; ++a)
#pragma unroll
        for (int b = 0; b < 2; ++b)
#pragma unroll
            for (int m = 0; m < 4; ++m)
#pragma unroll
                for (int n = 0; n < 2; ++n) acc[a][b][m][n] = (f32x4){0.f, 0.f, 0.f, 0.f};
    bf16x8 At[4][2], B0[2][2], B1[2][2];
    const char* cA = (const char*)g.A + (size_t)cur.pm * tstepA + cur.koff; const char* cB = (const char*)g.Bt + (size_t)cur.pn * tstepB + cur.koff;
    S.a_ready(cur);
    if constexpr (SP2) {
        PG8_STAGE(PG8_SB(0, 0), cB, voffB); PG8_STAGE(PG8_SB(0, 1), cB + hstepB, voffB); PG8_STAGE(PG8_SA(0, 0), cA, voffA); PG8_STAGE(PG8_SA(0, 1), cA + hstepA, voffA);
        if (wr == 1) PG8_BAR;
        PG8_WAIT_V(2); PG8_BAR;
        PG8_STAGE(PG8_SB(1, 0), cB + kstep, voffB); PG8_STAGE(PG8_SA(1, 0), cA + kstep, voffA); PG8_STAGE(PG8_SB(1, 1), cB + hstepB + kstep, voffB);
        PG8_WAIT_V(6); PG8_BAR;
    } else {
        PG8_STAGE(PG8_SB(0, 0), cB, voffB); PG8_STAGE(PG8_SA(0, 0), cA, voffA); PG8_STAGE(PG8_SB(0, 1), cB + hstepB, voffB); PG8_STAGE(PG8_SA(0, 1), cA + hstepA, voffA);
        if (wr == 1) PG8_BAR;
        PG8_WAIT_V(4); PG8_BAR;
        PG8_STAGE(PG8_SB(1, 0), cB + kstep, voffB); PG8_STAGE(PG8_SA(1, 0), cA + kstep, voffA); PG8_STAGE(PG8_SB(1, 1), cB + hstepB + kstep, voffB);
        PG8_WAIT_V(6); PG8_BAR;
    }
    for (;;) {
        const bool has_next = S.next(ui + 1, nxt);
        const char* nA = has_next ? (const char*)g.A + (size_t)nxt.pm * tstepA + nxt.koff : cA; const char* nB = has_next ? (const char*)g.Bt + (size_t)nxt.pn * tstepB + nxt.koff : cB;
#pragma unroll 1
        for (int t = 0; t < nt; t += 2) {
            const bool last = (t == nt - 2);
            const char* a1 = cA + (size_t)(t + 1) * kstep;
            const char* a2 = last ? nA : cA + (size_t)(t + 2) * kstep; const char* b2 = last ? nB : cB + (size_t)(t + 2) * kstep;
            const char* a3 = a2 + kstep; const char* b3 = b2 + kstep;
            if (last && has_next) S.a_ready(nxt);
            if constexpr (SP2) {
            PG8_LDB(B0, 0, 0); PG8_LDB(B1, 0, 1); PG8_SCHED; PG8_LDA(At, 0, 0); PG8_STAGE(PG8_SA(1, 1), a1 + hstepA, voffA);
            PG8_WAIT_V(8); PG8_WAIT_L(0); PG8_BAR; PG8_MMA(0, 0, At, B0); PG8_MMA(0, 1, At, B1); PG8_BAR; PG8_SCHED;
            PG8_LDA(At, 0, 1); PG8_STAGE(PG8_SB(0, 0), b2, voffB); PG8_STAGE(PG8_SB(0, 1), b2 + hstepB, voffB); PG8_STAGE(PG8_SA(0, 0), a2, voffA);
            PG8_WAIT_V(8); PG8_WAIT_L(0); PG8_BAR; PG8_MMA(1, 0, At, B0); PG8_MMA(1, 1, At, B1); PG8_BAR; PG8_SCHED;
            PG8_LDB(B0, 1, 0); PG8_LDB(B1, 1, 1); PG8_SCHED; PG8_LDA(At, 1, 0); PG8_STAGE(PG8_SA(0, 1), a2 + hstepA, voffA);
            PG8_WAIT_V(8); PG8_WAIT_L(0); PG8_BAR; PG8_MMA(0, 0, At, B0); PG8_MMA(0, 1, At, B1); PG8_BAR; PG8_SCHED;
            PG8_LDA(At, 1, 1); PG8_STAGE(PG8_SB(1, 0), b3, voffB); PG8_STAGE(PG8_SB(1, 1), b3 + hstepB, voffB); PG8_STAGE(PG8_SA(1, 0), a3, voffA);
            PG8_WAIT_V(8); PG8_WAIT_L(0); PG8_BAR; PG8_MMA(1, 0, At, B0); PG8_MMA(1, 1, At, B1); PG8_BAR; PG8_SCHED;
            } else {
            PG8_LDB(B0, 0, 0); PG8_SCHED; PG8_LDA(At, 0, 0); PG8_STAGE(PG8_SA(1, 1), a1 + hstepA, voffA);
            PG8_WAIT_L(8); PG8_BAR; PG8_WAIT_L(0); PG8_MMA(0, 0, At, B0); PG8_BAR; PG8_SCHED;
            PG8_LDB(B1, 0, 1); PG8_STAGE(PG8_SB(0, 0), b2, voffB);
            PG8_BAR; PG8_WAIT_L(0); PG8_MMA(0, 1, At, B1); PG8_BAR;
            PG8_LDA(At, 0, 1); PG8_STAGE(PG8_SA(0, 0), a2, voffA);
            PG8_BAR; PG8_WAIT_L(0); PG8_MMA(1, 0, At, B0); PG8_BAR; PG8_SCHED;
            PG8_STAGE(PG8_SB(0, 1), b2 + hstepB, voffB);
            PG8_WAIT_V(6); PG8_BAR; PG8_MMA(1, 1, At, B1); PG8_BAR;
            PG8_LDB(B0, 1, 0); PG8_SCHED; PG8_LDA(At, 1, 0); PG8_STAGE(PG8_SA(0, 1), a2 + hstepA, voffA);
            PG8_WAIT_L(8); PG8_BAR; PG8_WAIT_L(0); PG8_MMA(0, 0, At, B0); PG8_BAR; PG8_SCHED;
            PG8_LDB(B1, 1, 1); PG8_STAGE(PG8_SB(1, 0), b3, voffB);
            PG8_BAR; PG8_WAIT_L(0); PG8_MMA(0, 1, At, B1); PG8_BAR;
            PG8_LDA(At, 1, 1); PG8_STAGE(PG8_SA(1, 0), a3, voffA);
            PG8_BAR; PG8_WAIT_L(0); PG8_MMA(1, 0, At, B0); PG8_BAR; PG8_SCHED;
            PG8_STAGE(PG8_SB(1, 1), b3 + hstepB, voffB);
            PG8_WAIT_V(6); PG8_BAR; PG8_MMA(1, 1, At, B1); PG8_BAR;
            }
        }
        if constexpr (ALIGN_EPI) { if (wr == 0) PG8_BAR; }
        if constexpr (!Epi::AFTER_DRAIN) { E(acc, cur, wr, wc, fr, fq); S.done(cur); }
        if (!has_next) break;
#pragma unroll
        for (int a = 0; a < 2; ++a)
#pragma unroll
            for (int b = 0; b < 2; ++b)
#pragma unroll
                for (int m = 0; m < 4; ++m)
#pragma unroll
                    for (int n = 0; n < 2; ++n) acc[a][b][m][n] = (f32x4){0.f, 0.f, 0.f, 0.f};
        cur = nxt; cA = nA; cB = nB; ++ui;
        if constexpr (ALIGN_EPI) { if (wr == 1) PG8_BAR; }
    }
    PG8_WAIT_V(0);
    if constexpr (!ALIGN_EPI) { if (wr == 0) PG8_BAR; }
    PG8_BAR;
    if constexpr (Epi::AFTER_DRAIN) { E.fused(acc, cur, wr, wc, fr, fq, lds, wid, lane); S.done(cur); }
#undef PG8_SA
#undef PG8_SB
#undef PG8_STAGE
#undef PG8_LDA
#undef PG8_LDB
#undef PG8_MMA
#undef PG8_WAIT_V
#undef PG8_WAIT_L
#undef PG8_BAR
#undef PG8_SCHED
}
}

constexpr int NWAVES = 8, NTHR = NWAVES * 64;
constexpr int D = 2048, BATCH = 2, SEQ = 8192, ML = BATCH * SEQ, CTXL = 256, MC = BATCH * CTXL, M = ML + MC;
constexpr int FF = 5632, EA = 4096, NH = 16, HDIM = 256, CHUNK = 128, NCHUNK = M / CHUNK;
constexpr int SG = 128, SP = 64, SQ = 16;
constexpr int DEPTH = 4;
constexpr float EPS = 1e-6f;
static_assert(M % 256 == 0 && NCHUNK == 132, "row tiling");

constexpr size_t MiB = 1u << 20;
constexpr size_t WS_CTL = 0, CTL_ZERO_BYTES = 1 * MiB;
constexpr size_t WS_MOD = 1 * MiB;
constexpr size_t WS_S5A = 2 * MiB;
constexpr size_t WS_S5B = 3 * MiB;
constexpr size_t WS_WSB = 11 * MiB;
constexpr size_t WS_VSTAT = 12 * MiB;
constexpr size_t WS_RSTAT = 21 * MiB;
constexpr size_t WS_WGIN = 32 * MiB;
constexpr size_t WS_WGOUT = 96 * MiB;
constexpr size_t WS_WF13 = 128 * MiB;
constexpr size_t WS_WF2 = 304 * MiB;
constexpr size_t WS_WSIN = 392 * MiB;
constexpr size_t WS_WGLU = 408 * MiB;
constexpr size_t WS_H = 440 * MiB;
constexpr size_t WS_XN = 572 * MiB;
constexpr size_t WS_BIG = 640 * MiB;
constexpr size_t WS_ZU = WS_BIG, WS_ZV = WS_BIG + 132 * MiB;
constexpr size_t WS_HID = WS_BIG;
constexpr size_t WS_SU = WS_BIG, WS_SZ = WS_BIG + 66 * MiB;
constexpr size_t WS_YF = WS_BIG + 132 * MiB, WS_YB = WS_BIG + 264 * MiB;
constexpr size_t WS_XL = WS_BIG, WS_XC = WS_BIG + 128 * MiB;
constexpr size_t WS_SL = WS_BIG + 132 * MiB, WS_SC = WS_BIG + 196 * MiB;
constexpr size_t WS_SZ2 = WS_BIG + 200 * MiB;
constexpr size_t WS_MOUTT = WS_BIG + 396 * MiB;
constexpr size_t WS_M2T = WS_MOUTT + 64 * MiB;
constexpr size_t WS_A16 = WS_M2T + 32 * MiB;
constexpr size_t WS_SLAB = WS_A16 + 2 * MiB;
constexpr size_t WS_END = WS_SLAB + 44 * MiB;
#ifndef S5_NAIVE
#define S5_NAIVE 0
#endif
constexpr size_t WS_Z = S5_NAIVE ? WS_SZ : WS_SZ2;
constexpr int CW_BAR = 4096;

constexpr int RING_OFF = 0, RING_BYTES = 131072;
constexpr int LDSCTL_OFF = RING_BYTES, MISC_OFF = LDSCTL_OFF + 320;
constexpr int LDS_BYTES = 147456;
static_assert(MISC_OFF + 128 <= LDS_BYTES, "LDS map");

#define GAS __attribute__((address_space(1)))
#define LAS __attribute__((address_space(3)))
typedef unsigned short bf16;
typedef unsigned v4u __attribute__((ext_vector_type(4)));
typedef unsigned v2u __attribute__((ext_vector_type(2)));
typedef float f32x4 __attribute__((ext_vector_type(4)));
typedef float f32x2 __attribute__((ext_vector_type(2)));
typedef float f32x16 __attribute__((ext_vector_type(16)));
typedef short bf16x8 __attribute__((ext_vector_type(8)));
typedef GAS unsigned gu32;
#define RLX_AGENT __ATOMIC_RELAXED, __HIP_MEMORY_SCOPE_AGENT
#define LDS_WAIT() asm volatile("s_waitcnt lgkmcnt(0)" ::: "memory")
__device__ __forceinline__ unsigned f2bf(float f) { unsigned u = __builtin_bit_cast(unsigned, f); return (u + 0x7fffu + ((u >> 16) & 1u)) >> 16; }
__device__ __forceinline__ unsigned pk2(float lo, float hi) { return f2bf(lo) | (f2bf(hi) << 16); }
__device__ __forceinline__ float bf2f(unsigned short b) { return __builtin_bit_cast(float, (unsigned)b << 16); }
__device__ __forceinline__ float wave_sum(float v) {
#pragma unroll
    for (int o = 1; o < 64; o <<= 1) v += __shfl_xor(v, o);
    return v;
}

#define XB_TMO      128
#define XB_XCNT(j)  (256  + 64 * (j))
#define XB_XSUB(j)  (1280 + 64 * (j))
#define XB_XGEN(j)  (2304 + 64 * (j))
#define XB_TOP      3328
#define XB_TOPGEN   3392
#define XCD_BAR_WORDS 3456
#define XB_SPIN_CAP (1u << 18)

__device__ __forceinline__ unsigned xb_ld(unsigned* p)              { return __hip_atomic_load(p, __ATOMIC_RELAXED, __HIP_MEMORY_SCOPE_AGENT); }
__device__ __forceinline__ unsigned xb_add(unsigned* p, unsigned v) { return __hip_atomic_fetch_add(p, v, __ATOMIC_RELAXED, __HIP_MEMORY_SCOPE_AGENT); }
__device__ __forceinline__ unsigned xb_xcc_id() { return (unsigned)__builtin_amdgcn_s_getreg((3 << 11) | 20) & 0xFu; }
#define XB_SPIN(cond, bar) do { unsigned _sp = 0; while (cond) { __builtin_amdgcn_s_sleep(1); \
    if ((++_sp & 255u) == 0u) { if (xb_ld(&(bar)[XB_TMO])) break; if (_sp > XB_SPIN_CAP) { atomicAdd(&(bar)[XB_TMO], 1u); break; } } } } while (0)

struct XcdBarrier {
    unsigned* bar; unsigned x;
    volatile LAS unsigned* st;
};

__device__ __forceinline__ XcdBarrier xcd_barrier_post(unsigned* bar, volatile LAS unsigned* st) {
    XcdBarrier b; b.bar = bar; b.x = xb_xcc_id(); b.st = st;
    if (threadIdx.x == 0) (void)xb_add(&bar[XB_XCNT(b.x)], 1u);
    return b;
}
__device__ __forceinline__ void xcd_barrier_complete(unsigned* bar, unsigned x, unsigned& nloc, unsigned& nx) {
    const unsigned G = gridDim.x * gridDim.y * gridDim.z;
    unsigned sum, cnt, mine, sp = 0u;
    for (;;) {
        sum = 0u; cnt = 0u; mine = 0u;
        unsigned c16[16];
#pragma unroll
        for (unsigned j = 0; j < 16; ++j) c16[j] = xb_ld(&bar[XB_XCNT(j)]);
        __builtin_amdgcn_sched_barrier(0);
#pragma unroll
        for (unsigned j = 0; j < 16; ++j) { const unsigned c = c16[j]; sum += c; cnt += (c > 0u) ? 1u : 0u; mine = (j == x) ? c : mine; }
        if (sum == G) break;
        __builtin_amdgcn_s_sleep(1);
        if ((++sp & 255u) == 0u) { if (xb_ld(&bar[XB_TMO])) break; if (sp > XB_SPIN_CAP) { atomicAdd(&bar[XB_TMO], 1u); break; } }
    }
    nloc = mine > 0u ? mine : 1u; nx = cnt > 0u ? cnt : 1u;
}

__device__ __forceinline__ void xcd_barrier(const XcdBarrier& b) {
    asm volatile("s_waitcnt vmcnt(0)" ::: "memory");
    __syncthreads();
    if (threadIdx.x == 0) {
        unsigned* bar = b.bar; asm volatile("" : "+s"(bar));
        unsigned xq = __builtin_amdgcn_readfirstlane(b.x); asm volatile("" : "+s"(xq));
        __builtin_amdgcn_s_waitcnt(0);
        unsigned nloc = b.st[0], nx = b.st[1];
        if (nloc == 0u) { xcd_barrier_complete(bar, xq, nloc, nx); b.st[0] = nloc; b.st[1] = nx; }
        const unsigned old = xb_add(&bar[XB_XSUB(xq)], 1u);
        const unsigned gen = old / nloc;
        if (old + 1u == (gen + 1u) * nloc) {
            __builtin_amdgcn_fence(__ATOMIC_RELEASE, "agent");
            asm volatile("s_waitcnt vmcnt(0)" ::: "memory");
            const unsigned og = xb_add(&bar[XB_TOP], 1u);
            const unsigned tg = og / nx;
            if (og + 1u == (tg + 1u) * nx) xb_add(&bar[XB_TOPGEN], 1u);
            else XB_SPIN(xb_ld(&bar[XB_TOPGEN]) == tg, bar);
            __builtin_amdgcn_fence(__ATOMIC_ACQUIRE, "agent");
            xb_add(&bar[XB_XGEN(xq)], 1u);
            asm volatile("s_waitcnt vmcnt(0)" ::: "memory");
        } else {
            XB_SPIN(xb_ld(&bar[XB_XGEN(xq)]) == gen, bar);
            __builtin_amdgcn_fence(__ATOMIC_ACQUIRE, "agent");
            asm volatile("s_waitcnt vmcnt(0)" ::: "memory");
        }
    }
    __syncthreads();
}

struct Args { const float* in[28]; float* out; unsigned char* ws; int ph_lo, ph_hi; };
enum InIdx { I_X = 0, I_C, I_CTX, I_CCTX, I_ADAW, I_ADAB, I_N1G, I_N2G, I_W1, I_W3, I_W2, I_GWIN, I_GLNG, I_GLNB, I_GWS, I_GBS, I_GWOUT,
             I_SWIN, I_SARE, I_SAIM, I_SLDT, I_SBRE, I_SBIM, I_SCRE, I_SCIM, I_SD, I_SWGLU, I_FING };

__device__ __forceinline__ int opaque_tid() { int t = threadIdx.x; asm volatile("" : "+v"(t)); return t; }
#define PHASE_IDS const int tid = opaque_tid(), lane = tid & 63, wave = __builtin_amdgcn_readfirstlane(tid >> 6); (void)tid; (void)lane; (void)wave

__device__ __forceinline__ void adaln_items(const Args& a, LAS unsigned char* lds, int wg, int nwg) {
    PHASE_IDS;
    LAS float* cs = (LAS float*)lds;
    LAS float* red = cs + 3 * 2048;
    const float* c = a.in[I_C]; const float* cc = a.in[I_CCTX];
    for (int i = tid; i < 3 * 2048; i += NTHR) { const int s = i >> 11, k = i & 2047; const float v = s < 2 ? c[s * 2048 + k] : cc[k]; cs[i] = v / (1.0f + expf(-v)); }
    __syncthreads();
    float* MOD = (float*)(a.ws + WS_MOD);
    const int cq = tid & 15, kg = tid >> 4;
    for (int item = wg; item < DEPTH * 192; item += nwg) {
        const int layer = item / 192, n0 = (item % 192) * 64;
        const float* W = a.in[I_ADAW] + (size_t)layer * 2048 * 12288 + n0 + 4 * cq;
        f32x4 a0 = {0.f, 0.f, 0.f, 0.f}, a1 = a0, a2 = a0;
#define ADA_LD(dst, p) asm volatile("global_load_dwordx4 %0, %1, off" : "=v"(dst) : "v"(p) : "memory")
#define ADA_WAIT(n, r) asm volatile("s_waitcnt vmcnt(" #n ")" : "+v"(r[0]), "+v"(r[1]), "+v"(r[2]), "+v"(r[3]) :: "memory")
        const GAS f32x4* wp = (const GAS f32x4*)(W + (size_t)kg * 12288);
        constexpr size_t KST = (size_t)32 * 12288 / 4;
        f32x4 wa[4], wc[4];
        asm volatile("s_waitcnt vmcnt(0)" ::: "memory");
#pragma unroll
        for (int j = 0; j < 4; ++j) ADA_LD(wa[j], wp + j * KST);
        wp += 4 * KST;
#pragma unroll 1
        for (int b = 0; b < 16; b += 2) {
#pragma unroll
            for (int j = 0; j < 4; ++j) ADA_LD(wc[j], wp + j * KST);
            const GAS f32x4* wn = wp + (b + 2 < 16 ? 4 * KST : 0);
            ADA_WAIT(4, wa);
#pragma unroll
            for (int j = 0; j < 4; ++j) { const int k = kg + 32 * (4 * b + j); a0 += cs[k] * wa[j]; a1 += cs[2048 + k] * wa[j]; a2 += cs[4096 + k] * wa[j]; }
            asm volatile("" : "+v"(a0), "+v"(a1), "+v"(a2));
#pragma unroll
            for (int j = 0; j < 4; ++j) ADA_LD(wa[j], wn + j * KST);
            wp = wn + (b + 2 < 16 ? 4 * KST : 0);
            ADA_WAIT(4, wc);
#pragma unroll
            for (int j = 0; j < 4; ++j) { const int k = kg + 32 * (4 * (b + 1) + j); a0 += cs[k] * wc[j]; a1 += cs[2048 + k] * wc[j]; a2 += cs[4096 + k] * wc[j]; }
            asm volatile("" : "+v"(a0), "+v"(a1), "+v"(a2));
        }
        ADA_WAIT(0, wa);
#undef ADA_LD
#undef ADA_WAIT
#pragma unroll
        for (int e = 0; e < 4; ++e) { red[(kg * 3 + 0) * 64 + 4 * cq + e] = a0[e]; red[(kg * 3 + 1) * 64 + 4 * cq + e] = a1[e]; red[(kg * 3 + 2) * 64 + 4 * cq + e] = a2[e]; }
        __syncthreads();
        if (tid < 192) { const int s = tid >> 6, col = tid & 63; float t = 0.f;
            for (int g = 0; g < 32; ++g) t += red[(g * 3 + s) * 64 + col];
            MOD[(size_t)(layer * 3 + s) * 12288 + n0 + col] = t + a.in[I_ADAB][layer * 12288 + n0 + col]; }
        __syncthreads();
    }
}
__device__ __forceinline__ void tr_item(const float* W, int ld, int K, int ncols, bf16* WT, int mode, LAS float* scr, int item, int lane) {
    const int nblk = ncols / 32, kb = item / nblk, nb = item % nblk, k0 = 64 * kb, n0 = 32 * nb;
    const int drow0 = mode == 0 ? n0 : (256 * (n0 >> 7) + (n0 & 127) + (mode == 2 ? 128 : 0));
    float tv[32];
#pragma unroll
    for (int i = 0; i < 32; ++i) { const int kk = 2 * i + (lane >> 5); tv[i] = W[(size_t)(k0 + kk) * ld + n0 + (lane & 31)]; }
#pragma unroll
    for (int i = 0; i < 32; ++i) { const int kk = 2 * i + (lane >> 5); scr[kk * 33 + (lane & 31)] = tv[i]; }
    LDS_WAIT(); asm volatile("" ::: "memory");
    const int c = lane & 7;
#pragma unroll
    for (int j = 0; j < 4; ++j) { const int n = (lane >> 3) + 8 * j; const LAS float* s = scr + (8 * c) * 33 + n;
        v4u o; o.x = pk2(s[0 * 33], s[1 * 33]); o.y = pk2(s[2 * 33], s[3 * 33]); o.z = pk2(s[4 * 33], s[5 * 33]); o.w = pk2(s[6 * 33], s[7 * 33]);
        *(GAS v4u*)(WT + (size_t)(drow0 + n) * K + k0 + 8 * c) = o; }
    LDS_WAIT(); asm volatile("" ::: "memory");
}
constexpr int TR_GIN = 2 * 8192, TR_GOUT = 2 * 4096, TR_FFN = 4 * 3 * 5632, TR_SIN = 2 * 2048, TR_GLU = 2 * 2 * 2048, TR_TOTAL = TR_GIN + TR_GOUT + TR_FFN + TR_SIN + TR_GLU;
__device__ __forceinline__ void tr_dispatch(const Args& a, LAS float* scr, int it, int lane) {
    unsigned char* ws = a.ws;
    if (it < TR_GIN) { const int j = it / 8192, r = it % 8192; tr_item(a.in[I_GWIN] + (size_t)j * 2048 * 8192, 8192, 2048, 8192, (bf16*)(ws + WS_WGIN) + (size_t)j * 8192 * 2048, 0, scr, r, lane); return; } it -= TR_GIN;
    if (it < TR_GOUT) { const int j = it / 4096, r = it % 4096; tr_item(a.in[I_GWOUT] + (size_t)j * 4096 * 2048, 2048, 4096, 2048, (bf16*)(ws + WS_WGOUT) + (size_t)j * 2048 * 4096, 0, scr, r, lane); return; } it -= TR_GOUT;
    if (it < TR_FFN) { const int i = it / 16896, r = it % 16896, which = r / 5632, rr = r % 5632;
        if (which == 0) tr_item(a.in[I_W1] + (size_t)i * 2048 * 5632, 5632, 2048, 5632, (bf16*)(ws + WS_WF13) + (size_t)i * 11264 * 2048, 1, scr, rr, lane);
        else if (which == 1) tr_item(a.in[I_W3] + (size_t)i * 2048 * 5632, 5632, 2048, 5632, (bf16*)(ws + WS_WF13) + (size_t)i * 11264 * 2048, 2, scr, rr, lane);
        else tr_item(a.in[I_W2] + (size_t)i * 5632 * 2048, 2048, 5632, 2048, (bf16*)(ws + WS_WF2) + (size_t)i * 2048 * 5632, 0, scr, rr, lane);
        return; } it -= TR_FFN;
    if (it < TR_SIN) { const int j = it / 2048, r = it % 2048; tr_item(a.in[I_SWIN] + (size_t)j * 2048 * 2048, 2048, 2048, 2048, (bf16*)(ws + WS_WSIN) + (size_t)j * 2048 * 2048, 0, scr, r, lane); return; } it -= TR_SIN;
    { const int j = it / 4096, r = it % 4096, half = r / 2048, rr = r % 2048;
      tr_item(a.in[I_SWGLU] + (size_t)j * 2048 * 4096 + half * 2048, 4096, 2048, 2048, (bf16*)(ws + WS_WGLU) + (size_t)j * 4096 * 2048, 1 + half, scr, rr, lane); }
}
__device__ __forceinline__ int need_to_item(int q) {
    if (q < 8192) return q;               q -= 8192;
    if (q < 4096) return 16384 + q;       q -= 4096;
    if (q < 16896) return 24576 + q;      q -= 16896;
    if (q < 2048) return 92160 + q;       q -= 2048;
    if (q < 4096) return 96256 + q;       q -= 4096;
    if (q < 16896) return 41472 + q;      q -= 16896;
    if (q < 8192) return 8192 + q;        q -= 8192;
    if (q < 4096) return 20480 + q;       q -= 4096;
    if (q < 16896) return 58368 + q;      q -= 16896;
    if (q < 2048) return 94208 + q;       q -= 2048;
    if (q < 4096) return 100352 + q;      q -= 4096;
    return 75264 + q;
}
#ifndef CV_IPW
#define CV_IPW 6
#endif
constexpr int CV_CAP1 = 192 * 8 * CV_IPW, CV_CAP2 = 168 * 8 * CV_IPW, CV_CAP3 = 240 * 8 * CV_IPW, CV_CAP4 = 224 * 8 * CV_IPW;
constexpr int CV_D1 = 8192, CV_D2 = 23552, CV_D3 = 31232, CV_D4 = 35328, CV_D5 = 46592, CV_D6 = 60416, CV_D7 = 75776, CV_D8 = 83456;
constexpr int cv_max(int a, int b) { return a > b ? a : b; }
constexpr int CV_O2 = CV_CAP1, CV_O3 = CV_O2 + CV_CAP2, CV_O4 = CV_O3 + CV_CAP3, CV_O5 = CV_O4 + CV_CAP4, CV_O6 = CV_O5 + CV_CAP2, CV_O7 = CV_O6 + CV_CAP1, CV_O8 = CV_O7 + CV_CAP2, CV_O9 = CV_O8 + CV_CAP3;
constexpr int CV_P1 = cv_max(cv_max(cv_max(CV_D1, CV_D2 - CV_O2), cv_max(CV_D3 - CV_O3, CV_D4 - CV_O4)), cv_max(cv_max(CV_D5 - CV_O5, CV_D6 - CV_O6), cv_max(CV_D7 - CV_O7, CV_D8 - CV_O8)));
constexpr int CV_L1 = CV_P1, CV_L2 = CV_P1 + CV_O2, CV_L3 = CV_P1 + CV_O3, CV_L4 = CV_P1 + CV_O4, CV_L5 = CV_P1 + CV_O5, CV_L6 = CV_P1 + CV_O6, CV_L7 = CV_P1 + CV_O7, CV_L8 = CV_P1 + CV_O8;
constexpr int CV_T = (CV_P1 + CV_O9) < TR_TOTAL ? (CV_P1 + CV_O9) : TR_TOTAL;
static_assert(CV_L1 >= CV_D1 && CV_L2 >= CV_D2 && CV_L3 >= CV_D3 && CV_L4 >= CV_D4 && CV_L5 >= CV_D5 && CV_L6 >= CV_D6 && CV_L7 >= CV_D7 && CV_L8 >= CV_D8 && CV_L8 <= TR_TOTAL, "conversion slots");
__device__ __forceinline__ void transpose_items(const Args& a, LAS unsigned char* lds, int vcu, int G) {
    PHASE_IDS; const int gw = vcu * NWAVES + wave, ngw = G * NWAVES;
    LAS float* scr = (LAS float*)(lds + wave * 16384);
    for (int r = gw; r < CV_P1 + (TR_TOTAL - CV_T); r += ngw) tr_dispatch(a, scr, need_to_item(r < CV_P1 ? r : r - CV_P1 + CV_T), lane);
}
__device__ __forceinline__ void conv_slot(const Args& a, LAS unsigned char* lds, int c, int G, int units, int lo, int hi) {
    PHASE_IDS; const int R = units % G, nidle = R ? G - R : G, idx = R ? c - R : c;
    if (idx < 0) return;
    LAS float* scr = (LAS float*)(lds + wave * 16384);
    if (hi > TR_TOTAL) hi = TR_TOTAL;
    for (int q = lo + idx * NWAVES + wave; q < hi; q += nidle * NWAVES) tr_dispatch(a, scr, need_to_item(q), lane);
}
__device__ __forceinline__ void small_prologue(const Args& a, int vcu, int G) {
    PHASE_IDS; const int gtid = vcu * NTHR + tid, ngt = G * NTHR;
    bf16* WSB = (bf16*)(a.ws + WS_WSB);
    for (int i = gtid; i < 2 * 16 * 128 * 128; i += ngt) WSB[i] = (bf16)f2bf(a.in[I_GWS][i]);
#if S5_NAIVE
    f32x2* S5A = (f32x2*)(a.ws + WS_S5A); f32x2* S5B = (f32x2*)(a.ws + WS_S5B);
    for (int i = gtid; i < 2 * 2 * SG * SP; i += ngt) {
        const int lg = i / SP;
        const float dt = expf(a.in[I_SLDT][lg]), are = a.in[I_SARE][i], aim = a.in[I_SAIM][i];
        const float e = expf(dt * are), th = dt * aim, abr = e * cosf(th), abi = e * sinf(th);
        f32x2 ab; ab.x = abr; ab.y = abi; S5A[i] = ab;
        const float nr = abr - 1.0f, ni = abi, den = 1.0f / (are * are + aim * aim);
        const float cr = (nr * are + ni * aim) * den, ci = (ni * are - nr * aim) * den;
        for (int q = 0; q < SQ; ++q) { const float br = a.in[I_SBRE][(size_t)i * SQ + q], bi = a.in[I_SBIM][(size_t)i * SQ + q];
            f32x2 o; o.x = cr * br - ci * bi; o.y = cr * bi + ci * br; S5B[(size_t)i * SQ + q] = o; }
    }
#endif
}

typedef _Float16 h16x8 __attribute__((ext_vector_type(8)));
template <bool INIT> __device__ __forceinline__ void norm_phase(const Args& a, const float* gain, const float* modl  , int which, int vcu, int G, int nslab = 0, const float* sgate = nullptr, int mrows = M) {
    PHASE_IDS; const int gw = vcu * NWAVES + wave, ngw = G * NWAVES;
    _Float16* H = (_Float16*)(a.ws + WS_H); bf16* XN = (bf16*)(a.ws + WS_XN);
    f32x4 xc[8], xn[8]; h16x8 hc[4], hn[4];
#define NP_LOAD(row_, xd, hd) do { if (INIT) { const float* src_ = (row_) < ML ? a.in[I_X] + (size_t)(row_) * D : a.in[I_CTX] + (size_t)((row_) - ML) * D; const GAS f32x4* xr_ = (const GAS f32x4*)src_ + 2 * lane; \
        _Pragma("unroll") for (int j = 0; j < 4; ++j) { xd[2 * j] = xr_[128 * j]; xd[2 * j + 1] = xr_[128 * j + 1]; } } \
      else { const GAS h16x8* hr_ = (const GAS h16x8*)(H + (size_t)(row_) * D) + lane; _Pragma("unroll") for (int j = 0; j < 4; ++j) hd[j] = hr_[64 * j]; } } while (0)
    int cset = -1; float gg[4][8], shv[4][8];
    if (gw < mrows) NP_LOAD(gw, xc, hc);
    for (int row = gw; row < mrows; row += ngw) {
        const int set = row < ML ? (row >> 13) : 2;
        const int nrow = row + ngw;
        if (nrow < mrows) NP_LOAD(nrow, xn, hn);
        if (!INIT && set != cset) { cset = set;
            const GAS f32x4* gp = (const GAS f32x4*)gain + 2 * lane;
            const GAS f32x4* shp = (const GAS f32x4*)(modl + (size_t)set * 12288 + (which * 3 + 0) * D) + 2 * lane;
            const GAS f32x4* scp = (const GAS f32x4*)(modl + (size_t)set * 12288 + (which * 3 + 1) * D) + 2 * lane;
#pragma unroll
            for (int j = 0; j < 4; ++j)
#pragma unroll
                for (int hlf = 0; hlf < 2; ++hlf) { const f32x4 g = gp[128 * j + hlf], sh = shp[128 * j + hlf], sc = scp[128 * j + hlf];
#pragma unroll
                    for (int e = 0; e < 4; ++e) { gg[j][4 * hlf + e] = g[e] * (1.0f + sc[e]); shv[j][4 * hlf + e] = sh[e]; } } }
        GAS h16x8* hr = (GAS h16x8*)(H + (size_t)row * D) + lane;
        float v[4][8];
        if (INIT) {
#pragma unroll
            for (int j = 0; j < 4; ++j)
#pragma unroll
                for (int e = 0; e < 4; ++e) { v[j][e] = xc[2 * j][e]; v[j][4 + e] = xc[2 * j + 1][e]; }
            if (row < ML) {
                const int t = row & (SEQ - 1); const float pr = (float)(t >> 6), pc = (float)(t & 63);
#pragma unroll
                for (int e = 0; e < 8; ++e) { const float om = exp2f(-(float)(8 * lane + e) * (13.287712379549449f / 512.0f)); const float ar = pr * om, ac = pc * om;
                    v[0][e] += sinf(ar); v[1][e] += cosf(ar); v[2][e] += sinf(ac); v[3][e] += cosf(ac); }
            }
        } else {
#pragma unroll
            for (int j = 0; j < 4; ++j)
#pragma unroll
                for (int e = 0; e < 8; ++e) v[j][e] = (float)hc[j][e];
            if (nslab > 0 && row >= ML) {
                const GAS f32x4* sp = (const GAS f32x4*)((const float*)(a.ws + WS_SLAB) + (size_t)(row - ML) * D) + 2 * lane; const GAS f32x4* gp2 = (const GAS f32x4*)sgate + 2 * lane;
                f32x4 t[4][2];
#pragma unroll
                for (int j = 0; j < 4; ++j) { t[j][0] = sp[128 * j]; t[j][1] = sp[128 * j + 1]; }
                for (int s = 1; s < nslab; ++s) {
#pragma unroll
                    for (int jh = 0; jh < 4; jh += 2) { f32x4 u0[2][2];
#pragma unroll
                        for (int j = 0; j < 2; ++j) { u0[j][0] = sp[(size_t)s * (512 * D / 4) + 128 * (jh + j)]; u0[j][1] = sp[(size_t)s * (512 * D / 4) + 128 * (jh + j) + 1]; }
                        __builtin_amdgcn_sched_barrier(0);
#pragma unroll
                        for (int j = 0; j < 2; ++j) { t[jh + j][0] += u0[j][0]; t[jh + j][1] += u0[j][1]; }
                        __builtin_amdgcn_sched_barrier(0); } }
#pragma unroll
                for (int j = 0; j < 4; ++j) { const f32x4 g0 = gp2[128 * j], g1 = gp2[128 * j + 1];
#pragma unroll
                    for (int e = 0; e < 4; ++e) { v[j][e] += g0[e] * t[j][0][e]; v[j][4 + e] += g1[e] * t[j][1][e]; } }
            }
        }
        if (INIT || (nslab > 0 && row >= ML)) {
#pragma unroll
            for (int j = 0; j < 4; ++j) { h16x8 hv;
#pragma unroll
                for (int e = 0; e < 8; ++e) { hv[e] = (_Float16)v[j][e]; v[j][e] = (float)hv[e]; }
                hr[64 * j] = hv; }
        }
        float ss = 0.f;
#pragma unroll
        for (int j = 0; j < 4; ++j)
#pragma unroll
            for (int e = 0; e < 8; ++e) ss += v[j][e] * v[j][e];
        const float rinv = 1.0f / sqrtf(wave_sum(ss) * (1.0f / D) + EPS);
        GAS v4u* o16 = (GAS v4u*)(XN + (size_t)row * D) + lane;
#pragma unroll
        for (int j = 0; j < 4; ++j) { float y[8];
            if (INIT) {
                const GAS f32x4* gp = (const GAS f32x4*)gain + 2 * lane;
                const GAS f32x4* shp = (const GAS f32x4*)(modl + (size_t)set * 12288 + (which * 3 + 0) * D) + 2 * lane;
                const GAS f32x4* scp = (const GAS f32x4*)(modl + (size_t)set * 12288 + (which * 3 + 1) * D) + 2 * lane;
#pragma unroll
                for (int hlf = 0; hlf < 2; ++hlf) { const f32x4 g = gp[128 * j + hlf], sh = shp[128 * j + hlf], sc = scp[128 * j + hlf];
#pragma unroll
                    for (int e = 0; e < 4; ++e) y[4 * hlf + e] = v[j][4 * hlf + e] * rinv * g[e] * (1.0f + sc[e]) + sh[e]; }
            } else {
#pragma unroll
                for (int e = 0; e < 8; ++e) y[e] = v[j][e] * rinv * gg[j][e] + shv[j][e]; }
            v4u o; o.x = pk2(y[0], y[1]); o.y = pk2(y[2], y[3]); o.z = pk2(y[4], y[5]); o.w = pk2(y[6], y[7]); o16[64 * j] = o; }
#pragma unroll
        for (int j = 0; j < 8; ++j) xc[j] = xn[j];
#pragma unroll
        for (int j = 0; j < 4; ++j) hc[j] = hn[j];
    }
#undef NP_LOAD
}
__device__ __forceinline__ void final_phase(const Args& a, int vcu, int G) {
    PHASE_IDS; const int gw = vcu * NWAVES + wave, ngw = G * NWAVES;
    const _Float16* H = (const _Float16*)(a.ws + WS_H);
    float gv[4][8];
    { const GAS f32x4* gp = (const GAS f32x4*)a.in[I_FING] + 2 * lane;
#pragma unroll
      for (int j = 0; j < 4; ++j)
#pragma unroll
          for (int hlf = 0; hlf < 2; ++hlf) { const f32x4 g = gp[128 * j + hlf];
#pragma unroll
              for (int e = 0; e < 4; ++e) gv[j][4 * hlf + e] = g[e]; } }
    h16x8 hc[4], hn[4];
    if (gw < ML) { const GAS h16x8* hr = (const GAS h16x8*)(H + (size_t)gw * D) + lane;
#pragma unroll
        for (int j = 0; j < 4; ++j) hc[j] = hr[64 * j]; }
    for (int row = gw; row < ML; row += ngw) {
        if (row + ngw < ML) { const GAS h16x8* hr = (const GAS h16x8*)(H + (size_t)(row + ngw) * D) + lane;
#pragma unroll
            for (int j = 0; j < 4; ++j) hn[j] = hr[64 * j]; }
        float v[4][8]; float ss = 0.f;
#pragma unroll
        for (int j = 0; j < 4; ++j)
#pragma unroll
            for (int e = 0; e < 8; ++e) { v[j][e] = (float)hc[j][e]; ss += v[j][e] * v[j][e]; }
        const float rinv = 1.0f / sqrtf(wave_sum(ss) * (1.0f / D) + EPS);
        GAS f32x4* o = (GAS f32x4*)(a.out + (size_t)row * D) + 2 * lane;
#pragma unroll
        for (int j = 0; j < 4; ++j)
#pragma unroll
            for (int hlf = 0; hlf < 2; ++hlf) { f32x4 r;
#pragma unroll
                for (int e = 0; e < 4; ++e) r[e] = v[j][4 * hlf + e] * rinv * gv[j][4 * hlf + e];
                o[128 * j + hlf] = r; }
#pragma unroll
        for (int j = 0; j < 4; ++j) hc[j] = hn[j];
    }
}

__device__ __forceinline__ void vstat_phase(const Args& a, int vcu, int G) {
    PHASE_IDS; const int gw = vcu * NWAVES + wave, ngw = G * NWAVES;
    const f32x2* VS = (const f32x2*)(a.ws + WS_VSTAT); f32x2* RS = (f32x2*)(a.ws + WS_RSTAT);
    for (int row = gw; row < M; row += ngw) { const f32x2 p = VS[(size_t)row * 64 + lane];
        const float s = wave_sum(p.x), ss = wave_sum(p.y), mean = s * (1.0f / EA), var = ss * (1.0f / EA) - mean * mean;
        if (lane == 0) { f32x2 o; o.x = mean; o.y = 1.0f / sqrtf(var + EPS); RS[row] = o; } }
}

__device__ __forceinline__ void sgu_phase(const Args& a, int gl  , LAS unsigned char* lds, int wg, int nwg, int dry) {
    PHASE_IDS;
    bf16* ZU = (bf16*)(a.ws + WS_ZU); const bf16* ZV = (const bf16*)(a.ws + WS_ZV);
    const bf16* WSB = (const bf16*)(a.ws + WS_WSB) + (size_t)gl * 16 * 128 * 128;
    const float* bs = a.in[I_GBS] + gl * 16 * 128; const float* lng = a.in[I_GLNG] + gl * EA; const float* lnb = a.in[I_GLNB] + gl * EA;
    constexpr int VP = 528;
    constexpr int SP4 = 36;
    constexpr int WP = 272;
    LAS unsigned char* vl = lds;
    LAS f32x2* st = (LAS f32x2*)(lds + 128 * VP);
    LAS unsigned char* wl = lds + 73728;
    LAS float* sstrip = (LAS float*)(lds + wave * (64 * SP4 * 4));
    LAS float* bl = (LAS float*)(lds + 73728 + 128 * WP);
    const int n = lane & 31, h = lane >> 5, c4 = lane & 3, rb = lane >> 2;
    v4u vraw[8], ucur[8]; f32x2 srow;
#define SGU_LDX4(dst, voff, sb) asm volatile("s_nop 4\n\tglobal_load_dwordx4 %0, %1, %2" : "=v"(dst) : "v"(voff), "s"(sb) : "memory")
#define SGU_LDX2(dst, voff, sb) asm volatile("s_nop 4\n\tglobal_load_dwordx2 %0, %1, %2" : "=v"(dst) : "v"(voff), "s"(sb) : "memory")
#define SGU_WAITV(n) asm volatile("s_waitcnt vmcnt(" #n ")" : "+v"(vraw[0]), "+v"(vraw[1]), "+v"(vraw[2]), "+v"(vraw[3]), "+v"(vraw[4]), "+v"(vraw[5]), "+v"(vraw[6]), "+v"(vraw[7]), "+v"(srow) :: "memory")
#define SGU_WAITU(n) asm volatile("s_waitcnt vmcnt(" #n ")" : "+v"(ucur[0]), "+v"(ucur[1]), "+v"(ucur[2]), "+v"(ucur[3]), "+v"(ucur[4]), "+v"(ucur[5]), "+v"(ucur[6]), "+v"(ucur[7]) :: "memory")
    const unsigned voffv = (unsigned)(((tid >> 5) * EA + 8 * (tid & 31)) * 2), voffu = (unsigned)((rb * EA + 32 * wave + 8 * c4) * 2), voffs = (unsigned)((tid & 127) * 8);
#define SGU_PREFETCH(unit_) do { const int c_ = (unit_) / NH, hd_ = (unit_) % NH, r0_ = c_ * CHUNK; const unsigned char* vb_ = (const unsigned char*)(ZV + (size_t)r0_ * EA + hd_ * HDIM); \
        _Pragma("unroll") for (int t = 0; t < 8; ++t) SGU_LDX4(vraw[t], voffv, vb_ + (size_t)t * (16 * EA * 2)); \
        SGU_LDX2(srow, voffs, a.ws + WS_RSTAT + (size_t)r0_ * 8); } while (0)
#define SGU_UPREFETCH(unit_) do { const int c_ = (unit_) / NH, hd_ = (unit_) % NH, r0_ = c_ * CHUNK; const unsigned char* ub_ = (const unsigned char*)(ZU + (size_t)r0_ * EA + hd_ * HDIM); \
        _Pragma("unroll") for (int p = 0; p < 8; ++p) SGU_LDX4(ucur[p], voffu, ub_ + (size_t)p * (16 * EA * 2)); } while (0)
    int cur_hd = -1;
    LAS float* gnl = bl + 128;
    asm volatile("s_waitcnt vmcnt(0)" ::: "memory");
    { const int u0 = wg < NCHUNK * NH ? wg : NCHUNK * NH - 1; SGU_PREFETCH(u0); SGU_UPREFETCH(u0); }
    SGU_WAITV(8);
    for (int unit = wg; unit < NCHUNK * NH; unit += nwg) {
        const int c = unit / NH, hd = unit % NH, r0 = c * CHUNK;
        SGU_WAITV(8);
        if (hd != cur_hd) { cur_hd = hd; v4u wimg[4]; float bv_, lgv_, lbv_;
            const GAS v4u* ip_ = (const GAS v4u*)(WSB + ((size_t)hd * 128 + (tid >> 4)) * 128 + 8 * (tid & 15));
            const GAS float* bp_ = (const GAS float*)(bs + hd * 128 + (tid & 127)); const GAS float* gp_ = (const GAS float*)(lng + hd * HDIM + 32 * wave + n); const GAS float* lp_ = (const GAS float*)(lnb + hd * HDIM + 32 * wave + n);
            asm volatile("global_load_dwordx4 %0, %7, off\n\tglobal_load_dwordx4 %1, %8, off\n\tglobal_load_dwordx4 %2, %9, off\n\tglobal_load_dwordx4 %3, %10, off\n\t"
                         "global_load_dword %4, %11, off\n\tglobal_load_dword %5, %12, off\n\tglobal_load_dword %6, %13, off\n\ts_waitcnt vmcnt(0)"
                         : "=&v"(wimg[0]), "=&v"(wimg[1]), "=&v"(wimg[2]), "=&v"(wimg[3]), "=&v"(bv_), "=&v"(lgv_), "=&v"(lbv_)
                         : "v"(ip_), "v"(ip_ + 512), "v"(ip_ + 1024), "v"(ip_ + 1536), "v"(bp_), "v"(gp_), "v"(lp_) : "memory");
#pragma unroll
            for (int t = 0; t < 4; ++t) { const int q = tid + 512 * t, i2 = q >> 4, kc = q & 15; *(LAS v4u*)(wl + i2 * WP + 16 * kc) = wimg[t]; }
            if (tid < 128) bl[tid] = bv_;
            gnl[32 * wave + n] = lgv_; gnl[256 + 32 * wave + n] = lbv_; }
        if (tid < 128) st[tid] = srow;
#pragma unroll
        for (int t = 0; t < 8; ++t) { const int q = tid + 512 * t, j = q >> 5, dc = q & 31; *(LAS v4u*)(vl + j * VP + 16 * dc) = vraw[t]; }
        __syncthreads();
        const int nunit = unit + nwg < NCHUNK * NH ? unit + nwg : unit;
        SGU_PREFETCH(nunit);
        const float lg = gnl[32 * wave + n], lb = gnl[256 + 32 * wave + n];
        bf16x8 Bf[8];
#pragma unroll
        for (int ks = 0; ks < 8; ++ks) { float f[8];
#pragma unroll
            for (int e = 0; e < 8; ++e) { const int j = 16 * ks + 8 * h + e; const f32x2 m = st[j]; f[e] = (bf2f(*(const LAS unsigned short*)(vl + j * VP + 2 * (32 * wave + n))) - m.x) * m.y * lg + lb; }
            v4u w; w.x = pk2(f[0], f[1]); w.y = pk2(f[2], f[3]); w.z = pk2(f[4], f[5]); w.w = pk2(f[6], f[7]); Bf[ks] = __builtin_bit_cast(bf16x8, w); }
        __syncthreads();
        GAS v4u* up = (GAS v4u*)(ZU + (size_t)(r0 + rb) * EA + hd * HDIM + 32 * wave + 8 * c4);
        SGU_WAITU(9);
#pragma unroll
        for (int hf = 0; hf < 2; ++hf) {
#pragma unroll
            for (int ib2 = 0; ib2 < 2; ++ib2) { const int ib = 2 * hf + ib2;
                f32x16 acc;
#pragma unroll
                for (int r = 0; r < 16; ++r) acc[r] = 0.f;
                const LAS unsigned char* ap = wl + (32 * ib + n) * WP + 16 * h;
#pragma unroll
                for (int ks = 0; ks < 8; ++ks) { const bf16x8 Af = *(const LAS bf16x8*)(ap + 32 * ks); acc = __builtin_amdgcn_mfma_f32_32x32x16_bf16(Af, Bf[ks], acc, 0, 0, 0); }
#pragma unroll
                for (int r = 0; r < 16; ++r) { const int il = 32 * ib2 + (r & 3) + 8 * (r >> 2) + 4 * h; sstrip[il * SP4 + n] = acc[r] + bl[64 * hf + il]; }
            }
            LDS_WAIT(); asm volatile("" ::: "memory");
#pragma unroll
            for (int p2 = 0; p2 < 4; ++p2) { const int il = 16 * p2 + rb, p = 4 * hf + p2;
                const f32x4 s0 = *(const LAS f32x4*)(sstrip + il * SP4 + 8 * c4), s1 = *(const LAS f32x4*)(sstrip + il * SP4 + 8 * c4 + 4);
                const v4u u = ucur[p]; v4u o;
                o.x = pk2(__builtin_bit_cast(float, u.x << 16) * s0[0], __builtin_bit_cast(float, u.x & 0xffff0000u) * s0[1]);
                o.y = pk2(__builtin_bit_cast(float, u.y << 16) * s0[2], __builtin_bit_cast(float, u.y & 0xffff0000u) * s0[3]);
                o.z = pk2(__builtin_bit_cast(float, u.z << 16) * s1[0], __builtin_bit_cast(float, u.z & 0xffff0000u) * s1[1]);
                o.w = pk2(__builtin_bit_cast(float, u.w << 16) * s1[2], __builtin_bit_cast(float, u.w & 0xffff0000u) * s1[3]);
                if (!dry) up[(size_t)p * (16 * EA / 8)] = o; }
            LDS_WAIT(); asm volatile("" ::: "memory");
        }
        SGU_UPREFETCH(nunit);
        __syncthreads();
    }
    SGU_WAITV(0); SGU_WAITU(0);
#undef SGU_PREFETCH
#undef SGU_UPREFETCH
#undef SGU_LDX4
#undef SGU_LDX2
#undef SGU_WAITV
#undef SGU_WAITU
}

__device__ __forceinline__ void s5_naive_phase(const Args& a, int sl  , int wg, int nwg) {
    PHASE_IDS;
    if (wave >= 2) return;
    const bf16* U = (const bf16*)(a.ws + WS_SU);
    for (int item = wg * 2 + wave; item < 2 * 2 * SG; item += nwg * 2) {
        const int b = item & 1, k = (item >> 1) & 1, g = item >> 2;
        const int pg = ((sl * 2 + k) * SG + g);
        const f32x2 ab = ((const f32x2*)(a.ws + WS_S5A))[(size_t)pg * SP + lane];
        float bre[16], bim[16], cr[16], ci[16];
#pragma unroll
        for (int q = 0; q < 16; ++q) { const f32x2 bb = ((const f32x2*)(a.ws + WS_S5B))[((size_t)pg * SP + lane) * SQ + q]; bre[q] = bb.x; bim[q] = bb.y;
            cr[q] = a.in[I_SCRE][((size_t)pg * SQ + q) * SP + lane]; ci[q] = a.in[I_SCIM][((size_t)pg * SQ + q) * SP + lane]; }
        float* Y = (float*)(a.ws + (k ? WS_YB : WS_YF));
        float hr = 0.f, hi = 0.f;
#pragma unroll 1
        for (int seg = 0; seg < 2; ++seg) {
            const int L = seg ? SEQ : CTXL, base = seg ? b * SEQ : ML + b * CTXL;
#pragma unroll 1
            for (int blk = 0; blk < L; blk += 64) {
                const int myt = k ? (L - 1 - (blk + lane)) : (blk + lane);
                const size_t row = (size_t)(base + myt);
                const GAS v4u* up = (const GAS v4u*)(U + row * D + 16 * g);
                const v4u u0 = up[0], u1 = up[1];
                float keep[16];
#pragma unroll
                for (int q = 0; q < 16; ++q) keep[q] = 0.f;
#pragma unroll 1
                for (int s = 0; s < 64; ++s) {
                    unsigned w[8];
                    w[0] = __builtin_amdgcn_readlane(u0.x, s); w[1] = __builtin_amdgcn_readlane(u0.y, s); w[2] = __builtin_amdgcn_readlane(u0.z, s); w[3] = __builtin_amdgcn_readlane(u0.w, s);
                    w[4] = __builtin_amdgcn_readlane(u1.x, s); w[5] = __builtin_amdgcn_readlane(u1.y, s); w[6] = __builtin_amdgcn_readlane(u1.z, s); w[7] = __builtin_amdgcn_readlane(u1.w, s);
                    float br = 0.f, bi = 0.f;
#pragma unroll
                    for (int q2 = 0; q2 < 8; ++q2) { const float ulo = __builtin_bit_cast(float, w[q2] << 16), uhi = __builtin_bit_cast(float, w[q2] & 0xffff0000u);
                        br += bre[2 * q2] * ulo + bre[2 * q2 + 1] * uhi; bi += bim[2 * q2] * ulo + bim[2 * q2 + 1] * uhi; }
                    const float nhr = ab.x * hr - ab.y * hi + br, nhi = ab.x * hi + ab.y * hr + bi; hr = nhr; hi = nhi;
#pragma unroll
                    for (int q = 0; q < 16; ++q) { const float y = wave_sum(cr[q] * hr - ci[q] * hi); keep[q] = (lane == s) ? y : keep[q]; }
                }
                GAS f32x4* yp = (GAS f32x4*)(Y + row * D + 16 * g);
#pragma unroll
                for (int q4 = 0; q4 < 4; ++q4) { f32x4 o; o.x = keep[4 * q4]; o.y = keep[4 * q4 + 1]; o.z = keep[4 * q4 + 2]; o.w = keep[4 * q4 + 3]; yp[q4] = o; }
            }
        }
    }
}
__device__ __forceinline__ void s5_combine_phase(const Args& a, int sl, int vcu, int G) {
    PHASE_IDS; const int gw = vcu * NWAVES + wave, ngw = G * NWAVES;
    const float* YF = (const float*)(a.ws + WS_YF); const float* YB = (const float*)(a.ws + WS_YB); const bf16* U = (const bf16*)(a.ws + WS_SU); bf16* Z = (bf16*)(a.ws + WS_SZ);
    const GAS f32x4* dp = (const GAS f32x4*)(a.in[I_SD] + sl * D) + lane;
    for (int row = gw; row < M; row += ngw) {
        const GAS f32x4* yf = (const GAS f32x4*)(YF + (size_t)row * D) + lane; const GAS f32x4* yb = (const GAS f32x4*)(YB + (size_t)row * D) + lane;
        const GAS v2u* up = (const GAS v2u*)(U + (size_t)row * D) + lane; GAS v2u* zp = (GAS v2u*)(Z + (size_t)row * D) + lane;
#pragma unroll
        for (int j = 0; j < 8; ++j) { const f32x4 f = yf[64 * j], bk = yb[64 * j], dd = dp[64 * j]; const v2u uu = up[64 * j];
            f32x4 u4; u4.x = __builtin_bit_cast(float, uu.x << 16); u4.y = __builtin_bit_cast(float, uu.x & 0xffff0000u); u4.z = __builtin_bit_cast(float, uu.y << 16); u4.w = __builtin_bit_cast(float, uu.y & 0xffff0000u);
            const f32x4 y = f + bk + u4 * dd;
            v2u o; o.x = pk2(pg8::gelu_tanh_f(y.x), pg8::gelu_tanh_f(y.y)); o.y = pk2(pg8::gelu_tanh_f(y.z), pg8::gelu_tanh_f(y.w)); zp[64 * j] = o; }
    }
}

__device__ __forceinline__ f32x2 cmul(f32x2 a, f32x2 b) { f32x2 r; r.x = a.x * b.x - a.y * b.y; r.y = a.x * b.y + a.y * b.x; return r; }
#ifndef PROBE_S5P
#define PROBE_S5P 0
#endif
#define S5P_MARK(k) do { if (PROBE_S5P) { __syncthreads(); const unsigned long long tn_ = __builtin_amdgcn_s_memrealtime(); if (PROBE_S5P == (k)) *pticks += tn_ - tprev; tprev = tn_; } } while (0)
__device__ __forceinline__ void s5_precompute(const Args& a, LAS unsigned char* lds, int wg, int nwg, unsigned long long* pticks = nullptr) {
    PHASE_IDS; unsigned long long tprev = PROBE_S5P ? __builtin_amdgcn_s_memrealtime() : 0ull; (void)tprev;
    LAS f32x2* apw = (LAS f32x2*)lds;
    LAS f32x2* bbl = apw + 2 * 17 * 64;
    constexpr int CP = 65;
    LAS f32x2* ccl = bbl + 2 * 64 * 16;
    constexpr int KP = 260;
    LAS float* ktab = (LAS float*)(ccl + 2 * 16 * CP);
    LAS float* sdl = ktab + 2 * 16 * KP;
    for (int item = wg; item < 2 * SG; item += nwg) {
        const int sl = item >> 7, g = item & 127;
        for (int e = tid; e < 2 * 17 * 64; e += NTHR) { const int d = e / (17 * 64), l = (e / 64) % 17, p = e & 63, pg = (sl * 2 + d) * SG + g, i = pg * SP + p;
            const float dt = expf(a.in[I_SLDT][pg]), are = a.in[I_SARE][i], aim = a.in[I_SAIM][i];
            const float ex = expf((float)l * (dt * are)), th = (float)l * (dt * aim); f32x2 o; o.x = ex * cosf(th); o.y = ex * sinf(th); apw[e] = o;
            if (l == 16) ((f32x2*)(a.ws + WS_A16))[i] = o; }
        if (tid < 16) sdl[tid] = a.in[I_SD][sl * D + 16 * g + tid];
        for (int e = tid; e < 2 * 16 * 64; e += NTHR) { const int d = e >> 10, q = (e >> 6) & 15, p = e & 63; const size_t ci = ((size_t)((sl * 2 + d) * SG + g) * SQ + q) * SP + p;
            f32x2 o; o.x = a.in[I_SCRE][ci]; o.y = a.in[I_SCIM][ci]; ccl[(d * 16 + q) * CP + p] = o; }
        __syncthreads();
        for (int e = tid; e < 2 * 64 * 16; e += NTHR) { const int d = e >> 10, p = (e >> 4) & 63, q = e & 15, i = ((sl * 2 + d) * SG + g) * SP + p;
            const float are = a.in[I_SARE][i], aim = a.in[I_SAIM][i]; const f32x2 ab = apw[(d * 17 + 1) * 64 + p];
            const float nr = ab.x - 1.0f, ni = ab.y, den = 1.0f / (are * are + aim * aim);
            f32x2 coef; coef.x = (nr * are + ni * aim) * den; coef.y = (ni * are - nr * aim) * den;
            f32x2 bq; bq.x = a.in[I_SBRE][(size_t)i * SQ + q]; bq.y = a.in[I_SBIM][(size_t)i * SQ + q]; bbl[e] = cmul(coef, bq); }
        __syncthreads();
        S5P_MARK(1);
        for (int o4 = tid; o4 < 2048; o4 += NTHR) {
            const int d = o4 >> 10, l = (o4 >> 6) & 15, q = (o4 >> 2) & 15, qp0 = 4 * (o4 & 3); f32x4 acc = {0.f, 0.f, 0.f, 0.f};
#pragma unroll 4
            for (int p = 0; p < 64; ++p) { const f32x2 ca = cmul(ccl[(d * 16 + q) * CP + p], apw[(d * 17 + l) * 64 + p]);
                const LAS f32x4* bp = (const LAS f32x4*)(bbl + (d * 64 + p) * 16 + qp0); const f32x4 b01 = bp[0], b23 = bp[1];
                acc[0] += ca.x * b01[0] - ca.y * b01[1]; acc[1] += ca.x * b01[2] - ca.y * b01[3]; acc[2] += ca.x * b23[0] - ca.y * b23[1]; acc[3] += ca.x * b23[2] - ca.y * b23[3]; }
            *(LAS f32x4*)(ktab + ((d * 16 + l) * KP + q * 16 + qp0)) = acc; }
        __syncthreads();
        S5P_MARK(2);
        bf16* MoutT = (bf16*)(a.ws + WS_MOUTT) + (size_t)(sl * SG + g) * 256 * 512;
        bf16* M2T = (bf16*)(a.ws + WS_M2T) + (size_t)(sl * SG + g) * 256 * 256;
        for (int ch = tid; ch < 256 * 32; ch += NTHR) { const int n = ch >> 5, jj = ch & 31, t = n >> 4, q = n & 15, s = jj >> 1, q0 = 8 * (jj & 1);
            const LAS float* kp = ktab + ((s <= t ? (t - s) : (16 + s - t)) * KP + q * 16 + q0);
            f32x4 v0 = *(const LAS f32x4*)kp, v1 = *(const LAS f32x4*)(kp + 4);
            if (s == t) { const LAS float* kb = ktab + (16 * KP + q * 16 + q0); v0 += *(const LAS f32x4*)kb; v1 += *(const LAS f32x4*)(kb + 4);
                const float dsk = sdl[q];
#pragma unroll
                for (int e = 0; e < 4; ++e) { v0[e] += (q == q0 + e) ? dsk : 0.f; v1[e] += (q == q0 + 4 + e) ? dsk : 0.f; } }
            v4u w; w.x = pk2(v0[0], v0[1]); w.y = pk2(v0[2], v0[3]); w.z = pk2(v1[0], v1[1]); w.w = pk2(v1[2], v1[3]);
            *(GAS v4u*)(MoutT + (size_t)n * 512 + 8 * jj) = w; }
        for (int ch = tid; ch < 256 * 32; ch += NTHR) { const int n = ch >> 5, j2 = ch & 31, t = n >> 4, q = n & 15, d = j2 >> 4, p0 = (j2 & 15) * 4, ex = d == 0 ? t + 1 : 16 - t; float v[8];
#pragma unroll
            for (int pp = 0; pp < 4; ++pp) { const f32x2 ca = cmul(ccl[(d * 16 + q) * CP + p0 + pp], apw[(d * 17 + ex) * 64 + p0 + pp]); v[2 * pp] = ca.x; v[2 * pp + 1] = -ca.y; }
            v4u w; w.x = pk2(v[0], v[1]); w.y = pk2(v[2], v[3]); w.z = pk2(v[4], v[5]); w.w = pk2(v[6], v[7]);
            *(GAS v4u*)(MoutT + (size_t)n * 512 + 8 * (32 + j2)) = w; }
        S5P_MARK(3);
        for (int ch = tid; ch < 256 * 32; ch += NTHR) { const int n = ch >> 5, jj = ch & 31, d = n >> 7, p = (n & 127) >> 1, im = n & 1, s = jj >> 1, q0 = 8 * (jj & 1), ex = d == 0 ? 15 - s : s; float v[8];
            const f32x2 ap = apw[(d * 17 + ex) * 64 + p];
#pragma unroll
            for (int e = 0; e < 8; ++e) { const f32x2 r = cmul(ap, bbl[(d * 64 + p) * 16 + q0 + e]); v[e] = im ? r.y : r.x; }
            v4u w; w.x = pk2(v[0], v[1]); w.y = pk2(v[2], v[3]); w.z = pk2(v[4], v[5]); w.w = pk2(v[6], v[7]);
            *(GAS v4u*)(M2T + (size_t)n * 256 + 8 * jj) = w; }
        S5P_MARK(4);
        __syncthreads();
    }
}
template <bool OUT> __device__ __forceinline__ void s5_ctx_gemm(const Args& a, int sl, int wg, int nwg) {
    PHASE_IDS;
    constexpr int K = OUT ? 512 : 256;
    const int r = lane & 31, hh = lane >> 5;
    for (int g = wg; g < SG; g += nwg) {
        const GAS bf16x8* ap = (const GAS bf16x8*)((const bf16*)(a.ws + WS_XC) + (size_t)(g * 32 + r) * 512 + 8 * hh);
        const bf16* Bt = OUT ? (const bf16*)(a.ws + WS_MOUTT) + (size_t)(sl * SG + g) * 256 * 512 : (const bf16*)(a.ws + WS_M2T) + (size_t)(sl * SG + g) * 256 * 256;
        const GAS bf16x8* bp = (const GAS bf16x8*)(Bt + (size_t)(32 * wave + r) * K + 8 * hh);
        f32x16 acc;
#pragma unroll
        for (int i = 0; i < 16; ++i) acc[i] = 0.f;
        constexpr int NCH = K / 16 / 8;
        bf16x8 av[2][8], bv[2][8];
#pragma unroll
        for (int j = 0; j < 8; ++j) { av[0][j] = ap[2 * j]; bv[0][j] = bp[2 * j]; }
#pragma unroll
        for (int c = 0; c < NCH; ++c) {
            if (c + 1 < NCH) {
#pragma unroll
                for (int j = 0; j < 8; ++j) { av[(c + 1) & 1][j] = ap[2 * (8 * (c + 1) + j)]; bv[(c + 1) & 1][j] = bp[2 * (8 * (c + 1) + j)]; } }
            __builtin_amdgcn_sched_barrier(0);
#pragma unroll
            for (int j = 0; j < 8; ++j) acc = __builtin_amdgcn_mfma_f32_32x32x16_bf16(av[c & 1][j], bv[c & 1][j], acc, 0, 0, 0);
            __builtin_amdgcn_sched_barrier(0);
        }
        const int n = 32 * wave + r;
#pragma unroll
        for (int i = 0; i < 16; ++i) { const int c = (i & 3) + 8 * (i >> 2) + 4 * hh;
            if (OUT) { const int t = n >> 4, q = n & 15; ((GAS bf16*)(a.ws + WS_Z))[(size_t)(ML + 16 * c + t) * D + 16 * g + q] = (bf16)f2bf(pg8::gelu_tanh_f(acc[i])); }
            else ((GAS bf16*)(a.ws + WS_SC))[(size_t)(g * 32 + c) * 256 + n] = (bf16)f2bf(acc[i]); }
    }
}
__device__ __forceinline__ void s5_carry_phase(const Args& a, int sl, LAS unsigned char* lds, int wg, int nwg) {
    PHASE_IDS;
    LAS f32x2* EX = (LAS f32x2*)lds;
    const int seg = wave;
    for (int item = wg; item < 2 * 2 * SG; item += nwg) {
        const int b = item & 1, d = (item >> 1) & 1, g = item >> 2;
        const f32x2 a16 = ((const f32x2*)(a.ws + WS_A16))[(size_t)((sl * 2 + d) * SG + g) * SP + lane];
        const int c0 = d ? 511 - seg * 64 : seg * 64;
        const long sst = d ? -128 : 128, xst = d ? -256 : 256;
        const GAS unsigned* sp = (const GAS unsigned*)(a.ws + WS_SL) + (size_t)(g * 1024 + b * 512 + c0) * 128 + d * 64 + lane;
        GAS unsigned* xp = (GAS unsigned*)(a.ws + WS_XL) + (size_t)(g * 1024 + b * 512 + c0) * 256 + 128 + d * 64 + lane;
        unsigned sw[64];
#pragma unroll
        for (int j = 0; j < 64; ++j) { sw[j] = *sp; sp += sst; asm volatile("" : "+v"(sp)); }
        float hr = 0.f, hi = 0.f;
#define S5_STEP(word) do { const float sr = __builtin_bit_cast(float, (word) << 16), si = __builtin_bit_cast(float, (word) & 0xffff0000u); \
            const float nr = a16.x * hr - a16.y * hi + sr, ni = a16.x * hi + a16.y * hr + si; hr = nr; hi = ni; } while (0)
        if (seg == 0) {
            const int cc0 = d ? 15 : 0;
            const GAS unsigned* cp = (const GAS unsigned*)(a.ws + WS_SC) + (size_t)(g * 32 + b * 16 + cc0) * 128 + d * 64 + lane;
            GAS unsigned* xcp = (GAS unsigned*)(a.ws + WS_XC) + (size_t)(g * 32 + b * 16 + cc0) * 256 + 128 + d * 64 + lane;
            unsigned cw[16];
#pragma unroll
            for (int j = 0; j < 16; ++j) { cw[j] = *cp; cp += sst; asm volatile("" : "+v"(cp)); }
#pragma unroll
            for (int j = 0; j < 16; ++j) { *xcp = pk2(hr, hi); xcp += xst; asm volatile("" : "+v"(xcp)); S5_STEP(cw[j]); }
#pragma unroll
            for (int j = 0; j < 64; ++j) { *xp = pk2(hr, hi); xp += xst; asm volatile("" : "+v"(xp)); S5_STEP(sw[j]); }
        } else {
#pragma unroll
            for (int j = 0; j < 64; ++j) S5_STEP(sw[j]);
        }
        { f32x2 o; o.x = hr; o.y = hi; EX[seg * 64 + lane] = o; }
        __syncthreads();
        if (seg != 0) {
            f32x2 P = a16;
#pragma unroll
            for (int q = 0; q < 6; ++q) P = cmul(P, P);
            f32x2 F = EX[lane];
            for (int k = 1; k < seg; ++k) { const f32x2 E = EX[k * 64 + lane]; const f32x2 pf = cmul(P, F); F.x = pf.x + E.x; F.y = pf.y + E.y; }
            hr = F.x; hi = F.y;
#pragma unroll
            for (int j = 0; j < 64; ++j) { *xp = pk2(hr, hi); xp += xst; asm volatile("" : "+v"(xp)); S5_STEP(sw[j]); }
        }
#undef S5_STEP
        __syncthreads();
    }
}
__device__ __forceinline__ void probe_flush(const Args& a, int vcu, int G) {
    PHASE_IDS; const int gt = vcu * NTHR + tid, ngt = G * NTHR;
    const GAS f32x4* p1 = (const GAS f32x4*)a.in[I_W1]; const GAS f32x4* p3 = (const GAS f32x4*)a.in[I_W3];
    f32x4 s = {0.f, 0.f, 0.f, 0.f};
    const int n4 = 4 * 2048 * 5632 / 4;
#pragma unroll 8
    for (int i = gt; i < n4; i += ngt) { s += p1[i]; s += p3[i]; }
    if (s.x + s.y + s.z + s.w == 1.2345e30f) ((float*)(a.ws + WS_CTL))[1000 + (tid & 7)] = s.x;
    __syncthreads();
}

#ifndef GEMM_ALIGN
#define GEMM_ALIGN true
#endif
#ifndef GEMM_SP2
#define GEMM_SP2 true
#endif
#ifndef MK_ONE_LAUNCH
#define MK_ONE_LAUNCH 1
#endif
constexpr int N_PHASES = 2 + 2 * 17;

__global__ void __launch_bounds__(NTHR, 2) fwd_kernel(Args args) {
    extern __shared__ __attribute__((aligned(16))) unsigned char lds_raw[];
    LAS unsigned char* lds = (LAS unsigned char*)lds_raw;
    const int tid = threadIdx.x;
    const int G = gridDim.x, bx = blockIdx.x;
    const int vcu = (G % 8 == 0) ? (bx % 8) * (G / 8) + bx / 8 : bx;
    unsigned char* ws = args.ws;
    volatile LAS unsigned* MISC = (volatile LAS unsigned*)(lds + MISC_OFF);
    for (int u = tid; u < (LDS_BYTES - LDSCTL_OFF) / 4; u += NTHR) ((LAS unsigned*)(lds + LDSCTL_OFF))[u] = 0u;
    __syncthreads();
    const int lo = args.ph_lo, hi = args.ph_hi; (void)lo; (void)hi;
#ifdef PROBE_WALL0
    const unsigned long long probe_t00 = __builtin_amdgcn_s_memrealtime();
#endif
    XcdBarrier bar; bar.bar = (unsigned*)(ws + WS_CTL) + CW_BAR; bar.x = 0; bar.st = nullptr;
    if (MK_ONE_LAUNCH || hi - lo > 1) bar = xcd_barrier_post((unsigned*)(ws + WS_CTL) + CW_BAR, MISC + 8);
#if MK_ONE_LAUNCH
#define RUN(k) true
#else
#define RUN(k) (lo <= (k) && (k) < hi)
#endif
#ifndef PROBE_MASK
#define PROBE_MASK 0
#endif
#define REP(kind) for (int rep = 0, nrep = 1 + ((PROBE_MASK >> (kind)) & 1); rep < nrep; ++rep)
#ifndef PROBE_WET
#define PROBE_WET 0
#endif
#define GATE(p) ((PROBE_WET && rep) ? (const float*)(ws + WS_CTL + 512 * 1024) : (p))
#define DRY (PROBE_WET ? 0 : rep)
#ifndef PROBE_FLUSH
#define PROBE_FLUSH 0
#endif
#define REPSYNC() do { if (rep + 1 < nrep) { __syncthreads(); if (PROBE_FLUSH == 1) probe_flush(args, vcu, G); } else if (PROBE_FLUSH == 2) { __syncthreads(); probe_flush(args, vcu, G); } } while (0)
#ifndef PROBE_BARTIME
#define PROBE_BARTIME 0
#endif
#ifndef PROBE_KIND
#define PROBE_KIND 0
#endif
#ifndef PROBE_PRO
#define PROBE_PRO 0
#endif
    unsigned long long probe_ticks = 0, probe_prev = (PROBE_KIND || PROBE_BARTIME || PROBE_PRO || PROBE_S5P) ? __builtin_amdgcn_s_memrealtime() : 0ull;
#define PRO_MARK(k) do { if (PROBE_PRO) { __syncthreads(); const unsigned long long tn_ = __builtin_amdgcn_s_memrealtime(); if (PROBE_PRO == (k)) probe_ticks += tn_ - probe_prev; probe_prev = tn_; } } while (0)
#define PHASE_KIND(k) ((k) == 0 ? 0 : (k) == 1 ? 1 : (((k) - 2) % 17) == 0 ? 2 : (((k) - 2) % 17) == 1 ? 12 : (((k) - 2) % 17) == 2 ? 3 : (((k) - 2) % 17) == 3 ? 4 : (((k) - 2) % 17) == 4 ? 1 : (((k) - 2) % 17) == 5 ? 5 : (((k) - 2) % 17) == 6 ? 6 : \
        (((k) - 2) % 17) == 7 ? 1 : (((k) - 2) % 17) == 8 ? 7 : (((k) - 2) % 17) == 9 ? 8 : (((k) - 2) % 17) == 10 ? 9 : (((k) - 2) % 17) == 11 ? 10 : (((k) - 2) % 17) == 12 ? 11 : (((k) - 2) % 17) == 13 ? 1 : (((k) - 2) % 17) == 14 ? 5 : (((k) - 2) % 17) == 15 ? 6 : 1)
#define SEAM(k) do { if (PROBE_KIND) { const unsigned long long tn_ = __builtin_amdgcn_s_memrealtime(); if (PHASE_KIND(k) == PROBE_KIND - 1) probe_ticks += tn_ - probe_prev; } \
        if (RUN(k) && RUN((k) + 1)) { const unsigned long long tb_ = PROBE_BARTIME ? __builtin_amdgcn_s_memrealtime() : 0ull; xcd_barrier(bar); if ((PROBE_MASK >> 12) & 1) xcd_barrier(bar); \
        if (PROBE_BARTIME) probe_ticks += __builtin_amdgcn_s_memrealtime() - tb_; } \
        if (PROBE_KIND) probe_prev = __builtin_amdgcn_s_memrealtime(); } while (0)
    _Float16* H = (_Float16*)(ws + WS_H); pg8::bf16_t* XN = (pg8::bf16_t*)(ws + WS_XN);
    const float* MOD = (const float*)(ws + WS_MOD);

#ifndef NO_PRO
    if (RUN(0)) REP(0) {
#ifndef PRO_ALT
#define PRO_ALT 1
#endif
#pragma unroll 1
        for (int step = 0; step < 2; ++step) {
            if ((step == 0) != (PRO_ALT && (vcu & 1) != 0)) {
                adaln_items(args, lds, vcu, G); PRO_MARK(1);
                transpose_items(args, lds, vcu, G); PRO_MARK(2);
                small_prologue(args, vcu, G);
            } else {
#if !S5_NAIVE
                s5_precompute(args, lds, vcu, G, &probe_ticks); PRO_MARK(4);
#endif
            }
            __syncthreads();
        }
        REPSYNC();
    }
#endif
    SEAM(0);
#ifdef PROBE_WALL0
    probe_ticks = __builtin_amdgcn_s_memrealtime() - probe_t00;
#endif
    if (RUN(1)) REP(1) norm_phase<true>(args, args.in[I_N1G], MOD, 0, vcu, G);
    SEAM(1);

#ifdef UNROLL_LP
#pragma unroll
#else
#pragma unroll 1
#endif
    for (int lp = 0; lp < 2; ++lp) {
        const int pb = 2 + lp * 17;
        {
            const int layer = 2 * lp; const float* modl = MOD + (size_t)layer * 3 * 12288;
            if (RUN(pb + 0)) { REP(2) {
                pg8::Gemm g{XN, (const pg8::bf16_t*)(ws + WS_WGIN) + (size_t)lp * 8192 * 2048, M, 8192, D}; pg8::StaticOrder S; S.init(M, 8192, G, bx);
                pg8::EpiG1 E{(pg8::bf16_t*)(ws + WS_ZU), (pg8::bf16_t*)(ws + WS_ZV), (float*)(ws + WS_VSTAT), 0};
                pg8::gemm_phase<pg8::EpiG1, pg8::StaticOrder, GEMM_ALIGN, GEMM_SP2>(lds + RING_OFF, g, S, E);
                if (rep == 0) conv_slot(args, lds, bx, G, (M / 256) * 32, lp == 0 ? CV_L1 : CV_L6, lp == 0 ? CV_L2 : CV_L7);
                REPSYNC(); }
            }
            SEAM(pb + 0);
            if (RUN(pb + 1)) vstat_phase(args, vcu, G);
            SEAM(pb + 1);
            #ifndef NO_SGU
            if (RUN(pb + 2)) REP(3) sgu_phase(args, lp, lds, bx, G, rep);
#endif
            SEAM(pb + 2);
            if (RUN(pb + 3)) { REP(4) {
                pg8::Gemm g{(const pg8::bf16_t*)(ws + WS_ZU), (const pg8::bf16_t*)(ws + WS_WGOUT) + (size_t)lp * 2048 * 4096, ML, D, EA}; pg8::StaticOrder S; S.init(ML, D, G, bx);
                pg8::EpiResid E{H, GATE(modl + 2 * D), DRY};
                pg8::gemm_phase<pg8::EpiResid, pg8::StaticOrder, GEMM_ALIGN, GEMM_SP2>(lds + RING_OFF, g, S, E);
                __syncthreads();
                pg8::Gemm gc{(const pg8::bf16_t*)(ws + WS_ZU), (const pg8::bf16_t*)(ws + WS_WGOUT) + (size_t)lp * 2048 * 4096, M, D, 512, EA, EA}; pg8::SliceOrder SS; SS.init(G, bx, 8, 512);
                pg8::EpiSlab ES{(float*)(ws + WS_SLAB), 1024};
                pg8::gemm_phase<pg8::EpiSlab, pg8::SliceOrder, GEMM_ALIGN, GEMM_SP2>(lds + RING_OFF, gc, SS, ES);
                REPSYNC(); }
            }
            SEAM(pb + 3);
            if (RUN(pb + 4)) REP(1) norm_phase<false>(args, args.in[I_N2G] + layer * D, modl, 1, vcu, G, rep ? 0 : 8, modl + 2 * 12288 + 2 * D);
            SEAM(pb + 4);
            if (RUN(pb + 5)) { REP(5) {
                pg8::Gemm g{XN, (const pg8::bf16_t*)(ws + WS_WF13) + (size_t)layer * 11264 * 2048, M, 2 * FF, D}; pg8::StaticOrder S; S.init(M, 2 * FF, G, bx);
                pg8::EpiSwiGLU E{(pg8::bf16_t*)(ws + WS_HID)};
                pg8::gemm_phase<pg8::EpiSwiGLU, pg8::StaticOrder, GEMM_ALIGN, GEMM_SP2>(lds + RING_OFF, g, S, E);
                if (rep == 0) conv_slot(args, lds, bx, G, (M / 256) * 44, lp == 0 ? CV_L2 : CV_L7, lp == 0 ? CV_L3 : CV_L8);
                REPSYNC(); }
            }
            SEAM(pb + 5);
            if (RUN(pb + 6)) { REP(6) {
                pg8::Gemm g{(const pg8::bf16_t*)(ws + WS_HID), (const pg8::bf16_t*)(ws + WS_WF2) + (size_t)layer * 2048 * 5632, ML, D, FF}; pg8::StaticOrder S; S.init(ML, D, G, bx);
                pg8::EpiResid E{H, GATE(modl + 5 * D), DRY};
                pg8::gemm_phase<pg8::EpiResid, pg8::StaticOrder, GEMM_ALIGN, GEMM_SP2>(lds + RING_OFF, g, S, E);
                if (true) { __syncthreads();
                pg8::Gemm gc{(const pg8::bf16_t*)(ws + WS_HID), (const pg8::bf16_t*)(ws + WS_WF2) + (size_t)layer * 2048 * 5632, M, D, 512, FF, FF}; pg8::SliceOrder SS; SS.init(G, bx, 11, 512);
                pg8::EpiSlab ES{(float*)(ws + WS_SLAB), 1024};
                pg8::gemm_phase<pg8::EpiSlab, pg8::SliceOrder, GEMM_ALIGN, GEMM_SP2>(lds + RING_OFF, gc, SS, ES); }
                REPSYNC(); }
            }
            SEAM(pb + 6);
            if (RUN(pb + 7)) REP(1) norm_phase<false>(args, args.in[I_N1G] + (layer + 1) * D, modl + 3 * 12288, 0, vcu, G, rep ? 0 : 11, modl + 2 * 12288 + 5 * D);
            SEAM(pb + 7);
        }
        {
            const int layer = 2 * lp + 1; const float* modl = MOD + (size_t)layer * 3 * 12288; const int ps = pb + 8;
            const int Mrows = lp == 0 ? M : ML;
#if S5_NAIVE
            if (RUN(ps + 0)) {
                pg8::Gemm g{XN, (const pg8::bf16_t*)(ws + WS_WSIN) + (size_t)lp * 2048 * 2048, M, D, D}; pg8::StaticOrder S; S.init(M, D, G, bx);
                pg8::EpiPlainBf16 E{(pg8::bf16_t*)(ws + WS_SU), D};
                pg8::gemm_phase<pg8::EpiPlainBf16, pg8::StaticOrder, GEMM_ALIGN, GEMM_SP2>(lds + RING_OFF, g, S, E);
            }
            SEAM(ps + 0);
            if (RUN(ps + 1)) s5_naive_phase(args, lp, bx, G);
            SEAM(ps + 1);
            if (RUN(ps + 2)) s5_combine_phase(args, lp, vcu, G);
            SEAM(ps + 2);
            SEAM(ps + 3);
#else
            if (RUN(ps + 0)) { REP(7) {
                pg8::Gemm g{XN, (const pg8::bf16_t*)(ws + WS_WSIN) + (size_t)lp * 2048 * 2048, M, D, D}; pg8::StaticOrder S; S.init(M, D, G, bx);
                pg8::EpiS5In E{(pg8::bf16_t*)(ws + WS_XL), (pg8::bf16_t*)(ws + WS_XC)};
                pg8::gemm_phase<pg8::EpiS5In, pg8::StaticOrder, GEMM_ALIGN, GEMM_SP2>(lds + RING_OFF, g, S, E);
                if (rep == 0) conv_slot(args, lds, bx, G, (M / 256) * 8, lp == 0 ? CV_L3 : CV_L8, lp == 0 ? CV_L4 : CV_T);
                REPSYNC(); }
            }
            SEAM(ps + 0);
            if (RUN(ps + 1)) { REP(8) {
                pg8::Gemm g{(const pg8::bf16_t*)(ws + WS_XL), (const pg8::bf16_t*)(ws + WS_M2T) + (size_t)lp * SG * 256 * 256, SG * 1024, 256, 256, 512}; pg8::GroupOrder S; S.init(G, vcu);
                pg8::EpiS5State E{(pg8::bf16_t*)(ws + WS_SL)};
                pg8::gemm_phase<pg8::EpiS5State, pg8::GroupOrder, GEMM_ALIGN, GEMM_SP2>(lds + RING_OFF, g, S, E);
                s5_ctx_gemm<false>(args, lp, vcu, G);
                REPSYNC(); }
            }
            SEAM(ps + 1);
            if (RUN(ps + 2)) REP(9) s5_carry_phase(args, lp, lds, bx, G);
            SEAM(ps + 2);
            if (RUN(ps + 3)) { REP(10) {
                pg8::Gemm g{(const pg8::bf16_t*)(ws + WS_XL), (const pg8::bf16_t*)(ws + WS_MOUTT) + (size_t)lp * SG * 256 * 512, SG * 1024, 256, 512, 512}; pg8::GroupOrder S; S.init(G, vcu);
                pg8::EpiS5Out E{(pg8::bf16_t*)(ws + WS_Z)};
                pg8::gemm_phase<pg8::EpiS5Out, pg8::GroupOrder, GEMM_ALIGN, GEMM_SP2>(lds + RING_OFF, g, S, E);
                s5_ctx_gemm<true>(args, lp, vcu, G);
                REPSYNC(); }
            }
            SEAM(ps + 3);
#endif
            if (RUN(ps + 4)) { REP(11) {
                pg8::Gemm g{(const pg8::bf16_t*)(ws + WS_Z), (const pg8::bf16_t*)(ws + WS_WGLU) + (size_t)lp * 4096 * 2048, Mrows, 2 * D, D}; pg8::StaticOrder S; S.init(Mrows, 2 * D, G, bx);
                pg8::EpiGluResid E{H, GATE(modl + 2 * D), DRY};
                pg8::gemm_phase<pg8::EpiGluResid, pg8::StaticOrder, GEMM_ALIGN, GEMM_SP2>(lds + RING_OFF, g, S, E);
                if (rep == 0 && lp == 0) conv_slot(args, lds, bx, G, (M / 256) * 16, CV_L4, CV_L5);
                REPSYNC(); }
            }
            SEAM(ps + 4);
            if (RUN(ps + 5)) REP(1) norm_phase<false>(args, args.in[I_N2G] + layer * D, modl, 1, vcu, G, 0, nullptr, Mrows);
            SEAM(ps + 5);
            if (RUN(ps + 6)) { REP(5) {
                pg8::Gemm g{XN, (const pg8::bf16_t*)(ws + WS_WF13) + (size_t)layer * 11264 * 2048, Mrows, 2 * FF, D}; pg8::StaticOrder S; S.init(Mrows, 2 * FF, G, bx);
                pg8::EpiSwiGLU E{(pg8::bf16_t*)(ws + WS_HID)};
                pg8::gemm_phase<pg8::EpiSwiGLU, pg8::StaticOrder, GEMM_ALIGN, GEMM_SP2>(lds + RING_OFF, g, S, E);
                if (rep == 0 && lp == 0) conv_slot(args, lds, bx, G, (M / 256) * 44, CV_L5, CV_L6);
                REPSYNC(); }
            }
            SEAM(ps + 6);
            if (RUN(ps + 7)) { REP(6) {
                pg8::Gemm g{(const pg8::bf16_t*)(ws + WS_HID), (const pg8::bf16_t*)(ws + WS_WF2) + (size_t)layer * 2048 * 5632, ML, D, FF}; pg8::StaticOrder S; S.init(ML, D, G, bx);
                pg8::EpiResid E{H, GATE(modl + 5 * D), DRY};
                pg8::gemm_phase<pg8::EpiResid, pg8::StaticOrder, GEMM_ALIGN, GEMM_SP2>(lds + RING_OFF, g, S, E);
                if (lp == 0) { __syncthreads();
                pg8::Gemm gc{(const pg8::bf16_t*)(ws + WS_HID), (const pg8::bf16_t*)(ws + WS_WF2) + (size_t)layer * 2048 * 5632, M, D, 512, FF, FF}; pg8::SliceOrder SS; SS.init(G, bx, 11, 512);
                pg8::EpiSlab ES{(float*)(ws + WS_SLAB), 1024};
                pg8::gemm_phase<pg8::EpiSlab, pg8::SliceOrder, GEMM_ALIGN, GEMM_SP2>(lds + RING_OFF, gc, SS, ES); }
                REPSYNC(); }
            }
            SEAM(ps + 7);
            if (RUN(ps + 8)) {
                REP(1) if (lp == 0) norm_phase<false>(args, args.in[I_N1G] + (layer + 1) * D, modl + 3 * 12288, 0, vcu, G, rep ? 0 : 11, modl + 2 * 12288 + 5 * D);
                else final_phase(args, vcu, G);
            }
            SEAM(ps + 8);
        }
    }
#ifdef PROBE_WALL0
    if (blockIdx.x == 0 && threadIdx.x == 0) { const unsigned long long t0 = __builtin_amdgcn_s_memrealtime(); while (__builtin_amdgcn_s_memrealtime() - t0 < 10ull * probe_ticks) __builtin_amdgcn_s_sleep(8); }
#endif
    if (((PROBE_KIND || PROBE_PRO || PROBE_S5P) ? blockIdx.x == 0 : (PROBE_BARTIME && (int)blockIdx.x == PROBE_BARTIME - 1)) && threadIdx.x == 0) { const unsigned long long t0 = __builtin_amdgcn_s_memrealtime(); while (__builtin_amdgcn_s_memrealtime() - t0 < 10ull * probe_ticks) __builtin_amdgcn_s_sleep(8); }
#undef RUN
#undef SEAM
}

extern "C" void kernel_launch(void* const* d_in, const int* in_sizes, int n_in, void* d_out, int out_size, void* d_ws, size_t ws_size, hipStream_t stream) {
    static int grid = 0;
    if (grid == 0) {
        if (n_in != 28 || in_sizes[0] != ML * D || out_size != ML * D || ws_size < WS_END) {
            fprintf(stderr, "kernel_launch: unexpected problem (n_in %d, in0 %d, out %d, ws %zu, need ws >= %zu); nothing launched\n", n_in, n_in > 0 ? in_sizes[0] : -1, out_size, ws_size, (size_t)WS_END); grid = -1; return; }
        int dev = 0, cus = 0, per_cu = 0;
        if (hipGetDevice(&dev) != hipSuccess || hipDeviceGetAttribute(&cus, hipDeviceAttributeMultiprocessorCount, dev) != hipSuccess) { fprintf(stderr, "kernel_launch: device query failed\n"); grid = -1; return; }
        if (hipFuncSetAttribute((const void*)fwd_kernel, hipFuncAttributeMaxDynamicSharedMemorySize, LDS_BYTES) != hipSuccess) { fprintf(stderr, "kernel_launch: hipFuncSetAttribute failed\n"); grid = -1; return; }
        if (hipOccupancyMaxActiveBlocksPerMultiprocessor(&per_cu, (const void*)fwd_kernel, NTHR, LDS_BYTES) != hipSuccess || per_cu < 1) {
            fprintf(stderr, "kernel_launch: occupancy query reports %d workgroups per CU\n", per_cu); }
        (void)hipGetLastError();
        grid = cus;
    }
    if (grid < 0) return;
    if (hipMemsetAsync((char*)d_ws + WS_CTL, 0, (PROBE_MASK || PROBE_WET) ? CTL_ZERO_BYTES : 64 * 1024, stream) != hipSuccess) { fprintf(stderr, "kernel_launch: memset failed\n"); return; }
    Args a{};
    for (int i = 0; i < 28; ++i) a.in[i] = (const float*)d_in[i];
    a.out = (float*)d_out; a.ws = (unsigned char*)d_ws;
#if MK_ONE_LAUNCH
    a.ph_lo = 0; a.ph_hi = N_PHASES;
    hipLaunchKernelGGL(fwd_kernel, dim3(grid), dim3(NTHR), LDS_BYTES, stream, a);
#else
    for (int p = 0; p < N_PHASES; ++p) { a.ph_lo = p; a.ph_hi = p + 1; hipLaunchKernelGGL(fwd_kernel, dim3(grid), dim3(NTHR), LDS_BYTES, stream, a); }
#endif
    const hipError_t le = hipPeekAtLastError();
    if (le != hipSuccess) fprintf(stderr, "kernel_launch: launch failed: %s\n", hipGetErrorName(le));
}
```
